# Optimizing an MI355X kernel written in HIP

```python
import math
import jax
import jax.numpy as jnp
from jax import lax
import numpy as np

D_MODEL = 1024
BATCH = 2
SEQ = 8192
DEPTH = 4

CHUNK = 64
SSM_WIDTH = D_MODEL // 2
SSM_GROUP = 16
SSM_GROUPS = SSM_WIDTH // SSM_GROUP
SSM_STATE = 64
ATTN_WIDTH = D_MODEL // 2
N_HEADS = 8
HEAD_DIM = ATTN_WIDTH // N_HEADS
Q_BLOCK = 128
EPS = 1e-6
DT_MIN = 0.001
DT_MAX = 0.1
IN_SIZES = (SSM_WIDTH, SSM_WIDTH, ATTN_WIDTH, ATTN_WIDTH, ATTN_WIDTH, ATTN_WIDTH, D_MODEL, D_MODEL)
IN_COLS = sum(IN_SIZES)
IN_SPLITS = tuple(int(s) for s in np.cumsum(IN_SIZES)[:-1])

kernel_name = "hybrid_s5_stickbreaking_gated_block"


def rms_norm(x, g):
    xf = x.astype(jnp.float32)
    y = xf * lax.rsqrt(jnp.mean(xf * xf, axis=-1, keepdims=True) + EPS)
    return (y * g.astype(jnp.float32)).astype(x.dtype)


def s5_branch(u, a_re, a_im, log_dt, b_re, b_im, c_re, c_im, d_skip, w_glu, b_glu):
    bsz, seqlen, _ = u.shape
    f32 = jnp.float32
    ug = u.reshape(bsz, seqlen, SSM_GROUPS, SSM_GROUP).astype(f32)
    a_re = a_re.astype(f32)
    a_im = a_im.astype(f32)
    dt = jnp.exp(log_dt.astype(f32))[:, None]
    mag = jnp.exp(a_re * dt)
    abar_re = mag * jnp.cos(a_im * dt)
    abar_im = mag * jnp.sin(a_im * dt)
    nr = abar_re - 1.0
    ni = abar_im
    den = a_re * a_re + a_im * a_im
    f_re = (nr * a_re + ni * a_im) / den
    f_im = (ni * a_re - nr * a_im) / den
    b_re = b_re.astype(f32)
    b_im = b_im.astype(f32)
    bb_re = f_re[..., None] * b_re - f_im[..., None] * b_im
    bb_im = f_re[..., None] * b_im + f_im[..., None] * b_re
    bu_re = jnp.einsum('blgh,gph->blgp', ug, bb_re)
    bu_im = jnp.einsum('blgh,gph->blgp', ug, bb_im)
    ar_t = jnp.broadcast_to(abar_re, bu_re.shape)
    ai_t = jnp.broadcast_to(abar_im, bu_re.shape)

    def combine(e1, e2):
        a1r, a1i, b1r, b1i = e1
        a2r, a2i, b2r, b2i = e2
        return (a1r * a2r - a1i * a2i,
                a1r * a2i + a1i * a2r,
                a2r * b1r - a2i * b1i + b2r,
                a2r * b1i + a2i * b1r + b2i)

    _, _, xr, xi = lax.associative_scan(combine, (ar_t, ai_t, bu_re, bu_im), axis=1)
    y = (jnp.einsum('blgp,ghp->blgh', xr, c_re.astype(f32))
         - jnp.einsum('blgp,ghp->blgh', xi, c_im.astype(f32)))
    y = y + d_skip.astype(f32).reshape(SSM_GROUPS, SSM_GROUP) * ug
    y = jax.nn.gelu(y.reshape(bsz, seqlen, SSM_WIDTH)).astype(u.dtype)
    gl = y @ w_glu + b_glu
    ga, gb = jnp.split(gl, 2, axis=-1)
    return ga * jax.nn.sigmoid(gb)


def stick_breaking_attention(q, k, v):
    seqlen = q.shape[1]
    scale = HEAD_DIM ** -0.5
    outs = []
    for i in range(seqlen // Q_BLOCK):
        q0 = i * Q_BLOCK
        kend = q0 + Q_BLOCK
        qb = q[:, q0:kend]
        kb = k[:, :kend]
        vb = v[:, :kend]
        z = jnp.einsum('bqhd,bkhd->bhqk', qb, kb).astype(jnp.float32) * scale
        qpos = q0 + jnp.arange(Q_BLOCK)[:, None]
        kpos = jnp.arange(kend)[None, :]
        mask = kpos < qpos
        log_beta = jax.nn.log_sigmoid(z)
        log_1m = jnp.where(mask, log_beta - z, 0.0)
        after = lax.cumsum(log_1m, axis=3, reverse=True) - log_1m
        w = jnp.where(mask, jnp.exp(log_beta + after), 0.0)
        outs.append(jnp.einsum('bhqk,bkhd->bqhd', w.astype(v.dtype), vb))
    return jnp.concatenate(outs, axis=1)


def setup_inputs(seed: int = 0) -> dict:
    key = jax.random.key(seed)
    ks = jax.random.split(key, 20)
    f32 = jnp.float32
    nrm = lambda k, shape, s: jax.random.normal(k, shape, f32) * s
    x = jax.random.normal(ks[0], (BATCH, SEQ, D_MODEL), f32)
    pre_norm_g = 1.0 + nrm(ks[1], (DEPTH, D_MODEL), 0.02)
    post_norm_g = 1.0 + nrm(ks[2], (DEPTH, D_MODEL), 0.02)
    w_in = nrm(ks[3], (DEPTH, D_MODEL, IN_COLS), D_MODEL ** -0.5)
    ssm_a_re = -0.5 + nrm(ks[4], (DEPTH, SSM_GROUPS, SSM_STATE), 0.01)
    ssm_a_im = (math.pi * jnp.arange(SSM_STATE, dtype=f32))[None, None, :] + nrm(ks[5], (DEPTH, SSM_GROUPS, SSM_STATE), 0.01)
    ssm_log_dt = jax.random.uniform(ks[6], (DEPTH, SSM_GROUPS), f32, math.log(DT_MIN), math.log(DT_MAX))
    ssm_b_re = nrm(ks[7], (DEPTH, SSM_GROUPS, SSM_STATE, SSM_GROUP), (2 * SSM_GROUP) ** -0.5)
    ssm_b_im = nrm(ks[8], (DEPTH, SSM_GROUPS, SSM_STATE, SSM_GROUP), (2 * SSM_GROUP) ** -0.5)
    ssm_c_re = nrm(ks[9], (DEPTH, SSM_GROUPS, SSM_GROUP, SSM_STATE), (2 * SSM_STATE) ** -0.5)
    ssm_c_im = nrm(ks[10], (DEPTH, SSM_GROUPS, SSM_GROUP, SSM_STATE), (2 * SSM_STATE) ** -0.5)
    ssm_d = nrm(ks[11], (DEPTH, SSM_WIDTH), 1.0)
    w_glu = nrm(ks[12], (DEPTH, SSM_WIDTH, 2 * SSM_WIDTH), SSM_WIDTH ** -0.5)
    b_glu = nrm(ks[13], (DEPTH, 2 * SSM_WIDTH), 0.01)
    w_branch_ssm = nrm(ks[14], (DEPTH, SSM_WIDTH, D_MODEL), SSM_WIDTH ** -0.5)
    w_branch_attn = nrm(ks[15], (DEPTH, ATTN_WIDTH, D_MODEL), ATTN_WIDTH ** -0.5)
    w_out = nrm(ks[16], (DEPTH, D_MODEL, D_MODEL), D_MODEL ** -0.5)
    return {"x": x, "pre_norm_g": pre_norm_g, "post_norm_g": post_norm_g, "w_in": w_in,
            "ssm_a_re": ssm_a_re, "ssm_a_im": ssm_a_im, "ssm_log_dt": ssm_log_dt,
            "ssm_b_re": ssm_b_re, "ssm_b_im": ssm_b_im, "ssm_c_re": ssm_c_re, "ssm_c_im": ssm_c_im,
            "ssm_d": ssm_d, "w_glu": w_glu, "b_glu": b_glu,
            "w_branch_ssm": w_branch_ssm, "w_branch_attn": w_branch_attn, "w_out": w_out}


def reference(x, pre_norm_g, post_norm_g, w_in, ssm_a_re, ssm_a_im, ssm_log_dt,
              ssm_b_re, ssm_b_im, ssm_c_re, ssm_c_im, ssm_d, w_glu, b_glu,
              w_branch_ssm, w_branch_attn, w_out):
    bsz, seqlen, _ = x.shape
    for l in range(DEPTH):
        h = rms_norm(x, pre_norm_g[l])
        proj = h @ w_in[l]
        u, z_ssm, q, k, v, z_attn, g_ssm, g_attn = jnp.split(proj, IN_SPLITS, axis=-1)
        y_s = s5_branch(u, ssm_a_re[l], ssm_a_im[l], ssm_log_dt[l], ssm_b_re[l], ssm_b_im[l],
                        ssm_c_re[l], ssm_c_im[l], ssm_d[l], w_glu[l], b_glu[l])
        y_s = y_s * jax.nn.silu(z_ssm)
        hs = (bsz, seqlen, N_HEADS, HEAD_DIM)
        y_a = stick_breaking_attention(q.reshape(hs), k.reshape(hs), v.reshape(hs))
        y_a = y_a.reshape(bsz, seqlen, ATTN_WIDTH) * jax.nn.silu(z_attn)
        merged = (jax.nn.sigmoid(g_ssm) * (y_s @ w_branch_ssm[l])
                  + jax.nn.sigmoid(g_attn) * (y_a @ w_branch_attn[l]))
        out = merged @ w_out[l]
        x = x + rms_norm(out, post_norm_g[l])
    return x
```

```cpp
#include <hip/hip_runtime.h>
#include <hip/hip_cooperative_groups.h>
#include <cstdio>
#include <cstdint>
namespace cg = cooperative_groups;
namespace pg8 {
#define PG8_LAS __attribute__((address_space(3)))
typedef unsigned short bf16_t;
typedef short bf16x8 __attribute__((ext_vector_type(8)));
typedef float f32x4 __attribute__((ext_vector_type(4)));
typedef unsigned u32x4 __attribute__((ext_vector_type(4)));
constexpr int BM = 256, BK = 64, HALF = 128, HTB = HALF * BK * 2  , STAGE_BYTES = 8 * HTB, NXCD = 8, WGM = 8;

__host__ __device__ __forceinline__ int lds_byte(int r, int c) { const int st = (r >> 4) * 2 + (c >> 5), rr = r & 15, cc = c & 31, ob = rr * 64 + cc * 2; return st * 1024 + (ob ^ (((ob >> 9) & 1) << 5)); }
__host__ __device__ __forceinline__ void stage_rc(int b, int& R, int& C) { const int st = b / 1024, sb = b % 1024, swz = sb ^ (((sb >> 9) & 1) << 5); R = (st >> 1) * 16 + swz / 64; C = (st & 1) * 32 + (swz % 64) / 2; }
__host__ __device__ __forceinline__ int perm32(int rho) { const int n = rho >> 4, i = rho & 15; return 8 * (i >> 2) + 4 * n + (i & 3); }

struct Unit { int pm, pn; };
struct Gemm { const bf16_t* A; const bf16_t* Bt; int M, N, K; };

struct StaticOrder {
    int nM, nN, nwg, G, c;
    __host__ __device__ void init(int M, int N, int G_, int c_) { nM = M / BM; nN = N / BM; nwg = nM * nN; G = G_; c = c_; }
    __host__ __device__ bool next(int i, Unit& u) const {
        const long L = (long)i * G + c; if (L >= nwg) return false;
        int wgid = (int)L; { const int q = nwg / NXCD, r = nwg % NXCD, xcd = wgid % NXCD, off = wgid / NXCD; wgid = (xcd < r ? xcd * (q + 1) : r * (q + 1) + (xcd - r) * q) + off; }
        const int nig = WGM * nN, gid = wgid / nig, fm = gid * WGM, gsz = (nM - fm) < WGM ? (nM - fm) : WGM;
        u.pm = fm + ((wgid % nig) % gsz); u.pn = (wgid % nig) / gsz; return true;
    }
    __device__ __forceinline__ void a_ready(const Unit&) const {}
    __device__ __forceinline__ void done(const Unit&) const {}
};
__device__ __forceinline__ unsigned cvt_pk_bf16(float lo, float hi) { unsigned r; asm volatile("v_cvt_pk_bf16_f32 %0, %1, %2" : "=v"(r) : "v"(lo), "v"(hi)); return r; }
typedef float f32x2 __attribute__((ext_vector_type(2)));

template <class Epi, class Sched, bool ALIGN_EPI = false, bool SP2 = false>
__device__ __forceinline__ void gemm_phase(PG8_LAS unsigned char* lds, const Gemm g, const Sched& S, const Epi& E) {
    int tid_ = threadIdx.x; asm volatile("" : "+v"(tid_));
    const int tid = tid_, wid = __builtin_amdgcn_readfirstlane(tid >> 6), lane = tid & 63, wr = wid >> 2, wc = wid & 3, fr = lane & 15, fq = lane >> 4;
    const int K = g.K, nt = K / BK;
    unsigned voffA[2], voffB[2];
#pragma unroll
    for (int i = 0; i < 2; ++i) { int R, C; stage_rc(tid * 16 + i * 8192, R, C); const int Rb = Epi::PERM ? ((R & ~31) + perm32(R & 31)) : R;
        voffA[i] = (unsigned)(R * K + C) * 2u; voffB[i] = (unsigned)(Rb * K + C) * 2u; }
    const size_t kstep = (size_t)(BK * 2);
    const size_t hstep = (size_t)HALF * K * 2;
    const size_t tstep = 2 * hstep;
    const unsigned ldsw = (unsigned)wid * 1024u;
    const int aoff = lds_byte(wr * 64 + fr, fq * 8), boff = lds_byte(wc * 32 + fr, fq * 8);
#define PG8_SA(b, h) (((b) * 2 + (h)) * HTB)
#define PG8_SB(b, h) ((4 + (b) * 2 + (h)) * HTB)
#define PG8_STAGE(bufoff, gbase, voff) do { _Pragma("unroll") for (int _i = 0; _i < 2; ++_i) \
        __builtin_amdgcn_global_load_lds((const unsigned*)((const char*)(gbase) + (voff)[_i]), (PG8_LAS unsigned*)(lds + (bufoff) + ldsw + _i * 8192), 16, 0, 0); } while (0)
#define PG8_LDA(dst, b, h) do { _Pragma("unroll") for (int m = 0; m < 4; ++m) _Pragma("unroll") for (int k = 0; k < 2; ++k) dst[m][k] = *(const PG8_LAS bf16x8*)(lds + PG8_SA(b, h) + aoff + m * 2048 + k * 1024); } while (0)
#define PG8_LDB(dst, b, h) do { _Pragma("unroll") for (int n = 0; n < 2; ++n) _Pragma("unroll") for (int k = 0; k < 2; ++k) dst[n][k] = *(const PG8_LAS bf16x8*)(lds + PG8_SB(b, h) + boff + n * 2048 + k * 1024); } while (0)
#define PG8_MMA(ai, bj, At, Bt) do { __builtin_amdgcn_s_setprio(1); _Pragma("unroll") for (int m = 0; m < 4; ++m) _Pragma("unroll") for (int n = 0; n < 2; ++n) _Pragma("unroll") for (int k = 0; k < 2; ++k) \
        acc[ai][bj][m][n] = __builtin_amdgcn_mfma_f32_16x16x32_bf16(Bt[n][k], At[m][k], acc[ai][bj][m][n], 0, 0, 0); __builtin_amdgcn_s_setprio(0); } while (0)
#define PG8_WAIT_V(n) asm volatile("s_waitcnt vmcnt(" #n ")" ::: "memory")
#define PG8_WAIT_L(n) asm volatile("s_waitcnt lgkmcnt(" #n ")" ::: "memory")
#define PG8_BAR __builtin_amdgcn_s_barrier()
#define PG8_SCHED __builtin_amdgcn_sched_barrier(0)
    Unit cur, nxt; int ui = 0;
    if (!S.next(0, cur)) return;
    f32x4 acc[2][2][4][2];
#pragma unroll
    for (int a = 0; a < 2; ++a)
#pragma unroll
        for (int b = 0; b < 2; ++b)
#pragma unroll
            for (int m = 0; m < 4; ++m)
#pragma unroll
                for (int n = 0; n < 2; ++n) acc[a][b][m][n] = (f32x4){0.f, 0.f, 0.f, 0.f};
    bf16x8 At[4][2], B0[2][2], B1[2][2];
    const char* cA = (const char*)g.A + (size_t)cur.pm * tstep; const char* cB = (const char*)g.Bt + (size_t)cur.pn * tstep;
    S.a_ready(cur);
    if constexpr (SP2) {
        PG8_STAGE(PG8_SB(0, 0), cB, voffB); PG8_STAGE(PG8_SB(0, 1), cB + hstep, voffB); PG8_STAGE(PG8_SA(0, 0), cA, voffA); PG8_STAGE(PG8_SA(0, 1), cA + hstep, voffA);
        if (wr == 1) PG8_BAR;
        PG8_WAIT_V(2); PG8_BAR;
        PG8_STAGE(PG8_SB(1, 0), cB + kstep, voffB); PG8_STAGE(PG8_SA(1, 0), cA + kstep, voffA); PG8_STAGE(PG8_SB(1, 1), cB + hstep + kstep, voffB);
        PG8_WAIT_V(6); PG8_BAR;
    } else {
        PG8_STAGE(PG8_SB(0, 0), cB, voffB); PG8_STAGE(PG8_SA(0, 0), cA, voffA); PG8_STAGE(PG8_SB(0, 1), cB + hstep, voffB); PG8_STAGE(PG8_SA(0, 1), cA + hstep, voffA);
        if (wr == 1) PG8_BAR;
        PG8_WAIT_V(4); PG8_BAR;
        PG8_STAGE(PG8_SB(1, 0), cB + kstep, voffB); PG8_STAGE(PG8_SA(1, 0), cA + kstep, voffA); PG8_STAGE(PG8_SB(1, 1), cB + hstep + kstep, voffB);
        PG8_WAIT_V(6); PG8_BAR;
    }
    for (;;) {
        const bool has_next = S.next(ui + 1, nxt);
        const char* nA = has_next ? (const char*)g.A + (size_t)nxt.pm * tstep : cA; const char* nB = has_next ? (const char*)g.Bt + (size_t)nxt.pn * tstep : cB;
        for (int t = 0; t < nt; t += 2) {
            const bool last = (t == nt - 2);
            const char* a1 = cA + (size_t)(t + 1) * kstep;
            const char* a2 = last ? nA : cA + (size_t)(t + 2) * kstep; const char* b2 = last ? nB : cB + (size_t)(t + 2) * kstep;
            const char* a3 = a2 + kstep; const char* b3 = b2 + kstep;
            if (last && has_next) S.a_ready(nxt);
            if constexpr (SP2) {
            PG8_LDB(B0, 0, 0); PG8_LDB(B1, 0, 1); PG8_SCHED; PG8_LDA(At, 0, 0); PG8_STAGE(PG8_SA(1, 1), a1 + hstep, voffA);
            PG8_WAIT_V(8); PG8_WAIT_L(0); PG8_BAR; PG8_MMA(0, 0, At, B0); PG8_MMA(0, 1, At, B1); PG8_BAR; PG8_SCHED;
            PG8_LDA(At, 0, 1); PG8_STAGE(PG8_SB(0, 0), b2, voffB); PG8_STAGE(PG8_SB(0, 1), b2 + hstep, voffB); PG8_STAGE(PG8_SA(0, 0), a2, voffA);
            PG8_WAIT_V(8); PG8_WAIT_L(0); PG8_BAR; PG8_MMA(1, 0, At, B0); PG8_MMA(1, 1, At, B1); PG8_BAR; PG8_SCHED;
            PG8_LDB(B0, 1, 0); PG8_LDB(B1, 1, 1); PG8_SCHED; PG8_LDA(At, 1, 0); PG8_STAGE(PG8_SA(0, 1), a2 + hstep, voffA);
            PG8_WAIT_V(8); PG8_WAIT_L(0); PG8_BAR; PG8_MMA(0, 0, At, B0); PG8_MMA(0, 1, At, B1); PG8_BAR; PG8_SCHED;
            PG8_LDA(At, 1, 1); PG8_STAGE(PG8_SB(1, 0), b3, voffB); PG8_STAGE(PG8_SB(1, 1), b3 + hstep, voffB); PG8_STAGE(PG8_SA(1, 0), a3, voffA);
            PG8_WAIT_V(8); PG8_WAIT_L(0); PG8_BAR; PG8_MMA(1, 0, At, B0); PG8_MMA(1, 1, At, B1); PG8_BAR; PG8_SCHED;
            } else {
            PG8_LDB(B0, 0, 0); PG8_SCHED; PG8_LDA(At, 0, 0); PG8_STAGE(PG8_SA(1, 1), a1 + hstep, voffA);
            PG8_WAIT_L(8); PG8_BAR; PG8_WAIT_L(0); PG8_MMA(0, 0, At, B0); PG8_BAR; PG8_SCHED;
            PG8_LDB(B1, 0, 1); PG8_STAGE(PG8_SB(0, 0), b2, voffB);
            PG8_BAR; PG8_WAIT_L(0); PG8_MMA(0, 1, At, B1); PG8_BAR;
            PG8_LDA(At, 0, 1); PG8_STAGE(PG8_SA(0, 0), a2, voffA);
            PG8_BAR; PG8_WAIT_L(0); PG8_MMA(1, 0, At, B0); PG8_BAR; PG8_SCHED;
            PG8_STAGE(PG8_SB(0, 1), b2 + hstep, voffB);
            PG8_WAIT_V(6); PG8_BAR; PG8_MMA(1, 1, At, B1); PG8_BAR;
            PG8_LDB(B0, 1, 0); PG8_SCHED; PG8_LDA(At, 1, 0); PG8_STAGE(PG8_SA(0, 1), a2 + hstep, voffA);
            PG8_WAIT_L(8); PG8_BAR; PG8_WAIT_L(0); PG8_MMA(0, 0, At, B0); PG8_BAR; PG8_SCHED;
            PG8_LDB(B1, 1, 1); PG8_STAGE(PG8_SB(1, 0), b3, voffB);
            PG8_BAR; PG8_WAIT_L(0); PG8_MMA(0, 1, At, B1); PG8_BAR;
            PG8_LDA(At, 1, 1); PG8_STAGE(PG8_SA(1, 0), a3, voffA);
            PG8_BAR; PG8_WAIT_L(0); PG8_MMA(1, 0, At, B0); PG8_BAR; PG8_SCHED;
            PG8_STAGE(PG8_SB(1, 1), b3 + hstep, voffB);
            PG8_WAIT_V(6); PG8_BAR; PG8_MMA(1, 1, At, B1); PG8_BAR;
            }
        }
        if constexpr (ALIGN_EPI) { if (wr == 0) PG8_BAR; }
        if constexpr (!Epi::AFTER_DRAIN) { E(acc, cur, wr, wc, fr, fq); S.done(cur); }
        if (!has_next) break;
#pragma unroll
        for (int a = 0; a < 2; ++a)
#pragma unroll
            for (int b = 0; b < 2; ++b)
#pragma unroll
                for (int m = 0; m < 4; ++m)
#pragma unroll
                    for (int n = 0; n < 2; ++n) acc[a][b][m][n] = (f32x4){0.f, 0.f, 0.f, 0.f};
        cur = nxt; cA = nA; cB = nB; ++ui;
        if constexpr (ALIGN_EPI) { if (wr == 1) PG8_BAR; }
    }
    PG8_WAIT_V(0);
    if constexpr (!ALIGN_EPI) { if (wr == 0) PG8_BAR; }
    PG8_BAR;
    if constexpr (Epi::AFTER_DRAIN) { E.fused(acc, cur, wr, wc, fr, fq, lds, wid, lane); S.done(cur); }
#undef PG8_SA
#undef PG8_SB
#undef PG8_STAGE
#undef PG8_LDA
#undef PG8_LDB
#undef PG8_MMA
#undef PG8_WAIT_V
#undef PG8_WAIT_L
#undef PG8_BAR
#undef PG8_SCHED
}
}
#define DI __device__ __forceinline__
#define LAS __attribute__((address_space(3)))
typedef unsigned short bf16;
typedef float f32x4 __attribute__((ext_vector_type(4)));
typedef float f32x2 __attribute__((ext_vector_type(2)));
typedef float f32x16 __attribute__((ext_vector_type(16)));
typedef short bf16x8 __attribute__((ext_vector_type(8)));
typedef unsigned u32x4 __attribute__((ext_vector_type(4)));
typedef unsigned u32x2 __attribute__((ext_vector_type(2)));
typedef __bf16 bf16x2_t __attribute__((ext_vector_type(2)));

constexpr int NWAVES = 8, NTHR = 512;
constexpr int BATCH = 2, SEQ = 8192, DM = 1024, DEPTH = 4, M = BATCH * SEQ, NCOL = 5120;
constexpr int NG = 32, NP = 64, NCH = SEQ / 64;
constexpr float EPS = 1e-6f;
constexpr size_t MiB = 1u << 20;
constexpr size_t WS_WIN = 1 * MiB, WS_WGLU = 11 * MiB, WS_WBS = 12 * MiB, WS_WBA = 13 * MiB, WS_WOUT = 14 * MiB;
constexpr size_t WS_H = 16 * MiB;
constexpr size_t WS_U = 48 * MiB, WS_ZS = 64 * MiB, WS_Q = 80 * MiB, WS_K = 96 * MiB, WS_VT = 112 * MiB, WS_ZA = 128 * MiB;
constexpr size_t WS_GS = 144 * MiB, WS_GA = 176 * MiB;
constexpr size_t WS_KTAB = 208 * MiB;
constexpr size_t WS_WTAB = 210 * MiB;
constexpr size_t WS_VTAB = 218 * MiB;
constexpr size_t WS_S = 226 * MiB;
constexpr size_t WS_LAM = 230 * MiB;
constexpr size_t WS_END = 231 * MiB;
constexpr int KTAB_BYTES = 65 * 512;
constexpr int LDS_BYTES = 147456;
constexpr float QSCALE = 0.125f * 1.4426950408889634f;

struct Args {
    const float* x; const float* pre_g; const float* post_g; const float* w_in; const float* a_re; const float* a_im; const float* log_dt;
    const float* b_re; const float* b_im; const float* c_re; const float* c_im; const float* d_skip; const float* w_glu; const float* b_glu;
    const float* w_bs; const float* w_ba; const float* w_out; float* out; unsigned char* ws;
};

DI unsigned cvtpk(float lo, float hi) { f32x2 v = {lo, hi}; bf16x2_t b = __builtin_convertvector(v, bf16x2_t); return __builtin_bit_cast(unsigned, b); }
DI float bflo(unsigned w) { return __uint_as_float(w << 16); }
DI float bfhi(unsigned w) { return __uint_as_float(w & 0xffff0000u); }
DI float bf1(bf16 b) { return __uint_as_float((unsigned)b << 16); }
DI float sigm(float x) { return 1.0f / (1.0f + __expf(-x)); }
DI float silu(float x) { return x * sigm(x); }
DI float gelu_tanh(float x) { const float u = 1.5957691216057308f * (x + 0.044715f * x * x * x); return x * sigm(u); }
DI float wave_sum(float v) {
#pragma unroll
    for (int o = 1; o < 64; o <<= 1) v += __shfl_xor(v, o);
    return v;
}

struct EpiProj {
    static constexpr bool PERM = true, AFTER_DRAIN = false;
    unsigned char* ws;
    DI void operator()(const pg8::f32x4 (&acc)[2][2][4][2], const pg8::Unit& u, int wr, int wc, int fr, int fq) const {
        const int pn = u.pn;
        bf16* base; int ld, colt; float sc = 1.f;
        if (pn < 12) { base = (bf16*)(ws + WS_U + (size_t)(pn >> 1) * (16 * MiB)); ld = 512; colt = (pn & 1) * 256; if ((pn >> 1) == 2) sc = QSCALE; }
        else if (pn < 16) { base = (bf16*)(ws + WS_GS); ld = 1024; colt = (pn - 12) * 256; }
        else { base = (bf16*)(ws + WS_GA); ld = 1024; colt = (pn - 16) * 256; }
        const int row0 = u.pm * 256 + wr * 64 + fr, col0 = colt + wc * 32 + 8 * fq;
        if ((pn >> 1) == 4) {
            bf16* vt = (bf16*)(ws + WS_VT);
#pragma unroll
            for (int ai = 0; ai < 2; ++ai)
#pragma unroll
                for (int m = 0; m < 4; ++m) { const int r = row0 + ai * 128 + m * 16; const int bb = r >> 13, t = r & 8191;
#pragma unroll
                    for (int bj = 0; bj < 2; ++bj) { bf16* p = vt + ((size_t)(bb * 512 + col0 + bj * 128)) * 8192 + t;
#pragma unroll
                        for (int n = 0; n < 2; ++n)
#pragma unroll
                            for (int e = 0; e < 4; ++e) { *p = (bf16)(cvtpk(acc[ai][bj][m][n][e], 0.f) & 0xffffu); p += 8192; asm volatile("" : "+v"(p)); } }
                    __builtin_amdgcn_sched_barrier(0); }
            return;
        }
#pragma unroll
        for (int ai = 0; ai < 2; ++ai)
#pragma unroll
            for (int m = 0; m < 4; ++m) { bf16* rowp = base + (size_t)(row0 + ai * 128 + m * 16) * ld + col0;
#pragma unroll
                for (int bj = 0; bj < 2; ++bj) { const pg8::f32x4 v0 = acc[ai][bj][m][0] * sc, v1 = acc[ai][bj][m][1] * sc;
                    u32x4 w; w.x = cvtpk(v0[0], v0[1]); w.y = cvtpk(v0[2], v0[3]); w.z = cvtpk(v1[0], v1[1]); w.w = cvtpk(v1[2], v1[3]);
                    *(u32x4*)(rowp + bj * 128) = w; } }
    }
};
struct EpiGlu {
    static constexpr bool PERM = true, AFTER_DRAIN = false;
    bf16* zs; const float* bias;
    DI void operator()(const pg8::f32x4 (&acc)[2][2][4][2], const pg8::Unit& u, int wr, int wc, int fr, int fq) const {
        const int row0 = u.pm * 256 + wr * 64 + fr, col0 = u.pn * 128 + wc * 32 + 8 * fq;
        f32x4 ba0 = *(const f32x4*)(bias + col0), ba1 = *(const f32x4*)(bias + col0 + 4), bb0 = *(const f32x4*)(bias + 512 + col0), bb1 = *(const f32x4*)(bias + 512 + col0 + 4);
#pragma unroll
        for (int ai = 0; ai < 2; ++ai)
#pragma unroll
            for (int m = 0; m < 4; ++m) { bf16* p = zs + (size_t)(row0 + ai * 128 + m * 16) * 512 + col0;
                const u32x4 z = *(const u32x4*)p; float zf[8] = {bflo(z.x), bfhi(z.x), bflo(z.y), bfhi(z.y), bflo(z.z), bfhi(z.z), bflo(z.w), bfhi(z.w)}; float y[8];
#pragma unroll
                for (int e = 0; e < 4; ++e) { y[e] = (acc[ai][0][m][0][e] + ba0[e]) * sigm(acc[ai][1][m][0][e] + bb0[e]) * silu(zf[e]);
                                              y[4 + e] = (acc[ai][0][m][1][e] + ba1[e]) * sigm(acc[ai][1][m][1][e] + bb1[e]) * silu(zf[4 + e]); }
                u32x4 w; w.x = cvtpk(y[0], y[1]); w.y = cvtpk(y[2], y[3]); w.z = cvtpk(y[4], y[5]); w.w = cvtpk(y[6], y[7]); *(u32x4*)p = w; __builtin_amdgcn_sched_barrier(0); }
    }
};
template <int PASS> struct EpiBranch {
    static constexpr bool PERM = true, AFTER_DRAIN = false;
    bf16* G; const bf16* gate2;
    DI void operator()(const pg8::f32x4 (&acc)[2][2][4][2], const pg8::Unit& u, int wr, int wc, int fr, int fq) const {
        const int row0 = u.pm * 256 + wr * 64 + fr, col0 = u.pn * 256 + wc * 32 + 8 * fq;
#pragma unroll
        for (int ai = 0; ai < 2; ++ai)
#pragma unroll
            for (int m = 0; m < 4; ++m)
#pragma unroll
                for (int bj = 0; bj < 2; ++bj) { const size_t off = (size_t)(row0 + ai * 128 + m * 16) * 1024 + col0 + bj * 128;
                    const u32x4 g = *(const u32x4*)(G + off); float gf[8] = {bflo(g.x), bfhi(g.x), bflo(g.y), bfhi(g.y), bflo(g.z), bfhi(g.z), bflo(g.w), bfhi(g.w)}; float y[8];
                    if (PASS == 0) {
#pragma unroll
                        for (int e = 0; e < 4; ++e) { y[e] = sigm(gf[e]) * acc[ai][bj][m][0][e]; y[4 + e] = sigm(gf[4 + e]) * acc[ai][bj][m][1][e]; }
                    } else {
                        const u32x4 h = *(const u32x4*)(gate2 + off); float hf[8] = {bflo(h.x), bfhi(h.x), bflo(h.y), bfhi(h.y), bflo(h.z), bfhi(h.z), bflo(h.w), bfhi(h.w)};
#pragma unroll
                        for (int e = 0; e < 4; ++e) { y[e] = gf[e] + sigm(hf[e]) * acc[ai][bj][m][0][e]; y[4 + e] = gf[4 + e] + sigm(hf[4 + e]) * acc[ai][bj][m][1][e]; }
                    }
                    u32x4 w; w.x = cvtpk(y[0], y[1]); w.y = cvtpk(y[2], y[3]); w.z = cvtpk(y[4], y[5]); w.w = cvtpk(y[6], y[7]); *(u32x4*)(G + off) = w; __builtin_amdgcn_sched_barrier(0); }
    }
};
struct EpiPlain {
    static constexpr bool PERM = true, AFTER_DRAIN = false;
    bf16* O;
    DI void operator()(const pg8::f32x4 (&acc)[2][2][4][2], const pg8::Unit& u, int wr, int wc, int fr, int fq) const {
        const int row0 = u.pm * 256 + wr * 64 + fr, col0 = u.pn * 256 + wc * 32 + 8 * fq;
#pragma unroll
        for (int ai = 0; ai < 2; ++ai)
#pragma unroll
            for (int m = 0; m < 4; ++m)
#pragma unroll
                for (int bj = 0; bj < 2; ++bj) { const pg8::f32x4 v0 = acc[ai][bj][m][0], v1 = acc[ai][bj][m][1];
                    u32x4 w; w.x = cvtpk(v0[0], v0[1]); w.y = cvtpk(v0[2], v0[3]); w.z = cvtpk(v1[0], v1[1]); w.w = cvtpk(v1[2], v1[3]);
                    *(u32x4*)(O + (size_t)(row0 + ai * 128 + m * 16) * 1024 + col0 + bj * 128) = w; }
    }
};

DI void norm_row(const float* xin, const bf16* o, const float* g_post, float* xout, const float* g_pre, bf16* h, int lane) {
    f32x4 v[4];
#pragma unroll
    for (int j = 0; j < 4; ++j) v[j] = *((const f32x4*)xin + lane + 64 * j);
    if (o) {
        f32x4 ov[4]; float ss = 0.f;
#pragma unroll
        for (int j = 0; j < 4; ++j) { const u32x2 w = *((const u32x2*)o + lane + 64 * j); ov[j] = (f32x4){bflo(w.x), bfhi(w.x), bflo(w.y), bfhi(w.y)};
            ss += (ov[j].x * ov[j].x + ov[j].y * ov[j].y) + (ov[j].z * ov[j].z + ov[j].w * ov[j].w); }
        const float rstd = 1.0f / sqrtf(wave_sum(ss) * (1.0f / DM) + EPS);
#pragma unroll
        for (int j = 0; j < 4; ++j) { const f32x4 g = *((const f32x4*)g_post + lane + 64 * j); v[j] = v[j] + ov[j] * rstd * g; *((f32x4*)xout + lane + 64 * j) = v[j]; }
    }
    if (g_pre) {
        float ss = 0.f;
#pragma unroll
        for (int j = 0; j < 4; ++j) ss += (v[j].x * v[j].x + v[j].y * v[j].y) + (v[j].z * v[j].z + v[j].w * v[j].w);
        const float rstd = 1.0f / sqrtf(wave_sum(ss) * (1.0f / DM) + EPS);
#pragma unroll
        for (int j = 0; j < 4; ++j) { const f32x4 g = *((const f32x4*)g_pre + lane + 64 * j); const f32x4 y = v[j] * rstd * g;
            u32x2 w; w.x = cvtpk(y.x, y.y); w.y = cvtpk(y.z, y.w); *((u32x2*)h + lane + 64 * j) = w; }
    }
}
DI void transpose_item(const float* W, int K, int N, bf16* WT, int k0, int n0, int dst_row0, LAS float* scr, int lane) {
#pragma unroll 8
    for (int i = 0; i < 32; ++i) { const int kk = 2 * i + (lane >> 5); scr[kk * 33 + (lane & 31)] = W[(size_t)(k0 + kk) * N + n0 + (lane & 31)]; }
    asm volatile("s_waitcnt lgkmcnt(0)" ::: "memory");
    const int c = lane & 7;
#pragma unroll
    for (int j = 0; j < 4; ++j) { const int n = (lane >> 3) + 8 * j; const LAS float* s = scr + (8 * c) * 33 + n;
        u32x4 o; o.x = cvtpk(s[0 * 33], s[1 * 33]); o.y = cvtpk(s[2 * 33], s[3 * 33]); o.z = cvtpk(s[4 * 33], s[5 * 33]); o.w = cvtpk(s[6 * 33], s[7 * 33]);
        *(u32x4*)(WT + (size_t)(dst_row0 + n) * K + k0 + 8 * c) = o; }
    asm volatile("s_waitcnt lgkmcnt(0)" ::: "memory");
}
DI f32x2 cpow_k(float are, float aim, float dt, int k) {
    const float mag = __expf(are * dt * (float)k);
    const double turns = (double)aim * (double)dt * (double)k * 0.15915494309189535;
    const float fr = (float)(turns - floor(turns));
    return (f32x2){mag * __builtin_amdgcn_cosf(fr), mag * __builtin_amdgcn_sinf(fr)};
}
DI f32x2 cmul(f32x2 a, f32x2 b) { return (f32x2){a.x * b.x - a.y * b.y, a.x * b.y + a.y * b.x}; }
DI f32x2 zoh_factor(float are, float aim, float dt) {
    const f32x2 ab = cpow_k(are, aim, dt, 1); const float nr = ab.x - 1.0f, ni = ab.y, den = are * are + aim * aim;
    return (f32x2){(nr * are + ni * aim) / den, (ni * are - nr * aim) / den};
}

struct LayerP { const float *a_re, *a_im, *log_dt, *b_re, *b_im, *c_re, *c_im; };

DI void ktab_item(const LayerP& P, bf16* KTAB, int g, int tp, LAS unsigned char* lds, int tid) {
    LAS f32x2* CL = (LAS f32x2*)lds;
    LAS f32x2* BB = (LAS f32x2*)(lds + 16384);
    const float dt = __expf(P.log_dt[g]);
    for (int e = tid; e < 1024; e += NTHR) { const int p = e >> 4, hp = e & 15; const float are = P.a_re[g * 64 + p], aim = P.a_im[g * 64 + p];
        const f32x2 f = zoh_factor(are, aim, dt); const f32x2 bv = {P.b_re[(g * 64 + p) * 16 + hp], P.b_im[(g * 64 + p) * 16 + hp]}; BB[p * 16 + hp] = cmul(f, bv); }
    for (int e = tid; e < 2048; e += NTHR) { const int p = e & 63, h = (e >> 6) & 15, ts = e >> 10; const float are = P.a_re[g * 64 + p], aim = P.a_im[g * 64 + p];
        const f32x2 lp = cpow_k(are, aim, dt, 2 * tp + ts); const f32x2 cv = {P.c_re[(g * 16 + h) * 64 + p], P.c_im[(g * 16 + h) * 64 + p]}; CL[(ts * 16 + h) * 64 + p] = cmul(cv, lp); }
    __syncthreads();
    { const int ts = tid >> 8, h = (tid >> 4) & 15, hp = tid & 15; float s = 0.f;
#pragma unroll 8
      for (int p = 0; p < 64; ++p) { const f32x2 c = CL[(ts * 16 + h) * 64 + p], b = BB[p * 16 + hp]; s += c.x * b.x - c.y * b.y; }
      KTAB[((size_t)g * 65 + (2 * tp + ts + 1)) * 256 + h * 16 + hp] = (bf16)(cvtpk(s, 0.f) & 0xffffu);
      if (tp == 0 && tid < 256) KTAB[((size_t)g * 65) * 256 + tid] = 0; }
    __syncthreads();
}
DI void wv_item(const LayerP& P, bf16* WTAB, bf16* VTAB, float* LAM, int idx) {
    const int p = idx & 63, k = (idx >> 6) & 63, g = idx >> 12;
    const float dt = __expf(P.log_dt[g]), are = P.a_re[g * 64 + p], aim = P.a_im[g * 64 + p];
    const f32x2 f = zoh_factor(are, aim, dt), lk = cpow_k(are, aim, dt, k), lk1 = cpow_k(are, aim, dt, k + 1);
    const f32x2 fl = cmul(f, lk);
    unsigned wr_[8], wi_[8];
#pragma unroll
    for (int j = 0; j < 8; ++j) { const int i0 = (g * 64 + p) * 16 + 2 * j; const f32x2 v0 = cmul(fl, (f32x2){P.b_re[i0], P.b_im[i0]}), v1 = cmul(fl, (f32x2){P.b_re[i0 + 1], P.b_im[i0 + 1]});
        wr_[j] = cvtpk(v0.x, v1.x); wi_[j] = cvtpk(v0.y, v1.y); }
    bf16* wrow = WTAB + ((size_t)g * 128 + 2 * p) * 1024 + (63 - k) * 16;
    *(u32x4*)wrow = (u32x4){wr_[0], wr_[1], wr_[2], wr_[3]}; *(u32x4*)(wrow + 8) = (u32x4){wr_[4], wr_[5], wr_[6], wr_[7]};
    *(u32x4*)(wrow + 1024) = (u32x4){wi_[0], wi_[1], wi_[2], wi_[3]}; *(u32x4*)(wrow + 1024 + 8) = (u32x4){wi_[4], wi_[5], wi_[6], wi_[7]};
#pragma unroll
    for (int h = 0; h < 16; ++h) { const f32x2 cv = cmul((f32x2){P.c_re[(g * 16 + h) * 64 + p], P.c_im[(g * 16 + h) * 64 + p]}, lk1);
        *(unsigned*)(VTAB + ((size_t)g * 1024 + k * 16 + h) * 128 + 2 * p) = cvtpk(cv.x, -cv.y); }
    if (k == 63) { LAM[(g * 64 + p) * 2] = lk1.x; LAM[(g * 64 + p) * 2 + 1] = lk1.y; }
}

#define MFMA16(a, b, c) __builtin_amdgcn_mfma_f32_16x16x32_bf16((a), (b), (c), 0, 0, 0)
#define MFMA32(a, b, c) __builtin_amdgcn_mfma_f32_32x32x16_bf16((a), (b), (c), 0, 0, 0)
DI void ssm_state_unit(const bf16* U, const bf16* WTAB, float* S, int b, int g, int cb, int wave, int lane) {
    const int n = lane & 15, kg = lane >> 4;
    const bf16* up = U + ((size_t)b * SEQ + (size_t)(cb * 16 + n) * 64 + (kg >> 1)) * 512 + g * 16 + 8 * (kg & 1);
    const bf16* wp = WTAB + ((size_t)g * 128 + 16 * wave + n) * 1024 + 8 * kg;
    pg8::f32x4 acc = {0.f, 0.f, 0.f, 0.f};
#pragma unroll 8
    for (int ks = 0; ks < 32; ++ks) { const bf16x8 af = *(const bf16x8*)(wp + 32 * ks); const bf16x8 uf = *(const bf16x8*)(up + (size_t)(2 * ks) * 512); acc = MFMA16(af, uf, acc); }
    *(pg8::f32x4*)(S + (((size_t)b * NCH + cb * 16 + n) * NG + g) * 128 + 16 * wave + 4 * kg) = acc;
}
constexpr int XIN_OFF = 33280, XIN_PITCH = 272, TB_OFF = XIN_OFF + 16 * XIN_PITCH;
DI void ssm_out_unit(const bf16* U, const bf16* KTAB, const bf16* VTAB, const float* S, const float* LAM, const float* dsk, bf16* YS, int b, int g, int cb, LAS unsigned char* lds, int tid, int wave, int lane) {
    { const u32x4* src = (const u32x4*)((const unsigned char*)KTAB + (size_t)g * KTAB_BYTES); for (int i = tid; i < KTAB_BYTES / 16; i += NTHR) *(LAS u32x4*)(lds + 16 * i) = src[i]; }
    const f32x2 lam = *(const f32x2*)(LAM + (g * 64 + lane) * 2);
    f32x2 sv[16];
    LAS f32x2* TB = (LAS f32x2*)(lds + TB_OFF);
    if (wave <= cb) {
        const f32x2* sp = (const f32x2*)(S + (((size_t)b * NCH + wave * 16) * NG + g) * 128) + lane;
#pragma unroll
        for (int j = 0; j < 16; ++j) sv[j] = sp[(size_t)j * (NG * 64)];
        if (wave < cb) { f32x2 x = {0.f, 0.f};
#pragma unroll
            for (int j = 0; j < 16; ++j) { x = cmul(lam, x); x.x += sv[j].x; x.y += sv[j].y; }
            TB[wave * 64 + lane] = x; }
    }
    __syncthreads();
    if (wave == cb) {
        f32x2 l16 = lam;
#pragma unroll
        for (int j = 0; j < 4; ++j) l16 = cmul(l16, l16);
        f32x2 x = {0.f, 0.f};
        for (int w = 0; w < cb; ++w) { const f32x2 t = TB[w * 64 + lane]; x = cmul(l16, x); x.x += t.x; x.y += t.y; }
#pragma unroll
        for (int j = 0; j < 16; ++j) { *(LAS unsigned*)(lds + XIN_OFF + j * XIN_PITCH + 4 * lane) = cvtpk(x.x, x.y); x = cmul(lam, x); x.x += sv[j].x; x.y += sv[j].y; }
    }
    __syncthreads();
    const int n = lane & 15, kg = lane >> 4;
    pg8::f32x4 acc[8];
#pragma unroll
    for (int j = 0; j < 8; ++j) acc[j] = (pg8::f32x4){0.f, 0.f, 0.f, 0.f};
    const bf16* up = U + ((size_t)b * SEQ + (size_t)(cb * 16 + n) * 64 + (kg >> 1)) * 512 + g * 16 + 8 * (kg & 1);
    const LAS unsigned char* kt = lds + n * 32 + (kg & 1) * 16 + (1 - (kg >> 1)) * 512;
    bf16x8 uf = *(const bf16x8*)up;
#pragma unroll 1
    for (int ks = 0; ks < 32; ++ks) {
        const bf16x8 ufn = *(const bf16x8*)(up + (size_t)(2 * (ks < 31 ? ks + 1 : ks)) * 512);
#pragma unroll
        for (int j = 0; j < 8; ++j) { const int t = wave + 8 * j; if (t >= 2 * ks) { const bf16x8 af = *(const LAS bf16x8*)(kt + (t - 2 * ks) * 512); acc[j] = MFMA16(af, uf, acc[j]); } }
        uf = ufn;
    }
#pragma unroll 1
    for (int k2 = 0; k2 < 4; ++k2) { const bf16x8 xf = *(const LAS bf16x8*)(lds + XIN_OFF + n * XIN_PITCH + (32 * k2 + 8 * kg) * 2);
#pragma unroll
        for (int j = 0; j < 8; ++j) { const int t = wave + 8 * j; const bf16x8 af = *(const bf16x8*)(VTAB + ((size_t)g * 1024 + t * 16 + n) * 128 + 32 * k2 + 8 * kg); acc[j] = MFMA16(af, xf, acc[j]); } }
    const f32x4 dv = *(const f32x4*)(dsk + g * 16 + 4 * kg);
#pragma unroll
    for (int j = 0; j < 8; ++j) { const int t = wave + 8 * j; const size_t off = ((size_t)b * SEQ + (size_t)(cb * 16 + n) * 64 + t) * 512 + g * 16 + 4 * kg;
        const u32x2 uu = *(const u32x2*)(U + off);
        const float y0 = gelu_tanh(acc[j][0] + dv[0] * bflo(uu.x)), y1 = gelu_tanh(acc[j][1] + dv[1] * bfhi(uu.x)), y2 = gelu_tanh(acc[j][2] + dv[2] * bflo(uu.y)), y3 = gelu_tanh(acc[j][3] + dv[3] * bfhi(uu.y));
        u32x2 w; w.x = cvtpk(y0, y1); w.y = cvtpk(y2, y3); *(u32x2*)(YS + off) = w; }
    __syncthreads();
}

DI void attn_task(const bf16* Q, const bf16* Kb, const bf16* VT, const bf16* ZA, bf16* Y, int b, int h, int qt, int lane) {
    const int n = lane & 31, hi = lane >> 5;
    const size_t rowbase = (size_t)b * SEQ;
    bf16x8 qf[4];
    { const bf16* qp = Q + (rowbase + qt * 32 + n) * 512 + h * 64 + 8 * hi;
#pragma unroll
      for (int ks = 0; ks < 4; ++ks) qf[ks] = *(const bf16x8*)(qp + 16 * ks); }
    const int pm = (n & ~12) | (((n >> 2) & 1) << 3) | (((n >> 3) & 1) << 2);
    const bf16* kp = Kb + (rowbase + pm) * 512 + h * 64 + 8 * hi;
    const bf16* vp = VT + ((size_t)(b * 8 + h) * 64 + n) * SEQ + 8 * hi;
    f32x16 o0, o1;
#pragma unroll
    for (int r = 0; r < 16; ++r) { o0[r] = 0.f; o1[r] = 0.f; }
    float carry = 0.f;
    bf16x8 kf[4], vf[4];
    { const int key0 = qt * 32;
#pragma unroll
      for (int ks = 0; ks < 4; ++ks) kf[ks] = *(const bf16x8*)(kp + (size_t)key0 * 512 + 16 * ks);
      vf[0] = *(const bf16x8*)(vp + key0); vf[1] = *(const bf16x8*)(vp + key0 + 16); vf[2] = *(const bf16x8*)(vp + (size_t)32 * SEQ + key0); vf[3] = *(const bf16x8*)(vp + (size_t)32 * SEQ + key0 + 16); }
    for (int kt = qt; kt >= 0; --kt) {
        bf16x8 nk[4], nv[4];
        { const int key0 = (kt > 0 ? kt - 1 : 0) * 32;
#pragma unroll
          for (int ks = 0; ks < 4; ++ks) nk[ks] = *(const bf16x8*)(kp + (size_t)key0 * 512 + 16 * ks);
          nv[0] = *(const bf16x8*)(vp + key0); nv[1] = *(const bf16x8*)(vp + key0 + 16); nv[2] = *(const bf16x8*)(vp + (size_t)32 * SEQ + key0); nv[3] = *(const bf16x8*)(vp + (size_t)32 * SEQ + key0 + 16); }
        f32x16 s;
#pragma unroll
        for (int r = 0; r < 16; ++r) s[r] = 0.f;
#pragma unroll
        for (int ks = 0; ks < 4; ++ks) s = MFMA32(kf[ks], qf[ks], s);
        const bool diag = (kt == qt);
        float sp[16];
#pragma unroll
        for (int r = 0; r < 16; ++r) { const float z = s[r]; const float e = __builtin_amdgcn_exp2f(-fabsf(z)); sp[r] = fmaxf(z, 0.f) + __builtin_amdgcn_logf(1.0f + e);
            if (diag && (16 * (r >> 3) + 8 * hi + (r & 7)) >= n) sp[r] = 0.f; }
        float cum[16]; float c0 = 0.f, c1 = 0.f;
#pragma unroll
        for (int r = 7; r >= 0; --r) { c0 -= sp[r]; cum[r] = c0; c1 -= sp[8 + r]; cum[8 + r] = c1; }
        const float p0 = __shfl_xor(c0, 32), p1 = __shfl_xor(c1, 32);
        const float base1 = carry + (hi ? 0.f : p1), base0 = carry + c1 + p1 + (hi ? 0.f : p0);
        float w[16];
#pragma unroll
        for (int r = 0; r < 16; ++r) { w[r] = __builtin_amdgcn_exp2f(s[r] + cum[r] + (r < 8 ? base0 : base1));
            if (diag && (16 * (r >> 3) + 8 * hi + (r & 7)) >= n) w[r] = 0.f; }
        carry += (c0 + c1) + (p0 + p1);
        const u32x4 pa = {cvtpk(w[0], w[1]), cvtpk(w[2], w[3]), cvtpk(w[4], w[5]), cvtpk(w[6], w[7])}, pb = {cvtpk(w[8], w[9]), cvtpk(w[10], w[11]), cvtpk(w[12], w[13]), cvtpk(w[14], w[15])};
        const bf16x8 pf0 = __builtin_bit_cast(bf16x8, pa), pf1 = __builtin_bit_cast(bf16x8, pb);
        o0 = MFMA32(pf0, vf[0], o0); o0 = MFMA32(pf1, vf[1], o0); o1 = MFMA32(pf0, vf[2], o1); o1 = MFMA32(pf1, vf[3], o1);
        if (__ballot(carry >= -152.0f) == 0ull) break;
#pragma unroll
        for (int ks = 0; ks < 4; ++ks) { kf[ks] = nk[ks]; vf[ks] = nv[ks]; }
    }
#pragma unroll
    for (int r = 0; r < 16; ++r) { const int i = (r & 3) + 8 * (r >> 2) + 4 * hi; const size_t off = (rowbase + qt * 32 + i) * 512 + h * 64 + n;
        const float za0 = bf1(ZA[off]), za1 = bf1(ZA[off + 32]);
        Y[off] = (bf16)(cvtpk(o0[r] * silu(za0), 0.f) & 0xffffu); Y[off + 32] = (bf16)(cvtpk(o1[r] * silu(za1), 0.f) & 0xffffu); }
}
__global__ void __launch_bounds__(NTHR, 2) hybrid_fwd(Args a) {
    extern __shared__ __attribute__((aligned(16))) unsigned char lds_raw[];
    LAS unsigned char* lds = (LAS unsigned char*)lds_raw;
    cg::grid_group grid = cg::this_grid();
    const int tid0 = threadIdx.x, wave = __builtin_amdgcn_readfirstlane(tid0 >> 6);
    const int G = gridDim.x, bx = blockIdx.x;
    const int gw = bx * NWAVES + wave, NGW = G * NWAVES;
    unsigned char* ws = a.ws;
    bf16* const Win = (bf16*)(ws + WS_WIN); bf16* const Wglu = (bf16*)(ws + WS_WGLU); bf16* const Wbs = (bf16*)(ws + WS_WBS); bf16* const Wba = (bf16*)(ws + WS_WBA); bf16* const Wout = (bf16*)(ws + WS_WOUT);
    bf16* const Hb = (bf16*)(ws + WS_H); bf16* const Ub = (bf16*)(ws + WS_U); bf16* const ZSb = (bf16*)(ws + WS_ZS); bf16* const Qb = (bf16*)(ws + WS_Q); bf16* const Kb = (bf16*)(ws + WS_K);
    bf16* const VTb = (bf16*)(ws + WS_VT); bf16* const ZAb = (bf16*)(ws + WS_ZA); bf16* const GSb = (bf16*)(ws + WS_GS); bf16* const GAb = (bf16*)(ws + WS_GA);
    bf16* const KTAB = (bf16*)(ws + WS_KTAB); bf16* const WTAB = (bf16*)(ws + WS_WTAB); bf16* const VTAB = (bf16*)(ws + WS_VTAB); float* const Sb = (float*)(ws + WS_S); float* const LAM = (float*)(ws + WS_LAM);

    for (int l = 0; l <= DEPTH; ++l) {
        int tid = tid0; asm volatile("" : "+v"(tid)); const int lane = tid & 63;
        {
            const float* xin = (l <= 1) ? a.x : a.out;
            for (int m = gw; m < M; m += NGW)
                norm_row(xin + (size_t)m * DM, l > 0 ? GAb + (size_t)m * DM : nullptr, l > 0 ? a.post_g + (l - 1) * DM : nullptr, a.out + (size_t)m * DM,
                         l < DEPTH ? a.pre_g + l * DM : nullptr, Hb + (size_t)m * DM, lane);
            if (l == DEPTH) break;
            LAS float* scr = (LAS float*)(lds + wave * 16384);
            const float* w_in = a.w_in + (size_t)l * DM * NCOL; const float* w_glu = a.w_glu + (size_t)l * 512 * 1024; const float* w_bs = a.w_bs + (size_t)l * 512 * 1024;
            const float* w_ba = a.w_ba + (size_t)l * 512 * 1024; const float* w_out = a.w_out + (size_t)l * 1024 * 1024;
            constexpr int I_IN = 16 * 160, I_GLU = 8 * 32, I_BR = 8 * 32, I_OUT = 16 * 32, NITEMS = I_IN + I_GLU + 2 * I_BR + I_OUT;
            for (int it = gw; it < NITEMS; it += NGW) {
                int r = it;
                if (r < I_IN) { const int kb = r / 160, nb = r % 160; transpose_item(w_in, 1024, NCOL, Win, 64 * kb, 32 * nb, 32 * nb, scr, lane); continue; } r -= I_IN;
                if (r < I_GLU) { const int kb = r / 32, nb = r % 32, n0 = 32 * nb; const int bj = n0 >> 9, rem = n0 & 511, pn = rem >> 7, i0 = rem & 127;
                    transpose_item(w_glu, 512, 1024, Wglu, 64 * kb, n0, 256 * pn + 128 * bj + i0, scr, lane); continue; } r -= I_GLU;
                if (r < I_BR) { const int kb = r / 32, nb = r % 32; transpose_item(w_bs, 512, 1024, Wbs, 64 * kb, 32 * nb, 32 * nb, scr, lane); continue; } r -= I_BR;
                if (r < I_BR) { const int kb = r / 32, nb = r % 32; transpose_item(w_ba, 512, 1024, Wba, 64 * kb, 32 * nb, 32 * nb, scr, lane); continue; } r -= I_BR;
                { const int kb = r / 32, nb = r % 32; transpose_item(w_out, 1024, 1024, Wout, 64 * kb, 32 * nb, 32 * nb, scr, lane); }
            }
            __syncthreads();
            LayerP P{a.a_re + l * NG * NP, a.a_im + l * NG * NP, a.log_dt + l * NG, a.b_re + (size_t)l * NG * NP * 16, a.b_im + (size_t)l * NG * NP * 16, a.c_re + (size_t)l * NG * 16 * NP, a.c_im + (size_t)l * NG * 16 * NP};
#ifndef NO_TAB
            for (int it = bx; it < NG * 32; it += G) ktab_item(P, KTAB, it >> 5, it & 31, lds, tid);
            for (int idx = bx * NTHR + tid; idx < NG * NP * 64; idx += G * NTHR) wv_item(P, WTAB, VTAB, LAM, idx);
#endif
        }
        grid.sync();
#ifndef NO_A
        { pg8::Gemm g{Hb, Win, M, NCOL, DM}; pg8::StaticOrder S; S.init(M, NCOL, G, bx); EpiProj E{ws};
          pg8::gemm_phase<EpiProj, pg8::StaticOrder, true, true>(lds, g, S, E); }
#endif
        grid.sync();
#ifndef NO_B1
        for (int u = bx; u < 512; u += G) { const int g = u >> 4, nb = u & 15; ssm_state_unit(Ub, WTAB, Sb, nb >> 3, g, nb & 7, wave, lane); }
#endif
#ifndef NO_ATTN
        for (int t = gw; t < 4096; t += NGW) attn_task(Qb, Kb, VTb, ZAb, Qb, t >> 11, (t >> 8) & 7, t & 255, lane);
#endif
        grid.sync();
#ifndef NO_B3
        for (int u = bx; u < 512; u += G) { const int g = u >> 4, nb = u & 15; ssm_out_unit(Ub, KTAB, VTAB, Sb, LAM, a.d_skip + l * 512, Hb, nb >> 3, g, nb & 7, lds, tid, wave, lane); }
#endif
        grid.sync();
#ifndef NO_D1
        { pg8::Gemm g{Hb, Wglu, M, 1024, 512}; pg8::StaticOrder S; S.init(M, 1024, G, bx); EpiGlu E{ZSb, a.b_glu + l * 1024};
          pg8::gemm_phase<EpiGlu, pg8::StaticOrder, true, true>(lds, g, S, E); }
#endif
        grid.sync();
#ifndef NO_D2
        { pg8::Gemm g{ZSb, Wbs, M, 1024, 512}; pg8::StaticOrder S; S.init(M, 1024, G, bx); EpiBranch<0> E{GSb, GAb};
          pg8::gemm_phase<EpiBranch<0>, pg8::StaticOrder, true, true>(lds, g, S, E); }
        __syncthreads();
        { pg8::Gemm g{Qb, Wba, M, 1024, 512}; pg8::StaticOrder S; S.init(M, 1024, G, bx); EpiBranch<1> E{GSb, GAb};
          pg8::gemm_phase<EpiBranch<1>, pg8::StaticOrder, true, true>(lds, g, S, E); }
#endif
        grid.sync();
#ifndef NO_D3
        { pg8::Gemm g{GSb, Wout, M, 1024, 1024}; pg8::StaticOrder S; S.init(M, 1024, G, bx); EpiPlain E{GAb};
          pg8::gemm_phase<EpiPlain, pg8::StaticOrder, true, true>(lds, g, S, E); }
#endif
        grid.sync();
    }
}

extern "C" void kernel_launch(void* const* d_in, const int* in_sizes, int n_in, void* d_out, int out_size, void* d_ws, size_t ws_size, hipStream_t stream) {
    static int grid = 0;
    if (grid == 0) {
        if (n_in != 17 || out_size != M * DM || ws_size < WS_END) { fprintf(stderr, "kernel_launch: unexpected problem shape (n_in %d, out %d, ws %zu)\n", n_in, out_size, ws_size); grid = -1; return; }
        int dev = 0, cus = 0, per_cu = 0;
        (void)hipGetDevice(&dev); (void)hipDeviceGetAttribute(&cus, hipDeviceAttributeMultiprocessorCount, dev);
        if (hipFuncSetAttribute((const void*)hybrid_fwd, hipFuncAttributeMaxDynamicSharedMemorySize, LDS_BYTES) != hipSuccess) { fprintf(stderr, "kernel_launch: hipFuncSetAttribute failed\n"); grid = -1; return; }
        if (hipOccupancyMaxActiveBlocksPerMultiprocessor(&per_cu, (const void*)hybrid_fwd, NTHR, LDS_BYTES) != hipSuccess || per_cu < 1) { fprintf(stderr, "kernel_launch: occupancy query gave %d\n", per_cu); per_cu = 1; }
        (void)hipGetLastError();
        grid = cus * per_cu;
    }
    if (grid < 0) return;
    Args a{};
    a.x = (const float*)d_in[0]; a.pre_g = (const float*)d_in[1]; a.post_g = (const float*)d_in[2]; a.w_in = (const float*)d_in[3]; a.a_re = (const float*)d_in[4]; a.a_im = (const float*)d_in[5];
    a.log_dt = (const float*)d_in[6]; a.b_re = (const float*)d_in[7]; a.b_im = (const float*)d_in[8]; a.c_re = (const float*)d_in[9]; a.c_im = (const float*)d_in[10]; a.d_skip = (const float*)d_in[11];
    a.w_glu = (const float*)d_in[12]; a.b_glu = (const float*)d_in[13]; a.w_bs = (const float*)d_in[14]; a.w_ba = (const float*)d_in[15]; a.w_out = (const float*)d_in[16];
    a.out = (float*)d_out; a.ws = (unsigned char*)d_ws;
    void* args[] = {&a};
    const hipError_t e = hipLaunchCooperativeKernel((const void*)hybrid_fwd, dim3(grid), dim3(NTHR), args, LDS_BYTES, stream);
    if (e != hipSuccess) fprintf(stderr, "kernel_launch: cooperative launch failed: %s (grid %d)\n", hipGetErrorString(e), grid);
}
```

```cpp
#include <hip/hip_runtime.h>
#include <hip/hip_cooperative_groups.h>
#include <cstdio>
#include <cstdint>
namespace cg = cooperative_groups;
namespace pg8 {
#define PG8_LAS __attribute__((address_space(3)))
typedef unsigned short bf16_t;
typedef short bf16x8 __attribute__((ext_vector_type(8)));
typedef float f32x4 __attribute__((ext_vector_type(4)));
typedef unsigned u32x4 __attribute__((ext_vector_type(4)));
constexpr int BM = 256, BK = 64, HALF = 128, HTB = HALF * BK * 2  , STAGE_BYTES = 8 * HTB, NXCD = 8, WGM = 8;

__host__ __device__ __forceinline__ int lds_byte(int r, int c) { const int st = (r >> 4) * 2 + (c >> 5), rr = r & 15, cc = c & 31, ob = rr * 64 + cc * 2; return st * 1024 + (ob ^ (((ob >> 9) & 1) << 5)); }
__host__ __device__ __forceinline__ void stage_rc(int b, int& R, int& C) { const int st = b / 1024, sb = b % 1024, swz = sb ^ (((sb >> 9) & 1) << 5); R = (st >> 1) * 16 + swz / 64; C = (st & 1) * 32 + (swz % 64) / 2; }
__host__ __device__ __forceinline__ int perm32(int rho) { const int n = rho >> 4, i = rho & 15; return 8 * (i >> 2) + 4 * n + (i & 3); }

struct Unit { int pm, pn; };
struct Gemm { const bf16_t* A; const bf16_t* Bt; int M, N, K; };

struct StaticOrder {
    int nM, nN, nwg, G, c;
    __host__ __device__ void init(int M, int N, int G_, int c_) { nM = M / BM; nN = N / BM; nwg = nM * nN; G = G_; c = c_; }
    __host__ __device__ bool next(int i, Unit& u) const {
        const long L = (long)i * G + c; if (L >= nwg) return false;
        int wgid = (int)L; { const int q = nwg / NXCD, r = nwg % NXCD, xcd = wgid % NXCD, off = wgid / NXCD; wgid = (xcd < r ? xcd * (q + 1) : r * (q + 1) + (xcd - r) * q) + off; }
        const int nig = WGM * nN, gid = wgid / nig, fm = gid * WGM, gsz = (nM - fm) < WGM ? (nM - fm) : WGM;
        u.pm = fm + ((wgid % nig) % gsz); u.pn = (wgid % nig) / gsz; return true;
    }
    __device__ __forceinline__ void a_ready(const Unit&) const {}
    __device__ __forceinline__ void done(const Unit&) const {}
};
__device__ __forceinline__ unsigned cvt_pk_bf16(float lo, float hi) { unsigned r; asm volatile("v_cvt_pk_bf16_f32 %0, %1, %2" : "=v"(r) : "v"(lo), "v"(hi)); return r; }
typedef float f32x2 __attribute__((ext_vector_type(2)));

template <class Epi, class Sched, bool ALIGN_EPI = false, bool SP2 = false>
__device__ __forceinline__ void gemm_phase(PG8_LAS unsigned char* lds, const Gemm g, const Sched& S, const Epi& E) {
    int tid_ = threadIdx.x; asm volatile("" : "+v"(tid_));
    const int tid = tid_, wid = __builtin_amdgcn_readfirstlane(tid >> 6), lane = tid & 63, wr = wid >> 2, wc = wid & 3, fr = lane & 15, fq = lane >> 4;
    const int K = g.K, nt = K / BK;
    unsigned voffA[2], voffB[2];
#pragma unroll
    for (int i = 0; i < 2; ++i) { int R, C; stage_rc(tid * 16 + i * 8192, R, C); const int Rb = Epi::PERM ? ((R & ~31) + perm32(R & 31)) : R;
        voffA[i] = (unsigned)(R * K + C) * 2u; voffB[i] = (unsigned)(Rb * K + C) * 2u; }
    const size_t kstep = (size_t)(BK * 2);
    const size_t hstep = (size_t)HALF * K * 2;
    const size_t tstep = 2 * hstep;
    const unsigned ldsw = (unsigned)wid * 1024u;
    const int aoff = lds_byte(wr * 64 + fr, fq * 8), boff = lds_byte(wc * 32 + fr, fq * 8);
#define PG8_SA(b, h) (((b) * 2 + (h)) * HTB)
#define PG8_SB(b, h) ((4 + (b) * 2 + (h)) * HTB)
#define PG8_STAGE(bufoff, gbase, voff) do { _Pragma("unroll") for (int _i = 0; _i < 2; ++_i) \
        __builtin_amdgcn_global_load_lds((const unsigned*)((const char*)(gbase) + (voff)[_i]), (PG8_LAS unsigned*)(lds + (bufoff) + ldsw + _i * 8192), 16, 0, 0); } while (0)
#define PG8_LDA(dst, b, h) do { _Pragma("unroll") for (int m = 0; m < 4; ++m) _Pragma("unroll") for (int k = 0; k < 2; ++k) dst[m][k] = *(const PG8_LAS bf16x8*)(lds + PG8_SA(b, h) + aoff + m * 2048 + k * 1024); } while (0)
#define PG8_LDB(dst, b, h) do { _Pragma("unroll") for (int n = 0; n < 2; ++n) _Pragma("unroll") for (int k = 0; k < 2; ++k) dst[n][k] = *(const PG8_LAS bf16x8*)(lds + PG8_SB(b, h) + boff + n * 2048 + k * 1024); } while (0)
#define PG8_MMA(ai, bj, At, Bt) do { __builtin_amdgcn_s_setprio(1); _Pragma("unroll") for (int m = 0; m < 4; ++m) _Pragma("unroll") for (int n = 0; n < 2; ++n) _Pragma("unroll") for (int k = 0; k < 2; ++k) \
        acc[ai][bj][m][n] = __builtin_amdgcn_mfma_f32_16x16x32_bf16(Bt[n][k], At[m][k], acc[ai][bj][m][n], 0, 0, 0); __builtin_amdgcn_s_setprio(0); } while (0)
#define PG8_WAIT_V(n) asm volatile("s_waitcnt vmcnt(" #n ")" ::: "memory")
#define PG8_WAIT_L(n) asm volatile("s_waitcnt lgkmcnt(" #n ")" ::: "memory")
#define PG8_BAR __builtin_amdgcn_s_barrier()
#define PG8_SCHED __builtin_amdgcn_sched_barrier(0)
    Unit cur, nxt; int ui = 0;
    if (!S.next(0, cur)) return;
    f32x4 acc[2][2][4][2];
#pragma unroll
    for (int a = 0; a < 2; ++a)
#pragma unroll
        for (int b = 0; b < 2; ++b)
#pragma unroll
            for (int m = 0; m < 4; ++m)
#pragma unroll
                for (int n = 0; n < 2; ++n) acc[a][b][m][n] = (f32x4){0.f, 0.f, 0.f, 0.f};
    bf16x8 At[4][2], B0[2][2], B1[2][2];
    const char* cA = (const char*)g.A + (size_t)cur.pm * tstep; const char* cB = (const char*)g.Bt + (size_t)cur.pn * tstep;
    S.a_ready(cur);
    if constexpr (SP2) {
        PG8_STAGE(PG8_SB(0, 0), cB, voffB); PG8_STAGE(PG8_SB(0, 1), cB + hstep, voffB); PG8_STAGE(PG8_SA(0, 0), cA, voffA); PG8_STAGE(PG8_SA(0, 1), cA + hstep, voffA);
        if (wr == 1) PG8_BAR;
        PG8_WAIT_V(2); PG8_BAR;
        PG8_STAGE(PG8_SB(1, 0), cB + kstep, voffB); PG8_STAGE(PG8_SA(1, 0), cA + kstep, voffA); PG8_STAGE(PG8_SB(1, 1), cB + hstep + kstep, voffB);
        PG8_WAIT_V(6); PG8_BAR;
    } else {
        PG8_STAGE(PG8_SB(0, 0), cB, voffB); PG8_STAGE(PG8_SA(0, 0), cA, voffA); PG8_STAGE(PG8_SB(0, 1), cB + hstep, voffB); PG8_STAGE(PG8_SA(0, 1), cA + hstep, voffA);
        if (wr == 1) PG8_BAR;
        PG8_WAIT_V(4); PG8_BAR;
        PG8_STAGE(PG8_SB(1, 0), cB + kstep, voffB); PG8_STAGE(PG8_SA(1, 0), cA + kstep, voffA); PG8_STAGE(PG8_SB(1, 1), cB + hstep + kstep, voffB);
        PG8_WAIT_V(6); PG8_BAR;
    }
    for (;;) {
        const bool has_next = S.next(ui + 1, nxt);
        const char* nA = has_next ? (const char*)g.A + (size_t)nxt.pm * tstep : cA; const char* nB = has_next ? (const char*)g.Bt + (size_t)nxt.pn * tstep : cB;
        for (int t = 0; t < nt; t += 2) {
            const bool last = (t == nt - 2);
            const char* a1 = cA + (size_t)(t + 1) * kstep;
            const char* a2 = last ? nA : cA + (size_t)(t + 2) * kstep; const char* b2 = last ? nB : cB + (size_t)(t + 2) * kstep;
            const char* a3 = a2 + kstep; const char* b3 = b2 + kstep;
            if (last && has_next) S.a_ready(nxt);
            if constexpr (SP2) {
            PG8_LDB(B0, 0, 0); PG8_LDB(B1, 0, 1); PG8_SCHED; PG8_LDA(At, 0, 0); PG8_STAGE(PG8_SA(1, 1), a1 + hstep, voffA);
            PG8_WAIT_V(8); PG8_WAIT_L(0); PG8_BAR; PG8_MMA(0, 0, At, B0); PG8_MMA(0, 1, At, B1); PG8_BAR; PG8_SCHED;
            PG8_LDA(At, 0, 1); PG8_STAGE(PG8_SB(0, 0), b2, voffB); PG8_STAGE(PG8_SB(0, 1), b2 + hstep, voffB); PG8_STAGE(PG8_SA(0, 0), a2, voffA);
            PG8_WAIT_V(8); PG8_WAIT_L(0); PG8_BAR; PG8_MMA(1, 0, At, B0); PG8_MMA(1, 1, At, B1); PG8_BAR; PG8_SCHED;
            PG8_LDB(B0, 1, 0); PG8_LDB(B1, 1, 1); PG8_SCHED; PG8_LDA(At, 1, 0); PG8_STAGE(PG8_SA(0, 1), a2 + hstep, voffA);
            PG8_WAIT_V(8); PG8_WAIT_L(0); PG8_BAR; PG8_MMA(0, 0, At, B0); PG8_MMA(0, 1, At, B1); PG8_BAR; PG8_SCHED;
            PG8_LDA(At, 1, 1); PG8_STAGE(PG8_SB(1, 0), b3, voffB); PG8_STAGE(PG8_SB(1, 1), b3 + hstep, voffB); PG8_STAGE(PG8_SA(1, 0), a3, voffA);
            PG8_WAIT_V(8); PG8_WAIT_L(0); PG8_BAR; PG8_MMA(1, 0, At, B0); PG8_MMA(1, 1, At, B1); PG8_BAR; PG8_SCHED;
            } else {
            PG8_LDB(B0, 0, 0); PG8_SCHED; PG8_LDA(At, 0, 0); PG8_STAGE(PG8_SA(1, 1), a1 + hstep, voffA);
            PG8_WAIT_L(8); PG8_BAR; PG8_WAIT_L(0); PG8_MMA(0, 0, At, B0); PG8_BAR; PG8_SCHED;
            PG8_LDB(B1, 0, 1); PG8_STAGE(PG8_SB(0, 0), b2, voffB);
            PG8_BAR; PG8_WAIT_L(0); PG8_MMA(0, 1, At, B1); PG8_BAR;
            PG8_LDA(At, 0, 1); PG8_STAGE(PG8_SA(0, 0), a2, voffA);
            PG8_BAR; PG8_WAIT_L(0); PG8_MMA(1, 0, At, B0); PG8_BAR; PG8_SCHED;
            PG8_STAGE(PG8_SB(0, 1), b2 + hstep, voffB);
            PG8_WAIT_V(6); PG8_BAR; PG8_MMA(1, 1, At, B1); PG8_BAR;
            PG8_LDB(B0, 1, 0); PG8_SCHED; PG8_LDA(At, 1, 0); PG8_STAGE(PG8_SA(0, 1), a2 + hstep, voffA);
            PG8_WAIT_L(8); PG8_BAR; PG8_WAIT_L(0); PG8_MMA(0, 0, At, B0); PG8_BAR; PG8_SCHED;
            PG8_LDB(B1, 1, 1); PG8_STAGE(PG8_SB(1, 0), b3, voffB);
            PG8_BAR; PG8_WAIT_L(0); PG8_MMA(0, 1, At, B1); PG8_BAR;
            PG8_LDA(At, 1, 1); PG8_STAGE(PG8_SA(1, 0), a3, voffA);
            PG8_BAR; PG8_WAIT_L(0); PG8_MMA(1, 0, At, B0); PG8_BAR; PG8_SCHED;
            PG8_STAGE(PG8_SB(1, 1), b3 + hstep, voffB);
            PG8_WAIT_V(6); PG8_BAR; PG8_MMA(1, 1, At, B1); PG8_BAR;
            }
        }
        if constexpr (ALIGN_EPI) { if (wr == 0) PG8_BAR; }
        if constexpr (!Epi::AFTER_DRAIN) { E(acc, cur, wr, wc, fr, fq); S.done(cur); }
        if (!has_next) break;
#pragma unroll
        for (int a = 0; a < 2; ++a)
#pragma unroll
            for (int b = 0; b < 2; ++b)
#pragma unroll
                for (int m = 0; m < 4; ++m)
#pragma unroll
                    for (int n = 0; n < 2; ++n) acc[a][b][m][n] = (f32x4){0.f, 0.f, 0.f, 0.f};
        cur = nxt; cA = nA; cB = nB; ++ui;
        if constexpr (ALIGN_EPI) { if (wr == 1) PG8_BAR; }
    }
    PG8_WAIT_V(0);
    if constexpr (!ALIGN_EPI) { if (wr == 0) PG8_BAR; }
    PG8_BAR;
    if constexpr (Epi::AFTER_DRAIN) { E.fused(acc, cur, wr, wc, fr, fq, lds, wid, lane); S.done(cur); }
#undef PG8_SA
#undef PG8_SB
#undef PG8_STAGE
#undef PG8_LDA
#undef PG8_LDB
#undef PG8_MMA
#undef PG8_WAIT_V
#undef PG8_WAIT_L
#undef PG8_BAR
#undef PG8_SCHED
}
}
#define DI __device__ __forceinline__
#define LAS __attribute__((address_space(3)))
typedef unsigned short bf16;
typedef float f32x4 __attribute__((ext_vector_type(4)));
typedef float f32x2 __attribute__((ext_vector_type(2)));
typedef float f32x16 __attribute__((ext_vector_type(16)));
typedef short bf16x8 __attribute__((ext_vector_type(8)));
typedef unsigned u32x4 __attribute__((ext_vector_type(4)));
typedef unsigned u32x2 __attribute__((ext_vector_type(2)));
typedef __bf16 bf16x2_t __attribute__((ext_vector_type(2)));

constexpr int NWAVES = 8, NTHR = 512;
constexpr int BATCH = 2, SEQ = 8192, DM = 1024, DEPTH = 4, M = BATCH * SEQ, NCOL = 5120;
constexpr int NG = 32, NP = 64, NCH = SEQ / 64;
constexpr float EPS = 1e-6f;
constexpr size_t MiB = 1u << 20;
constexpr size_t WS_WIN = 1 * MiB, WS_WGLU = 11 * MiB, WS_WBS = 12 * MiB, WS_WBA = 13 * MiB, WS_WOUT = 14 * MiB;
constexpr size_t WS_H = 16 * MiB;
constexpr size_t WS_U = 48 * MiB, WS_ZS = 64 * MiB, WS_Q = 80 * MiB, WS_K = 96 * MiB, WS_VT = 112 * MiB, WS_ZA = 128 * MiB;
constexpr size_t WS_GS = 144 * MiB, WS_GA = 176 * MiB;
constexpr size_t WS_KTAB = 208 * MiB, KTAB_LSTRIDE = 1280 * 1024;
constexpr size_t WS_WTAB = 213 * MiB, WTAB_LSTRIDE = 2 * MiB;
constexpr size_t WS_VTAB = 221 * MiB, VTAB_LSTRIDE = 2 * MiB;
constexpr size_t WS_S = 229 * MiB, S_LSTRIDE = 4 * MiB;
constexpr size_t WS_LAM = 245 * MiB, LAM_LSTRIDE = 64 * 1024;
constexpr size_t WS_END = 246 * MiB;
constexpr int KTAB_BYTES = 65 * 512;
constexpr int LDS_BYTES = 147456;
constexpr float QSCALE = 0.125f * 1.4426950408889634f;

struct Args {
    const float* x; const float* pre_g; const float* post_g; const float* w_in; const float* a_re; const float* a_im; const float* log_dt;
    const float* b_re; const float* b_im; const float* c_re; const float* c_im; const float* d_skip; const float* w_glu; const float* b_glu;
    const float* w_bs; const float* w_ba; const float* w_out; float* out; unsigned char* ws;
};

DI unsigned cvtpk(float lo, float hi) { f32x2 v = {lo, hi}; bf16x2_t b = __builtin_convertvector(v, bf16x2_t); return __builtin_bit_cast(unsigned, b); }
DI float bflo(unsigned w) { return __uint_as_float(w << 16); }
DI float bfhi(unsigned w) { return __uint_as_float(w & 0xffff0000u); }
DI float bf1(bf16 b) { return __uint_as_float((unsigned)b << 16); }
DI float sigm(float x) { return __builtin_amdgcn_rcpf(1.0f + __expf(-x)); }
DI float silu(float x) { return x * sigm(x); }
DI float gelu_tanh(float x) { const float u = 1.5957691216057308f * (x + 0.044715f * x * x * x); return x * sigm(u); }
DI float wave_sum(float v) {
#pragma unroll
    for (int o = 1; o < 64; o <<= 1) v += __shfl_xor(v, o);
    return v;
}

struct EpiProj {
    static constexpr bool PERM = true, AFTER_DRAIN = false;
    unsigned char* ws;
    DI void operator()(const pg8::f32x4 (&acc)[2][2][4][2], const pg8::Unit& u, int wr, int wc, int fr, int fq) const {
        const int pn = u.pn;
        bf16* base; int ld, colt; float sc = 1.f;
        if (pn < 12) { base = (bf16*)(ws + WS_U + (size_t)(pn >> 1) * (16 * MiB)); ld = 512; colt = (pn & 1) * 256; if ((pn >> 1) == 2) sc = QSCALE; }
        else if (pn < 16) { base = (bf16*)(ws + WS_GS); ld = 1024; colt = (pn - 12) * 256; }
        else { base = (bf16*)(ws + WS_GA); ld = 1024; colt = (pn - 16) * 256; }
        const int row0 = u.pm * 256 + wr * 64 + fr, col0 = colt + wc * 32 + 8 * fq;
        if ((pn >> 1) == 4) {
            bf16* vt = (bf16*)(ws + WS_VT);
#pragma unroll
            for (int ai = 0; ai < 2; ++ai)
#pragma unroll
                for (int m = 0; m < 4; ++m) { const int r = row0 + ai * 128 + m * 16; const int bb = r >> 13, t = r & 8191;
#pragma unroll
                    for (int bj = 0; bj < 2; ++bj) { bf16* p = vt + ((size_t)(bb * 512 + col0 + bj * 128)) * 8192 + t;
#pragma unroll
                        for (int n = 0; n < 2; ++n)
#pragma unroll
                            for (int e = 0; e < 4; ++e) { *p = (bf16)(cvtpk(acc[ai][bj][m][n][e], 0.f) & 0xffffu); p += 8192; asm volatile("" : "+v"(p)); } }
                    __builtin_amdgcn_sched_barrier(0); }
            return;
        }
#pragma unroll
        for (int ai = 0; ai < 2; ++ai)
#pragma unroll
            for (int m = 0; m < 4; ++m) { bf16* rowp = base + (size_t)(row0 + ai * 128 + m * 16) * ld + col0;
#pragma unroll
                for (int bj = 0; bj < 2; ++bj) { const pg8::f32x4 v0 = acc[ai][bj][m][0] * sc, v1 = acc[ai][bj][m][1] * sc;
                    u32x4 w; w.x = cvtpk(v0[0], v0[1]); w.y = cvtpk(v0[2], v0[3]); w.z = cvtpk(v1[0], v1[1]); w.w = cvtpk(v1[2], v1[3]);
                    *(u32x4*)(rowp + bj * 128) = w; } }
    }
};
struct EpiGlu {
    static constexpr bool PERM = true, AFTER_DRAIN = false;
    bf16* zs; const float* bias;
    DI void operator()(const pg8::f32x4 (&acc)[2][2][4][2], const pg8::Unit& u, int wr, int wc, int fr, int fq) const {
        const int row0 = u.pm * 256 + wr * 64 + fr, col0 = u.pn * 128 + wc * 32 + 8 * fq;
        f32x4 ba0 = *(const f32x4*)(bias + col0), ba1 = *(const f32x4*)(bias + col0 + 4), bb0 = *(const f32x4*)(bias + 512 + col0), bb1 = *(const f32x4*)(bias + 512 + col0 + 4);
        u32x4 zv[2][4];
#pragma unroll
        for (int ai = 0; ai < 2; ++ai)
#pragma unroll
            for (int m = 0; m < 4; ++m) zv[ai][m] = *(const u32x4*)(zs + (size_t)(row0 + ai * 128 + m * 16) * 512 + col0);
        __builtin_amdgcn_sched_barrier(0);
#pragma unroll
        for (int ai = 0; ai < 2; ++ai)
#pragma unroll
            for (int m = 0; m < 4; ++m) { bf16* p = zs + (size_t)(row0 + ai * 128 + m * 16) * 512 + col0;
                const u32x4 z = zv[ai][m]; float zf[8] = {bflo(z.x), bfhi(z.x), bflo(z.y), bfhi(z.y), bflo(z.z), bfhi(z.z), bflo(z.w), bfhi(z.w)}; float y[8];
#pragma unroll
                for (int e = 0; e < 4; ++e) { y[e] = (acc[ai][0][m][0][e] + ba0[e]) * sigm(acc[ai][1][m][0][e] + bb0[e]) * silu(zf[e]);
                                              y[4 + e] = (acc[ai][0][m][1][e] + ba1[e]) * sigm(acc[ai][1][m][1][e] + bb1[e]) * silu(zf[4 + e]); }
                u32x4 w; w.x = cvtpk(y[0], y[1]); w.y = cvtpk(y[2], y[3]); w.z = cvtpk(y[4], y[5]); w.w = cvtpk(y[6], y[7]); *(u32x4*)p = w; }
    }
};
template <int PASS> struct EpiBranch {
    static constexpr bool PERM = true, AFTER_DRAIN = false;
    bf16* G; const bf16* gate2;
    DI void operator()(const pg8::f32x4 (&acc)[2][2][4][2], const pg8::Unit& u, int wr, int wc, int fr, int fq) const {
        const int row0 = u.pm * 256 + wr * 64 + fr, col0 = u.pn * 256 + wc * 32 + 8 * fq;
#pragma unroll
        for (int ai = 0; ai < 2; ++ai) {
            u32x4 gv[4][2], hv[4][2];
#pragma unroll
            for (int m = 0; m < 4; ++m)
#pragma unroll
                for (int bj = 0; bj < 2; ++bj) { const size_t off = (size_t)(row0 + ai * 128 + m * 16) * 1024 + col0 + bj * 128; gv[m][bj] = *(const u32x4*)(G + off); if (PASS == 1) hv[m][bj] = *(const u32x4*)(gate2 + off); }
            __builtin_amdgcn_sched_barrier(0);
#pragma unroll
            for (int m = 0; m < 4; ++m)
#pragma unroll
                for (int bj = 0; bj < 2; ++bj) { const size_t off = (size_t)(row0 + ai * 128 + m * 16) * 1024 + col0 + bj * 128;
                    const u32x4 g = gv[m][bj]; float gf[8] = {bflo(g.x), bfhi(g.x), bflo(g.y), bfhi(g.y), bflo(g.z), bfhi(g.z), bflo(g.w), bfhi(g.w)}; float y[8];
                    if (PASS == 0) {
#pragma unroll
                        for (int e = 0; e < 4; ++e) { y[e] = sigm(gf[e]) * acc[ai][bj][m][0][e]; y[4 + e] = sigm(gf[4 + e]) * acc[ai][bj][m][1][e]; }
                    } else {
                        const u32x4 h = hv[m][bj]; float hf[8] = {bflo(h.x), bfhi(h.x), bflo(h.y), bfhi(h.y), bflo(h.z), bfhi(h.z), bflo(h.w), bfhi(h.w)};
#pragma unroll
                        for (int e = 0; e < 4; ++e) { y[e] = gf[e] + sigm(hf[e]) * acc[ai][bj][m][0][e]; y[4 + e] = gf[4 + e] + sigm(hf[4 + e]) * acc[ai][bj][m][1][e]; }
                    }
                    u32x4 w; w.x = cvtpk(y[0], y[1]); w.y = cvtpk(y[2], y[3]); w.z = cvtpk(y[4], y[5]); w.w = cvtpk(y[6], y[7]); *(u32x4*)(G + off) = w; }
            __builtin_amdgcn_sched_barrier(0);
        }
    }
};
struct EpiPlain {
    static constexpr bool PERM = true, AFTER_DRAIN = false;
    bf16* O;
    DI void operator()(const pg8::f32x4 (&acc)[2][2][4][2], const pg8::Unit& u, int wr, int wc, int fr, int fq) const {
        const int row0 = u.pm * 256 + wr * 64 + fr, col0 = u.pn * 256 + wc * 32 + 8 * fq;
#pragma unroll
        for (int ai = 0; ai < 2; ++ai)
#pragma unroll
            for (int m = 0; m < 4; ++m)
#pragma unroll
                for (int bj = 0; bj < 2; ++bj) { const pg8::f32x4 v0 = acc[ai][bj][m][0], v1 = acc[ai][bj][m][1];
                    u32x4 w; w.x = cvtpk(v0[0], v0[1]); w.y = cvtpk(v0[2], v0[3]); w.z = cvtpk(v1[0], v1[1]); w.w = cvtpk(v1[2], v1[3]);
                    *(u32x4*)(O + (size_t)(row0 + ai * 128 + m * 16) * 1024 + col0 + bj * 128) = w; }
    }
};

DI void norm_row(const float* xin, const bf16* o, const float* g_post, float* xout, const float* g_pre, bf16* h, int lane) {
    f32x4 v[4];
#pragma unroll
    for (int j = 0; j < 4; ++j) v[j] = *((const f32x4*)xin + lane + 64 * j);
    if (o) {
        f32x4 ov[4]; float ss = 0.f;
#pragma unroll
        for (int j = 0; j < 4; ++j) { const u32x2 w = *((const u32x2*)o + lane + 64 * j); ov[j] = (f32x4){bflo(w.x), bfhi(w.x), bflo(w.y), bfhi(w.y)};
            ss += (ov[j].x * ov[j].x + ov[j].y * ov[j].y) + (ov[j].z * ov[j].z + ov[j].w * ov[j].w); }
        const float rstd = 1.0f / sqrtf(wave_sum(ss) * (1.0f / DM) + EPS);
#pragma unroll
        for (int j = 0; j < 4; ++j) { const f32x4 g = *((const f32x4*)g_post + lane + 64 * j); v[j] = v[j] + ov[j] * rstd * g; *((f32x4*)xout + lane + 64 * j) = v[j]; }
    }
    if (g_pre) {
        float ss = 0.f;
#pragma unroll
        for (int j = 0; j < 4; ++j) ss += (v[j].x * v[j].x + v[j].y * v[j].y) + (v[j].z * v[j].z + v[j].w * v[j].w);
        const float rstd = 1.0f / sqrtf(wave_sum(ss) * (1.0f / DM) + EPS);
#pragma unroll
        for (int j = 0; j < 4; ++j) { const f32x4 g = *((const f32x4*)g_pre + lane + 64 * j); const f32x4 y = v[j] * rstd * g;
            u32x2 w; w.x = cvtpk(y.x, y.y); w.y = cvtpk(y.z, y.w); *((u32x2*)h + lane + 64 * j) = w; }
    }
}
DI void transpose_item(const float* W, int K, int N, bf16* WT, int k0, int n0, int dst_row0, LAS float* scr, int lane) {
#pragma unroll 8
    for (int i = 0; i < 32; ++i) { const int kk = 2 * i + (lane >> 5); scr[kk * 33 + (lane & 31)] = W[(size_t)(k0 + kk) * N + n0 + (lane & 31)]; }
    asm volatile("s_waitcnt lgkmcnt(0)" ::: "memory");
    const int c = lane & 7;
#pragma unroll
    for (int j = 0; j < 4; ++j) { const int n = (lane >> 3) + 8 * j; const LAS float* s = scr + (8 * c) * 33 + n;
        u32x4 o; o.x = cvtpk(s[0 * 33], s[1 * 33]); o.y = cvtpk(s[2 * 33], s[3 * 33]); o.z = cvtpk(s[4 * 33], s[5 * 33]); o.w = cvtpk(s[6 * 33], s[7 * 33]);
        *(u32x4*)(WT + (size_t)(dst_row0 + n) * K + k0 + 8 * c) = o; }
    asm volatile("s_waitcnt lgkmcnt(0)" ::: "memory");
}
DI f32x2 cpow_k(float are, float aim, float dt, int k) {
    const float mag = __expf(are * dt * (float)k);
    const double turns = (double)aim * (double)dt * (double)k * 0.15915494309189535;
    const float fr = (float)(turns - floor(turns));
    return (f32x2){mag * __builtin_amdgcn_cosf(fr), mag * __builtin_amdgcn_sinf(fr)};
}
DI f32x2 cmul(f32x2 a, f32x2 b) { return (f32x2){a.x * b.x - a.y * b.y, a.x * b.y + a.y * b.x}; }
DI f32x2 zoh_factor(float are, float aim, float dt) {
    const f32x2 ab = cpow_k(are, aim, dt, 1); const float nr = ab.x - 1.0f, ni = ab.y, den = are * are + aim * aim;
    return (f32x2){(nr * are + ni * aim) / den, (ni * are - nr * aim) / den};
}

struct LayerP { const float *a_re, *a_im, *log_dt, *b_re, *b_im, *c_re, *c_im; };

DI void ktab_block(const LayerP& P, bf16* KTAB, int g, int tb, LAS unsigned char* lds, int tid) {
    LAS f32x2* CL = (LAS f32x2*)lds;
    LAS f32x2* BB = (LAS f32x2*)(lds + 16384);
    const float dt = __expf(P.log_dt[g]);
    const int p = tid & 63, h0 = tid >> 6, h1 = h0 + 8;
    const float are = P.a_re[g * 64 + p], aim = P.a_im[g * 64 + p];
    const f32x2 c0 = {P.c_re[(g * 16 + h0) * 64 + p], P.c_im[(g * 16 + h0) * 64 + p]}, c1 = {P.c_re[(g * 16 + h1) * 64 + p], P.c_im[(g * 16 + h1) * 64 + p]};
    const int e0 = tid, e1 = tid + NTHR; const int pa = e0 >> 4, pb = e1 >> 4, hp = tid & 15;
    const float area = P.a_re[g * 64 + pa], aima = P.a_im[g * 64 + pa], areb = P.a_re[g * 64 + pb], aimb = P.a_im[g * 64 + pb];
    const f32x2 bva = {P.b_re[(g * 64 + pa) * 16 + hp], P.b_im[(g * 64 + pa) * 16 + hp]}, bvb = {P.b_re[(g * 64 + pb) * 16 + hp], P.b_im[(g * 64 + pb) * 16 + hp]};
    BB[pa * 16 + hp] = cmul(zoh_factor(area, aima, dt), bva); BB[pb * 16 + hp] = cmul(zoh_factor(areb, aimb, dt), bvb);
    if (tb == 0 && tid < 256) KTAB[((size_t)g * 65) * 256 + tid] = 0;
#pragma unroll 1
    for (int tp = 0; tp < 4; ++tp) { const int tau0 = tb * 8 + 2 * tp;
        const f32x2 l0 = cpow_k(are, aim, dt, tau0), l1 = cpow_k(are, aim, dt, tau0 + 1);
        CL[(0 * 16 + h0) * 64 + p] = cmul(c0, l0); CL[(0 * 16 + h1) * 64 + p] = cmul(c1, l0); CL[(1 * 16 + h0) * 64 + p] = cmul(c0, l1); CL[(1 * 16 + h1) * 64 + p] = cmul(c1, l1);
        __syncthreads();
        { const int ts = tid >> 8, h = (tid >> 4) & 15; float sacc = 0.f;
#pragma unroll 8
          for (int q = 0; q < 64; ++q) { const f32x2 c = CL[(ts * 16 + h) * 64 + q], bq = BB[q * 16 + hp]; sacc += c.x * bq.x - c.y * bq.y; }
          KTAB[((size_t)g * 65 + (tau0 + ts + 1)) * 256 + h * 16 + hp] = (bf16)(cvtpk(sacc, 0.f) & 0xffffu); }
        __syncthreads();
    }
}
DI void wv_item(const LayerP& P, bf16* WTAB, bf16* VTAB, float* LAM, int idx) {
    const int p = idx & 63, k = (idx >> 6) & 15, g = idx >> 10;
    const float dt = __expf(P.log_dt[g]), are = P.a_re[g * 64 + p], aim = P.a_im[g * 64 + p];
    f32x2 cv[16];
#pragma unroll
    for (int j = 0; j < 16; ++j) cv[j] = (f32x2){P.c_re[(g * 16 + j) * 64 + p], P.c_im[(g * 16 + j) * 64 + p]};
    const f32x2 lk1 = cpow_k(are, aim, dt, k + 1);
#pragma unroll
    for (int h = 0; h < 16; ++h) { const f32x2 c = cmul(cv[h], lk1); *(unsigned*)(VTAB + ((size_t)g * 256 + k * 16 + h) * 128 + 2 * p) = cvtpk(c.x, -c.y); }
    if (k == 15) { const f32x2 l64 = cpow_k(are, aim, dt, 64); *(f32x4*)(LAM + (g * 64 + p) * 4) = (f32x4){l64.x, l64.y, lk1.x, lk1.y}; }
}

#define MFMA16(a, b, c) __builtin_amdgcn_mfma_f32_16x16x32_bf16((a), (b), (c), 0, 0, 0)
#define MFMA32(a, b, c) __builtin_amdgcn_mfma_f32_32x32x16_bf16((a), (b), (c), 0, 0, 0)
DI void make_wfrag(const LayerP& P, int g, int wave, int lane, bf16x8 (&af)[8], f32x2& l16a, f32x2& l16b) {
    const int n = lane & 15, kg = lane >> 4, p = 8 * wave + (n >> 1), ri = n & 1;
    const float dt = __expf(P.log_dt[g]), are = P.a_re[g * 64 + p], aim = P.a_im[g * 64 + p];
    const int pa = 8 * wave + 2 * kg;
    const float area = P.a_re[g * 64 + pa], aima = P.a_im[g * 64 + pa], areb = P.a_re[g * 64 + pa + 1], aimb = P.a_im[g * 64 + pa + 1];
    const f32x4 br0 = *(const f32x4*)(P.b_re + (g * 64 + p) * 16 + 8 * (kg & 1)), br1 = *(const f32x4*)(P.b_re + (g * 64 + p) * 16 + 8 * (kg & 1) + 4);
    const f32x4 bi0 = *(const f32x4*)(P.b_im + (g * 64 + p) * 16 + 8 * (kg & 1)), bi1 = *(const f32x4*)(P.b_im + (g * 64 + p) * 16 + 8 * (kg & 1) + 4);
    const f32x2 f = zoh_factor(are, aim, dt);
    f32x2 fb[8];
#pragma unroll
    for (int i = 0; i < 4; ++i) { fb[i] = cmul(f, (f32x2){br0[i], bi0[i]}); fb[4 + i] = cmul(f, (f32x2){br1[i], bi1[i]}); }
#pragma unroll
    for (int ks = 0; ks < 8; ++ks) { const f32x2 lp = cpow_k(are, aim, dt, 15 - 2 * ks - (kg >> 1)); float v[8];
#pragma unroll
        for (int i = 0; i < 8; ++i) { const f32x2 c = cmul(lp, fb[i]); v[i] = ri ? c.y : c.x; }
        const u32x4 w = {cvtpk(v[0], v[1]), cvtpk(v[2], v[3]), cvtpk(v[4], v[5]), cvtpk(v[6], v[7])}; af[ks] = __builtin_bit_cast(bf16x8, w); }
    l16a = cpow_k(area, aima, dt, 16); l16b = cpow_k(areb, aimb, dt, 16);
}
DI void ssm_state_unit(const bf16* U, const bf16x8 (&af)[8], f32x2 l16a, f32x2 l16b, float* S, int b, int g, int cb, int wave, int lane) {
    const int n = lane & 15, kg = lane >> 4;
    const bf16* up = U + ((size_t)b * SEQ + (size_t)(cb * 16 + n) * 64 + (kg >> 1)) * 512 + g * 16 + 8 * (kg & 1);
    bf16x8 uf[4][8];
#pragma unroll
    for (int a = 0; a < 4; ++a)
#pragma unroll
        for (int ks = 0; ks < 8; ++ks) uf[a][ks] = *(const bf16x8*)(up + (size_t)(16 * a + 2 * ks) * 512);
    __builtin_amdgcn_sched_barrier(0);
    pg8::f32x4 acc4[4];
#pragma unroll
    for (int a = 0; a < 4; ++a) acc4[a] = (pg8::f32x4){0.f, 0.f, 0.f, 0.f};
#pragma unroll
    for (int ks = 0; ks < 8; ++ks)
#pragma unroll
        for (int a = 0; a < 4; ++a) acc4[a] = MFMA16(af[ks], uf[a][ks], acc4[a]);
    __builtin_amdgcn_sched_barrier(0);
    pg8::f32x4 st = acc4[0];
#pragma unroll
    for (int a = 1; a < 4; ++a) {
        const f32x2 s0 = cmul(l16a, (f32x2){st[0], st[1]}), s1 = cmul(l16b, (f32x2){st[2], st[3]});
        st = (pg8::f32x4){s0.x + acc4[a][0], s0.y + acc4[a][1], s1.x + acc4[a][2], s1.y + acc4[a][3]};
    }
    *(pg8::f32x4*)(S + (((size_t)b * NCH + cb * 16 + n) * NG + g) * 128 + 16 * wave + 4 * kg) = st;
}
constexpr int XIN_OFF = 33280, XIN_PITCH = 272, XIN_VAR = 16 * XIN_PITCH, TB_OFF = XIN_OFF + 4 * XIN_VAR, UL_OFF = 57344, UL_PITCH = 2064;
template <int S> DI void toe_stage(pg8::f32x4 (&acc)[8], const LAS unsigned char* ul, const LAS unsigned char* kt, int wave, int lo, int hi) {
#pragma unroll 1
    for (int ks = lo; ks <= hi; ++ks) {
        const bf16x8 uf0 = *(const LAS bf16x8*)(ul + ks * 64);
        bf16x8 a0[8 - S];
#pragma unroll
        for (int j = S; j < 8; ++j) a0[j - S] = *(const LAS bf16x8*)(kt + (wave + 8 * j - 2 * ks) * 512);
        __builtin_amdgcn_sched_barrier(0);
#pragma unroll
        for (int j = S; j < 8; ++j) acc[j] = MFMA16(a0[j - S], uf0, acc[j]);
    }
}
#ifdef PROBE_SEL
#define QS(sel) do { if (PROBE_SEL == (sel)) tq0 = __builtin_amdgcn_s_memrealtime(); } while (0)
#define QT(sel) do { if (PROBE_SEL == (sel)) tqacc += __builtin_amdgcn_s_memrealtime() - tq0; } while (0)
#else
#define QS(sel) do {} while (0)
#define QT(sel) do {} while (0)
#endif
DI void ssm_out_unit(unsigned long long& tqacc, bool load_ktab, const bf16* U, const bf16* KTAB, const bf16* VTAB, const float* S, const float* LAM, const float* dsk, bf16* YS, int b, int g, int cb, LAS unsigned char* lds, int tid, int wave, int lane) {
    unsigned long long tq0 = 0ull; (void)tq0;
    const int n = lane & 15, kg = lane >> 4;
    QS(51);
    const f32x4 lam4 = *(const f32x4*)(LAM + (g * 64 + lane) * 4); const f32x2 lam = {lam4.x, lam4.y}, l16 = {lam4.z, lam4.w};
    f32x2 sv[16];
    {
        const u32x4* src = (const u32x4*)((const unsigned char*)KTAB + (size_t)g * KTAB_BYTES);
        u32x4 kt4[4], kt5 = {0u, 0u, 0u, 0u}, ut4[4];
        if (load_ktab) {
#pragma unroll
            for (int j = 0; j < 4; ++j) kt4[j] = src[tid + NTHR * j];
            if (tid < 32) kt5 = src[2048 + tid];
        }
#pragma unroll
        for (int j = 0; j < 4; ++j) { const int idx = tid + NTHR * j, cn = idx >> 7, tok = (idx >> 1) & 63, half = idx & 1;
            ut4[j] = *(const u32x4*)(U + ((size_t)b * SEQ + (size_t)(cb * 16 + cn) * 64 + tok) * 512 + g * 16 + 8 * half); }
        if (wave <= cb) { const f32x2* sp = (const f32x2*)(S + (((size_t)b * NCH + wave * 16) * NG + g) * 128) + lane;
#pragma unroll
            for (int j = 0; j < 16; ++j) sv[j] = sp[(size_t)j * (NG * 64)]; }
        __builtin_amdgcn_sched_barrier(0);
        if (load_ktab) {
#pragma unroll
            for (int j = 0; j < 4; ++j) *(LAS u32x4*)(lds + 16 * (tid + NTHR * j)) = kt4[j];
            if (tid < 32) *(LAS u32x4*)(lds + 16 * (2048 + tid)) = kt5;
        }
#pragma unroll
        for (int j = 0; j < 4; ++j) { const int idx = tid + NTHR * j, cn = idx >> 7, tok = (idx >> 1) & 63, half = idx & 1; *(LAS u32x4*)(lds + UL_OFF + cn * UL_PITCH + tok * 32 + half * 16) = ut4[j]; }
    }
    bf16x8 vfr[4][2];
#pragma unroll
    for (int k2 = 0; k2 < 4; ++k2)
#pragma unroll
        for (int jj = 0; jj < 2; ++jj) vfr[k2][jj] = *(const bf16x8*)(VTAB + ((size_t)g * 256 + (wave + 8 * jj) * 16 + n) * 128 + 32 * k2 + 8 * kg);
    __builtin_amdgcn_sched_barrier(0);
    LAS f32x2* TB = (LAS f32x2*)(lds + TB_OFF);
    if (wave < cb) { f32x2 x = {0.f, 0.f};
#pragma unroll
        for (int j = 0; j < 16; ++j) { x = cmul(lam, x); x.x += sv[j].x; x.y += sv[j].y; }
        TB[wave * 64 + lane] = x; }
    __syncthreads();
    if (wave == cb) {
        f32x2 l1k = lam;
#pragma unroll
        for (int j = 0; j < 4; ++j) l1k = cmul(l1k, l1k);
        f32x2 x = {0.f, 0.f};
        for (int w = 0; w < cb; ++w) { const f32x2 t = TB[w * 64 + lane]; x = cmul(l1k, x); x.x += t.x; x.y += t.y; }
#pragma unroll
        for (int j = 0; j < 16; ++j) { f32x2 xa = x;
#pragma unroll
            for (int a = 0; a < 4; ++a) { *(LAS unsigned*)(lds + XIN_OFF + a * XIN_VAR + j * XIN_PITCH + 4 * lane) = cvtpk(xa.x, xa.y); xa = cmul(l16, xa); }
            x = cmul(lam, x); x.x += sv[j].x; x.y += sv[j].y; }
    }
    __syncthreads();
    QT(51); QS(52);
    pg8::f32x4 acc[8];
#pragma unroll
    for (int j = 0; j < 8; ++j) acc[j] = (pg8::f32x4){0.f, 0.f, 0.f, 0.f};
    const LAS unsigned char* ul = lds + UL_OFF + n * UL_PITCH + (kg >> 1) * 32 + (kg & 1) * 16;
    const LAS unsigned char* kt = lds + n * 32 + (kg & 1) * 16 + (1 - (kg >> 1)) * 512;
    { const int hw = wave >> 1;
      toe_stage<0>(acc, ul, kt, wave, 0, hw);            toe_stage<1>(acc, ul, kt, wave, hw + 1, hw + 4);   toe_stage<2>(acc, ul, kt, wave, hw + 5, hw + 8);   toe_stage<3>(acc, ul, kt, wave, hw + 9, hw + 12);
      toe_stage<4>(acc, ul, kt, wave, hw + 13, hw + 16); toe_stage<5>(acc, ul, kt, wave, hw + 17, hw + 20); toe_stage<6>(acc, ul, kt, wave, hw + 21, hw + 24); toe_stage<7>(acc, ul, kt, wave, hw + 25, hw + 28); }
#pragma unroll
    for (int k2 = 0; k2 < 4; ++k2) {
        bf16x8 xf[4];
#pragma unroll
        for (int a = 0; a < 4; ++a) xf[a] = *(const LAS bf16x8*)(lds + XIN_OFF + a * XIN_VAR + n * XIN_PITCH + (32 * k2 + 8 * kg) * 2);
#pragma unroll
        for (int j = 0; j < 8; ++j) acc[j] = MFMA16(vfr[k2][j & 1], xf[j >> 1], acc[j]); }
    QT(52); QS(53);
    const f32x4 dv = *(const f32x4*)(dsk + g * 16 + 4 * kg);
#pragma unroll
    for (int j = 0; j < 8; ++j) { const int t = wave + 8 * j; const size_t off = ((size_t)b * SEQ + (size_t)(cb * 16 + n) * 64 + t) * 512 + g * 16 + 4 * kg;
        const u32x2 uu = *(const LAS u32x2*)(lds + UL_OFF + n * UL_PITCH + t * 32 + kg * 8);
        const float y0 = gelu_tanh(acc[j][0] + dv[0] * bflo(uu.x)), y1 = gelu_tanh(acc[j][1] + dv[1] * bfhi(uu.x)), y2 = gelu_tanh(acc[j][2] + dv[2] * bflo(uu.y)), y3 = gelu_tanh(acc[j][3] + dv[3] * bfhi(uu.y));
        u32x2 w; w.x = cvtpk(y0, y1); w.y = cvtpk(y2, y3); *(u32x2*)(YS + off) = w; }
    asm volatile("s_waitcnt lgkmcnt(0)\n\ts_barrier" ::: "memory");
    QT(53);
}

struct AttnSt { f32x16 o0, o1; float carry; };
DI bool attn_tile(AttnSt& st, const bf16x8 (&kf)[4], const bf16x8 (&vf)[4], const bf16x8 (&qf)[4], bool diag, int n, int hi) {
    f32x16 s;
#pragma unroll
    for (int r = 0; r < 16; ++r) s[r] = 0.f;
#pragma unroll
    for (int ks = 0; ks < 4; ++ks) s = MFMA32(kf[ks], qf[ks], s);
    float sp[16];
#pragma unroll
    for (int r = 0; r < 16; ++r) { const float z = s[r]; const float e = __builtin_amdgcn_exp2f(-fabsf(z)); sp[r] = fmaxf(z, 0.f) + __builtin_amdgcn_logf(1.0f + e);
        if (diag && (16 * (r >> 3) + 8 * hi + (r & 7)) >= n) sp[r] = 0.f; }
    float cum[16]; float c0 = 0.f, c1 = 0.f;
#pragma unroll
    for (int r = 7; r >= 0; --r) { c0 -= sp[r]; cum[r] = c0; c1 -= sp[8 + r]; cum[8 + r] = c1; }
    const float p0 = __shfl_xor(c0, 32), p1 = __shfl_xor(c1, 32);
    const float base1 = st.carry + (hi ? 0.f : p1), base0 = st.carry + c1 + p1 + (hi ? 0.f : p0);
    float w[16];
#pragma unroll
    for (int r = 0; r < 16; ++r) { w[r] = __builtin_amdgcn_exp2f(s[r] + cum[r] + (r < 8 ? base0 : base1));
        if (diag && (16 * (r >> 3) + 8 * hi + (r & 7)) >= n) w[r] = 0.f; }
    st.carry += (c0 + c1) + (p0 + p1);
    const u32x4 pa = {cvtpk(w[0], w[1]), cvtpk(w[2], w[3]), cvtpk(w[4], w[5]), cvtpk(w[6], w[7])}, pb = {cvtpk(w[8], w[9]), cvtpk(w[10], w[11]), cvtpk(w[12], w[13]), cvtpk(w[14], w[15])};
    const bf16x8 pf0 = __builtin_bit_cast(bf16x8, pa), pf1 = __builtin_bit_cast(bf16x8, pb);
    st.o0 = MFMA32(pf0, vf[0], st.o0); st.o0 = MFMA32(pf1, vf[1], st.o0); st.o1 = MFMA32(pf0, vf[2], st.o1); st.o1 = MFMA32(pf1, vf[3], st.o1);
    return __ballot(st.carry >= -152.0f) == 0ull;
}
DI void attn_task(const bf16* Q, const bf16* Kb, const bf16* VT, const bf16* ZA, bf16* Y, int b, int h, int qt, int lane) {
    const int n = lane & 31, hi = lane >> 5;
    const size_t rowbase = (size_t)b * SEQ;
    bf16x8 qf[4];
    { const bf16* qp = Q + (rowbase + qt * 32 + n) * 512 + h * 64 + 8 * hi;
#pragma unroll
      for (int ks = 0; ks < 4; ++ks) qf[ks] = *(const bf16x8*)(qp + 16 * ks); }
    const int pm = (n & ~12) | (((n >> 2) & 1) << 3) | (((n >> 3) & 1) << 2);
    const bf16* kp = Kb + (rowbase + pm) * 512 + h * 64 + 8 * hi;
    const bf16* vp = VT + ((size_t)(b * 8 + h) * 64 + n) * SEQ + 8 * hi;
    AttnSt st;
#pragma unroll
    for (int r = 0; r < 16; ++r) { st.o0[r] = 0.f; st.o1[r] = 0.f; }
    st.carry = 0.f;
    bf16x8 kA[4], vA[4], kB[4], vB[4], kC[4], vC[4];
#define ATT_LOAD(KF, VF, ktile) do { const int key0_ = ((ktile) > 0 ? (ktile) : 0) * 32; \
        _Pragma("unroll") for (int ks = 0; ks < 4; ++ks) KF[ks] = *(const bf16x8*)(kp + (size_t)key0_ * 512 + 16 * ks); \
        VF[0] = *(const bf16x8*)(vp + key0_); VF[1] = *(const bf16x8*)(vp + key0_ + 16); VF[2] = *(const bf16x8*)(vp + (size_t)32 * SEQ + key0_); VF[3] = *(const bf16x8*)(vp + (size_t)32 * SEQ + key0_ + 16); } while (0)
    ATT_LOAD(kA, vA, qt); ATT_LOAD(kB, vB, qt - 1);
    int kt = qt;
    for (;;) {
        ATT_LOAD(kC, vC, kt - 2); __builtin_amdgcn_sched_barrier(0);
        if (attn_tile(st, kA, vA, qf, kt == qt, n, hi) || kt == 0) break; --kt; __builtin_amdgcn_sched_barrier(0);
        ATT_LOAD(kA, vA, kt - 2); __builtin_amdgcn_sched_barrier(0);
        if (attn_tile(st, kB, vB, qf, false, n, hi) || kt == 0) break; --kt; __builtin_amdgcn_sched_barrier(0);
        ATT_LOAD(kB, vB, kt - 2); __builtin_amdgcn_sched_barrier(0);
        if (attn_tile(st, kC, vC, qf, false, n, hi) || kt == 0) break; --kt; __builtin_amdgcn_sched_barrier(0);
    }
#undef ATT_LOAD
    float za0[16], za1[16];
#pragma unroll
    for (int r = 0; r < 16; ++r) { const int i = (r & 3) + 8 * (r >> 2) + 4 * hi; const size_t off = (rowbase + qt * 32 + i) * 512 + h * 64 + n; za0[r] = bf1(ZA[off]); za1[r] = bf1(ZA[off + 32]); }
    __builtin_amdgcn_sched_barrier(0);
#pragma unroll
    for (int r = 0; r < 16; ++r) { const int i = (r & 3) + 8 * (r >> 2) + 4 * hi; const size_t off = (rowbase + qt * 32 + i) * 512 + h * 64 + n;
        Y[off] = (bf16)(cvtpk(st.o0[r] * silu(za0[r]), 0.f) & 0xffffu); Y[off + 32] = (bf16)(cvtpk(st.o1[r] * silu(za1[r]), 0.f) & 0xffffu); }
}
#define XB_TMO      128
#define XB_XCNT(j)  (256  + 64 * (j))
#define XB_XSUB(j)  (1280 + 64 * (j))
#define XB_XGEN(j)  (2304 + 64 * (j))
#define XB_TOP      3328
#define XB_TOPGEN   3392
#define XCD_BAR_WORDS 3456
#define XB_SPIN_CAP (1u << 18)

__device__ __forceinline__ unsigned xb_ld(unsigned* p)              { return __hip_atomic_load(p, __ATOMIC_RELAXED, __HIP_MEMORY_SCOPE_AGENT); }
__device__ __forceinline__ unsigned xb_add(unsigned* p, unsigned v) { return __hip_atomic_fetch_add(p, v, __ATOMIC_RELAXED, __HIP_MEMORY_SCOPE_AGENT); }
__device__ __forceinline__ unsigned xb_xcc_id() { return (unsigned)__builtin_amdgcn_s_getreg((3 << 11) | 20) & 0xFu; }
#define XB_SPIN(cond, bar) do { unsigned _sp = 0; while (cond) { __builtin_amdgcn_s_sleep(1); \
    if ((++_sp & 255u) == 0u) { if (xb_ld(&(bar)[XB_TMO])) break; if (_sp > XB_SPIN_CAP) { atomicAdd(&(bar)[XB_TMO], 1u); break; } } } } while (0)

struct XcdBarrier {
    unsigned* bar; unsigned x;
    volatile LAS unsigned* st;
};

__device__ __forceinline__ XcdBarrier xcd_barrier_post(unsigned* bar, volatile LAS unsigned* st) {
    XcdBarrier b; b.bar = bar; b.x = xb_xcc_id(); b.st = st;
    if (threadIdx.x == 0) (void)xb_add(&bar[XB_XCNT(b.x)], 1u);
    return b;
}
__device__ __forceinline__ void xcd_barrier_complete(unsigned* bar, unsigned x, unsigned& nloc, unsigned& nx) {
    const unsigned G = gridDim.x * gridDim.y * gridDim.z;
    unsigned sum, cnt, mine, sp = 0u;
    for (;;) {
        sum = 0u; cnt = 0u; mine = 0u;
#pragma unroll
        for (unsigned j = 0; j < 16; ++j) { const unsigned c = xb_ld(&bar[XB_XCNT(j)]); sum += c; cnt += (c > 0u) ? 1u : 0u; mine = (j == x) ? c : mine; }
        if (sum == G) break;
        __builtin_amdgcn_s_sleep(1);
        if ((++sp & 255u) == 0u) { if (xb_ld(&bar[XB_TMO])) break; if (sp > XB_SPIN_CAP) { atomicAdd(&bar[XB_TMO], 1u); break; } }
    }
    nloc = mine > 0u ? mine : 1u; nx = cnt > 0u ? cnt : 1u;
}

__device__ __forceinline__ void xcd_barrier(const XcdBarrier& b) {
    asm volatile("s_waitcnt vmcnt(0)" ::: "memory");
    __syncthreads();
    if (threadIdx.x == 0) {
        unsigned* bar = b.bar;
        __builtin_amdgcn_s_waitcnt(0);
        unsigned nloc = b.st[0], nx = b.st[1];
        if (nloc == 0u) { xcd_barrier_complete(bar, b.x, nloc, nx); b.st[0] = nloc; b.st[1] = nx; }
        const unsigned old = xb_add(&bar[XB_XSUB(b.x)], 1u);
        const unsigned gen = old / nloc;
        if (old + 1u == (gen + 1u) * nloc) {
            __builtin_amdgcn_fence(__ATOMIC_RELEASE, "agent");
            asm volatile("s_waitcnt vmcnt(0)" ::: "memory");
            const unsigned og = xb_add(&bar[XB_TOP], 1u);
            const unsigned tg = og / nx;
            if (og + 1u == (tg + 1u) * nx) xb_add(&bar[XB_TOPGEN], 1u);
            else XB_SPIN(xb_ld(&bar[XB_TOPGEN]) == tg, bar);
            __builtin_amdgcn_fence(__ATOMIC_ACQUIRE, "agent");
            xb_add(&bar[XB_XGEN(b.x)], 1u);
            asm volatile("s_waitcnt vmcnt(0)" ::: "memory");
        } else {
            XB_SPIN(xb_ld(&bar[XB_XGEN(b.x)]) == gen, bar);
            __builtin_amdgcn_fence(__ATOMIC_ACQUIRE, "agent");
            asm volatile("s_waitcnt vmcnt(0)" ::: "memory");
        }
    }
    __syncthreads();
}

__device__ __forceinline__ void xcd_barrier1(const XcdBarrier& b) {
    asm volatile("s_waitcnt vmcnt(0)" ::: "memory");
    __syncthreads();
    if (threadIdx.x == 0) {
        unsigned* bar = b.bar;
        __builtin_amdgcn_s_waitcnt(0);
        unsigned nloc = b.st[0], nx = b.st[1];
        if (nloc == 0u) { xcd_barrier_complete(bar, b.x, nloc, nx); b.st[0] = nloc; b.st[1] = nx; }
        const unsigned k = b.st[2]; b.st[2] = k + 1u;
        const unsigned old = xb_add(&bar[XB_XSUB(b.x)], 1u);
        const unsigned gen = old / nloc;
        if (old + 1u == (gen + 1u) * nloc) {
            __builtin_amdgcn_fence(__ATOMIC_RELEASE, "agent");
            asm volatile("s_waitcnt vmcnt(0)" ::: "memory");
            const unsigned og = xb_add(&bar[XB_TOP], 1u);
            if (og + 1u == (k + 1u) * nx) xb_add(&bar[XB_TOPGEN], 1u);
            else XB_SPIN(xb_ld(&bar[XB_TOPGEN]) == k, bar);
        } else {
            XB_SPIN(xb_ld(&bar[XB_TOPGEN]) == k, bar);
        }
        __builtin_amdgcn_fence(__ATOMIC_ACQUIRE, "agent");
        asm volatile("s_waitcnt vmcnt(0)" ::: "memory");
    }
    __syncthreads();
}
__global__ void __launch_bounds__(NTHR, 2) hybrid_fwd(Args a) {
    extern __shared__ __attribute__((aligned(16))) unsigned char lds_raw[];
    LAS unsigned char* lds = (LAS unsigned char*)lds_raw;
    cg::grid_group grid = cg::this_grid();
#ifdef EXP_INVL2
    if (threadIdx.x == 0) asm volatile("buffer_inv sc0 sc1\n\ts_waitcnt vmcnt(0)" ::: "memory");
    __syncthreads();
#endif
    volatile LAS unsigned* xb_st = (volatile LAS unsigned*)(lds + 131072 + 1024);
    if (threadIdx.x < 3) xb_st[threadIdx.x] = 0u;
    __syncthreads();
    const XcdBarrier xbar = xcd_barrier_post((unsigned*)a.ws, xb_st);
    const int tid0 = threadIdx.x, wave = __builtin_amdgcn_readfirstlane(tid0 >> 6);
    const int G = gridDim.x, bx = blockIdx.x;
    const int gw = bx * NWAVES + wave, NGW = G * NWAVES;
    unsigned char* ws = a.ws;
    bf16* const Win = (bf16*)(ws + WS_WIN); bf16* const Wglu = (bf16*)(ws + WS_WGLU); bf16* const Wbs = (bf16*)(ws + WS_WBS); bf16* const Wba = (bf16*)(ws + WS_WBA); bf16* const Wout = (bf16*)(ws + WS_WOUT);
    bf16* const Hb = (bf16*)(ws + WS_H); bf16* const Ub = (bf16*)(ws + WS_U); bf16* const ZSb = (bf16*)(ws + WS_ZS); bf16* const Qb = (bf16*)(ws + WS_Q); bf16* const Kb = (bf16*)(ws + WS_K);
    bf16* const VTb = (bf16*)(ws + WS_VT); bf16* const ZAb = (bf16*)(ws + WS_ZA); bf16* const GSb = (bf16*)(ws + WS_GS); bf16* const GAb = (bf16*)(ws + WS_GA);


    unsigned long long tqa = 0ull;
#ifdef PROBE_SEL
    unsigned long long tacc = 0ull, tbeg = 0ull;
#define PW(sel) do { if (PROBE_SEL == (sel) + 10) tacc += __builtin_amdgcn_s_memrealtime() - tbeg; if (PROBE_SEL == (sel) + 20) tbeg = __builtin_amdgcn_s_memrealtime(); } while (0)
#define PS(sel) do { if (PROBE_SEL == (sel)) tbeg = __builtin_amdgcn_s_memrealtime(); } while (0)
#define PT(sel) do { if (PROBE_SEL == (sel)) tacc += __builtin_amdgcn_s_memrealtime() - tbeg; } while (0)
#define PB(sel) do { if (PROBE_SEL == (sel) || PROBE_SEL == (sel) + 10) tbeg = __builtin_amdgcn_s_memrealtime(); } while (0)
#define PE(sel) do { if (PROBE_SEL == (sel) || PROBE_SEL == (sel) + 20) tacc += __builtin_amdgcn_s_memrealtime() - tbeg; } while (0)
#else
#define PB(sel) do {} while (0)
#define PW(sel) do {} while (0)
#define PS(sel) do {} while (0)
#define PT(sel) do {} while (0)
#define PE(sel) do {} while (0)
#endif
#define GSYNC() xcd_barrier1(xbar)
    PB(0);
    for (int l = 0; l <= DEPTH; ++l) {
        const int lt = l < DEPTH ? l : 0;
        bf16* const KTAB = (bf16*)(ws + WS_KTAB + lt * KTAB_LSTRIDE); bf16* const WTAB = (bf16*)(ws + WS_WTAB + lt * WTAB_LSTRIDE); bf16* const VTAB = (bf16*)(ws + WS_VTAB + lt * VTAB_LSTRIDE);
        float* const Sb = (float*)(ws + WS_S + lt * S_LSTRIDE); float* const LAM = (float*)(ws + WS_LAM + lt * LAM_LSTRIDE);
        int tid = tid0; asm volatile("" : "+v"(tid)); const int lane = tid & 63;
        PB(1);
        {
            const float* xin = (l <= 1) ? a.x : a.out;
        PS(43);
            for (int m = gw; m < M; m += NGW)
                norm_row(xin + (size_t)m * DM, l > 0 ? GAb + (size_t)m * DM : nullptr, l > 0 ? a.post_g + (l - 1) * DM : nullptr, a.out + (size_t)m * DM,
                         l < DEPTH ? a.pre_g + l * DM : nullptr, Hb + (size_t)m * DM, lane);
        PT(43);
            if (l == DEPTH) { PE(1); break; }
            LAS float* scr = (LAS float*)(lds + wave * 16384);
            const float* w_in = a.w_in + (size_t)l * DM * NCOL; const float* w_glu = a.w_glu + (size_t)l * 512 * 1024; const float* w_bs = a.w_bs + (size_t)l * 512 * 1024;
            const float* w_ba = a.w_ba + (size_t)l * 512 * 1024; const float* w_out = a.w_out + (size_t)l * 1024 * 1024;
            constexpr int I_IN = 16 * 160, I_GLU = 8 * 32, I_BR = 8 * 32, I_OUT = 16 * 32, NITEMS = I_IN + I_GLU + 2 * I_BR + I_OUT;
        PS(44);
            for (int it = gw; it < NITEMS; it += NGW) {
                int r = it;
                if (r < I_IN) { const int kb = r / 160, nb = r % 160; transpose_item(w_in, 1024, NCOL, Win, 64 * kb, 32 * nb, 32 * nb, scr, lane); continue; } r -= I_IN;
                if (r < I_GLU) { const int kb = r / 32, nb = r % 32, n0 = 32 * nb; const int bj = n0 >> 9, rem = n0 & 511, pn = rem >> 7, i0 = rem & 127;
                    transpose_item(w_glu, 512, 1024, Wglu, 64 * kb, n0, 256 * pn + 128 * bj + i0, scr, lane); continue; } r -= I_GLU;
                if (r < I_BR) { const int kb = r / 32, nb = r % 32; transpose_item(w_bs, 512, 1024, Wbs, 64 * kb, 32 * nb, 32 * nb, scr, lane); continue; } r -= I_BR;
                if (r < I_BR) { const int kb = r / 32, nb = r % 32; transpose_item(w_ba, 512, 1024, Wba, 64 * kb, 32 * nb, 32 * nb, scr, lane); continue; } r -= I_BR;
                { const int kb = r / 32, nb = r % 32; transpose_item(w_out, 1024, 1024, Wout, 64 * kb, 32 * nb, 32 * nb, scr, lane); }
            }
            __syncthreads();
            PT(44);
            LayerP P{a.a_re + l * NG * NP, a.a_im + l * NG * NP, a.log_dt + l * NG, a.b_re + (size_t)l * NG * NP * 16, a.b_im + (size_t)l * NG * NP * 16, a.c_re + (size_t)l * NG * 16 * NP, a.c_im + (size_t)l * NG * 16 * NP};
        PS(45);
#ifndef NO_TAB
            for (int it = bx; it < NG * 8; it += G) ktab_block(P, KTAB, it >> 3, it & 7, lds, tid);
            for (int idx = bx * NTHR + tid; idx < NG * NP * 16; idx += G * NTHR) wv_item(P, WTAB, VTAB, LAM, idx);
#endif
        PT(45);
        }
        PW(1);
        if (l == 0) grid.sync(); else GSYNC();
        PE(1);
        PB(2);
#ifndef NO_A
        { pg8::Gemm g{Hb, Win, M, NCOL, DM}; pg8::StaticOrder S; S.init(M, NCOL, G, bx); EpiProj E{ws};
          pg8::gemm_phase<EpiProj, pg8::StaticOrder, true, true>(lds, g, S, E); }
#endif
        PW(2);
        GSYNC();
        PE(2);
        PB(3);
        PS(41);
#ifndef NO_B1
        for (int u0 = 2 * bx; u0 < 512; u0 += 2 * G) { const int g = u0 >> 4;
            LayerP P{a.a_re + l * NG * NP, a.a_im + l * NG * NP, a.log_dt + l * NG, a.b_re + (size_t)l * NG * NP * 16, a.b_im + (size_t)l * NG * NP * 16, a.c_re + (size_t)l * NG * 16 * NP, a.c_im + (size_t)l * NG * 16 * NP};
            bf16x8 af[8]; f32x2 l16a, l16b;
            make_wfrag(P, g, wave, lane, af, l16a, l16b);
            for (int q = 0; q < 2; ++q) { const int nb = (u0 + q) & 15; ssm_state_unit(Ub, af, l16a, l16b, Sb, nb >> 3, g, nb & 7, wave, lane); } }
#endif
        PT(41);
        PS(42);
#ifndef NO_ATTN
        for (int t = gw; t < 4096; t += NGW) attn_task(Qb, Kb, VTb, ZAb, Qb, t >> 11, (t >> 8) & 7, t & 255, lane);
#endif
        PT(42);
        PW(3);
        GSYNC();
        PE(3);
        PB(4);
#ifndef NO_B3
        for (int u = 2 * bx; u < 512; u += (u & 1) ? 2 * G - 1 : 1) { const int g = u >> 4, nb = u & 15; ssm_out_unit(tqa, (u & 1) == 0, Ub, KTAB, VTAB, Sb, LAM, a.d_skip + l * 512, Hb, nb >> 3, g, nb & 7, lds, tid, wave, lane); }
#endif
        PW(4);
        GSYNC();
        PE(4);
        PB(5);
#ifndef NO_D1
        { pg8::Gemm g{Hb, Wglu, M, 1024, 512}; pg8::StaticOrder S; S.init(M, 1024, G, bx); EpiGlu E{ZSb, a.b_glu + l * 1024};
          pg8::gemm_phase<EpiGlu, pg8::StaticOrder, true, true>(lds, g, S, E); }
#endif
        PW(5);
        GSYNC();
        PE(5);
#ifndef NO_D2
        PB(6);
        { pg8::Gemm g{ZSb, Wbs, M, 1024, 512}; pg8::StaticOrder S; S.init(M, 1024, G, bx); EpiBranch<0> E{GSb, GAb};
          pg8::gemm_phase<EpiBranch<0>, pg8::StaticOrder, true, true>(lds, g, S, E); }
        __syncthreads();
        { pg8::Gemm g{Qb, Wba, M, 1024, 512}; pg8::StaticOrder S; S.init(M, 1024, G, bx); EpiBranch<1> E{GSb, GAb};
          pg8::gemm_phase<EpiBranch<1>, pg8::StaticOrder, true, true>(lds, g, S, E); }
#endif
        PW(6);
        GSYNC();
        PE(6);
#ifndef NO_D3
        PB(7);
        { pg8::Gemm g{GSb, Wout, M, 1024, 1024}; pg8::StaticOrder S; S.init(M, 1024, G, bx); EpiPlain E{GAb};
          pg8::gemm_phase<EpiPlain, pg8::StaticOrder, true, true>(lds, g, S, E); }
#endif
        PW(7);
        GSYNC();
        PE(7);
    }
    PE(0);
#ifdef PROBE_SEL
    grid.sync();
    if (bx == 0) { LAS unsigned long long* tb = (LAS unsigned long long*)lds; if (tid0 == 0) tb[0] = tacc + tqa; __syncthreads(); const unsigned long long K = tb[0] < 1000000ull ? tb[0] : 1000000ull;
        for (unsigned long long i = tid0; i < K; i += NTHR) a.out[i] += 0.05f; }
#endif
}

extern "C" void kernel_launch(void* const* d_in, const int* in_sizes, int n_in, void* d_out, int out_size, void* d_ws, size_t ws_size, hipStream_t stream) {
    static int grid = 0;
    if (grid == 0) {
        if (n_in != 17 || out_size != M * DM || ws_size < WS_END) { fprintf(stderr, "kernel_launch: unexpected problem shape (n_in %d, out %d, ws %zu)\n", n_in, out_size, ws_size); grid = -1; return; }
        int dev = 0, cus = 0, per_cu = 0;
        (void)hipGetDevice(&dev); (void)hipDeviceGetAttribute(&cus, hipDeviceAttributeMultiprocessorCount, dev);
        if (hipFuncSetAttribute((const void*)hybrid_fwd, hipFuncAttributeMaxDynamicSharedMemorySize, LDS_BYTES) != hipSuccess) { fprintf(stderr, "kernel_launch: hipFuncSetAttribute failed\n"); grid = -1; return; }
        if (hipOccupancyMaxActiveBlocksPerMultiprocessor(&per_cu, (const void*)hybrid_fwd, NTHR, LDS_BYTES) != hipSuccess || per_cu < 1) { fprintf(stderr, "kernel_launch: occupancy query gave %d\n", per_cu); per_cu = 1; }
        (void)hipGetLastError();
        grid = cus * per_cu;
    }
    if (grid < 0) return;
    if (hipMemsetAsync(d_ws, 0, 16384, stream) != hipSuccess) { fprintf(stderr, "kernel_launch: memset failed\n"); return; }
    Args a{};
    a.x = (const float*)d_in[0]; a.pre_g = (const float*)d_in[1]; a.post_g = (const float*)d_in[2]; a.w_in = (const float*)d_in[3]; a.a_re = (const float*)d_in[4]; a.a_im = (const float*)d_in[5];
    a.log_dt = (const float*)d_in[6]; a.b_re = (const float*)d_in[7]; a.b_im = (const float*)d_in[8]; a.c_re = (const float*)d_in[9]; a.c_im = (const float*)d_in[10]; a.d_skip = (const float*)d_in[11];
    a.w_glu = (const float*)d_in[12]; a.b_glu = (const float*)d_in[13]; a.w_bs = (const float*)d_in[14]; a.w_ba = (const float*)d_in[15]; a.w_out = (const float*)d_in[16];
    a.out = (float*)d_out; a.ws = (unsigned char*)d_ws;
    void* args[] = {&a};
    const hipError_t e = hipLaunchCooperativeKernel((const void*)hybrid_fwd, dim3(grid), dim3(NTHR), args, LDS_BYTES, stream);
    if (e != hipSuccess) fprintf(stderr, "kernel_launch: cooperative launch failed: %s (grid %d)\n", hipGetErrorString(e), grid);
}
```

```cpp
#include <hip/hip_runtime.h>
#include <hip/hip_cooperative_groups.h>
#include <cstdio>
#include <cstdint>
namespace cg = cooperative_groups;
namespace pg8 {
#define PG8_LAS __attribute__((address_space(3)))
typedef unsigned short bf16_t;
typedef short bf16x8 __attribute__((ext_vector_type(8)));
typedef float f32x4 __attribute__((ext_vector_type(4)));
typedef unsigned u32x4 __attribute__((ext_vector_type(4)));
constexpr int BM = 256, BK = 64, HALF = 128, HTB = HALF * BK * 2  , STAGE_BYTES = 8 * HTB, NXCD = 8, WGM = 8;

__host__ __device__ __forceinline__ int lds_byte(int r, int c) { const int st = (r >> 4) * 2 + (c >> 5), rr = r & 15, cc = c & 31, ob = rr * 64 + cc * 2; return st * 1024 + (ob ^ (((ob >> 9) & 1) << 5)); }
__host__ __device__ __forceinline__ void stage_rc(int b, int& R, int& C) { const int st = b / 1024, sb = b % 1024, swz = sb ^ (((sb >> 9) & 1) << 5); R = (st >> 1) * 16 + swz / 64; C = (st & 1) * 32 + (swz % 64) / 2; }
__host__ __device__ __forceinline__ int perm32(int rho) { const int n = rho >> 4, i = rho & 15; return 8 * (i >> 2) + 4 * n + (i & 3); }

struct Unit { int pm, pn; };
struct Gemm { const bf16_t* A; const bf16_t* Bt; int M, N, K; };

struct StaticOrder {
    int nM, nN, nwg, G, c;
    __host__ __device__ void init(int M, int N, int G_, int c_) { nM = M / BM; nN = N / BM; nwg = nM * nN; G = G_; c = c_; }
    __host__ __device__ bool next(int i, Unit& u) const {
        const long L = (long)i * G + c; if (L >= nwg) return false;
        int wgid = (int)L; { const int q = nwg / NXCD, r = nwg % NXCD, xcd = wgid % NXCD, off = wgid / NXCD; wgid = (xcd < r ? xcd * (q + 1) : r * (q + 1) + (xcd - r) * q) + off; }
        const int nig = WGM * nN, gid = wgid / nig, fm = gid * WGM, gsz = (nM - fm) < WGM ? (nM - fm) : WGM;
        u.pm = fm + ((wgid % nig) % gsz); u.pn = (wgid % nig) / gsz; return true;
    }
    __device__ __forceinline__ void a_ready(const Unit&) const {}
    __device__ __forceinline__ void done(const Unit&) const {}
};
__device__ __forceinline__ unsigned cvt_pk_bf16(float lo, float hi) { unsigned r; asm volatile("v_cvt_pk_bf16_f32 %0, %1, %2" : "=v"(r) : "v"(lo), "v"(hi)); return r; }
typedef float f32x2 __attribute__((ext_vector_type(2)));

template <class Epi, class Sched, bool ALIGN_EPI = false, bool SP2 = false>
__device__ __forceinline__ void gemm_phase(PG8_LAS unsigned char* lds, const Gemm g, const Sched& S, const Epi& E) {
    int tid_ = threadIdx.x; asm volatile("" : "+v"(tid_));
    const int tid = tid_, wid = __builtin_amdgcn_readfirstlane(tid >> 6), lane = tid & 63, wr = wid >> 2, wc = wid & 3, fr = lane & 15, fq = lane >> 4;
    const int K = g.K, nt = K / BK;
    unsigned voffA[2], voffB[2];
#pragma unroll
    for (int i = 0; i < 2; ++i) { int R, C; stage_rc(tid * 16 + i * 8192, R, C); const int Rb = Epi::PERM ? ((R & ~31) + perm32(R & 31)) : R;
        voffA[i] = (unsigned)(R * K + C) * 2u; voffB[i] = (unsigned)(Rb * K + C) * 2u; }
    const size_t kstep = (size_t)(BK * 2);
    const size_t hstep = (size_t)HALF * K * 2;
    const size_t tstep = 2 * hstep;
    const unsigned ldsw = (unsigned)wid * 1024u;
    const int aoff = lds_byte(wr * 64 + fr, fq * 8), boff = lds_byte(wc * 32 + fr, fq * 8);
#define PG8_SA(b, h) (((b) * 2 + (h)) * HTB)
#define PG8_SB(b, h) ((4 + (b) * 2 + (h)) * HTB)
#define PG8_STAGE(bufoff, gbase, voff) do { _Pragma("unroll") for (int _i = 0; _i < 2; ++_i) \
        __builtin_amdgcn_global_load_lds((const unsigned*)((const char*)(gbase) + (voff)[_i]), (PG8_LAS unsigned*)(lds + (bufoff) + ldsw + _i * 8192), 16, 0, 0); } while (0)
#define PG8_LDA(dst, b, h) do { _Pragma("unroll") for (int m = 0; m < 4; ++m) _Pragma("unroll") for (int k = 0; k < 2; ++k) dst[m][k] = *(const PG8_LAS bf16x8*)(lds + PG8_SA(b, h) + aoff + m * 2048 + k * 1024); } while (0)
#define PG8_LDB(dst, b, h) do { _Pragma("unroll") for (int n = 0; n < 2; ++n) _Pragma("unroll") for (int k = 0; k < 2; ++k) dst[n][k] = *(const PG8_LAS bf16x8*)(lds + PG8_SB(b, h) + boff + n * 2048 + k * 1024); } while (0)
#define PG8_MMA(ai, bj, At, Bt) do { __builtin_amdgcn_s_setprio(1); _Pragma("unroll") for (int m = 0; m < 4; ++m) _Pragma("unroll") for (int n = 0; n < 2; ++n) _Pragma("unroll") for (int k = 0; k < 2; ++k) \
        acc[ai][bj][m][n] = __builtin_amdgcn_mfma_f32_16x16x32_bf16(Bt[n][k], At[m][k], acc[ai][bj][m][n], 0, 0, 0); __builtin_amdgcn_s_setprio(0); } while (0)
#define PG8_WAIT_V(n) asm volatile("s_waitcnt vmcnt(" #n ")" ::: "memory")
#define PG8_WAIT_L(n) asm volatile("s_waitcnt lgkmcnt(" #n ")" ::: "memory")
#define PG8_BAR __builtin_amdgcn_s_barrier()
#define PG8_SCHED __builtin_amdgcn_sched_barrier(0)
    Unit cur, nxt; int ui = 0;
    if (!S.next(0, cur)) return;
    f32x4 acc[2][2][4][2];
#pragma unroll
    for (int a = 0; a < 2; ++a)
#pragma unroll
        for (int b = 0; b < 2; ++b)
#pragma unroll
            for (int m = 0; m < 4; ++m)
#pragma unroll
                for (int n = 0; n < 2; ++n) acc[a][b][m][n] = (f32x4){0.f, 0.f, 0.f, 0.f};
    bf16x8 At[4][2], B0[2][2], B1[2][2];
    const char* cA = (const char*)g.A + (size_t)cur.pm * tstep; const char* cB = (const char*)g.Bt + (size_t)cur.pn * tstep;
    S.a_ready(cur);
    if constexpr (SP2) {
        PG8_STAGE(PG8_SB(0, 0), cB, voffB); PG8_STAGE(PG8_SB(0, 1), cB + hstep, voffB); PG8_STAGE(PG8_SA(0, 0), cA, voffA); PG8_STAGE(PG8_SA(0, 1), cA + hstep, voffA);
        if (wr == 1) PG8_BAR;
        PG8_WAIT_V(2); PG8_BAR;
        PG8_STAGE(PG8_SB(1, 0), cB + kstep, voffB); PG8_STAGE(PG8_SA(1, 0), cA + kstep, voffA); PG8_STAGE(PG8_SB(1, 1), cB + hstep + kstep, voffB);
        PG8_WAIT_V(6); PG8_BAR;
    } else {
        PG8_STAGE(PG8_SB(0, 0), cB, voffB); PG8_STAGE(PG8_SA(0, 0), cA, voffA); PG8_STAGE(PG8_SB(0, 1), cB + hstep, voffB); PG8_STAGE(PG8_SA(0, 1), cA + hstep, voffA);
        if (wr == 1) PG8_BAR;
        PG8_WAIT_V(4); PG8_BAR;
        PG8_STAGE(PG8_SB(1, 0), cB + kstep, voffB); PG8_STAGE(PG8_SA(1, 0), cA + kstep, voffA); PG8_STAGE(PG8_SB(1, 1), cB + hstep + kstep, voffB);
        PG8_WAIT_V(6); PG8_BAR;
    }
    for (;;) {
        const bool has_next = S.next(ui + 1, nxt);
        const char* nA = has_next ? (const char*)g.A + (size_t)nxt.pm * tstep : cA; const char* nB = has_next ? (const char*)g.Bt + (size_t)nxt.pn * tstep : cB;
        for (int t = 0; t < nt; t += 2) {
            const bool last = (t == nt - 2);
            const char* a1 = cA + (size_t)(t + 1) * kstep;
            const char* a2 = last ? nA : cA + (size_t)(t + 2) * kstep; const char* b2 = last ? nB : cB + (size_t)(t + 2) * kstep;
            const char* a3 = a2 + kstep; const char* b3 = b2 + kstep;
            if (last && has_next) S.a_ready(nxt);
            if constexpr (SP2) {
            PG8_LDB(B0, 0, 0); PG8_LDB(B1, 0, 1); PG8_SCHED; PG8_LDA(At, 0, 0); PG8_STAGE(PG8_SA(1, 1), a1 + hstep, voffA);
            PG8_WAIT_V(8); PG8_WAIT_L(0); PG8_BAR; PG8_MMA(0, 0, At, B0); PG8_MMA(0, 1, At, B1); PG8_BAR; PG8_SCHED;
            PG8_LDA(At, 0, 1); PG8_STAGE(PG8_SB(0, 0), b2, voffB); PG8_STAGE(PG8_SB(0, 1), b2 + hstep, voffB); PG8_STAGE(PG8_SA(0, 0), a2, voffA);
            PG8_WAIT_V(8); PG8_WAIT_L(0); PG8_BAR; PG8_MMA(1, 0, At, B0); PG8_MMA(1, 1, At, B1); PG8_BAR; PG8_SCHED;
            PG8_LDB(B0, 1, 0); PG8_LDB(B1, 1, 1); PG8_SCHED; PG8_LDA(At, 1, 0); PG8_STAGE(PG8_SA(0, 1), a2 + hstep, voffA);
            PG8_WAIT_V(8); PG8_WAIT_L(0); PG8_BAR; PG8_MMA(0, 0, At, B0); PG8_MMA(0, 1, At, B1); PG8_BAR; PG8_SCHED;
            PG8_LDA(At, 1, 1); PG8_STAGE(PG8_SB(1, 0), b3, voffB); PG8_STAGE(PG8_SB(1, 1), b3 + hstep, voffB); PG8_STAGE(PG8_SA(1, 0), a3, voffA);
            PG8_WAIT_V(8); PG8_WAIT_L(0); PG8_BAR; PG8_MMA(1, 0, At, B0); PG8_MMA(1, 1, At, B1); PG8_BAR; PG8_SCHED;
            } else {
            PG8_LDB(B0, 0, 0); PG8_SCHED; PG8_LDA(At, 0, 0); PG8_STAGE(PG8_SA(1, 1), a1 + hstep, voffA);
            PG8_WAIT_L(8); PG8_BAR; PG8_WAIT_L(0); PG8_MMA(0, 0, At, B0); PG8_BAR; PG8_SCHED;
            PG8_LDB(B1, 0, 1); PG8_STAGE(PG8_SB(0, 0), b2, voffB);
            PG8_BAR; PG8_WAIT_L(0); PG8_MMA(0, 1, At, B1); PG8_BAR;
            PG8_LDA(At, 0, 1); PG8_STAGE(PG8_SA(0, 0), a2, voffA);
            PG8_BAR; PG8_WAIT_L(0); PG8_MMA(1, 0, At, B0); PG8_BAR; PG8_SCHED;
            PG8_STAGE(PG8_SB(0, 1), b2 + hstep, voffB);
            PG8_WAIT_V(6); PG8_BAR; PG8_MMA(1, 1, At, B1); PG8_BAR;
            PG8_LDB(B0, 1, 0); PG8_SCHED; PG8_LDA(At, 1, 0); PG8_STAGE(PG8_SA(0, 1), a2 + hstep, voffA);
            PG8_WAIT_L(8); PG8_BAR; PG8_WAIT_L(0); PG8_MMA(0, 0, At, B0); PG8_BAR; PG8_SCHED;
            PG8_LDB(B1, 1, 1); PG8_STAGE(PG8_SB(1, 0), b3, voffB);
            PG8_BAR; PG8_WAIT_L(0); PG8_MMA(0, 1, At, B1); PG8_BAR;
            PG8_LDA(At, 1, 1); PG8_STAGE(PG8_SA(1, 0), a3, voffA);
            PG8_BAR; PG8_WAIT_L(0); PG8_MMA(1, 0, At, B0); PG8_BAR; PG8_SCHED;
            PG8_STAGE(PG8_SB(1, 1), b3 + hstep, voffB);
            PG8_WAIT_V(6); PG8_BAR; PG8_MMA(1, 1, At, B1); PG8_BAR;
            }
        }
        if constexpr (ALIGN_EPI) { if (wr == 0) PG8_BAR; }
        if constexpr (!Epi::AFTER_DRAIN) { E(acc, cur, wr, wc, fr, fq); S.done(cur); }
        if (!has_next) break;
#pragma unroll
        for (int a = 0; a < 2; ++a)
#pragma unroll
            for (int b = 0; b < 2; ++b)
#pragma unroll
                for (int m = 0; m < 4; ++m)
#pragma unroll
                    for (int n = 0; n < 2; ++n) acc[a][b][m][n] = (f32x4){0.f, 0.f, 0.f, 0.f};
        cur = nxt; cA = nA; cB = nB; ++ui;
        if constexpr (ALIGN_EPI) { if (wr == 1) PG8_BAR; }
    }
    PG8_WAIT_V(0);
    if constexpr (!ALIGN_EPI) { if (wr == 0) PG8_BAR; }
    PG8_BAR;
    if constexpr (Epi::AFTER_DRAIN) { E.fused(acc, cur, wr, wc, fr, fq, lds, wid, lane); S.done(cur); }
#undef PG8_SA
#undef PG8_SB
#undef PG8_STAGE
#undef PG8_LDA
#undef PG8_LDB
#undef PG8_MMA
#undef PG8_WAIT_V
#undef PG8_WAIT_L
#undef PG8_BAR
#undef PG8_SCHED
}
}
#define DI __device__ __forceinline__
#define LAS __attribute__((address_space(3)))
typedef unsigned short bf16;
typedef float f32x4 __attribute__((ext_vector_type(4)));
typedef float f32x2 __attribute__((ext_vector_type(2)));
typedef float f32x16 __attribute__((ext_vector_type(16)));
typedef short bf16x8 __attribute__((ext_vector_type(8)));
typedef unsigned u32x4 __attribute__((ext_vector_type(4)));
typedef unsigned u32x2 __attribute__((ext_vector_type(2)));
typedef __bf16 bf16x2_t __attribute__((ext_vector_type(2)));

constexpr int NWAVES = 8, NTHR = 512;
constexpr int BATCH = 2, SEQ = 8192, DM = 1024, DEPTH = 4, M = BATCH * SEQ, NCOL = 5120;
constexpr int NG = 32, NP = 64, NCH = SEQ / 64;
constexpr float EPS = 1e-6f;
constexpr size_t MiB = 1u << 20;
constexpr size_t WS_WIN = 1 * MiB, WS_WGLU = 11 * MiB, WS_WBS = 12 * MiB, WS_WBA = 13 * MiB, WS_WOUT = 14 * MiB;
constexpr size_t WS_H = 16 * MiB;
constexpr size_t WS_U = 48 * MiB, WS_ZS = 64 * MiB, WS_Q = 80 * MiB, WS_K = 96 * MiB, WS_VT = 112 * MiB, WS_ZA = 128 * MiB;
constexpr size_t WS_GS = 144 * MiB, WS_GA = 176 * MiB;
constexpr size_t WS_KTAB = 208 * MiB, KTAB_LSTRIDE = 1280 * 1024;
constexpr size_t WS_WTAB = 213 * MiB, WTAB_LSTRIDE = 2 * MiB;
constexpr size_t WS_VTAB = 221 * MiB, VTAB_LSTRIDE = 2 * MiB;
constexpr size_t WS_S = 229 * MiB, S_LSTRIDE = 4 * MiB;
constexpr size_t WS_LAM = 245 * MiB, LAM_LSTRIDE = 64 * 1024;
constexpr size_t WS_END = 246 * MiB;
constexpr int KTAB_BYTES = 65 * 512;
constexpr int LDS_BYTES = 147456;
constexpr float QSCALE = 0.125f * 1.4426950408889634f;

struct Args {
    const float* x; const float* pre_g; const float* post_g; const float* w_in; const float* a_re; const float* a_im; const float* log_dt;
    const float* b_re; const float* b_im; const float* c_re; const float* c_im; const float* d_skip; const float* w_glu; const float* b_glu;
    const float* w_bs; const float* w_ba; const float* w_out; float* out; unsigned char* ws;
};

DI unsigned cvtpk(float lo, float hi) { f32x2 v = {lo, hi}; bf16x2_t b = __builtin_convertvector(v, bf16x2_t); return __builtin_bit_cast(unsigned, b); }
DI float bflo(unsigned w) { return __uint_as_float(w << 16); }
DI float bfhi(unsigned w) { return __uint_as_float(w & 0xffff0000u); }
DI float bf1(bf16 b) { return __uint_as_float((unsigned)b << 16); }
DI float sigm(float x) { return __builtin_amdgcn_rcpf(1.0f + __expf(-x)); }
DI float silu(float x) { return x * sigm(x); }
DI float gelu_tanh(float x) { const float u = 1.5957691216057308f * (x + 0.044715f * x * x * x); return x * sigm(u); }
DI float wave_sum(float v) {
#pragma unroll
    for (int o = 1; o < 64; o <<= 1) v += __shfl_xor(v, o);
    return v;
}

struct EpiProj {
    static constexpr bool PERM = true, AFTER_DRAIN = false;
    unsigned char* ws;
    DI void operator()(const pg8::f32x4 (&acc)[2][2][4][2], const pg8::Unit& u, int wr, int wc, int fr, int fq) const {
        const int pn = u.pn;
        bf16* base; int ld, colt; float sc = 1.f;
        if (pn < 12) { base = (bf16*)(ws + WS_U + (size_t)(pn >> 1) * (16 * MiB)); ld = 512; colt = (pn & 1) * 256; if ((pn >> 1) == 2) sc = QSCALE; }
        else if (pn < 16) { base = (bf16*)(ws + WS_GS); ld = 1024; colt = (pn - 12) * 256; }
        else { base = (bf16*)(ws + WS_GA); ld = 1024; colt = (pn - 16) * 256; }
        const int row0 = u.pm * 256 + wr * 64 + fr, col0 = colt + wc * 32 + 8 * fq;
        if ((pn >> 1) == 4) {
            bf16* vt = (bf16*)(ws + WS_VT);
#pragma unroll
            for (int ai = 0; ai < 2; ++ai)
#pragma unroll
                for (int m = 0; m < 4; ++m) { const int r = row0 + ai * 128 + m * 16; const int bb = r >> 13, t = r & 8191;
#pragma unroll
                    for (int bj = 0; bj < 2; ++bj) { bf16* p = vt + ((size_t)(bb * 512 + col0 + bj * 128)) * 8192 + t;
#pragma unroll
                        for (int n = 0; n < 2; ++n)
#pragma unroll
                            for (int e = 0; e < 4; ++e) { *p = (bf16)(cvtpk(acc[ai][bj][m][n][e], 0.f) & 0xffffu); p += 8192; asm volatile("" : "+v"(p)); } }
                    __builtin_amdgcn_sched_barrier(0); }
            return;
        }
#pragma unroll
        for (int ai = 0; ai < 2; ++ai)
#pragma unroll
            for (int m = 0; m < 4; ++m) { bf16* rowp = base + (size_t)(row0 + ai * 128 + m * 16) * ld + col0;
#pragma unroll
                for (int bj = 0; bj < 2; ++bj) { const pg8::f32x4 v0 = acc[ai][bj][m][0] * sc, v1 = acc[ai][bj][m][1] * sc;
                    u32x4 w; w.x = cvtpk(v0[0], v0[1]); w.y = cvtpk(v0[2], v0[3]); w.z = cvtpk(v1[0], v1[1]); w.w = cvtpk(v1[2], v1[3]);
                    *(u32x4*)(rowp + bj * 128) = w; } }
    }
};
struct EpiGlu {
    static constexpr bool PERM = true, AFTER_DRAIN = false;
    bf16* zs; const float* bias;
    DI void operator()(const pg8::f32x4 (&acc)[2][2][4][2], const pg8::Unit& u, int wr, int wc, int fr, int fq) const {
        const int row0 = u.pm * 256 + wr * 64 + fr, col0 = u.pn * 128 + wc * 32 + 8 * fq;
        f32x4 ba0 = *(const f32x4*)(bias + col0), ba1 = *(const f32x4*)(bias + col0 + 4), bb0 = *(const f32x4*)(bias + 512 + col0), bb1 = *(const f32x4*)(bias + 512 + col0 + 4);
        u32x4 zv[2][4];
#pragma unroll
        for (int ai = 0; ai < 2; ++ai)
#pragma unroll
            for (int m = 0; m < 4; ++m) zv[ai][m] = *(const u32x4*)(zs + (size_t)(row0 + ai * 128 + m * 16) * 512 + col0);
        __builtin_amdgcn_sched_barrier(0);
#pragma unroll
        for (int ai = 0; ai < 2; ++ai)
#pragma unroll
            for (int m = 0; m < 4; ++m) { bf16* p = zs + (size_t)(row0 + ai * 128 + m * 16) * 512 + col0;
                const u32x4 z = zv[ai][m]; float zf[8] = {bflo(z.x), bfhi(z.x), bflo(z.y), bfhi(z.y), bflo(z.z), bfhi(z.z), bflo(z.w), bfhi(z.w)}; float y[8];
#pragma unroll
                for (int e = 0; e < 4; ++e) { y[e] = (acc[ai][0][m][0][e] + ba0[e]) * sigm(acc[ai][1][m][0][e] + bb0[e]) * silu(zf[e]);
                                              y[4 + e] = (acc[ai][0][m][1][e] + ba1[e]) * sigm(acc[ai][1][m][1][e] + bb1[e]) * silu(zf[4 + e]); }
                u32x4 w; w.x = cvtpk(y[0], y[1]); w.y = cvtpk(y[2], y[3]); w.z = cvtpk(y[4], y[5]); w.w = cvtpk(y[6], y[7]); *(u32x4*)p = w; }
    }
};
template <int PASS> struct EpiBranch {
    static constexpr bool PERM = true, AFTER_DRAIN = false;
    bf16* G; const bf16* gate2;
    DI void operator()(const pg8::f32x4 (&acc)[2][2][4][2], const pg8::Unit& u, int wr, int wc, int fr, int fq) const {
        const int row0 = u.pm * 256 + wr * 64 + fr, col0 = u.pn * 256 + wc * 32 + 8 * fq;
#pragma unroll
        for (int ai = 0; ai < 2; ++ai) {
            u32x4 gv[4][2], hv[4][2];
#pragma unroll
            for (int m = 0; m < 4; ++m)
#pragma unroll
                for (int bj = 0; bj < 2; ++bj) { const size_t off = (size_t)(row0 + ai * 128 + m * 16) * 1024 + col0 + bj * 128; gv[m][bj] = *(const u32x4*)(G + off); if (PASS == 1) hv[m][bj] = *(const u32x4*)(gate2 + off); }
            __builtin_amdgcn_sched_barrier(0);
#pragma unroll
            for (int m = 0; m < 4; ++m)
#pragma unroll
                for (int bj = 0; bj < 2; ++bj) { const size_t off = (size_t)(row0 + ai * 128 + m * 16) * 1024 + col0 + bj * 128;
                    const u32x4 g = gv[m][bj]; float gf[8] = {bflo(g.x), bfhi(g.x), bflo(g.y), bfhi(g.y), bflo(g.z), bfhi(g.z), bflo(g.w), bfhi(g.w)}; float y[8];
                    if (PASS == 0) {
#pragma unroll
                        for (int e = 0; e < 4; ++e) { y[e] = sigm(gf[e]) * acc[ai][bj][m][0][e]; y[4 + e] = sigm(gf[4 + e]) * acc[ai][bj][m][1][e]; }
                    } else {
                        const u32x4 h = hv[m][bj]; float hf[8] = {bflo(h.x), bfhi(h.x), bflo(h.y), bfhi(h.y), bflo(h.z), bfhi(h.z), bflo(h.w), bfhi(h.w)};
#pragma unroll
                        for (int e = 0; e < 4; ++e) { y[e] = gf[e] + sigm(hf[e]) * acc[ai][bj][m][0][e]; y[4 + e] = gf[4 + e] + sigm(hf[4 + e]) * acc[ai][bj][m][1][e]; }
                    }
                    u32x4 w; w.x = cvtpk(y[0], y[1]); w.y = cvtpk(y[2], y[3]); w.z = cvtpk(y[4], y[5]); w.w = cvtpk(y[6], y[7]); *(u32x4*)(G + off) = w; }
            __builtin_amdgcn_sched_barrier(0);
        }
    }
};
struct EpiPlain {
    static constexpr bool PERM = true, AFTER_DRAIN = false;
    bf16* O;
    DI void operator()(const pg8::f32x4 (&acc)[2][2][4][2], const pg8::Unit& u, int wr, int wc, int fr, int fq) const {
        const int row0 = u.pm * 256 + wr * 64 + fr, col0 = u.pn * 256 + wc * 32 + 8 * fq;
#pragma unroll
        for (int ai = 0; ai < 2; ++ai)
#pragma unroll
            for (int m = 0; m < 4; ++m)
#pragma unroll
                for (int bj = 0; bj < 2; ++bj) { const pg8::f32x4 v0 = acc[ai][bj][m][0], v1 = acc[ai][bj][m][1];
                    u32x4 w; w.x = cvtpk(v0[0], v0[1]); w.y = cvtpk(v0[2], v0[3]); w.z = cvtpk(v1[0], v1[1]); w.w = cvtpk(v1[2], v1[3]);
                    *(u32x4*)(O + (size_t)(row0 + ai * 128 + m * 16) * 1024 + col0 + bj * 128) = w; }
    }
};

DI void norm_row(const float* xin, const bf16* o, const float* g_post, float* xout, const float* g_pre, bf16* h, int lane) {
    f32x4 v[4];
#pragma unroll
    for (int j = 0; j < 4; ++j) v[j] = *((const f32x4*)xin + lane + 64 * j);
    if (o) {
        f32x4 ov[4]; float ss = 0.f;
#pragma unroll
        for (int j = 0; j < 4; ++j) { const u32x2 w = *((const u32x2*)o + lane + 64 * j); ov[j] = (f32x4){bflo(w.x), bfhi(w.x), bflo(w.y), bfhi(w.y)};
            ss += (ov[j].x * ov[j].x + ov[j].y * ov[j].y) + (ov[j].z * ov[j].z + ov[j].w * ov[j].w); }
        const float rstd = 1.0f / sqrtf(wave_sum(ss) * (1.0f / DM) + EPS);
#pragma unroll
        for (int j = 0; j < 4; ++j) { const f32x4 g = *((const f32x4*)g_post + lane + 64 * j); v[j] = v[j] + ov[j] * rstd * g; *((f32x4*)xout + lane + 64 * j) = v[j]; }
    }
    if (g_pre) {
        float ss = 0.f;
#pragma unroll
        for (int j = 0; j < 4; ++j) ss += (v[j].x * v[j].x + v[j].y * v[j].y) + (v[j].z * v[j].z + v[j].w * v[j].w);
        const float rstd = 1.0f / sqrtf(wave_sum(ss) * (1.0f / DM) + EPS);
#pragma unroll
        for (int j = 0; j < 4; ++j) { const f32x4 g = *((const f32x4*)g_pre + lane + 64 * j); const f32x4 y = v[j] * rstd * g;
            u32x2 w; w.x = cvtpk(y.x, y.y); w.y = cvtpk(y.z, y.w); *((u32x2*)h + lane + 64 * j) = w; }
    }
}
DI void transpose_item(const float* W, int K, int N, bf16* WT, int k0, int n0, int dst_row0, LAS float* scr, int lane) {
#pragma unroll 8
    for (int i = 0; i < 32; ++i) { const int kk = 2 * i + (lane >> 5); scr[kk * 33 + (lane & 31)] = W[(size_t)(k0 + kk) * N + n0 + (lane & 31)]; }
    asm volatile("s_waitcnt lgkmcnt(0)" ::: "memory");
    const int c = lane & 7;
#pragma unroll
    for (int j = 0; j < 4; ++j) { const int n = (lane >> 3) + 8 * j; const LAS float* s = scr + (8 * c) * 33 + n;
        u32x4 o; o.x = cvtpk(s[0 * 33], s[1 * 33]); o.y = cvtpk(s[2 * 33], s[3 * 33]); o.z = cvtpk(s[4 * 33], s[5 * 33]); o.w = cvtpk(s[6 * 33], s[7 * 33]);
        *(u32x4*)(WT + (size_t)(dst_row0 + n) * K + k0 + 8 * c) = o; }
    asm volatile("s_waitcnt lgkmcnt(0)" ::: "memory");
}
DI f32x2 cpow_k(float are, float aim, float dt, int k) {
    const float mag = __expf(are * dt * (float)k);
    const double turns = (double)aim * (double)dt * (double)k * 0.15915494309189535;
    const float fr = (float)(turns - floor(turns));
    return (f32x2){mag * __builtin_amdgcn_cosf(fr), mag * __builtin_amdgcn_sinf(fr)};
}
DI f32x2 cmul(f32x2 a, f32x2 b) { return (f32x2){a.x * b.x - a.y * b.y, a.x * b.y + a.y * b.x}; }
DI f32x2 zoh_factor(float are, float aim, float dt) {
    const f32x2 ab = cpow_k(are, aim, dt, 1); const float nr = ab.x - 1.0f, ni = ab.y, den = are * are + aim * aim;
    return (f32x2){(nr * are + ni * aim) / den, (ni * are - nr * aim) / den};
}

struct LayerP { const float *a_re, *a_im, *log_dt, *b_re, *b_im, *c_re, *c_im; };

DI void ktab_block(const LayerP& P, bf16* KTAB, int g, int tb, LAS unsigned char* lds, int tid) {
    LAS f32x2* CL = (LAS f32x2*)lds;
    LAS f32x2* BB = (LAS f32x2*)(lds + 16384);
    const float dt = __expf(P.log_dt[g]);
    const int p = tid & 63, h0 = tid >> 6, h1 = h0 + 8;
    const float are = P.a_re[g * 64 + p], aim = P.a_im[g * 64 + p];
    const f32x2 c0 = {P.c_re[(g * 16 + h0) * 64 + p], P.c_im[(g * 16 + h0) * 64 + p]}, c1 = {P.c_re[(g * 16 + h1) * 64 + p], P.c_im[(g * 16 + h1) * 64 + p]};
    const int e0 = tid, e1 = tid + NTHR; const int pa = e0 >> 4, pb = e1 >> 4, hp = tid & 15;
    const float area = P.a_re[g * 64 + pa], aima = P.a_im[g * 64 + pa], areb = P.a_re[g * 64 + pb], aimb = P.a_im[g * 64 + pb];
    const f32x2 bva = {P.b_re[(g * 64 + pa) * 16 + hp], P.b_im[(g * 64 + pa) * 16 + hp]}, bvb = {P.b_re[(g * 64 + pb) * 16 + hp], P.b_im[(g * 64 + pb) * 16 + hp]};
    BB[pa * 16 + hp] = cmul(zoh_factor(area, aima, dt), bva); BB[pb * 16 + hp] = cmul(zoh_factor(areb, aimb, dt), bvb);
    if (tb == 0 && tid < 256) KTAB[((size_t)g * 65) * 256 + tid] = 0;
#pragma unroll 1
    for (int tp = 0; tp < 4; ++tp) { const int tau0 = tb * 8 + 2 * tp;
        const f32x2 l0 = cpow_k(are, aim, dt, tau0), l1 = cpow_k(are, aim, dt, tau0 + 1);
        CL[(0 * 16 + h0) * 64 + p] = cmul(c0, l0); CL[(0 * 16 + h1) * 64 + p] = cmul(c1, l0); CL[(1 * 16 + h0) * 64 + p] = cmul(c0, l1); CL[(1 * 16 + h1) * 64 + p] = cmul(c1, l1);
        __syncthreads();
        { const int ts = tid >> 8, h = (tid >> 4) & 15; float sacc = 0.f;
#pragma unroll 8
          for (int q = 0; q < 64; ++q) { const f32x2 c = CL[(ts * 16 + h) * 64 + q], bq = BB[q * 16 + hp]; sacc += c.x * bq.x - c.y * bq.y; }
          KTAB[((size_t)g * 65 + (tau0 + ts + 1)) * 256 + h * 16 + hp] = (bf16)(cvtpk(sacc, 0.f) & 0xffffu); }
        __syncthreads();
    }
}
DI void wv_item(const LayerP& P, bf16* WTAB, bf16* VTAB, float* LAM, int idx) {
    const int p = idx & 63, k = (idx >> 6) & 15, g = idx >> 10;
    const float dt = __expf(P.log_dt[g]), are = P.a_re[g * 64 + p], aim = P.a_im[g * 64 + p];
    f32x2 cv[16];
#pragma unroll
    for (int j = 0; j < 16; ++j) cv[j] = (f32x2){P.c_re[(g * 16 + j) * 64 + p], P.c_im[(g * 16 + j) * 64 + p]};
    const f32x2 lk1 = cpow_k(are, aim, dt, k + 1);
#pragma unroll
    for (int h = 0; h < 16; ++h) { const f32x2 c = cmul(cv[h], lk1); *(unsigned*)(VTAB + ((size_t)g * 256 + k * 16 + h) * 128 + 2 * p) = cvtpk(c.x, -c.y); }
    if (k == 15) { const f32x2 l64 = cpow_k(are, aim, dt, 64); *(f32x4*)(LAM + (g * 64 + p) * 4) = (f32x4){l64.x, l64.y, lk1.x, lk1.y}; }
}

#define MFMA16(a, b, c) __builtin_amdgcn_mfma_f32_16x16x32_bf16((a), (b), (c), 0, 0, 0)
#define MFMA32(a, b, c) __builtin_amdgcn_mfma_f32_32x32x16_bf16((a), (b), (c), 0, 0, 0)
DI void make_wfrag(const LayerP& P, int g, int wave, int lane, bf16x8 (&af)[8], f32x2& l16a, f32x2& l16b) {
    const int n = lane & 15, kg = lane >> 4, p = 8 * wave + (n >> 1), ri = n & 1;
    const float dt = __expf(P.log_dt[g]), are = P.a_re[g * 64 + p], aim = P.a_im[g * 64 + p];
    const int pa = 8 * wave + 2 * kg;
    const float area = P.a_re[g * 64 + pa], aima = P.a_im[g * 64 + pa], areb = P.a_re[g * 64 + pa + 1], aimb = P.a_im[g * 64 + pa + 1];
    const f32x4 br0 = *(const f32x4*)(P.b_re + (g * 64 + p) * 16 + 8 * (kg & 1)), br1 = *(const f32x4*)(P.b_re + (g * 64 + p) * 16 + 8 * (kg & 1) + 4);
    const f32x4 bi0 = *(const f32x4*)(P.b_im + (g * 64 + p) * 16 + 8 * (kg & 1)), bi1 = *(const f32x4*)(P.b_im + (g * 64 + p) * 16 + 8 * (kg & 1) + 4);
    const f32x2 f = zoh_factor(are, aim, dt);
    f32x2 fb[8];
#pragma unroll
    for (int i = 0; i < 4; ++i) { fb[i] = cmul(f, (f32x2){br0[i], bi0[i]}); fb[4 + i] = cmul(f, (f32x2){br1[i], bi1[i]}); }
#pragma unroll
    for (int ks = 0; ks < 8; ++ks) { const f32x2 lp = cpow_k(are, aim, dt, 15 - 2 * ks - (kg >> 1)); float v[8];
#pragma unroll
        for (int i = 0; i < 8; ++i) { const f32x2 c = cmul(lp, fb[i]); v[i] = ri ? c.y : c.x; }
        const u32x4 w = {cvtpk(v[0], v[1]), cvtpk(v[2], v[3]), cvtpk(v[4], v[5]), cvtpk(v[6], v[7])}; af[ks] = __builtin_bit_cast(bf16x8, w); }
    l16a = cpow_k(area, aima, dt, 16); l16b = cpow_k(areb, aimb, dt, 16);
}
DI void ssm_state_unit(const bf16* U, const bf16x8 (&af)[8], f32x2 l16a, f32x2 l16b, float* S, int b, int g, int cb, int wave, int lane) {
    const int n = lane & 15, kg = lane >> 4;
    const bf16* up = U + ((size_t)b * SEQ + (size_t)(cb * 16 + n) * 64 + (kg >> 1)) * 512 + g * 16 + 8 * (kg & 1);
    bf16x8 uf[4][8];
#pragma unroll
    for (int a = 0; a < 4; ++a)
#pragma unroll
        for (int ks = 0; ks < 8; ++ks) uf[a][ks] = *(const bf16x8*)(up + (size_t)(16 * a + 2 * ks) * 512);
    __builtin_amdgcn_sched_barrier(0);
    pg8::f32x4 acc4[4];
#pragma unroll
    for (int a = 0; a < 4; ++a) acc4[a] = (pg8::f32x4){0.f, 0.f, 0.f, 0.f};
#pragma unroll
    for (int ks = 0; ks < 8; ++ks)
#pragma unroll
        for (int a = 0; a < 4; ++a) acc4[a] = MFMA16(af[ks], uf[a][ks], acc4[a]);
    __builtin_amdgcn_sched_barrier(0);
    pg8::f32x4 st = acc4[0];
#pragma unroll
    for (int a = 1; a < 4; ++a) {
        const f32x2 s0 = cmul(l16a, (f32x2){st[0], st[1]}), s1 = cmul(l16b, (f32x2){st[2], st[3]});
        st = (pg8::f32x4){s0.x + acc4[a][0], s0.y + acc4[a][1], s1.x + acc4[a][2], s1.y + acc4[a][3]};
    }
    *(pg8::f32x4*)(S + (((size_t)b * NCH + cb * 16 + n) * NG + g) * 128 + 16 * wave + 4 * kg) = st;
}
constexpr int XIN_OFF = 33280, XIN_PITCH = 272, XIN_VAR = 16 * XIN_PITCH, TB_OFF = XIN_OFF + 4 * XIN_VAR, UL_OFF = 57344, UL_PITCH = 2064;
template <int S> DI void toe_stage(pg8::f32x4 (&acc)[8], const LAS unsigned char* ul, const LAS unsigned char* kt, int wave, int lo, int hi) {
#pragma unroll 1
    for (int ks = lo; ks <= hi; ++ks) {
        const bf16x8 uf0 = *(const LAS bf16x8*)(ul + ks * 64);
        bf16x8 a0[8 - S];
#pragma unroll
        for (int j = S; j < 8; ++j) a0[j - S] = *(const LAS bf16x8*)(kt + (wave + 8 * j - 2 * ks) * 512);
        __builtin_amdgcn_sched_barrier(0);
#pragma unroll
        for (int j = S; j < 8; ++j) acc[j] = MFMA16(a0[j - S], uf0, acc[j]);
    }
}
#ifdef PROBE_SEL
#define QS(sel) do { if (PROBE_SEL == (sel)) tq0 = __builtin_amdgcn_s_memrealtime(); } while (0)
#define QT(sel) do { if (PROBE_SEL == (sel)) tqacc += __builtin_amdgcn_s_memrealtime() - tq0; } while (0)
#else
#define QS(sel) do {} while (0)
#define QT(sel) do {} while (0)
#endif
DI void ssm_out_unit(unsigned long long& tqacc, bool load_ktab, const bf16* U, const bf16* KTAB, const bf16* VTAB, const float* S, const float* LAM, const float* dsk, bf16* YS, int b, int g, int cb, LAS unsigned char* lds, int tid, int wave, int lane) {
    unsigned long long tq0 = 0ull; (void)tq0;
    const int n = lane & 15, kg = lane >> 4;
    QS(51);
    const f32x4 lam4 = *(const f32x4*)(LAM + (g * 64 + lane) * 4); const f32x2 lam = {lam4.x, lam4.y}, l16 = {lam4.z, lam4.w};
    f32x2 sv[16];
    {
        const u32x4* src = (const u32x4*)((const unsigned char*)KTAB + (size_t)g * KTAB_BYTES);
        u32x4 kt4[4], kt5 = {0u, 0u, 0u, 0u}, ut4[4];
        if (load_ktab) {
#pragma unroll
            for (int j = 0; j < 4; ++j) kt4[j] = src[tid + NTHR * j];
            if (tid < 32) kt5 = src[2048 + tid];
        }
#pragma unroll
        for (int j = 0; j < 4; ++j) { const int idx = tid + NTHR * j, cn = idx >> 7, tok = (idx >> 1) & 63, half = idx & 1;
            ut4[j] = *(const u32x4*)(U + ((size_t)b * SEQ + (size_t)(cb * 16 + cn) * 64 + tok) * 512 + g * 16 + 8 * half); }
        if (wave <= cb) { const f32x2* sp = (const f32x2*)(S + (((size_t)b * NCH + wave * 16) * NG + g) * 128) + lane;
#pragma unroll
            for (int j = 0; j < 16; ++j) sv[j] = sp[(size_t)j * (NG * 64)]; }
        __builtin_amdgcn_sched_barrier(0);
        if (load_ktab) {
#pragma unroll
            for (int j = 0; j < 4; ++j) *(LAS u32x4*)(lds + 16 * (tid + NTHR * j)) = kt4[j];
            if (tid < 32) *(LAS u32x4*)(lds + 16 * (2048 + tid)) = kt5;
        }
#pragma unroll
        for (int j = 0; j < 4; ++j) { const int idx = tid + NTHR * j, cn = idx >> 7, tok = (idx >> 1) & 63, half = idx & 1; *(LAS u32x4*)(lds + UL_OFF + cn * UL_PITCH + tok * 32 + half * 16) = ut4[j]; }
    }
    bf16x8 vfr[4][2];
#pragma unroll
    for (int k2 = 0; k2 < 4; ++k2)
#pragma unroll
        for (int jj = 0; jj < 2; ++jj) vfr[k2][jj] = *(const bf16x8*)(VTAB + ((size_t)g * 256 + (wave + 8 * jj) * 16 + n) * 128 + 32 * k2 + 8 * kg);
    __builtin_amdgcn_sched_barrier(0);
    LAS f32x2* TB = (LAS f32x2*)(lds + TB_OFF);
    if (wave < cb) { f32x2 x = {0.f, 0.f};
#pragma unroll
        for (int j = 0; j < 16; ++j) { x = cmul(lam, x); x.x += sv[j].x; x.y += sv[j].y; }
        TB[wave * 64 + lane] = x; }
    __syncthreads();
    if (wave == cb) {
        f32x2 l1k = lam;
#pragma unroll
        for (int j = 0; j < 4; ++j) l1k = cmul(l1k, l1k);
        f32x2 x = {0.f, 0.f};
        for (int w = 0; w < cb; ++w) { const f32x2 t = TB[w * 64 + lane]; x = cmul(l1k, x); x.x += t.x; x.y += t.y; }
#pragma unroll
        for (int j = 0; j < 16; ++j) { f32x2 xa = x;
#pragma unroll
            for (int a = 0; a < 4; ++a) { *(LAS unsigned*)(lds + XIN_OFF + a * XIN_VAR + j * XIN_PITCH + 4 * lane) = cvtpk(xa.x, xa.y); xa = cmul(l16, xa); }
            x = cmul(lam, x); x.x += sv[j].x; x.y += sv[j].y; }
    }
    __syncthreads();
    QT(51); QS(52);
    pg8::f32x4 acc[8];
#pragma unroll
    for (int j = 0; j < 8; ++j) acc[j] = (pg8::f32x4){0.f, 0.f, 0.f, 0.f};
    const LAS unsigned char* ul = lds + UL_OFF + n * UL_PITCH + (kg >> 1) * 32 + (kg & 1) * 16;
    const LAS unsigned char* kt = lds + n * 32 + (kg & 1) * 16 + (1 - (kg >> 1)) * 512;
    { const int hw = wave >> 1;
      toe_stage<0>(acc, ul, kt, wave, 0, hw);            toe_stage<1>(acc, ul, kt, wave, hw + 1, hw + 4);   toe_stage<2>(acc, ul, kt, wave, hw + 5, hw + 8);   toe_stage<3>(acc, ul, kt, wave, hw + 9, hw + 12);
      toe_stage<4>(acc, ul, kt, wave, hw + 13, hw + 16); toe_stage<5>(acc, ul, kt, wave, hw + 17, hw + 20); toe_stage<6>(acc, ul, kt, wave, hw + 21, hw + 24); toe_stage<7>(acc, ul, kt, wave, hw + 25, hw + 28); }
#pragma unroll
    for (int k2 = 0; k2 < 4; ++k2) {
        bf16x8 xf[4];
#pragma unroll
        for (int a = 0; a < 4; ++a) xf[a] = *(const LAS bf16x8*)(lds + XIN_OFF + a * XIN_VAR + n * XIN_PITCH + (32 * k2 + 8 * kg) * 2);
#pragma unroll
        for (int j = 0; j < 8; ++j) acc[j] = MFMA16(vfr[k2][j & 1], xf[j >> 1], acc[j]); }
    QT(52); QS(53);
    const f32x4 dv = *(const f32x4*)(dsk + g * 16 + 4 * kg);
#pragma unroll
    for (int j = 0; j < 8; ++j) { const int t = wave + 8 * j; const size_t off = ((size_t)b * SEQ + (size_t)(cb * 16 + n) * 64 + t) * 512 + g * 16 + 4 * kg;
        const u32x2 uu = *(const LAS u32x2*)(lds + UL_OFF + n * UL_PITCH + t * 32 + kg * 8);
        const float y0 = gelu_tanh(acc[j][0] + dv[0] * bflo(uu.x)), y1 = gelu_tanh(acc[j][1] + dv[1] * bfhi(uu.x)), y2 = gelu_tanh(acc[j][2] + dv[2] * bflo(uu.y)), y3 = gelu_tanh(acc[j][3] + dv[3] * bfhi(uu.y));
        u32x2 w; w.x = cvtpk(y0, y1); w.y = cvtpk(y2, y3); *(u32x2*)(YS + off) = w; }
    asm volatile("s_waitcnt lgkmcnt(0)\n\ts_barrier" ::: "memory");
    QT(53);
}

struct AttnSt { f32x16 o0, o1; float carry; };
DI bool attn_tile(AttnSt& st, const bf16x8 (&kf)[4], const bf16x8 (&vf)[4], const bf16x8 (&qf)[4], bool diag, int n, int hi) {
    f32x16 s;
#pragma unroll
    for (int r = 0; r < 16; ++r) s[r] = 0.f;
#pragma unroll
    for (int ks = 0; ks < 4; ++ks) s = MFMA32(kf[ks], qf[ks], s);
    float sp[16];
#pragma unroll
    for (int r = 0; r < 16; ++r) { const float z = s[r]; const float e = __builtin_amdgcn_exp2f(-fabsf(z)); sp[r] = fmaxf(z, 0.f) + __builtin_amdgcn_logf(1.0f + e);
        if (diag && (16 * (r >> 3) + 8 * hi + (r & 7)) >= n) sp[r] = 0.f; }
    float cum[16]; float c0 = 0.f, c1 = 0.f;
#pragma unroll
    for (int r = 7; r >= 0; --r) { c0 -= sp[r]; cum[r] = c0; c1 -= sp[8 + r]; cum[8 + r] = c1; }
    const float p0 = __shfl_xor(c0, 32), p1 = __shfl_xor(c1, 32);
    const float base1 = st.carry + (hi ? 0.f : p1), base0 = st.carry + c1 + p1 + (hi ? 0.f : p0);
    float w[16];
#pragma unroll
    for (int r = 0; r < 16; ++r) { w[r] = __builtin_amdgcn_exp2f(s[r] + cum[r] + (r < 8 ? base0 : base1));
        if (diag && (16 * (r >> 3) + 8 * hi + (r & 7)) >= n) w[r] = 0.f; }
    st.carry += (c0 + c1) + (p0 + p1);
    const u32x4 pa = {cvtpk(w[0], w[1]), cvtpk(w[2], w[3]), cvtpk(w[4], w[5]), cvtpk(w[6], w[7])}, pb = {cvtpk(w[8], w[9]), cvtpk(w[10], w[11]), cvtpk(w[12], w[13]), cvtpk(w[14], w[15])};
    const bf16x8 pf0 = __builtin_bit_cast(bf16x8, pa), pf1 = __builtin_bit_cast(bf16x8, pb);
    st.o0 = MFMA32(pf0, vf[0], st.o0); st.o0 = MFMA32(pf1, vf[1], st.o0); st.o1 = MFMA32(pf0, vf[2], st.o1); st.o1 = MFMA32(pf1, vf[3], st.o1);
    return __ballot(st.carry >= -152.0f) == 0ull;
}
DI void attn_task(const bf16* Q, const bf16* Kb, const bf16* VT, const bf16* ZA, bf16* Y, int b, int h, int qt, int lane) {
    const int n = lane & 31, hi = lane >> 5;
    const size_t rowbase = (size_t)b * SEQ;
    bf16x8 qf[4];
    { const bf16* qp = Q + (rowbase + qt * 32 + n) * 512 + h * 64 + 8 * hi;
#pragma unroll
      for (int ks = 0; ks < 4; ++ks) qf[ks] = *(const bf16x8*)(qp + 16 * ks); }
    const int pm = (n & ~12) | (((n >> 2) & 1) << 3) | (((n >> 3) & 1) << 2);
    const bf16* kp = Kb + (rowbase + pm) * 512 + h * 64 + 8 * hi;
    const bf16* vp = VT + ((size_t)(b * 8 + h) * 64 + n) * SEQ + 8 * hi;
    AttnSt st;
#pragma unroll
    for (int r = 0; r < 16; ++r) { st.o0[r] = 0.f; st.o1[r] = 0.f; }
    st.carry = 0.f;
    bf16x8 kA[4], vA[4], kB[4], vB[4], kC[4], vC[4];
#define ATT_LOAD(KF, VF, ktile) do { const int key0_ = ((ktile) > 0 ? (ktile) : 0) * 32; \
        _Pragma("unroll") for (int ks = 0; ks < 4; ++ks) KF[ks] = *(const bf16x8*)(kp + (size_t)key0_ * 512 + 16 * ks); \
        VF[0] = *(const bf16x8*)(vp + key0_); VF[1] = *(const bf16x8*)(vp + key0_ + 16); VF[2] = *(const bf16x8*)(vp + (size_t)32 * SEQ + key0_); VF[3] = *(const bf16x8*)(vp + (size_t)32 * SEQ + key0_ + 16); } while (0)
    ATT_LOAD(kA, vA, qt); ATT_LOAD(kB, vB, qt - 1);
    int kt = qt;
    for (;;) {
        ATT_LOAD(kC, vC, kt - 2); __builtin_amdgcn_sched_barrier(0);
        if (attn_tile(st, kA, vA, qf, kt == qt, n, hi) || kt == 0) break; --kt; __builtin_amdgcn_sched_barrier(0);
        ATT_LOAD(kA, vA, kt - 2); __builtin_amdgcn_sched_barrier(0);
        if (attn_tile(st, kB, vB, qf, false, n, hi) || kt == 0) break; --kt; __builtin_amdgcn_sched_barrier(0);
        ATT_LOAD(kB, vB, kt - 2); __builtin_amdgcn_sched_barrier(0);
        if (attn_tile(st, kC, vC, qf, false, n, hi) || kt == 0) break; --kt; __builtin_amdgcn_sched_barrier(0);
    }
#undef ATT_LOAD
    float za0[16], za1[16];
#pragma unroll
    for (int r = 0; r < 16; ++r) { const int i = (r & 3) + 8 * (r >> 2) + 4 * hi; const size_t off = (rowbase + qt * 32 + i) * 512 + h * 64 + n; za0[r] = bf1(ZA[off]); za1[r] = bf1(ZA[off + 32]); }
    __builtin_amdgcn_sched_barrier(0);
#pragma unroll
    for (int r = 0; r < 16; ++r) { const int i = (r & 3) + 8 * (r >> 2) + 4 * hi; const size_t off = (rowbase + qt * 32 + i) * 512 + h * 64 + n;
        Y[off] = (bf16)(cvtpk(st.o0[r] * silu(za0[r]), 0.f) & 0xffffu); Y[off + 32] = (bf16)(cvtpk(st.o1[r] * silu(za1[r]), 0.f) & 0xffffu); }
}
#define XB_TMO      128
#define XB_XCNT(j)  (256  + 64 * (j))
#define XB_XSUB(j)  (1280 + 64 * (j))
#define XB_XGEN(j)  (2304 + 64 * (j))
#define XB_TOP      3328
#define XB_TOPGEN   3392
#define XCD_BAR_WORDS 3456
#define XB_SPIN_CAP (1u << 18)

__device__ __forceinline__ unsigned xb_ld(unsigned* p)              { return __hip_atomic_load(p, __ATOMIC_RELAXED, __HIP_MEMORY_SCOPE_AGENT); }
__device__ __forceinline__ unsigned xb_add(unsigned* p, unsigned v) { return __hip_atomic_fetch_add(p, v, __ATOMIC_RELAXED, __HIP_MEMORY_SCOPE_AGENT); }
__device__ __forceinline__ unsigned xb_xcc_id() { return (unsigned)__builtin_amdgcn_s_getreg((3 << 11) | 20) & 0xFu; }
#define XB_SPIN(cond, bar) do { unsigned _sp = 0; while (cond) { __builtin_amdgcn_s_sleep(1); \
    if ((++_sp & 255u) == 0u) { if (xb_ld(&(bar)[XB_TMO])) break; if (_sp > XB_SPIN_CAP) { atomicAdd(&(bar)[XB_TMO], 1u); break; } } } } while (0)

struct XcdBarrier {
    unsigned* bar; unsigned x;
    volatile LAS unsigned* st;
};

__device__ __forceinline__ XcdBarrier xcd_barrier_post(unsigned* bar, volatile LAS unsigned* st) {
    XcdBarrier b; b.bar = bar; b.x = xb_xcc_id(); b.st = st;
    if (threadIdx.x == 0) (void)xb_add(&bar[XB_XCNT(b.x)], 1u);
    return b;
}
__device__ __forceinline__ void xcd_barrier_complete(unsigned* bar, unsigned x, unsigned& nloc, unsigned& nx) {
    const unsigned G = gridDim.x * gridDim.y * gridDim.z;
    unsigned sum, cnt, mine, sp = 0u;
    for (;;) {
        sum = 0u; cnt = 0u; mine = 0u;
#pragma unroll
        for (unsigned j = 0; j < 16; ++j) { const unsigned c = xb_ld(&bar[XB_XCNT(j)]); sum += c; cnt += (c > 0u) ? 1u : 0u; mine = (j == x) ? c : mine; }
        if (sum == G) break;
        __builtin_amdgcn_s_sleep(1);
        if ((++sp & 255u) == 0u) { if (xb_ld(&bar[XB_TMO])) break; if (sp > XB_SPIN_CAP) { atomicAdd(&bar[XB_TMO], 1u); break; } }
    }
    nloc = mine > 0u ? mine : 1u; nx = cnt > 0u ? cnt : 1u;
}

__device__ __forceinline__ void xcd_barrier(const XcdBarrier& b) {
    asm volatile("s_waitcnt vmcnt(0)" ::: "memory");
    __syncthreads();
    if (threadIdx.x == 0) {
        unsigned* bar = b.bar;
        __builtin_amdgcn_s_waitcnt(0);
        unsigned nloc = b.st[0], nx = b.st[1];
        if (nloc == 0u) { xcd_barrier_complete(bar, b.x, nloc, nx); b.st[0] = nloc; b.st[1] = nx; }
        const unsigned old = xb_add(&bar[XB_XSUB(b.x)], 1u);
        const unsigned gen = old / nloc;
        if (old + 1u == (gen + 1u) * nloc) {
            __builtin_amdgcn_fence(__ATOMIC_RELEASE, "agent");
            asm volatile("s_waitcnt vmcnt(0)" ::: "memory");
            const unsigned og = xb_add(&bar[XB_TOP], 1u);
            const unsigned tg = og / nx;
            if (og + 1u == (tg + 1u) * nx) xb_add(&bar[XB_TOPGEN], 1u);
            else XB_SPIN(xb_ld(&bar[XB_TOPGEN]) == tg, bar);
            __builtin_amdgcn_fence(__ATOMIC_ACQUIRE, "agent");
            xb_add(&bar[XB_XGEN(b.x)], 1u);
            asm volatile("s_waitcnt vmcnt(0)" ::: "memory");
        } else {
            XB_SPIN(xb_ld(&bar[XB_XGEN(b.x)]) == gen, bar);
            __builtin_amdgcn_fence(__ATOMIC_ACQUIRE, "agent");
            asm volatile("s_waitcnt vmcnt(0)" ::: "memory");
        }
    }
    __syncthreads();
}

__device__ __forceinline__ void xcd_barrier1(const XcdBarrier& b) {
    asm volatile("s_waitcnt vmcnt(0)" ::: "memory");
    __syncthreads();
    if (threadIdx.x == 0) {
        unsigned* bar = b.bar;
        __builtin_amdgcn_s_waitcnt(0);
        unsigned nloc = b.st[0], nx = b.st[1];
        if (nloc == 0u) { xcd_barrier_complete(bar, b.x, nloc, nx); b.st[0] = nloc; b.st[1] = nx; }
        const unsigned k = b.st[2]; b.st[2] = k + 1u;
        const unsigned old = xb_add(&bar[XB_XSUB(b.x)], 1u);
        const unsigned gen = old / nloc;
        if (old + 1u == (gen + 1u) * nloc) {
            __builtin_amdgcn_fence(__ATOMIC_RELEASE, "agent");
            asm volatile("s_waitcnt vmcnt(0)" ::: "memory");
            const unsigned og = xb_add(&bar[XB_TOP], 1u);
            if (og + 1u == (k + 1u) * nx) xb_add(&bar[XB_TOPGEN], 1u);
            else XB_SPIN(xb_ld(&bar[XB_TOPGEN]) == k, bar);
        } else {
            XB_SPIN(xb_ld(&bar[XB_TOPGEN]) == k, bar);
        }
        __builtin_amdgcn_fence(__ATOMIC_ACQUIRE, "agent");
        asm volatile("s_waitcnt vmcnt(0)" ::: "memory");
    }
    __syncthreads();
}
__global__ void __launch_bounds__(NTHR, 2) hybrid_fwd(Args a) {
    extern __shared__ __attribute__((aligned(16))) unsigned char lds_raw[];
    LAS unsigned char* lds = (LAS unsigned char*)lds_raw;
    cg::grid_group grid = cg::this_grid();
#ifdef EXP_INVL2
    if (threadIdx.x == 0) asm volatile("buffer_inv sc0 sc1\n\ts_waitcnt vmcnt(0)" ::: "memory");
    __syncthreads();
#endif
    volatile LAS unsigned* xb_st = (volatile LAS unsigned*)(lds + 131072 + 1024);
    if (threadIdx.x < 3) xb_st[threadIdx.x] = 0u;
    __syncthreads();
    if (blockIdx.x == 0) for (int i = threadIdx.x; i < 4096; i += NTHR) __hip_atomic_store((unsigned*)a.ws + i, 0u, __ATOMIC_RELAXED, __HIP_MEMORY_SCOPE_AGENT);
    XcdBarrier xbar; xbar.bar = (unsigned*)a.ws; xbar.x = 0; xbar.st = xb_st;
    const int tid0 = threadIdx.x, wave = __builtin_amdgcn_readfirstlane(tid0 >> 6);
    const int G = gridDim.x, bx = blockIdx.x;
    const int gw = bx * NWAVES + wave, NGW = G * NWAVES;
    unsigned char* ws = a.ws;
    bf16* const Win = (bf16*)(ws + WS_WIN); bf16* const Wglu = (bf16*)(ws + WS_WGLU); bf16* const Wbs = (bf16*)(ws + WS_WBS); bf16* const Wba = (bf16*)(ws + WS_WBA); bf16* const Wout = (bf16*)(ws + WS_WOUT);
    bf16* const Hb = (bf16*)(ws + WS_H); bf16* const Ub = (bf16*)(ws + WS_U); bf16* const ZSb = (bf16*)(ws + WS_ZS); bf16* const Qb = (bf16*)(ws + WS_Q); bf16* const Kb = (bf16*)(ws + WS_K);
    bf16* const VTb = (bf16*)(ws + WS_VT); bf16* const ZAb = (bf16*)(ws + WS_ZA); bf16* const GSb = (bf16*)(ws + WS_GS); bf16* const GAb = (bf16*)(ws + WS_GA);


    unsigned long long tqa = 0ull;
#ifdef PROBE_SEL
    unsigned long long tacc = 0ull, tbeg = 0ull;
#define PW(sel) do { if (PROBE_SEL == (sel) + 10) tacc += __builtin_amdgcn_s_memrealtime() - tbeg; if (PROBE_SEL == (sel) + 20) tbeg = __builtin_amdgcn_s_memrealtime(); } while (0)
#define PS(sel) do { if (PROBE_SEL == (sel)) tbeg = __builtin_amdgcn_s_memrealtime(); } while (0)
#define PT(sel) do { if (PROBE_SEL == (sel)) tacc += __builtin_amdgcn_s_memrealtime() - tbeg; } while (0)
#define PB(sel) do { if (PROBE_SEL == (sel) || PROBE_SEL == (sel) + 10) tbeg = __builtin_amdgcn_s_memrealtime(); } while (0)
#define PE(sel) do { if (PROBE_SEL == (sel) || PROBE_SEL == (sel) + 20) tacc += __builtin_amdgcn_s_memrealtime() - tbeg; } while (0)
#else
#define PB(sel) do {} while (0)
#define PW(sel) do {} while (0)
#define PS(sel) do {} while (0)
#define PT(sel) do {} while (0)
#define PE(sel) do {} while (0)
#endif
#define GSYNC() xcd_barrier1(xbar)
    PB(0);
    for (int l = 0; l <= DEPTH; ++l) {
        const int lt = l < DEPTH ? l : 0;
        bf16* const KTAB = (bf16*)(ws + WS_KTAB + lt * KTAB_LSTRIDE); bf16* const WTAB = (bf16*)(ws + WS_WTAB + lt * WTAB_LSTRIDE); bf16* const VTAB = (bf16*)(ws + WS_VTAB + lt * VTAB_LSTRIDE);
        float* const Sb = (float*)(ws + WS_S + lt * S_LSTRIDE); float* const LAM = (float*)(ws + WS_LAM + lt * LAM_LSTRIDE);
        int tid = tid0; asm volatile("" : "+v"(tid)); const int lane = tid & 63;
        PB(1);
        {
            const float* xin = (l <= 1) ? a.x : a.out;
        PS(43);
            for (int m = gw; m < M; m += NGW)
                norm_row(xin + (size_t)m * DM, l > 0 ? GAb + (size_t)m * DM : nullptr, l > 0 ? a.post_g + (l - 1) * DM : nullptr, a.out + (size_t)m * DM,
                         l < DEPTH ? a.pre_g + l * DM : nullptr, Hb + (size_t)m * DM, lane);
        PT(43);
            if (l == DEPTH) { PE(1); break; }
            LAS float* scr = (LAS float*)(lds + wave * 16384);
            const float* w_in = a.w_in + (size_t)l * DM * NCOL; const float* w_glu = a.w_glu + (size_t)l * 512 * 1024; const float* w_bs = a.w_bs + (size_t)l * 512 * 1024;
            const float* w_ba = a.w_ba + (size_t)l * 512 * 1024; const float* w_out = a.w_out + (size_t)l * 1024 * 1024;
            constexpr int I_IN = 16 * 160, I_GLU = 8 * 32, I_BR = 8 * 32, I_OUT = 16 * 32, NITEMS = I_IN + I_GLU + 2 * I_BR + I_OUT;
        PS(44);
            for (int it = gw; it < NITEMS; it += NGW) {
                int r = it;
                if (r < I_IN) { const int kb = r / 160, nb = r % 160; transpose_item(w_in, 1024, NCOL, Win, 64 * kb, 32 * nb, 32 * nb, scr, lane); continue; } r -= I_IN;
                if (r < I_GLU) { const int kb = r / 32, nb = r % 32, n0 = 32 * nb; const int bj = n0 >> 9, rem = n0 & 511, pn = rem >> 7, i0 = rem & 127;
                    transpose_item(w_glu, 512, 1024, Wglu, 64 * kb, n0, 256 * pn + 128 * bj + i0, scr, lane); continue; } r -= I_GLU;
                if (r < I_BR) { const int kb = r / 32, nb = r % 32; transpose_item(w_bs, 512, 1024, Wbs, 64 * kb, 32 * nb, 32 * nb, scr, lane); continue; } r -= I_BR;
                if (r < I_BR) { const int kb = r / 32, nb = r % 32; transpose_item(w_ba, 512, 1024, Wba, 64 * kb, 32 * nb, 32 * nb, scr, lane); continue; } r -= I_BR;
                { const int kb = r / 32, nb = r % 32; transpose_item(w_out, 1024, 1024, Wout, 64 * kb, 32 * nb, 32 * nb, scr, lane); }
            }
            __syncthreads();
            PT(44);
            LayerP P{a.a_re + l * NG * NP, a.a_im + l * NG * NP, a.log_dt + l * NG, a.b_re + (size_t)l * NG * NP * 16, a.b_im + (size_t)l * NG * NP * 16, a.c_re + (size_t)l * NG * 16 * NP, a.c_im + (size_t)l * NG * 16 * NP};
        PS(45);
#ifndef NO_TAB
            for (int it = bx; it < NG * 8; it += G) ktab_block(P, KTAB, it >> 3, it & 7, lds, tid);
            for (int idx = bx * NTHR + tid; idx < NG * NP * 16; idx += G * NTHR) wv_item(P, WTAB, VTAB, LAM, idx);
#endif
        PT(45);
        }
        PW(1);
        if (l == 0) { grid.sync(); xbar = xcd_barrier_post((unsigned*)a.ws, xb_st); } else GSYNC();
        PE(1);
        PB(2);
#ifndef NO_A
        { pg8::Gemm g{Hb, Win, M, NCOL, DM}; pg8::StaticOrder S; S.init(M, NCOL, G, bx); EpiProj E{ws};
          pg8::gemm_phase<EpiProj, pg8::StaticOrder, true, true>(lds, g, S, E); }
#endif
        PW(2);
        GSYNC();
        PE(2);
        PB(3);
        PS(41);
#ifndef NO_B1
        for (int u0 = 2 * bx; u0 < 512; u0 += 2 * G) { const int g = u0 >> 4;
            LayerP P{a.a_re + l * NG * NP, a.a_im + l * NG * NP, a.log_dt + l * NG, a.b_re + (size_t)l * NG * NP * 16, a.b_im + (size_t)l * NG * NP * 16, a.c_re + (size_t)l * NG * 16 * NP, a.c_im + (size_t)l * NG * 16 * NP};
            bf16x8 af[8]; f32x2 l16a, l16b;
            make_wfrag(P, g, wave, lane, af, l16a, l16b);
            for (int q = 0; q < 2; ++q) { const int nb = (u0 + q) & 15; ssm_state_unit(Ub, af, l16a, l16b, Sb, nb >> 3, g, nb & 7, wave, lane); } }
#endif
        PT(41);
        PS(42);
#ifndef NO_ATTN
        for (int t = gw; t < 4096; t += NGW) attn_task(Qb, Kb, VTb, ZAb, Qb, t >> 11, (t >> 8) & 7, t & 255, lane);
#endif
        PT(42);
        PW(3);
        GSYNC();
        PE(3);
        PB(4);
#ifndef NO_B3
        for (int u = 2 * bx; u < 512; u += (u & 1) ? 2 * G - 1 : 1) { const int g = u >> 4, nb = u & 15; ssm_out_unit(tqa, (u & 1) == 0, Ub, KTAB, VTAB, Sb, LAM, a.d_skip + l * 512, Hb, nb >> 3, g, nb & 7, lds, tid, wave, lane); }
#endif
        PW(4);
        GSYNC();
        PE(4);
        PB(5);
#ifndef NO_D1
        { pg8::Gemm g{Hb, Wglu, M, 1024, 512}; pg8::StaticOrder S; S.init(M, 1024, G, bx); EpiGlu E{ZSb, a.b_glu + l * 1024};
          pg8::gemm_phase<EpiGlu, pg8::StaticOrder, true, true>(lds, g, S, E); }
#endif
        PW(5);
        GSYNC();
        PE(5);
#ifndef NO_D2
        PB(6);
        { pg8::Gemm g{ZSb, Wbs, M, 1024, 512}; pg8::StaticOrder S; S.init(M, 1024, G, bx); EpiBranch<0> E{GSb, GAb};
          pg8::gemm_phase<EpiBranch<0>, pg8::StaticOrder, true, true>(lds, g, S, E); }
        __syncthreads();
        { pg8::Gemm g{Qb, Wba, M, 1024, 512}; pg8::StaticOrder S; S.init(M, 1024, G, bx); EpiBranch<1> E{GSb, GAb};
          pg8::gemm_phase<EpiBranch<1>, pg8::StaticOrder, true, true>(lds, g, S, E); }
#endif
        PW(6);
        GSYNC();
        PE(6);
#ifndef NO_D3
        PB(7);
        { pg8::Gemm g{GSb, Wout, M, 1024, 1024}; pg8::StaticOrder S; S.init(M, 1024, G, bx); EpiPlain E{GAb};
          pg8::gemm_phase<EpiPlain, pg8::StaticOrder, true, true>(lds, g, S, E); }
#endif
        PW(7);
        GSYNC();
        PE(7);
    }
    PE(0);
#ifdef PROBE_SEL
    grid.sync();
    if (bx == 0) { LAS unsigned long long* tb = (LAS unsigned long long*)lds; if (tid0 == 0) tb[0] = tacc + tqa; __syncthreads(); const unsigned long long K = tb[0] < 1000000ull ? tb[0] : 1000000ull;
        for (unsigned long long i = tid0; i < K; i += NTHR) a.out[i] += 0.05f; }
#endif
}

extern "C" void kernel_launch(void* const* d_in, const int* in_sizes, int n_in, void* d_out, int out_size, void* d_ws, size_t ws_size, hipStream_t stream) {
    static int grid = 0;
    if (grid == 0) {
        if (n_in != 17 || out_size != M * DM || ws_size < WS_END) { fprintf(stderr, "kernel_launch: unexpected problem shape (n_in %d, out %d, ws %zu)\n", n_in, out_size, ws_size); grid = -1; return; }
        int dev = 0, cus = 0, per_cu = 0;
        (void)hipGetDevice(&dev); (void)hipDeviceGetAttribute(&cus, hipDeviceAttributeMultiprocessorCount, dev);
        if (hipFuncSetAttribute((const void*)hybrid_fwd, hipFuncAttributeMaxDynamicSharedMemorySize, LDS_BYTES) != hipSuccess) { fprintf(stderr, "kernel_launch: hipFuncSetAttribute failed\n"); grid = -1; return; }
        if (hipOccupancyMaxActiveBlocksPerMultiprocessor(&per_cu, (const void*)hybrid_fwd, NTHR, LDS_BYTES) != hipSuccess || per_cu < 1) { fprintf(stderr, "kernel_launch: occupancy query gave %d\n", per_cu); per_cu = 1; }
        (void)hipGetLastError();
        grid = cus * per_cu;
    }
    if (grid < 0) return;
    Args a{};
    a.x = (const float*)d_in[0]; a.pre_g = (const float*)d_in[1]; a.post_g = (const float*)d_in[2]; a.w_in = (const float*)d_in[3]; a.a_re = (const float*)d_in[4]; a.a_im = (const float*)d_in[5];
    a.log_dt = (const float*)d_in[6]; a.b_re = (const float*)d_in[7]; a.b_im = (const float*)d_in[8]; a.c_re = (const float*)d_in[9]; a.c_im = (const float*)d_in[10]; a.d_skip = (const float*)d_in[11];
    a.w_glu = (const float*)d_in[12]; a.b_glu = (const float*)d_in[13]; a.w_bs = (const float*)d_in[14]; a.w_ba = (const float*)d_in[15]; a.w_out = (const float*)d_in[16];
    a.out = (float*)d_out; a.ws = (unsigned char*)d_ws;
    void* args[] = {&a};
    const hipError_t e = hipLaunchCooperativeKernel((const void*)hybrid_fwd, dim3(grid), dim3(NTHR), args, LDS_BYTES, stream);
    if (e != hipSuccess) fprintf(stderr, "kernel_launch: cooperative launch failed: %s (grid %d)\n", hipGetErrorString(e), grid);
}
```

```cpp
#include <hip/hip_runtime.h>
#include <hip/hip_cooperative_groups.h>
#include <cstdio>
#include <cstdint>
namespace cg = cooperative_groups;
namespace pg8 {
#define PG8_LAS __attribute__((address_space(3)))
typedef unsigned short bf16_t;
typedef short bf16x8 __attribute__((ext_vector_type(8)));
typedef float f32x4 __attribute__((ext_vector_type(4)));
typedef unsigned u32x4 __attribute__((ext_vector_type(4)));
constexpr int BM = 256, BK = 64, HALF = 128, HTB = HALF * BK * 2  , STAGE_BYTES = 8 * HTB, NXCD = 8, WGM = 8;

__host__ __device__ __forceinline__ int lds_byte(int r, int c) { const int st = (r >> 4) * 2 + (c >> 5), rr = r & 15, cc = c & 31, ob = rr * 64 + cc * 2; return st * 1024 + (ob ^ (((ob >> 9) & 1) << 5)); }
__host__ __device__ __forceinline__ void stage_rc(int b, int& R, int& C) { const int st = b / 1024, sb = b % 1024, swz = sb ^ (((sb >> 9) & 1) << 5); R = (st >> 1) * 16 + swz / 64; C = (st & 1) * 32 + (swz % 64) / 2; }
__host__ __device__ __forceinline__ int perm32(int rho) { const int n = rho >> 4, i = rho & 15; return 8 * (i >> 2) + 4 * n + (i & 3); }

struct Unit { int pm, pn, sel; };
struct Gemm { const bf16_t* A; const bf16_t* Bt; int M, N, K; const bf16_t* A2; const bf16_t* Bt2; };

struct StaticOrder {
    int nM, nN, nwg, G, c;
    __host__ __device__ void init(int M, int N, int G_, int c_) { nM = M / BM; nN = N / BM; nwg = nM * nN; G = G_; c = c_; }
    __host__ __device__ bool next(int i, Unit& u) const {
        const long L = (long)i * G + c; if (L >= nwg) return false;
        int wgid = (int)L; { const int q = nwg / NXCD, r = nwg % NXCD, xcd = wgid % NXCD, off = wgid / NXCD; wgid = (xcd < r ? xcd * (q + 1) : r * (q + 1) + (xcd - r) * q) + off; }
        const int nig = WGM * nN, gid = wgid / nig, fm = gid * WGM, gsz = (nM - fm) < WGM ? (nM - fm) : WGM;
        u.pm = fm + ((wgid % nig) % gsz); u.pn = (wgid % nig) / gsz; u.sel = 0; return true;
    }
    __device__ __forceinline__ void a_ready(const Unit&) const {}
    __device__ __forceinline__ void done(const Unit&) const {}
};
__device__ __forceinline__ unsigned cvt_pk_bf16(float lo, float hi) { unsigned r; asm volatile("v_cvt_pk_bf16_f32 %0, %1, %2" : "=v"(r) : "v"(lo), "v"(hi)); return r; }
typedef float f32x2 __attribute__((ext_vector_type(2)));
struct ChainOrder { StaticOrder B;
    __host__ __device__ bool next(int i, Unit& u) const { if (!B.next(i >> 1, u)) return false; u.sel = i & 1; return true; }
    __device__ __forceinline__ void a_ready(const Unit&) const {}
    __device__ __forceinline__ void done(const Unit&) const {}
};

template <class Epi, class Sched, bool ALIGN_EPI = false, bool SP2 = false>
__device__ __forceinline__ void gemm_phase(PG8_LAS unsigned char* lds, const Gemm g, const Sched& S, const Epi& E) {
    int tid_ = threadIdx.x; asm volatile("" : "+v"(tid_));
    const int tid = tid_, wid = __builtin_amdgcn_readfirstlane(tid >> 6), lane = tid & 63, wr = wid >> 2, wc = wid & 3, fr = lane & 15, fq = lane >> 4;
    const int K = g.K, nt = K / BK;
    unsigned voffA[2], voffB[2];
#pragma unroll
    for (int i = 0; i < 2; ++i) { int R, C; stage_rc(tid * 16 + i * 8192, R, C); const int Rb = Epi::PERM ? ((R & ~31) + perm32(R & 31)) : R;
        voffA[i] = (unsigned)(R * K + C) * 2u; voffB[i] = (unsigned)(Rb * K + C) * 2u; }
    const size_t kstep = (size_t)(BK * 2);
    const size_t hstep = (size_t)HALF * K * 2;
    const size_t tstep = 2 * hstep;
    const unsigned ldsw = (unsigned)wid * 1024u;
    const int aoff = lds_byte(wr * 64 + fr, fq * 8), boff = lds_byte(wc * 32 + fr, fq * 8);
#define PG8_SA(b, h) (((b) * 2 + (h)) * HTB)
#define PG8_SB(b, h) ((4 + (b) * 2 + (h)) * HTB)
#define PG8_STAGE(bufoff, gbase, voff) do { _Pragma("unroll") for (int _i = 0; _i < 2; ++_i) \
        __builtin_amdgcn_global_load_lds((const unsigned*)((const char*)(gbase) + (voff)[_i]), (PG8_LAS unsigned*)(lds + (bufoff) + ldsw + _i * 8192), 16, 0, 0); } while (0)
#define PG8_LDA(dst, b, h) do { _Pragma("unroll") for (int m = 0; m < 4; ++m) _Pragma("unroll") for (int k = 0; k < 2; ++k) dst[m][k] = *(const PG8_LAS bf16x8*)(lds + PG8_SA(b, h) + aoff + m * 2048 + k * 1024); } while (0)
#define PG8_LDB(dst, b, h) do { _Pragma("unroll") for (int n = 0; n < 2; ++n) _Pragma("unroll") for (int k = 0; k < 2; ++k) dst[n][k] = *(const PG8_LAS bf16x8*)(lds + PG8_SB(b, h) + boff + n * 2048 + k * 1024); } while (0)
#define PG8_MMA(ai, bj, At, Bt) do { __builtin_amdgcn_s_setprio(1); _Pragma("unroll") for (int m = 0; m < 4; ++m) _Pragma("unroll") for (int n = 0; n < 2; ++n) _Pragma("unroll") for (int k = 0; k < 2; ++k) \
        acc[ai][bj][m][n] = __builtin_amdgcn_mfma_f32_16x16x32_bf16(Bt[n][k], At[m][k], acc[ai][bj][m][n], 0, 0, 0); __builtin_amdgcn_s_setprio(0); } while (0)
#define PG8_WAIT_V(n) asm volatile("s_waitcnt vmcnt(" #n ")" ::: "memory")
#define PG8_WAIT_L(n) asm volatile("s_waitcnt lgkmcnt(" #n ")" ::: "memory")
#define PG8_BAR __builtin_amdgcn_s_barrier()
#define PG8_SCHED __builtin_amdgcn_sched_barrier(0)
    Unit cur, nxt; int ui = 0;
    if (!S.next(0, cur)) return;
    f32x4 acc[2][2][4][2];
#pragma unroll
    for (int a = 0; a < 2; ++a)
#pragma unroll
        for (int b = 0; b < 2; ++b)
#pragma unroll
            for (int m = 0; m < 4; ++m)
#pragma unroll
                for (int n = 0; n < 2; ++n) acc[a][b][m][n] = (f32x4){0.f, 0.f, 0.f, 0.f};
    bf16x8 At[4][2], B0[2][2], B1[2][2];
    const char* cA = (const char*)(cur.sel ? g.A2 : g.A) + (size_t)cur.pm * tstep; const char* cB = (const char*)(cur.sel ? g.Bt2 : g.Bt) + (size_t)cur.pn * tstep;
    S.a_ready(cur);
    if constexpr (SP2) {
        PG8_STAGE(PG8_SB(0, 0), cB, voffB); PG8_STAGE(PG8_SB(0, 1), cB + hstep, voffB); PG8_STAGE(PG8_SA(0, 0), cA, voffA); PG8_STAGE(PG8_SA(0, 1), cA + hstep, voffA);
        if (wr == 1) PG8_BAR;
        PG8_WAIT_V(2); PG8_BAR;
        PG8_STAGE(PG8_SB(1, 0), cB + kstep, voffB); PG8_STAGE(PG8_SA(1, 0), cA + kstep, voffA); PG8_STAGE(PG8_SB(1, 1), cB + hstep + kstep, voffB);
        PG8_WAIT_V(6); PG8_BAR;
    } else {
        PG8_STAGE(PG8_SB(0, 0), cB, voffB); PG8_STAGE(PG8_SA(0, 0), cA, voffA); PG8_STAGE(PG8_SB(0, 1), cB + hstep, voffB); PG8_STAGE(PG8_SA(0, 1), cA + hstep, voffA);
        if (wr == 1) PG8_BAR;
        PG8_WAIT_V(4); PG8_BAR;
        PG8_STAGE(PG8_SB(1, 0), cB + kstep, voffB); PG8_STAGE(PG8_SA(1, 0), cA + kstep, voffA); PG8_STAGE(PG8_SB(1, 1), cB + hstep + kstep, voffB);
        PG8_WAIT_V(6); PG8_BAR;
    }
    for (;;) {
        const bool has_next = S.next(ui + 1, nxt);
        const char* nA = has_next ? (const char*)(nxt.sel ? g.A2 : g.A) + (size_t)nxt.pm * tstep : cA; const char* nB = has_next ? (const char*)(nxt.sel ? g.Bt2 : g.Bt) + (size_t)nxt.pn * tstep : cB;
        for (int t = 0; t < nt; t += 2) {
            const bool last = (t == nt - 2);
            const char* a1 = cA + (size_t)(t + 1) * kstep;
            const char* a2 = last ? nA : cA + (size_t)(t + 2) * kstep; const char* b2 = last ? nB : cB + (size_t)(t + 2) * kstep;
            const char* a3 = a2 + kstep; const char* b3 = b2 + kstep;
            if (last && has_next) S.a_ready(nxt);
            if constexpr (SP2) {
            PG8_LDB(B0, 0, 0); PG8_LDB(B1, 0, 1); PG8_SCHED; PG8_LDA(At, 0, 0); PG8_STAGE(PG8_SA(1, 1), a1 + hstep, voffA);
            PG8_WAIT_V(8); PG8_WAIT_L(0); PG8_BAR; PG8_MMA(0, 0, At, B0); PG8_MMA(0, 1, At, B1); PG8_BAR; PG8_SCHED;
            PG8_LDA(At, 0, 1); PG8_STAGE(PG8_SB(0, 0), b2, voffB); PG8_STAGE(PG8_SB(0, 1), b2 + hstep, voffB); PG8_STAGE(PG8_SA(0, 0), a2, voffA);
            PG8_WAIT_V(8); PG8_WAIT_L(0); PG8_BAR; PG8_MMA(1, 0, At, B0); PG8_MMA(1, 1, At, B1); PG8_BAR; PG8_SCHED;
            PG8_LDB(B0, 1, 0); PG8_LDB(B1, 1, 1); PG8_SCHED; PG8_LDA(At, 1, 0); PG8_STAGE(PG8_SA(0, 1), a2 + hstep, voffA);
            PG8_WAIT_V(8); PG8_WAIT_L(0); PG8_BAR; PG8_MMA(0, 0, At, B0); PG8_MMA(0, 1, At, B1); PG8_BAR; PG8_SCHED;
            PG8_LDA(At, 1, 1); PG8_STAGE(PG8_SB(1, 0), b3, voffB); PG8_STAGE(PG8_SB(1, 1), b3 + hstep, voffB); PG8_STAGE(PG8_SA(1, 0), a3, voffA);
            PG8_WAIT_V(8); PG8_WAIT_L(0); PG8_BAR; PG8_MMA(1, 0, At, B0); PG8_MMA(1, 1, At, B1); PG8_BAR; PG8_SCHED;
            } else {
            PG8_LDB(B0, 0, 0); PG8_SCHED; PG8_LDA(At, 0, 0); PG8_STAGE(PG8_SA(1, 1), a1 + hstep, voffA);
            PG8_WAIT_L(8); PG8_BAR; PG8_WAIT_L(0); PG8_MMA(0, 0, At, B0); PG8_BAR; PG8_SCHED;
            PG8_LDB(B1, 0, 1); PG8_STAGE(PG8_SB(0, 0), b2, voffB);
            PG8_BAR; PG8_WAIT_L(0); PG8_MMA(0, 1, At, B1); PG8_BAR;
            PG8_LDA(At, 0, 1); PG8_STAGE(PG8_SA(0, 0), a2, voffA);
            PG8_BAR; PG8_WAIT_L(0); PG8_MMA(1, 0, At, B0); PG8_BAR; PG8_SCHED;
            PG8_STAGE(PG8_SB(0, 1), b2 + hstep, voffB);
            PG8_WAIT_V(6); PG8_BAR; PG8_MMA(1, 1, At, B1); PG8_BAR;
            PG8_LDB(B0, 1, 0); PG8_SCHED; PG8_LDA(At, 1, 0); PG8_STAGE(PG8_SA(0, 1), a2 + hstep, voffA);
            PG8_WAIT_L(8); PG8_BAR; PG8_WAIT_L(0); PG8_MMA(0, 0, At, B0); PG8_BAR; PG8_SCHED;
            PG8_LDB(B1, 1, 1); PG8_STAGE(PG8_SB(1, 0), b3, voffB);
            PG8_BAR; PG8_WAIT_L(0); PG8_MMA(0, 1, At, B1); PG8_BAR;
            PG8_LDA(At, 1, 1); PG8_STAGE(PG8_SA(1, 0), a3, voffA);
            PG8_BAR; PG8_WAIT_L(0); PG8_MMA(1, 0, At, B0); PG8_BAR; PG8_SCHED;
            PG8_STAGE(PG8_SB(1, 1), b3 + hstep, voffB);
            PG8_WAIT_V(6); PG8_BAR; PG8_MMA(1, 1, At, B1); PG8_BAR;
            }
        }
        if constexpr (ALIGN_EPI) { if (wr == 0) PG8_BAR; }
        if constexpr (!Epi::AFTER_DRAIN) { E(acc, cur, wr, wc, fr, fq); S.done(cur); }
        if (!has_next) break;
#pragma unroll
        for (int a = 0; a < 2; ++a)
#pragma unroll
            for (int b = 0; b < 2; ++b)
#pragma unroll
                for (int m = 0; m < 4; ++m)
#pragma unroll
                    for (int n = 0; n < 2; ++n) acc[a][b][m][n] = (f32x4){0.f, 0.f, 0.f, 0.f};
        cur = nxt; cA = nA; cB = nB; ++ui;
        if constexpr (ALIGN_EPI) { if (wr == 1) PG8_BAR; }
    }
    PG8_WAIT_V(0);
    if constexpr (!ALIGN_EPI) { if (wr == 0) PG8_BAR; }
    PG8_BAR;
    if constexpr (Epi::AFTER_DRAIN) { E.fused(acc, cur, wr, wc, fr, fq, lds, wid, lane); S.done(cur); }
#undef PG8_SA
#undef PG8_SB
#undef PG8_STAGE
#undef PG8_LDA
#undef PG8_LDB
#undef PG8_MMA
#undef PG8_WAIT_V
#undef PG8_WAIT_L
#undef PG8_BAR
#undef PG8_SCHED
}
}
#define DI __device__ __forceinline__
#define LAS __attribute__((address_space(3)))
typedef unsigned short bf16;
typedef float f32x4 __attribute__((ext_vector_type(4)));
typedef float f32x2 __attribute__((ext_vector_type(2)));
typedef float f32x16 __attribute__((ext_vector_type(16)));
typedef short bf16x8 __attribute__((ext_vector_type(8)));
typedef unsigned u32x4 __attribute__((ext_vector_type(4)));
typedef unsigned u32x2 __attribute__((ext_vector_type(2)));
typedef __bf16 bf16x2_t __attribute__((ext_vector_type(2)));

constexpr int NWAVES = 8, NTHR = 512;
constexpr int BATCH = 2, SEQ = 8192, DM = 1024, DEPTH = 4, M = BATCH * SEQ, NCOL = 5120;
constexpr int NG = 32, NP = 64, NCH = SEQ / 64;
constexpr float EPS = 1e-6f;
constexpr size_t MiB = 1u << 20;
constexpr size_t WS_WIN = 1 * MiB, WS_WGLU = 11 * MiB, WS_WBS = 12 * MiB, WS_WBA = 13 * MiB, WS_WOUT = 14 * MiB;
constexpr size_t WS_H = 16 * MiB;
constexpr size_t WS_U = 48 * MiB, WS_ZS = 64 * MiB, WS_Q = 80 * MiB, WS_K = 96 * MiB, WS_VT = 112 * MiB, WS_ZA = 128 * MiB;
constexpr size_t WS_GS = 144 * MiB, WS_GA = 176 * MiB;
constexpr size_t WS_KTAB = 208 * MiB, KTAB_LSTRIDE = 1280 * 1024;
constexpr size_t WS_WTAB = 213 * MiB, WTAB_LSTRIDE = 2 * MiB;
constexpr size_t WS_VTAB = 221 * MiB, VTAB_LSTRIDE = 2 * MiB;
constexpr size_t WS_S = 229 * MiB, S_LSTRIDE = 4 * MiB;
constexpr size_t WS_LAM = 245 * MiB, LAM_LSTRIDE = 64 * 1024;
constexpr size_t WS_END = 246 * MiB;
constexpr int KTAB_BYTES = 65 * 512;
constexpr int LDS_BYTES = 147456;
constexpr float QSCALE = 0.125f * 1.4426950408889634f;

struct Args {
    const float* x; const float* pre_g; const float* post_g; const float* w_in; const float* a_re; const float* a_im; const float* log_dt;
    const float* b_re; const float* b_im; const float* c_re; const float* c_im; const float* d_skip; const float* w_glu; const float* b_glu;
    const float* w_bs; const float* w_ba; const float* w_out; float* out; unsigned char* ws;
};

DI unsigned cvtpk(float lo, float hi) { f32x2 v = {lo, hi}; bf16x2_t b = __builtin_convertvector(v, bf16x2_t); return __builtin_bit_cast(unsigned, b); }
DI float bflo(unsigned w) { return __uint_as_float(w << 16); }
DI float bfhi(unsigned w) { return __uint_as_float(w & 0xffff0000u); }
DI float bf1(bf16 b) { return __uint_as_float((unsigned)b << 16); }
DI float sigm(float x) { return __builtin_amdgcn_rcpf(1.0f + __expf(-x)); }
DI float silu(float x) { return x * sigm(x); }
DI float gelu_tanh(float x) { const float u = 1.5957691216057308f * (x + 0.044715f * x * x * x); return x * sigm(u); }
DI float wave_sum(float v) {
#pragma unroll
    for (int o = 1; o < 64; o <<= 1) v += __shfl_xor(v, o);
    return v;
}

struct EpiProj {
    static constexpr bool PERM = true, AFTER_DRAIN = false;
    unsigned char* ws;
    DI void operator()(const pg8::f32x4 (&acc)[2][2][4][2], const pg8::Unit& u, int wr, int wc, int fr, int fq) const {
        const int pn = u.pn;
        bf16* base; int ld, colt; float sc = 1.f;
        if (pn < 12) { base = (bf16*)(ws + WS_U + (size_t)(pn >> 1) * (16 * MiB)); ld = 512; colt = (pn & 1) * 256; if ((pn >> 1) == 2) sc = QSCALE; }
        else if (pn < 16) { base = (bf16*)(ws + WS_GS); ld = 1024; colt = (pn - 12) * 256; }
        else { base = (bf16*)(ws + WS_GA); ld = 1024; colt = (pn - 16) * 256; }
        const int row0 = u.pm * 256 + wr * 64 + fr, col0 = colt + wc * 32 + 8 * fq;
        if ((pn >> 1) == 4) {
            bf16* vt = (bf16*)(ws + WS_VT);
#pragma unroll
            for (int ai = 0; ai < 2; ++ai)
#pragma unroll
                for (int m = 0; m < 4; ++m) { const int r = row0 + ai * 128 + m * 16; const int bb = r >> 13, t = r & 8191;
#pragma unroll
                    for (int bj = 0; bj < 2; ++bj) { bf16* p = vt + ((size_t)(bb * 512 + col0 + bj * 128)) * 8192 + t;
#pragma unroll
                        for (int n = 0; n < 2; ++n)
#pragma unroll
                            for (int e = 0; e < 4; ++e) { *p = (bf16)(cvtpk(acc[ai][bj][m][n][e], 0.f) & 0xffffu); p += 8192; asm volatile("" : "+v"(p)); } }
                    __builtin_amdgcn_sched_barrier(0); }
            return;
        }
#pragma unroll
        for (int ai = 0; ai < 2; ++ai)
#pragma unroll
            for (int m = 0; m < 4; ++m) { bf16* rowp = base + (size_t)(row0 + ai * 128 + m * 16) * ld + col0;
#pragma unroll
                for (int bj = 0; bj < 2; ++bj) { const pg8::f32x4 v0 = acc[ai][bj][m][0] * sc, v1 = acc[ai][bj][m][1] * sc;
                    u32x4 w; w.x = cvtpk(v0[0], v0[1]); w.y = cvtpk(v0[2], v0[3]); w.z = cvtpk(v1[0], v1[1]); w.w = cvtpk(v1[2], v1[3]);
                    *(u32x4*)(rowp + bj * 128) = w; } }
    }
};
struct EpiGlu {
    static constexpr bool PERM = true, AFTER_DRAIN = false;
    bf16* zs; const float* bias;
    DI void operator()(const pg8::f32x4 (&acc)[2][2][4][2], const pg8::Unit& u, int wr, int wc, int fr, int fq) const {
        const int row0 = u.pm * 256 + wr * 64 + fr, col0 = u.pn * 128 + wc * 32 + 8 * fq;
        f32x4 ba0 = *(const f32x4*)(bias + col0), ba1 = *(const f32x4*)(bias + col0 + 4), bb0 = *(const f32x4*)(bias + 512 + col0), bb1 = *(const f32x4*)(bias + 512 + col0 + 4);
        u32x4 zv[2][4];
#pragma unroll
        for (int ai = 0; ai < 2; ++ai)
#pragma unroll
            for (int m = 0; m < 4; ++m) zv[ai][m] = *(const u32x4*)(zs + (size_t)(row0 + ai * 128 + m * 16) * 512 + col0);
        __builtin_amdgcn_sched_barrier(0);
#pragma unroll
        for (int ai = 0; ai < 2; ++ai)
#pragma unroll
            for (int m = 0; m < 4; ++m) { bf16* p = zs + (size_t)(row0 + ai * 128 + m * 16) * 512 + col0;
                const u32x4 z = zv[ai][m]; float zf[8] = {bflo(z.x), bfhi(z.x), bflo(z.y), bfhi(z.y), bflo(z.z), bfhi(z.z), bflo(z.w), bfhi(z.w)}; float y[8];
#pragma unroll
                for (int e = 0; e < 4; ++e) { y[e] = (acc[ai][0][m][0][e] + ba0[e]) * sigm(acc[ai][1][m][0][e] + bb0[e]) * silu(zf[e]);
                                              y[4 + e] = (acc[ai][0][m][1][e] + ba1[e]) * sigm(acc[ai][1][m][1][e] + bb1[e]) * silu(zf[4 + e]); }
                u32x4 w; w.x = cvtpk(y[0], y[1]); w.y = cvtpk(y[2], y[3]); w.z = cvtpk(y[4], y[5]); w.w = cvtpk(y[6], y[7]); *(u32x4*)p = w; }
    }
};
template <int PASS> struct EpiBranch {
    static constexpr bool PERM = true, AFTER_DRAIN = false;
    bf16* G; const bf16* gate2;
    DI void operator()(const pg8::f32x4 (&acc)[2][2][4][2], const pg8::Unit& u, int wr, int wc, int fr, int fq) const {
        const int row0 = u.pm * 256 + wr * 64 + fr, col0 = u.pn * 256 + wc * 32 + 8 * fq;
#pragma unroll
        for (int ai = 0; ai < 2; ++ai)
#pragma unroll
          for (int mh = 0; mh < 2; ++mh) {
            u32x4 gv[2][2], hv[2][2];
#pragma unroll
            for (int mm = 0; mm < 2; ++mm)
#pragma unroll
                for (int bj = 0; bj < 2; ++bj) { const int m = 2 * mh + mm; const size_t off = (size_t)(row0 + ai * 128 + m * 16) * 1024 + col0 + bj * 128; gv[mm][bj] = *(const u32x4*)(G + off); if (PASS == 1) hv[mm][bj] = *(const u32x4*)(gate2 + off); }
            __builtin_amdgcn_sched_barrier(0);
#pragma unroll
            for (int mm = 0; mm < 2; ++mm)
#pragma unroll
                for (int bj = 0; bj < 2; ++bj) { const int m = 2 * mh + mm; const size_t off = (size_t)(row0 + ai * 128 + m * 16) * 1024 + col0 + bj * 128;
                    const u32x4 g = gv[mm][bj]; float gf[8] = {bflo(g.x), bfhi(g.x), bflo(g.y), bfhi(g.y), bflo(g.z), bfhi(g.z), bflo(g.w), bfhi(g.w)}; float y[8];
                    if (PASS == 0) {
#pragma unroll
                        for (int e = 0; e < 4; ++e) { y[e] = sigm(gf[e]) * acc[ai][bj][m][0][e]; y[4 + e] = sigm(gf[4 + e]) * acc[ai][bj][m][1][e]; }
                    } else {
                        const u32x4 h = hv[mm][bj]; float hf[8] = {bflo(h.x), bfhi(h.x), bflo(h.y), bfhi(h.y), bflo(h.z), bfhi(h.z), bflo(h.w), bfhi(h.w)};
#pragma unroll
                        for (int e = 0; e < 4; ++e) { y[e] = gf[e] + sigm(hf[e]) * acc[ai][bj][m][0][e]; y[4 + e] = gf[4 + e] + sigm(hf[4 + e]) * acc[ai][bj][m][1][e]; }
                    }
                    u32x4 w; w.x = cvtpk(y[0], y[1]); w.y = cvtpk(y[2], y[3]); w.z = cvtpk(y[4], y[5]); w.w = cvtpk(y[6], y[7]); *(u32x4*)(G + off) = w; }
            __builtin_amdgcn_sched_barrier(0);
          }
    }
};
struct EpiBranchBoth {
    static constexpr bool PERM = true, AFTER_DRAIN = false;
    bf16* G; const bf16* gate2;
    DI void operator()(const pg8::f32x4 (&acc)[2][2][4][2], const pg8::Unit& u, int wr, int wc, int fr, int fq) const {
        if (u.sel == 0) { EpiBranch<0> e{G, gate2}; e(acc, u, wr, wc, fr, fq); } else { EpiBranch<1> e{G, gate2}; e(acc, u, wr, wc, fr, fq); }
    }
};
struct EpiPlain {
    static constexpr bool PERM = true, AFTER_DRAIN = false;
    bf16* O;
    DI void operator()(const pg8::f32x4 (&acc)[2][2][4][2], const pg8::Unit& u, int wr, int wc, int fr, int fq) const {
        const int row0 = u.pm * 256 + wr * 64 + fr, col0 = u.pn * 256 + wc * 32 + 8 * fq;
#pragma unroll
        for (int ai = 0; ai < 2; ++ai)
#pragma unroll
            for (int m = 0; m < 4; ++m)
#pragma unroll
                for (int bj = 0; bj < 2; ++bj) { const pg8::f32x4 v0 = acc[ai][bj][m][0], v1 = acc[ai][bj][m][1];
                    u32x4 w; w.x = cvtpk(v0[0], v0[1]); w.y = cvtpk(v0[2], v0[3]); w.z = cvtpk(v1[0], v1[1]); w.w = cvtpk(v1[2], v1[3]);
                    *(u32x4*)(O + (size_t)(row0 + ai * 128 + m * 16) * 1024 + col0 + bj * 128) = w; }
    }
};

DI void norm_row(const float* xin, const bf16* o, const float* g_post, float* xout, const float* g_pre, bf16* h, int lane) {
    f32x4 v[4];
#pragma unroll
    for (int j = 0; j < 4; ++j) v[j] = *((const f32x4*)xin + lane + 64 * j);
    if (o) {
        f32x4 ov[4]; float ss = 0.f;
#pragma unroll
        for (int j = 0; j < 4; ++j) { const u32x2 w = *((const u32x2*)o + lane + 64 * j); ov[j] = (f32x4){bflo(w.x), bfhi(w.x), bflo(w.y), bfhi(w.y)};
            ss += (ov[j].x * ov[j].x + ov[j].y * ov[j].y) + (ov[j].z * ov[j].z + ov[j].w * ov[j].w); }
        const float rstd = 1.0f / sqrtf(wave_sum(ss) * (1.0f / DM) + EPS);
#pragma unroll
        for (int j = 0; j < 4; ++j) { const f32x4 g = *((const f32x4*)g_post + lane + 64 * j); v[j] = v[j] + ov[j] * rstd * g; *((f32x4*)xout + lane + 64 * j) = v[j]; }
    }
    if (g_pre) {
        float ss = 0.f;
#pragma unroll
        for (int j = 0; j < 4; ++j) ss += (v[j].x * v[j].x + v[j].y * v[j].y) + (v[j].z * v[j].z + v[j].w * v[j].w);
        const float rstd = 1.0f / sqrtf(wave_sum(ss) * (1.0f / DM) + EPS);
#pragma unroll
        for (int j = 0; j < 4; ++j) { const f32x4 g = *((const f32x4*)g_pre + lane + 64 * j); const f32x4 y = v[j] * rstd * g;
            u32x2 w; w.x = cvtpk(y.x, y.y); w.y = cvtpk(y.z, y.w); *((u32x2*)h + lane + 64 * j) = w; }
    }
}
DI void transpose_item(const float* W, int K, int N, bf16* WT, int k0, int n0, int dst_row0, LAS float* scr, int lane) {
#pragma unroll 8
    for (int i = 0; i < 32; ++i) { const int kk = 2 * i + (lane >> 5); scr[kk * 33 + (lane & 31)] = W[(size_t)(k0 + kk) * N + n0 + (lane & 31)]; }
    asm volatile("s_waitcnt lgkmcnt(0)" ::: "memory");
    const int c = lane & 7;
#pragma unroll
    for (int j = 0; j < 4; ++j) { const int n = (lane >> 3) + 8 * j; const LAS float* s = scr + (8 * c) * 33 + n;
        u32x4 o; o.x = cvtpk(s[0 * 33], s[1 * 33]); o.y = cvtpk(s[2 * 33], s[3 * 33]); o.z = cvtpk(s[4 * 33], s[5 * 33]); o.w = cvtpk(s[6 * 33], s[7 * 33]);
        *(u32x4*)(WT + (size_t)(dst_row0 + n) * K + k0 + 8 * c) = o; }
    asm volatile("s_waitcnt lgkmcnt(0)" ::: "memory");
}
DI f32x2 cpow_k(float are, float aim, float dt, int k) {
    const float mag = __expf(are * dt * (float)k);
    const double turns = (double)aim * (double)dt * (double)k * 0.15915494309189535;
    const float fr = (float)(turns - floor(turns));
    return (f32x2){mag * __builtin_amdgcn_cosf(fr), mag * __builtin_amdgcn_sinf(fr)};
}
DI f32x2 cmul(f32x2 a, f32x2 b) { return (f32x2){a.x * b.x - a.y * b.y, a.x * b.y + a.y * b.x}; }
DI f32x2 zoh_factor(float are, float aim, float dt) {
    const f32x2 ab = cpow_k(are, aim, dt, 1); const float nr = ab.x - 1.0f, ni = ab.y, den = are * are + aim * aim;
    return (f32x2){(nr * are + ni * aim) / den, (ni * are - nr * aim) / den};
}

struct LayerP { const float *a_re, *a_im, *log_dt, *b_re, *b_im, *c_re, *c_im; };

DI void ktab_block(const LayerP& P, bf16* KTAB, int g, int tb, LAS unsigned char* lds, int tid) {
    LAS f32x2* CL = (LAS f32x2*)lds;
    LAS f32x2* BB = (LAS f32x2*)(lds + 16384);
    const float dt = __expf(P.log_dt[g]);
    const int p = tid & 63, h0 = tid >> 6, h1 = h0 + 8;
    const float are = P.a_re[g * 64 + p], aim = P.a_im[g * 64 + p];
    const f32x2 c0 = {P.c_re[(g * 16 + h0) * 64 + p], P.c_im[(g * 16 + h0) * 64 + p]}, c1 = {P.c_re[(g * 16 + h1) * 64 + p], P.c_im[(g * 16 + h1) * 64 + p]};
    const int e0 = tid, e1 = tid + NTHR; const int pa = e0 >> 4, pb = e1 >> 4, hp = tid & 15;
    const float area = P.a_re[g * 64 + pa], aima = P.a_im[g * 64 + pa], areb = P.a_re[g * 64 + pb], aimb = P.a_im[g * 64 + pb];
    const f32x2 bva = {P.b_re[(g * 64 + pa) * 16 + hp], P.b_im[(g * 64 + pa) * 16 + hp]}, bvb = {P.b_re[(g * 64 + pb) * 16 + hp], P.b_im[(g * 64 + pb) * 16 + hp]};
    BB[pa * 16 + hp] = cmul(zoh_factor(area, aima, dt), bva); BB[pb * 16 + hp] = cmul(zoh_factor(areb, aimb, dt), bvb);
    if (tb == 0 && tid < 256) KTAB[((size_t)g * 65) * 256 + tid] = 0;
#pragma unroll 1
    for (int tp = 0; tp < 4; ++tp) { const int tau0 = tb * 8 + 2 * tp;
        const f32x2 l0 = cpow_k(are, aim, dt, tau0), l1 = cpow_k(are, aim, dt, tau0 + 1);
        CL[(0 * 16 + h0) * 64 + p] = cmul(c0, l0); CL[(0 * 16 + h1) * 64 + p] = cmul(c1, l0); CL[(1 * 16 + h0) * 64 + p] = cmul(c0, l1); CL[(1 * 16 + h1) * 64 + p] = cmul(c1, l1);
        __syncthreads();
        { const int ts = tid >> 8, h = (tid >> 4) & 15; float sacc = 0.f;
#pragma unroll 8
          for (int q = 0; q < 64; ++q) { const f32x2 c = CL[(ts * 16 + h) * 64 + q], bq = BB[q * 16 + hp]; sacc += c.x * bq.x - c.y * bq.y; }
          KTAB[((size_t)g * 65 + (tau0 + ts + 1)) * 256 + h * 16 + hp] = (bf16)(cvtpk(sacc, 0.f) & 0xffffu); }
        __syncthreads();
    }
}
DI void wv_item(const LayerP& P, bf16* WTAB, bf16* VTAB, float* LAM, int idx) {
    const int p = idx & 63, k = (idx >> 6) & 15, g = idx >> 10;
    const float dt = __expf(P.log_dt[g]), are = P.a_re[g * 64 + p], aim = P.a_im[g * 64 + p];
    f32x2 cv[16];
#pragma unroll
    for (int j = 0; j < 16; ++j) cv[j] = (f32x2){P.c_re[(g * 16 + j) * 64 + p], P.c_im[(g * 16 + j) * 64 + p]};
    const f32x2 lk1 = cpow_k(are, aim, dt, k + 1);
#pragma unroll
    for (int h = 0; h < 16; ++h) { const f32x2 c = cmul(cv[h], lk1); *(unsigned*)(VTAB + ((size_t)g * 256 + k * 16 + h) * 128 + 2 * p) = cvtpk(c.x, -c.y); }
    if (k == 15) { const f32x2 l64 = cpow_k(are, aim, dt, 64); *(f32x4*)(LAM + (g * 64 + p) * 4) = (f32x4){l64.x, l64.y, lk1.x, lk1.y}; }
}

#define MFMA16(a, b, c) __builtin_amdgcn_mfma_f32_16x16x32_bf16((a), (b), (c), 0, 0, 0)
#define MFMA32(a, b, c) __builtin_amdgcn_mfma_f32_32x32x16_bf16((a), (b), (c), 0, 0, 0)
DI void make_wfrag(const LayerP& P, int g, int wave, int lane, bf16x8 (&af)[8], f32x2& l16a, f32x2& l16b) {
    const int n = lane & 15, kg = lane >> 4, p = 8 * wave + (n >> 1), ri = n & 1;
    const float dt = __expf(P.log_dt[g]), are = P.a_re[g * 64 + p], aim = P.a_im[g * 64 + p];
    const int pa = 8 * wave + 2 * kg;
    const float area = P.a_re[g * 64 + pa], aima = P.a_im[g * 64 + pa], areb = P.a_re[g * 64 + pa + 1], aimb = P.a_im[g * 64 + pa + 1];
    const f32x4 br0 = *(const f32x4*)(P.b_re + (g * 64 + p) * 16 + 8 * (kg & 1)), br1 = *(const f32x4*)(P.b_re + (g * 64 + p) * 16 + 8 * (kg & 1) + 4);
    const f32x4 bi0 = *(const f32x4*)(P.b_im + (g * 64 + p) * 16 + 8 * (kg & 1)), bi1 = *(const f32x4*)(P.b_im + (g * 64 + p) * 16 + 8 * (kg & 1) + 4);
    const f32x2 f = zoh_factor(are, aim, dt);
    f32x2 fb[8];
#pragma unroll
    for (int i = 0; i < 4; ++i) { fb[i] = cmul(f, (f32x2){br0[i], bi0[i]}); fb[4 + i] = cmul(f, (f32x2){br1[i], bi1[i]}); }
#pragma unroll
    for (int ks = 0; ks < 8; ++ks) { const f32x2 lp = cpow_k(are, aim, dt, 15 - 2 * ks - (kg >> 1)); float v[8];
#pragma unroll
        for (int i = 0; i < 8; ++i) { const f32x2 c = cmul(lp, fb[i]); v[i] = ri ? c.y : c.x; }
        const u32x4 w = {cvtpk(v[0], v[1]), cvtpk(v[2], v[3]), cvtpk(v[4], v[5]), cvtpk(v[6], v[7])}; af[ks] = __builtin_bit_cast(bf16x8, w); }
    l16a = cpow_k(area, aima, dt, 16); l16b = cpow_k(areb, aimb, dt, 16);
}
DI void ssm_state_unit(const bf16* U, const bf16x8 (&af)[8], f32x2 l16a, f32x2 l16b, float* S, int b, int g, int cb, int wave, int lane) {
    const int n = lane & 15, kg = lane >> 4;
    const bf16* up = U + ((size_t)b * SEQ + (size_t)(cb * 16 + n) * 64 + (kg >> 1)) * 512 + g * 16 + 8 * (kg & 1);
    bf16x8 uf[4][8];
#pragma unroll
    for (int a = 0; a < 4; ++a)
#pragma unroll
        for (int ks = 0; ks < 8; ++ks) uf[a][ks] = *(const bf16x8*)(up + (size_t)(16 * a + 2 * ks) * 512);
    __builtin_amdgcn_sched_barrier(0);
    pg8::f32x4 acc4[4];
#pragma unroll
    for (int a = 0; a < 4; ++a) acc4[a] = (pg8::f32x4){0.f, 0.f, 0.f, 0.f};
#pragma unroll
    for (int ks = 0; ks < 8; ++ks)
#pragma unroll
        for (int a = 0; a < 4; ++a) acc4[a] = MFMA16(af[ks], uf[a][ks], acc4[a]);
    __builtin_amdgcn_sched_barrier(0);
    pg8::f32x4 st = acc4[0];
#pragma unroll
    for (int a = 1; a < 4; ++a) {
        const f32x2 s0 = cmul(l16a, (f32x2){st[0], st[1]}), s1 = cmul(l16b, (f32x2){st[2], st[3]});
        st = (pg8::f32x4){s0.x + acc4[a][0], s0.y + acc4[a][1], s1.x + acc4[a][2], s1.y + acc4[a][3]};
    }
    *(pg8::f32x4*)(S + (((size_t)b * NCH + cb * 16 + n) * NG + g) * 128 + 16 * wave + 4 * kg) = st;
}
constexpr int XIN_OFF = 33280, XIN_PITCH = 272, XIN_VAR = 16 * XIN_PITCH, TB_OFF = XIN_OFF + 4 * XIN_VAR, UL_OFF = 57344, UL_PITCH = 2064;
template <int S> DI void toe_stage(pg8::f32x4 (&acc)[8], const LAS unsigned char* ul, const LAS unsigned char* kt, int wave, int lo, int hi) {
#pragma unroll 1
    for (int ks = lo; ks <= hi; ++ks) {
        const bf16x8 uf0 = *(const LAS bf16x8*)(ul + ks * 64);
        bf16x8 a0[8 - S];
#pragma unroll
        for (int j = S; j < 8; ++j) a0[j - S] = *(const LAS bf16x8*)(kt + (wave + 8 * j - 2 * ks) * 512);
        __builtin_amdgcn_sched_barrier(0);
#pragma unroll
        for (int j = S; j < 8; ++j) acc[j] = MFMA16(a0[j - S], uf0, acc[j]);
    }
}
#ifdef PROBE_SEL
#define QS(sel) do { if (PROBE_SEL == (sel)) tq0 = __builtin_amdgcn_s_memrealtime(); } while (0)
#define QT(sel) do { if (PROBE_SEL == (sel)) tqacc += __builtin_amdgcn_s_memrealtime() - tq0; } while (0)
#else
#define QS(sel) do {} while (0)
#define QT(sel) do {} while (0)
#endif
DI void ssm_out_unit(unsigned long long& tqacc, bool load_ktab, const bf16* U, const bf16* KTAB, const bf16* VTAB, const float* S, const float* LAM, const float* dsk, bf16* YS, int b, int g, int cb, LAS unsigned char* lds, int tid, int wave, int lane) {
    unsigned long long tq0 = 0ull; (void)tq0;
    const int n = lane & 15, kg = lane >> 4;
    QS(51);
    const f32x4 lam4 = *(const f32x4*)(LAM + (g * 64 + lane) * 4); const f32x2 lam = {lam4.x, lam4.y}, l16 = {lam4.z, lam4.w};
    f32x2 sv[16];
    {
        const u32x4* src = (const u32x4*)((const unsigned char*)KTAB + (size_t)g * KTAB_BYTES);
        u32x4 kt4[4], kt5 = {0u, 0u, 0u, 0u}, ut4[4];
        if (load_ktab) {
#pragma unroll
            for (int j = 0; j < 4; ++j) kt4[j] = src[tid + NTHR * j];
            if (tid < 32) kt5 = src[2048 + tid];
        }
#pragma unroll
        for (int j = 0; j < 4; ++j) { const int idx = tid + NTHR * j, cn = idx >> 7, tok = (idx >> 1) & 63, half = idx & 1;
            ut4[j] = *(const u32x4*)(U + ((size_t)b * SEQ + (size_t)(cb * 16 + cn) * 64 + tok) * 512 + g * 16 + 8 * half); }
        if (wave <= cb) { const f32x2* sp = (const f32x2*)(S + (((size_t)b * NCH + wave * 16) * NG + g) * 128) + lane;
#pragma unroll
            for (int j = 0; j < 16; ++j) sv[j] = sp[(size_t)j * (NG * 64)]; }
        __builtin_amdgcn_sched_barrier(0);
        if (load_ktab) {
#pragma unroll
            for (int j = 0; j < 4; ++j) *(LAS u32x4*)(lds + 16 * (tid + NTHR * j)) = kt4[j];
            if (tid < 32) *(LAS u32x4*)(lds + 16 * (2048 + tid)) = kt5;
        }
#pragma unroll
        for (int j = 0; j < 4; ++j) { const int idx = tid + NTHR * j, cn = idx >> 7, tok = (idx >> 1) & 63, half = idx & 1; *(LAS u32x4*)(lds + UL_OFF + cn * UL_PITCH + tok * 32 + half * 16) = ut4[j]; }
    }
    bf16x8 vfr[4][2];
#pragma unroll
    for (int k2 = 0; k2 < 4; ++k2)
#pragma unroll
        for (int jj = 0; jj < 2; ++jj) vfr[k2][jj] = *(const bf16x8*)(VTAB + ((size_t)g * 256 + (wave + 8 * jj) * 16 + n) * 128 + 32 * k2 + 8 * kg);
    __builtin_amdgcn_sched_barrier(0);
    LAS f32x2* TB = (LAS f32x2*)(lds + TB_OFF);
    if (wave < cb) { f32x2 x = {0.f, 0.f};
#pragma unroll
        for (int j = 0; j < 16; ++j) { x = cmul(lam, x); x.x += sv[j].x; x.y += sv[j].y; }
        TB[wave * 64 + lane] = x; }
    __syncthreads();
    if (wave == cb) {
        f32x2 l1k = lam;
#pragma unroll
        for (int j = 0; j < 4; ++j) l1k = cmul(l1k, l1k);
        f32x2 x = {0.f, 0.f};
        for (int w = 0; w < cb; ++w) { const f32x2 t = TB[w * 64 + lane]; x = cmul(l1k, x); x.x += t.x; x.y += t.y; }
#pragma unroll
        for (int j = 0; j < 16; ++j) { f32x2 xa = x;
#pragma unroll
            for (int a = 0; a < 4; ++a) { *(LAS unsigned*)(lds + XIN_OFF + a * XIN_VAR + j * XIN_PITCH + 4 * lane) = cvtpk(xa.x, xa.y); xa = cmul(l16, xa); }
            x = cmul(lam, x); x.x += sv[j].x; x.y += sv[j].y; }
    }
    __syncthreads();
    QT(51); QS(52);
    pg8::f32x4 acc[8];
#pragma unroll
    for (int j = 0; j < 8; ++j) acc[j] = (pg8::f32x4){0.f, 0.f, 0.f, 0.f};
    const LAS unsigned char* ul = lds + UL_OFF + n * UL_PITCH + (kg >> 1) * 32 + (kg & 1) * 16;
    const LAS unsigned char* kt = lds + n * 32 + (kg & 1) * 16 + (1 - (kg >> 1)) * 512;
    { const int hw = wave >> 1;
      toe_stage<0>(acc, ul, kt, wave, 0, hw);            toe_stage<1>(acc, ul, kt, wave, hw + 1, hw + 4);   toe_stage<2>(acc, ul, kt, wave, hw + 5, hw + 8);   toe_stage<3>(acc, ul, kt, wave, hw + 9, hw + 12);
      toe_stage<4>(acc, ul, kt, wave, hw + 13, hw + 16); toe_stage<5>(acc, ul, kt, wave, hw + 17, hw + 20); toe_stage<6>(acc, ul, kt, wave, hw + 21, hw + 24); toe_stage<7>(acc, ul, kt, wave, hw + 25, hw + 28); }
#pragma unroll
    for (int k2 = 0; k2 < 4; ++k2) {
        bf16x8 xf[4];
#pragma unroll
        for (int a = 0; a < 4; ++a) xf[a] = *(const LAS bf16x8*)(lds + XIN_OFF + a * XIN_VAR + n * XIN_PITCH + (32 * k2 + 8 * kg) * 2);
#pragma unroll
        for (int j = 0; j < 8; ++j) acc[j] = MFMA16(vfr[k2][j & 1], xf[j >> 1], acc[j]); }
    QT(52); QS(53);
    const f32x4 dv = *(const f32x4*)(dsk + g * 16 + 4 * kg);
#pragma unroll
    for (int j = 0; j < 8; ++j) { const int t = wave + 8 * j; const size_t off = ((size_t)b * SEQ + (size_t)(cb * 16 + n) * 64 + t) * 512 + g * 16 + 4 * kg;
        const u32x2 uu = *(const LAS u32x2*)(lds + UL_OFF + n * UL_PITCH + t * 32 + kg * 8);
        const float y0 = gelu_tanh(acc[j][0] + dv[0] * bflo(uu.x)), y1 = gelu_tanh(acc[j][1] + dv[1] * bfhi(uu.x)), y2 = gelu_tanh(acc[j][2] + dv[2] * bflo(uu.y)), y3 = gelu_tanh(acc[j][3] + dv[3] * bfhi(uu.y));
        u32x2 w; w.x = cvtpk(y0, y1); w.y = cvtpk(y2, y3); *(u32x2*)(YS + off) = w; }
    asm volatile("s_waitcnt lgkmcnt(0)\n\ts_barrier" ::: "memory");
    QT(53);
}

struct AttnSt { f32x16 o0, o1; float carry; };
DI bool attn_tile(AttnSt& st, const bf16x8 (&kf)[4], const bf16x8 (&vf)[4], const bf16x8 (&qf)[4], bool diag, int n, int hi) {
    f32x16 s;
#pragma unroll
    for (int r = 0; r < 16; ++r) s[r] = 0.f;
#pragma unroll
    for (int ks = 0; ks < 4; ++ks) s = MFMA32(kf[ks], qf[ks], s);
    float sp[16];
#pragma unroll
    for (int r = 0; r < 16; ++r) { const float z = s[r]; const float e = __builtin_amdgcn_exp2f(-fabsf(z)); sp[r] = fmaxf(z, 0.f) + __builtin_amdgcn_logf(1.0f + e);
        if (diag && (16 * (r >> 3) + 8 * hi + (r & 7)) >= n) sp[r] = 0.f; }
    float cum[16]; float c0 = 0.f, c1 = 0.f;
#pragma unroll
    for (int r = 7; r >= 0; --r) { c0 -= sp[r]; cum[r] = c0; c1 -= sp[8 + r]; cum[8 + r] = c1; }
    const float p0 = __shfl_xor(c0, 32), p1 = __shfl_xor(c1, 32);
    const float base1 = st.carry + (hi ? 0.f : p1), base0 = st.carry + c1 + p1 + (hi ? 0.f : p0);
    float w[16];
#pragma unroll
    for (int r = 0; r < 16; ++r) { w[r] = __builtin_amdgcn_exp2f(s[r] + cum[r] + (r < 8 ? base0 : base1));
        if (diag && (16 * (r >> 3) + 8 * hi + (r & 7)) >= n) w[r] = 0.f; }
    st.carry += (c0 + c1) + (p0 + p1);
    const u32x4 pa = {cvtpk(w[0], w[1]), cvtpk(w[2], w[3]), cvtpk(w[4], w[5]), cvtpk(w[6], w[7])}, pb = {cvtpk(w[8], w[9]), cvtpk(w[10], w[11]), cvtpk(w[12], w[13]), cvtpk(w[14], w[15])};
    const bf16x8 pf0 = __builtin_bit_cast(bf16x8, pa), pf1 = __builtin_bit_cast(bf16x8, pb);
    st.o0 = MFMA32(pf0, vf[0], st.o0); st.o0 = MFMA32(pf1, vf[1], st.o0); st.o1 = MFMA32(pf0, vf[2], st.o1); st.o1 = MFMA32(pf1, vf[3], st.o1);
    return __ballot(st.carry >= -152.0f) == 0ull;
}
DI void attn_task(const bf16* Q, const bf16* Kb, const bf16* VT, const bf16* ZA, bf16* Y, int b, int h, int qt, int lane) {
    const int n = lane & 31, hi = lane >> 5;
    const size_t rowbase = (size_t)b * SEQ;
    bf16x8 qf[4];
    { const bf16* qp = Q + (rowbase + qt * 32 + n) * 512 + h * 64 + 8 * hi;
#pragma unroll
      for (int ks = 0; ks < 4; ++ks) qf[ks] = *(const bf16x8*)(qp + 16 * ks); }
    const int pm = (n & ~12) | (((n >> 2) & 1) << 3) | (((n >> 3) & 1) << 2);
    const bf16* kp = Kb + (rowbase + pm) * 512 + h * 64 + 8 * hi;
    const bf16* vp = VT + ((size_t)(b * 8 + h) * 64 + n) * SEQ + 8 * hi;
    AttnSt st;
#pragma unroll
    for (int r = 0; r < 16; ++r) { st.o0[r] = 0.f; st.o1[r] = 0.f; }
    st.carry = 0.f;
    bf16x8 kA[4], vA[4], kB[4], vB[4], kC[4], vC[4];
#define ATT_LOAD(KF, VF, ktile) do { const int key0_ = ((ktile) > 0 ? (ktile) : 0) * 32; \
        _Pragma("unroll") for (int ks = 0; ks < 4; ++ks) KF[ks] = *(const bf16x8*)(kp + (size_t)key0_ * 512 + 16 * ks); \
        VF[0] = *(const bf16x8*)(vp + key0_); VF[1] = *(const bf16x8*)(vp + key0_ + 16); VF[2] = *(const bf16x8*)(vp + (size_t)32 * SEQ + key0_); VF[3] = *(const bf16x8*)(vp + (size_t)32 * SEQ + key0_ + 16); } while (0)
    ATT_LOAD(kA, vA, qt); ATT_LOAD(kB, vB, qt - 1);
    int kt = qt;
    for (;;) {
        ATT_LOAD(kC, vC, kt - 2); __builtin_amdgcn_sched_barrier(0);
        if (attn_tile(st, kA, vA, qf, kt == qt, n, hi) || kt == 0) break; --kt; __builtin_amdgcn_sched_barrier(0);
        ATT_LOAD(kA, vA, kt - 2); __builtin_amdgcn_sched_barrier(0);
        if (attn_tile(st, kB, vB, qf, false, n, hi) || kt == 0) break; --kt; __builtin_amdgcn_sched_barrier(0);
        ATT_LOAD(kB, vB, kt - 2); __builtin_amdgcn_sched_barrier(0);
        if (attn_tile(st, kC, vC, qf, false, n, hi) || kt == 0) break; --kt; __builtin_amdgcn_sched_barrier(0);
    }
#undef ATT_LOAD
    float za0[16], za1[16];
#pragma unroll
    for (int r = 0; r < 16; ++r) { const int i = (r & 3) + 8 * (r >> 2) + 4 * hi; const size_t off = (rowbase + qt * 32 + i) * 512 + h * 64 + n; za0[r] = bf1(ZA[off]); za1[r] = bf1(ZA[off + 32]); }
    __builtin_amdgcn_sched_barrier(0);
#pragma unroll
    for (int r = 0; r < 16; ++r) { const int i = (r & 3) + 8 * (r >> 2) + 4 * hi; const size_t off = (rowbase + qt * 32 + i) * 512 + h * 64 + n;
        Y[off] = (bf16)(cvtpk(st.o0[r] * silu(za0[r]), 0.f) & 0xffffu); Y[off + 32] = (bf16)(cvtpk(st.o1[r] * silu(za1[r]), 0.f) & 0xffffu); }
}
#define XB_TMO      128
#define XB_XCNT(j)  (256  + 64 * (j))
#define XB_XSUB(j)  (1280 + 64 * (j))
#define XB_XGEN(j)  (2304 + 64 * (j))
#define XB_TOP      3328
#define XB_TOPGEN   3392
#define XCD_BAR_WORDS 3456
#define XB_SPIN_CAP (1u << 18)

__device__ __forceinline__ unsigned xb_ld(unsigned* p)              { return __hip_atomic_load(p, __ATOMIC_RELAXED, __HIP_MEMORY_SCOPE_AGENT); }
__device__ __forceinline__ unsigned xb_add(unsigned* p, unsigned v) { return __hip_atomic_fetch_add(p, v, __ATOMIC_RELAXED, __HIP_MEMORY_SCOPE_AGENT); }
__device__ __forceinline__ unsigned xb_xcc_id() { return (unsigned)__builtin_amdgcn_s_getreg((3 << 11) | 20) & 0xFu; }
#define XB_SPIN(cond, bar) do { unsigned _sp = 0; while (cond) { __builtin_amdgcn_s_sleep(1); \
    if ((++_sp & 255u) == 0u) { if (xb_ld(&(bar)[XB_TMO])) break; if (_sp > XB_SPIN_CAP) { atomicAdd(&(bar)[XB_TMO], 1u); break; } } } } while (0)

struct XcdBarrier {
    unsigned* bar; unsigned x;
    volatile LAS unsigned* st;
};

__device__ __forceinline__ XcdBarrier xcd_barrier_post(unsigned* bar, volatile LAS unsigned* st) {
    XcdBarrier b; b.bar = bar; b.x = xb_xcc_id(); b.st = st;
    if (threadIdx.x == 0) (void)xb_add(&bar[XB_XCNT(b.x)], 1u);
    return b;
}
__device__ __forceinline__ void xcd_barrier_complete(unsigned* bar, unsigned x, unsigned& nloc, unsigned& nx) {
    const unsigned G = gridDim.x * gridDim.y * gridDim.z;
    unsigned sum, cnt, mine, sp = 0u;
    for (;;) {
        sum = 0u; cnt = 0u; mine = 0u;
#pragma unroll
        for (unsigned j = 0; j < 16; ++j) { const unsigned c = xb_ld(&bar[XB_XCNT(j)]); sum += c; cnt += (c > 0u) ? 1u : 0u; mine = (j == x) ? c : mine; }
        if (sum == G) break;
        __builtin_amdgcn_s_sleep(1);
        if ((++sp & 255u) == 0u) { if (xb_ld(&bar[XB_TMO])) break; if (sp > XB_SPIN_CAP) { atomicAdd(&bar[XB_TMO], 1u); break; } }
    }
    nloc = mine > 0u ? mine : 1u; nx = cnt > 0u ? cnt : 1u;
}

__device__ __forceinline__ void xcd_barrier(const XcdBarrier& b) {
    asm volatile("s_waitcnt vmcnt(0)" ::: "memory");
    __syncthreads();
    if (threadIdx.x == 0) {
        unsigned* bar = b.bar;
        __builtin_amdgcn_s_waitcnt(0);
        unsigned nloc = b.st[0], nx = b.st[1];
        if (nloc == 0u) { xcd_barrier_complete(bar, b.x, nloc, nx); b.st[0] = nloc; b.st[1] = nx; }
        const unsigned old = xb_add(&bar[XB_XSUB(b.x)], 1u);
        const unsigned gen = old / nloc;
        if (old + 1u == (gen + 1u) * nloc) {
            __builtin_amdgcn_fence(__ATOMIC_RELEASE, "agent");
            asm volatile("s_waitcnt vmcnt(0)" ::: "memory");
            const unsigned og = xb_add(&bar[XB_TOP], 1u);
            const unsigned tg = og / nx;
            if (og + 1u == (tg + 1u) * nx) xb_add(&bar[XB_TOPGEN], 1u);
            else XB_SPIN(xb_ld(&bar[XB_TOPGEN]) == tg, bar);
            __builtin_amdgcn_fence(__ATOMIC_ACQUIRE, "agent");
            xb_add(&bar[XB_XGEN(b.x)], 1u);
            asm volatile("s_waitcnt vmcnt(0)" ::: "memory");
        } else {
            XB_SPIN(xb_ld(&bar[XB_XGEN(b.x)]) == gen, bar);
            __builtin_amdgcn_fence(__ATOMIC_ACQUIRE, "agent");
            asm volatile("s_waitcnt vmcnt(0)" ::: "memory");
        }
    }
    __syncthreads();
}

__device__ __forceinline__ void xcd_barrier1(const XcdBarrier& b) {
    asm volatile("s_waitcnt vmcnt(0)" ::: "memory");
    __syncthreads();
    if (threadIdx.x == 0) {
        unsigned* bar = b.bar;
        __builtin_amdgcn_s_waitcnt(0);
        unsigned nloc = b.st[0], nx = b.st[1];
        if (nloc == 0u) { xcd_barrier_complete(bar, b.x, nloc, nx); b.st[0] = nloc; b.st[1] = nx; }
        const unsigned k = b.st[2]; b.st[2] = k + 1u;
        const unsigned old = xb_add(&bar[XB_XSUB(b.x)], 1u);
        const unsigned gen = old / nloc;
        if (old + 1u == (gen + 1u) * nloc) {
            __builtin_amdgcn_fence(__ATOMIC_RELEASE, "agent");
            asm volatile("s_waitcnt vmcnt(0)" ::: "memory");
            const unsigned og = xb_add(&bar[XB_TOP], 1u);
            if (og + 1u == (k + 1u) * nx) xb_add(&bar[XB_TOPGEN], 1u);
            else XB_SPIN(xb_ld(&bar[XB_TOPGEN]) == k, bar);
        } else {
            XB_SPIN(xb_ld(&bar[XB_TOPGEN]) == k, bar);
        }
        __builtin_amdgcn_fence(__ATOMIC_ACQUIRE, "agent");
        asm volatile("s_waitcnt vmcnt(0)" ::: "memory");
    }
    __syncthreads();
}
__global__ void __launch_bounds__(NTHR, 2) hybrid_fwd(Args a) {
    extern __shared__ __attribute__((aligned(16))) unsigned char lds_raw[];
    LAS unsigned char* lds = (LAS unsigned char*)lds_raw;
    cg::grid_group grid = cg::this_grid();
#ifdef EXP_INVL2
    if (threadIdx.x == 0) asm volatile("buffer_inv sc0 sc1\n\ts_waitcnt vmcnt(0)" ::: "memory");
    __syncthreads();
#endif
    volatile LAS unsigned* xb_st = (volatile LAS unsigned*)(lds + 131072 + 1024);
    if (threadIdx.x < 3) xb_st[threadIdx.x] = 0u;
    __syncthreads();
    if (blockIdx.x == 0) for (int i = threadIdx.x; i < 4096; i += NTHR) __hip_atomic_store((unsigned*)a.ws + i, 0u, __ATOMIC_RELAXED, __HIP_MEMORY_SCOPE_AGENT);
    XcdBarrier xbar; xbar.bar = (unsigned*)a.ws; xbar.x = 0; xbar.st = xb_st;
    const int tid0 = threadIdx.x, wave = __builtin_amdgcn_readfirstlane(tid0 >> 6);
    const int G = gridDim.x, bx = blockIdx.x;
    const int gw = bx * NWAVES + wave, NGW = G * NWAVES;
    unsigned char* ws = a.ws;
    bf16* const Win = (bf16*)(ws + WS_WIN); bf16* const Wglu = (bf16*)(ws + WS_WGLU); bf16* const Wbs = (bf16*)(ws + WS_WBS); bf16* const Wba = (bf16*)(ws + WS_WBA); bf16* const Wout = (bf16*)(ws + WS_WOUT);
    bf16* const Hb = (bf16*)(ws + WS_H); bf16* const Ub = (bf16*)(ws + WS_U); bf16* const ZSb = (bf16*)(ws + WS_ZS); bf16* const Qb = (bf16*)(ws + WS_Q); bf16* const Kb = (bf16*)(ws + WS_K);
    bf16* const VTb = (bf16*)(ws + WS_VT); bf16* const ZAb = (bf16*)(ws + WS_ZA); bf16* const GSb = (bf16*)(ws + WS_GS); bf16* const GAb = (bf16*)(ws + WS_GA);


    unsigned long long tqa = 0ull;
#ifdef PROBE_SEL
    unsigned long long tacc = 0ull, tbeg = 0ull;
#define PW(sel) do { if (PROBE_SEL == (sel) + 10) tacc += __builtin_amdgcn_s_memrealtime() - tbeg; if (PROBE_SEL == (sel) + 20) tbeg = __builtin_amdgcn_s_memrealtime(); } while (0)
#define PS(sel) do { if (PROBE_SEL == (sel)) tbeg = __builtin_amdgcn_s_memrealtime(); } while (0)
#define PT(sel) do { if (PROBE_SEL == (sel)) tacc += __builtin_amdgcn_s_memrealtime() - tbeg; } while (0)
#define PB(sel) do { if (PROBE_SEL == (sel) || PROBE_SEL == (sel) + 10) tbeg = __builtin_amdgcn_s_memrealtime(); } while (0)
#define PE(sel) do { if (PROBE_SEL == (sel) || PROBE_SEL == (sel) + 20) tacc += __builtin_amdgcn_s_memrealtime() - tbeg; } while (0)
#else
#define PB(sel) do {} while (0)
#define PW(sel) do {} while (0)
#define PS(sel) do {} while (0)
#define PT(sel) do {} while (0)
#define PE(sel) do {} while (0)
#endif
#define GSYNC() xcd_barrier1(xbar)
    PB(0);
    for (int l = 0; l <= DEPTH; ++l) {
        const int lt = l < DEPTH ? l : 0;
        bf16* const KTAB = (bf16*)(ws + WS_KTAB + lt * KTAB_LSTRIDE); bf16* const WTAB = (bf16*)(ws + WS_WTAB + lt * WTAB_LSTRIDE); bf16* const VTAB = (bf16*)(ws + WS_VTAB + lt * VTAB_LSTRIDE);
        float* const Sb = (float*)(ws + WS_S + lt * S_LSTRIDE); float* const LAM = (float*)(ws + WS_LAM + lt * LAM_LSTRIDE);
        int tid = tid0; asm volatile("" : "+v"(tid)); const int lane = tid & 63;
        PB(1);
        {
            const float* xin = (l <= 1) ? a.x : a.out;
        PS(43);
            for (int m = gw; m < M; m += NGW)
                norm_row(xin + (size_t)m * DM, l > 0 ? GAb + (size_t)m * DM : nullptr, l > 0 ? a.post_g + (l - 1) * DM : nullptr, a.out + (size_t)m * DM,
                         l < DEPTH ? a.pre_g + l * DM : nullptr, Hb + (size_t)m * DM, lane);
        PT(43);
            if (l == DEPTH) { PE(1); break; }
            LAS float* scr = (LAS float*)(lds + wave * 16384);
            const float* w_in = a.w_in + (size_t)l * DM * NCOL; const float* w_glu = a.w_glu + (size_t)l * 512 * 1024; const float* w_bs = a.w_bs + (size_t)l * 512 * 1024;
            const float* w_ba = a.w_ba + (size_t)l * 512 * 1024; const float* w_out = a.w_out + (size_t)l * 1024 * 1024;
            constexpr int I_IN = 16 * 160, I_GLU = 8 * 32, I_BR = 8 * 32, I_OUT = 16 * 32, NITEMS = I_IN + I_GLU + 2 * I_BR + I_OUT;
        PS(44);
            for (int it = gw; it < NITEMS; it += NGW) {
                int r = it;
                if (r < I_IN) { const int kb = r / 160, nb = r % 160; transpose_item(w_in, 1024, NCOL, Win, 64 * kb, 32 * nb, 32 * nb, scr, lane); continue; } r -= I_IN;
                if (r < I_GLU) { const int kb = r / 32, nb = r % 32, n0 = 32 * nb; const int bj = n0 >> 9, rem = n0 & 511, pn = rem >> 7, i0 = rem & 127;
                    transpose_item(w_glu, 512, 1024, Wglu, 64 * kb, n0, 256 * pn + 128 * bj + i0, scr, lane); continue; } r -= I_GLU;
                if (r < I_BR) { const int kb = r / 32, nb = r % 32; transpose_item(w_bs, 512, 1024, Wbs, 64 * kb, 32 * nb, 32 * nb, scr, lane); continue; } r -= I_BR;
                if (r < I_BR) { const int kb = r / 32, nb = r % 32; transpose_item(w_ba, 512, 1024, Wba, 64 * kb, 32 * nb, 32 * nb, scr, lane); continue; } r -= I_BR;
                { const int kb = r / 32, nb = r % 32; transpose_item(w_out, 1024, 1024, Wout, 64 * kb, 32 * nb, 32 * nb, scr, lane); }
            }
            __syncthreads();
            PT(44);
            LayerP P{a.a_re + l * NG * NP, a.a_im + l * NG * NP, a.log_dt + l * NG, a.b_re + (size_t)l * NG * NP * 16, a.b_im + (size_t)l * NG * NP * 16, a.c_re + (size_t)l * NG * 16 * NP, a.c_im + (size_t)l * NG * 16 * NP};
        PS(45);
#ifndef NO_TAB
            for (int it = bx; it < NG * 8; it += G) ktab_block(P, KTAB, it >> 3, it & 7, lds, tid);
            for (int idx = bx * NTHR + tid; idx < NG * NP * 16; idx += G * NTHR) wv_item(P, WTAB, VTAB, LAM, idx);
#endif
        PT(45);
        }
        PW(1);
        if (l == 0) { grid.sync(); xbar = xcd_barrier_post((unsigned*)a.ws, xb_st); } else GSYNC();
        PE(1);
        PB(2);
#ifndef NO_A
        { pg8::Gemm g{Hb, Win, M, NCOL, DM}; pg8::StaticOrder S; S.init(M, NCOL, G, bx); EpiProj E{ws};
          pg8::gemm_phase<EpiProj, pg8::StaticOrder, true, true>(lds, g, S, E); }
#endif
        PW(2);
        GSYNC();
        PE(2);
        PB(3);
        PS(41);
#ifndef NO_B1
        for (int u0 = 2 * bx; u0 < 512; u0 += 2 * G) { const int g = u0 >> 4;
            LayerP P{a.a_re + l * NG * NP, a.a_im + l * NG * NP, a.log_dt + l * NG, a.b_re + (size_t)l * NG * NP * 16, a.b_im + (size_t)l * NG * NP * 16, a.c_re + (size_t)l * NG * 16 * NP, a.c_im + (size_t)l * NG * 16 * NP};
            bf16x8 af[8]; f32x2 l16a, l16b;
            make_wfrag(P, g, wave, lane, af, l16a, l16b);
            for (int q = 0; q < 2; ++q) { const int nb = (u0 + q) & 15; ssm_state_unit(Ub, af, l16a, l16b, Sb, nb >> 3, g, nb & 7, wave, lane); } }
#endif
        PT(41);
        PS(42);
#ifndef NO_ATTN
        for (int t = gw; t < 4096; t += NGW) attn_task(Qb, Kb, VTb, ZAb, Qb, t >> 11, (t >> 8) & 7, t & 255, lane);
#endif
        PT(42);
        PW(3);
        GSYNC();
        PE(3);
        PB(4);
#ifndef NO_B3
        for (int u = 2 * bx; u < 512; u += (u & 1) ? 2 * G - 1 : 1) { const int g = u >> 4, nb = u & 15; ssm_out_unit(tqa, (u & 1) == 0, Ub, KTAB, VTAB, Sb, LAM, a.d_skip + l * 512, Hb, nb >> 3, g, nb & 7, lds, tid, wave, lane); }
#endif
        PW(4);
        GSYNC();
        PE(4);
        PB(5);
#ifndef NO_D1
        { pg8::Gemm g{Hb, Wglu, M, 1024, 512}; pg8::StaticOrder S; S.init(M, 1024, G, bx); EpiGlu E{ZSb, a.b_glu + l * 1024};
          pg8::gemm_phase<EpiGlu, pg8::StaticOrder, true, true>(lds, g, S, E); }
#endif
        PW(5);
        GSYNC();
        PE(5);
#ifndef NO_D2
        PB(6);
        { pg8::Gemm g{ZSb, Wbs, M, 1024, 512, Qb, Wba}; pg8::ChainOrder S; S.B.init(M, 1024, G, bx); EpiBranchBoth E{GSb, GAb};
          pg8::gemm_phase<EpiBranchBoth, pg8::ChainOrder, true, true>(lds, g, S, E); }
#endif
        PW(6);
        GSYNC();
        PE(6);
#ifndef NO_D3
        PB(7);
        { pg8::Gemm g{GSb, Wout, M, 1024, 1024}; pg8::StaticOrder S; S.init(M, 1024, G, bx); EpiPlain E{GAb};
          pg8::gemm_phase<EpiPlain, pg8::StaticOrder, true, true>(lds, g, S, E); }
#endif
        PW(7);
        GSYNC();
        PE(7);
    }
    PE(0);
#ifdef PROBE_SEL
    grid.sync();
    if (bx == 0) { LAS unsigned long long* tb = (LAS unsigned long long*)lds; if (tid0 == 0) tb[0] = tacc + tqa; __syncthreads(); const unsigned long long K = tb[0] < 1000000ull ? tb[0] : 1000000ull;
        for (unsigned long long i = tid0; i < K; i += NTHR) a.out[i] += 0.05f; }
#endif
}

extern "C" void kernel_launch(void* const* d_in, const int* in_sizes, int n_in, void* d_out, int out_size, void* d_ws, size_t ws_size, hipStream_t stream) {
    static int grid = 0;
    if (grid == 0) {
        if (n_in != 17 || out_size != M * DM || ws_size < WS_END) { fprintf(stderr, "kernel_launch: unexpected problem shape (n_in %d, out %d, ws %zu)\n", n_in, out_size, ws_size); grid = -1; return; }
        int dev = 0, cus = 0, per_cu = 0;
        (void)hipGetDevice(&dev); (void)hipDeviceGetAttribute(&cus, hipDeviceAttributeMultiprocessorCount, dev);
        if (hipFuncSetAttribute((const void*)hybrid_fwd, hipFuncAttributeMaxDynamicSharedMemorySize, LDS_BYTES) != hipSuccess) { fprintf(stderr, "kernel_launch: hipFuncSetAttribute failed\n"); grid = -1; return; }
        if (hipOccupancyMaxActiveBlocksPerMultiprocessor(&per_cu, (const void*)hybrid_fwd, NTHR, LDS_BYTES) != hipSuccess || per_cu < 1) { fprintf(stderr, "kernel_launch: occupancy query gave %d\n", per_cu); per_cu = 1; }
        (void)hipGetLastError();
        grid = cus * per_cu;
    }
    if (grid < 0) return;
    Args a{};
    a.x = (const float*)d_in[0]; a.pre_g = (const float*)d_in[1]; a.post_g = (const float*)d_in[2]; a.w_in = (const float*)d_in[3]; a.a_re = (const float*)d_in[4]; a.a_im = (const float*)d_in[5];
    a.log_dt = (const float*)d_in[6]; a.b_re = (const float*)d_in[7]; a.b_im = (const float*)d_in[8]; a.c_re = (const float*)d_in[9]; a.c_im = (const float*)d_in[10]; a.d_skip = (const float*)d_in[11];
    a.w_glu = (const float*)d_in[12]; a.b_glu = (const float*)d_in[13]; a.w_bs = (const float*)d_in[14]; a.w_ba = (const float*)d_in[15]; a.w_out = (const float*)d_in[16];
    a.out = (float*)d_out; a.ws = (unsigned char*)d_ws;
    void* args[] = {&a};
    const hipError_t e = hipLaunchCooperativeKernel((const void*)hybrid_fwd, dim3(grid), dim3(NTHR), args, LDS_BYTES, stream);
    if (e != hipSuccess) fprintf(stderr, "kernel_launch: cooperative launch failed: %s (grid %d)\n", hipGetErrorString(e), grid);
}
```

```cpp
#include <hip/hip_runtime.h>
#include <hip/hip_cooperative_groups.h>
#include <cstdio>
#include <cstdint>
namespace cg = cooperative_groups;
namespace pg8 {
#define PG8_LAS __attribute__((address_space(3)))
typedef unsigned short bf16_t;
typedef short bf16x8 __attribute__((ext_vector_type(8)));
typedef float f32x4 __attribute__((ext_vector_type(4)));
typedef unsigned u32x4 __attribute__((ext_vector_type(4)));
constexpr int BM = 256, BK = 64, HALF = 128, HTB = HALF * BK * 2  , STAGE_BYTES = 8 * HTB, NXCD = 8, WGM = 8;

__host__ __device__ __forceinline__ int lds_byte(int r, int c) { const int st = (r >> 4) * 2 + (c >> 5), rr = r & 15, cc = c & 31, ob = rr * 64 + cc * 2; return st * 1024 + (ob ^ (((ob >> 9) & 1) << 5)); }
__host__ __device__ __forceinline__ void stage_rc(int b, int& R, int& C) { const int st = b / 1024, sb = b % 1024, swz = sb ^ (((sb >> 9) & 1) << 5); R = (st >> 1) * 16 + swz / 64; C = (st & 1) * 32 + (swz % 64) / 2; }
__host__ __device__ __forceinline__ int perm32(int rho) { const int n = rho >> 4, i = rho & 15; return 8 * (i >> 2) + 4 * n + (i & 3); }

struct Unit { int pm, pn, sel; };
struct Gemm { const bf16_t* A; const bf16_t* Bt; int M, N, K; const bf16_t* A2; const bf16_t* Bt2; };

struct StaticOrder {
    int nM, nN, nwg, G, c;
    __host__ __device__ void init(int M, int N, int G_, int c_) { nM = M / BM; nN = N / BM; nwg = nM * nN; G = G_; c = c_; }
    __host__ __device__ bool next(int i, Unit& u) const {
        const long L = (long)i * G + c; if (L >= nwg) return false;
        int wgid = (int)L; { const int q = nwg / NXCD, r = nwg % NXCD, xcd = wgid % NXCD, off = wgid / NXCD; wgid = (xcd < r ? xcd * (q + 1) : r * (q + 1) + (xcd - r) * q) + off; }
        const int nig = WGM * nN, gid = wgid / nig, fm = gid * WGM, gsz = (nM - fm) < WGM ? (nM - fm) : WGM;
        u.pm = fm + ((wgid % nig) % gsz); u.pn = (wgid % nig) / gsz; u.sel = 0; return true;
    }
    __device__ __forceinline__ void a_ready(const Unit&) const {}
    __device__ __forceinline__ void done(const Unit&) const {}
};
__device__ __forceinline__ unsigned cvt_pk_bf16(float lo, float hi) { unsigned r; asm volatile("v_cvt_pk_bf16_f32 %0, %1, %2" : "=v"(r) : "v"(lo), "v"(hi)); return r; }
typedef float f32x2 __attribute__((ext_vector_type(2)));
struct ChainOrder { StaticOrder B;
    __host__ __device__ bool next(int i, Unit& u) const { if (!B.next(i >> 1, u)) return false; u.sel = i & 1; return true; }
    __device__ __forceinline__ void a_ready(const Unit&) const {}
    __device__ __forceinline__ void done(const Unit&) const {}
};

template <class Epi, class Sched, bool ALIGN_EPI = false, bool SP2 = false>
__device__ __forceinline__ void gemm_phase(PG8_LAS unsigned char* lds, const Gemm g, const Sched& S, const Epi& E) {
    int tid_ = threadIdx.x; asm volatile("" : "+v"(tid_));
    const int tid = tid_, wid = __builtin_amdgcn_readfirstlane(tid >> 6), lane = tid & 63, wr = wid >> 2, wc = wid & 3, fr = lane & 15, fq = lane >> 4;
    const int K = g.K, nt = K / BK;
    unsigned voffA[2], voffB[2];
#pragma unroll
    for (int i = 0; i < 2; ++i) { int R, C; stage_rc(tid * 16 + i * 8192, R, C); const int Rb = Epi::PERM ? ((R & ~31) + perm32(R & 31)) : R;
        voffA[i] = (unsigned)(R * K + C) * 2u; voffB[i] = (unsigned)(Rb * K + C) * 2u; }
    const size_t kstep = (size_t)(BK * 2);
    const size_t hstep = (size_t)HALF * K * 2;
    const size_t tstep = 2 * hstep;
    const unsigned ldsw = (unsigned)wid * 1024u;
    const int aoff = lds_byte(wr * 64 + fr, fq * 8), boff = lds_byte(wc * 32 + fr, fq * 8);
#define PG8_SA(b, h) (((b) * 2 + (h)) * HTB)
#define PG8_SB(b, h) ((4 + (b) * 2 + (h)) * HTB)
#define PG8_STAGE(bufoff, gbase, voff) do { _Pragma("unroll") for (int _i = 0; _i < 2; ++_i) \
        __builtin_amdgcn_global_load_lds((const unsigned*)((const char*)(gbase) + (voff)[_i]), (PG8_LAS unsigned*)(lds + (bufoff) + ldsw + _i * 8192), 16, 0, 0); } while (0)
#define PG8_LDA(dst, b, h) do { _Pragma("unroll") for (int m = 0; m < 4; ++m) _Pragma("unroll") for (int k = 0; k < 2; ++k) dst[m][k] = *(const PG8_LAS bf16x8*)(lds + PG8_SA(b, h) + aoff + m * 2048 + k * 1024); } while (0)
#define PG8_LDB(dst, b, h) do { _Pragma("unroll") for (int n = 0; n < 2; ++n) _Pragma("unroll") for (int k = 0; k < 2; ++k) dst[n][k] = *(const PG8_LAS bf16x8*)(lds + PG8_SB(b, h) + boff + n * 2048 + k * 1024); } while (0)
#define PG8_MMA(ai, bj, At, Bt) do { __builtin_amdgcn_s_setprio(1); _Pragma("unroll") for (int m = 0; m < 4; ++m) _Pragma("unroll") for (int n = 0; n < 2; ++n) _Pragma("unroll") for (int k = 0; k < 2; ++k) \
        acc[ai][bj][m][n] = __builtin_amdgcn_mfma_f32_16x16x32_bf16(Bt[n][k], At[m][k], acc[ai][bj][m][n], 0, 0, 0); __builtin_amdgcn_s_setprio(0); } while (0)
#define PG8_WAIT_V(n) asm volatile("s_waitcnt vmcnt(" #n ")" ::: "memory")
#define PG8_WAIT_L(n) asm volatile("s_waitcnt lgkmcnt(" #n ")" ::: "memory")
#define PG8_BAR __builtin_amdgcn_s_barrier()
#define PG8_SCHED __builtin_amdgcn_sched_barrier(0)
    Unit cur, nxt; int ui = 0;
    if (!S.next(0, cur)) return;
    f32x4 acc[2][2][4][2];
#pragma unroll
    for (int a = 0; a < 2; ++a)
#pragma unroll
        for (int b = 0; b < 2; ++b)
#pragma unroll
            for (int m = 0; m < 4; ++m)
#pragma unroll
                for (int n = 0; n < 2; ++n) acc[a][b][m][n] = (f32x4){0.f, 0.f, 0.f, 0.f};
    bf16x8 At[4][2], B0[2][2], B1[2][2];
    const char* cA = (const char*)(cur.sel ? g.A2 : g.A) + (size_t)cur.pm * tstep; const char* cB = (const char*)(cur.sel ? g.Bt2 : g.Bt) + (size_t)cur.pn * tstep;
    S.a_ready(cur);
    if constexpr (SP2) {
        PG8_STAGE(PG8_SB(0, 0), cB, voffB); PG8_STAGE(PG8_SB(0, 1), cB + hstep, voffB); PG8_STAGE(PG8_SA(0, 0), cA, voffA); PG8_STAGE(PG8_SA(0, 1), cA + hstep, voffA);
        if (wr == 1) PG8_BAR;
        PG8_WAIT_V(2); PG8_BAR;
        PG8_STAGE(PG8_SB(1, 0), cB + kstep, voffB); PG8_STAGE(PG8_SA(1, 0), cA + kstep, voffA); PG8_STAGE(PG8_SB(1, 1), cB + hstep + kstep, voffB);
        PG8_WAIT_V(6); PG8_BAR;
    } else {
        PG8_STAGE(PG8_SB(0, 0), cB, voffB); PG8_STAGE(PG8_SA(0, 0), cA, voffA); PG8_STAGE(PG8_SB(0, 1), cB + hstep, voffB); PG8_STAGE(PG8_SA(0, 1), cA + hstep, voffA);
        if (wr == 1) PG8_BAR;
        PG8_WAIT_V(4); PG8_BAR;
        PG8_STAGE(PG8_SB(1, 0), cB + kstep, voffB); PG8_STAGE(PG8_SA(1, 0), cA + kstep, voffA); PG8_STAGE(PG8_SB(1, 1), cB + hstep + kstep, voffB);
        PG8_WAIT_V(6); PG8_BAR;
    }
    for (;;) {
        const bool has_next = S.next(ui + 1, nxt);
        const char* nA = has_next ? (const char*)(nxt.sel ? g.A2 : g.A) + (size_t)nxt.pm * tstep : cA; const char* nB = has_next ? (const char*)(nxt.sel ? g.Bt2 : g.Bt) + (size_t)nxt.pn * tstep : cB;
        for (int t = 0; t < nt; t += 2) {
            const bool last = (t == nt - 2);
            const char* a1 = cA + (size_t)(t + 1) * kstep;
            const char* a2 = last ? nA : cA + (size_t)(t + 2) * kstep; const char* b2 = last ? nB : cB + (size_t)(t + 2) * kstep;
            const char* a3 = a2 + kstep; const char* b3 = b2 + kstep;
            if (last && has_next) S.a_ready(nxt);
            if constexpr (SP2) {
            PG8_LDB(B0, 0, 0); PG8_LDB(B1, 0, 1); PG8_SCHED; PG8_LDA(At, 0, 0); PG8_STAGE(PG8_SA(1, 1), a1 + hstep, voffA);
            PG8_WAIT_V(8); PG8_WAIT_L(0); PG8_BAR; PG8_MMA(0, 0, At, B0); PG8_MMA(0, 1, At, B1); PG8_BAR; PG8_SCHED;
            PG8_LDA(At, 0, 1); PG8_STAGE(PG8_SB(0, 0), b2, voffB); PG8_STAGE(PG8_SB(0, 1), b2 + hstep, voffB); PG8_STAGE(PG8_SA(0, 0), a2, voffA);
            PG8_WAIT_V(8); PG8_WAIT_L(0); PG8_BAR; PG8_MMA(1, 0, At, B0); PG8_MMA(1, 1, At, B1); PG8_BAR; PG8_SCHED;
            PG8_LDB(B0, 1, 0); PG8_LDB(B1, 1, 1); PG8_SCHED; PG8_LDA(At, 1, 0); PG8_STAGE(PG8_SA(0, 1), a2 + hstep, voffA);
            PG8_WAIT_V(8); PG8_WAIT_L(0); PG8_BAR; PG8_MMA(0, 0, At, B0); PG8_MMA(0, 1, At, B1); PG8_BAR; PG8_SCHED;
            PG8_LDA(At, 1, 1); PG8_STAGE(PG8_SB(1, 0), b3, voffB); PG8_STAGE(PG8_SB(1, 1), b3 + hstep, voffB); PG8_STAGE(PG8_SA(1, 0), a3, voffA);
            PG8_WAIT_V(8); PG8_WAIT_L(0); PG8_BAR; PG8_MMA(1, 0, At, B0); PG8_MMA(1, 1, At, B1); PG8_BAR; PG8_SCHED;
            } else {
            PG8_LDB(B0, 0, 0); PG8_SCHED; PG8_LDA(At, 0, 0); PG8_STAGE(PG8_SA(1, 1), a1 + hstep, voffA);
            PG8_WAIT_L(8); PG8_BAR; PG8_WAIT_L(0); PG8_MMA(0, 0, At, B0); PG8_BAR; PG8_SCHED;
            PG8_LDB(B1, 0, 1); PG8_STAGE(PG8_SB(0, 0), b2, voffB);
            PG8_BAR; PG8_WAIT_L(0); PG8_MMA(0, 1, At, B1); PG8_BAR;
            PG8_LDA(At, 0, 1); PG8_STAGE(PG8_SA(0, 0), a2, voffA);
            PG8_BAR; PG8_WAIT_L(0); PG8_MMA(1, 0, At, B0); PG8_BAR; PG8_SCHED;
            PG8_STAGE(PG8_SB(0, 1), b2 + hstep, voffB);
            PG8_WAIT_V(6); PG8_BAR; PG8_MMA(1, 1, At, B1); PG8_BAR;
            PG8_LDB(B0, 1, 0); PG8_SCHED; PG8_LDA(At, 1, 0); PG8_STAGE(PG8_SA(0, 1), a2 + hstep, voffA);
            PG8_WAIT_L(8); PG8_BAR; PG8_WAIT_L(0); PG8_MMA(0, 0, At, B0); PG8_BAR; PG8_SCHED;
            PG8_LDB(B1, 1, 1); PG8_STAGE(PG8_SB(1, 0), b3, voffB);
            PG8_BAR; PG8_WAIT_L(0); PG8_MMA(0, 1, At, B1); PG8_BAR;
            PG8_LDA(At, 1, 1); PG8_STAGE(PG8_SA(1, 0), a3, voffA);
            PG8_BAR; PG8_WAIT_L(0); PG8_MMA(1, 0, At, B0); PG8_BAR; PG8_SCHED;
            PG8_STAGE(PG8_SB(1, 1), b3 + hstep, voffB);
            PG8_WAIT_V(6); PG8_BAR; PG8_MMA(1, 1, At, B1); PG8_BAR;
            }
        }
        if constexpr (ALIGN_EPI) { if (wr == 0) PG8_BAR; }
        if constexpr (!Epi::AFTER_DRAIN) { E(acc, cur, wr, wc, fr, fq); S.done(cur); }
        if (!has_next) break;
#pragma unroll
        for (int a = 0; a < 2; ++a)
#pragma unroll
            for (int b = 0; b < 2; ++b)
#pragma unroll
                for (int m = 0; m < 4; ++m)
#pragma unroll
                    for (int n = 0; n < 2; ++n) acc[a][b][m][n] = (f32x4){0.f, 0.f, 0.f, 0.f};
        cur = nxt; cA = nA; cB = nB; ++ui;
        if constexpr (ALIGN_EPI) { if (wr == 1) PG8_BAR; }
    }
    PG8_WAIT_V(0);
    if constexpr (!ALIGN_EPI) { if (wr == 0) PG8_BAR; }
    PG8_BAR;
    if constexpr (Epi::AFTER_DRAIN) { E.fused(acc, cur, wr, wc, fr, fq, lds, wid, lane); S.done(cur); }
#undef PG8_SA
#undef PG8_SB
#undef PG8_STAGE
#undef PG8_LDA
#undef PG8_LDB
#undef PG8_MMA
#undef PG8_WAIT_V
#undef PG8_WAIT_L
#undef PG8_BAR
#undef PG8_SCHED
}
}
#define DI __device__ __forceinline__
#define LAS __attribute__((address_space(3)))
typedef unsigned short bf16;
typedef float f32x4 __attribute__((ext_vector_type(4)));
typedef float f32x2 __attribute__((ext_vector_type(2)));
typedef float f32x16 __attribute__((ext_vector_type(16)));
typedef short bf16x8 __attribute__((ext_vector_type(8)));
typedef unsigned u32x4 __attribute__((ext_vector_type(4)));
typedef unsigned u32x2 __attribute__((ext_vector_type(2)));
typedef __bf16 bf16x2_t __attribute__((ext_vector_type(2)));

constexpr int NWAVES = 8, NTHR = 512;
constexpr int BATCH = 2, SEQ = 8192, DM = 1024, DEPTH = 4, M = BATCH * SEQ, NCOL = 5120;
constexpr int NG = 32, NP = 64, NCH = SEQ / 64;
constexpr float EPS = 1e-6f;
constexpr size_t MiB = 1u << 20;
constexpr size_t WS_WIN = 1 * MiB, WS_WGLU = 11 * MiB, WS_WBS = 12 * MiB, WS_WBA = 13 * MiB, WS_WOUT = 14 * MiB;
constexpr size_t WS_H = 16 * MiB;
constexpr size_t WS_U = 48 * MiB, WS_ZS = 64 * MiB, WS_Q = 80 * MiB, WS_K = 96 * MiB, WS_VT = 112 * MiB, WS_ZA = 128 * MiB;
constexpr size_t WS_GS = 144 * MiB, WS_GA = 176 * MiB;
constexpr size_t WS_KTAB = 208 * MiB, KTAB_LSTRIDE = 1280 * 1024;
constexpr size_t WS_WTAB = 213 * MiB, WTAB_LSTRIDE = 2 * MiB;
constexpr size_t WS_VTAB = 221 * MiB, VTAB_LSTRIDE = 2 * MiB;
constexpr size_t WS_S = 229 * MiB, S_LSTRIDE = 4 * MiB;
constexpr size_t WS_LAM = 245 * MiB, LAM_LSTRIDE = 64 * 1024;
constexpr size_t WS_END = 246 * MiB;
constexpr int KTAB_BYTES = 65 * 512;
constexpr int LDS_BYTES = 147456;
constexpr float QSCALE = 0.125f * 1.4426950408889634f;

struct Args {
    const float* x; const float* pre_g; const float* post_g; const float* w_in; const float* a_re; const float* a_im; const float* log_dt;
    const float* b_re; const float* b_im; const float* c_re; const float* c_im; const float* d_skip; const float* w_glu; const float* b_glu;
    const float* w_bs; const float* w_ba; const float* w_out; float* out; unsigned char* ws;
};

DI unsigned cvtpk(float lo, float hi) { f32x2 v = {lo, hi}; bf16x2_t b = __builtin_convertvector(v, bf16x2_t); return __builtin_bit_cast(unsigned, b); }
DI float bflo(unsigned w) { return __uint_as_float(w << 16); }
DI float bfhi(unsigned w) { return __uint_as_float(w & 0xffff0000u); }
DI float bf1(bf16 b) { return __uint_as_float((unsigned)b << 16); }
DI float sigm(float x) { return __builtin_amdgcn_rcpf(1.0f + __expf(-x)); }
DI float silu(float x) { return x * sigm(x); }
DI float gelu_tanh(float x) { const float u = 1.5957691216057308f * (x + 0.044715f * x * x * x); return x * sigm(u); }
DI float wave_sum(float v) {
#pragma unroll
    for (int o = 1; o < 64; o <<= 1) v += __shfl_xor(v, o);
    return v;
}

struct EpiProj {
    static constexpr bool PERM = true, AFTER_DRAIN = false;
    unsigned char* ws;
    DI void operator()(const pg8::f32x4 (&acc)[2][2][4][2], const pg8::Unit& u, int wr, int wc, int fr, int fq) const {
        const int pn = u.pn;
        bf16* base; int ld, colt; float sc = 1.f;
        if (pn < 12) { base = (bf16*)(ws + WS_U + (size_t)(pn >> 1) * (16 * MiB)); ld = 512; colt = (pn & 1) * 256; if ((pn >> 1) == 2) sc = QSCALE; }
        else if (pn < 16) { base = (bf16*)(ws + WS_GS); ld = 1024; colt = (pn - 12) * 256; }
        else { base = (bf16*)(ws + WS_GA); ld = 1024; colt = (pn - 16) * 256; }
        const int row0 = u.pm * 256 + wr * 64 + fr, col0 = colt + wc * 32 + 8 * fq;
        if ((pn >> 1) == 4) {
            bf16* vt = (bf16*)(ws + WS_VT);
#pragma unroll
            for (int ai = 0; ai < 2; ++ai)
#pragma unroll
                for (int m = 0; m < 4; ++m) { const int r = row0 + ai * 128 + m * 16; const int bb = r >> 13, t = r & 8191;
#pragma unroll
                    for (int bj = 0; bj < 2; ++bj) { bf16* p = vt + ((size_t)(bb * 512 + col0 + bj * 128)) * 8192 + t;
#pragma unroll
                        for (int n = 0; n < 2; ++n)
#pragma unroll
                            for (int e = 0; e < 4; ++e) { *p = (bf16)(cvtpk(acc[ai][bj][m][n][e], 0.f) & 0xffffu); p += 8192; asm volatile("" : "+v"(p)); } }
                    __builtin_amdgcn_sched_barrier(0); }
            return;
        }
#pragma unroll
        for (int ai = 0; ai < 2; ++ai)
#pragma unroll
            for (int m = 0; m < 4; ++m) { bf16* rowp = base + (size_t)(row0 + ai * 128 + m * 16) * ld + col0;
#pragma unroll
                for (int bj = 0; bj < 2; ++bj) { const pg8::f32x4 v0 = acc[ai][bj][m][0] * sc, v1 = acc[ai][bj][m][1] * sc;
                    u32x4 w; w.x = cvtpk(v0[0], v0[1]); w.y = cvtpk(v0[2], v0[3]); w.z = cvtpk(v1[0], v1[1]); w.w = cvtpk(v1[2], v1[3]);
                    *(u32x4*)(rowp + bj * 128) = w; } }
    }
};
struct EpiGlu {
    static constexpr bool PERM = true, AFTER_DRAIN = false;
    bf16* zs; const float* bias;
    DI void operator()(const pg8::f32x4 (&acc)[2][2][4][2], const pg8::Unit& u, int wr, int wc, int fr, int fq) const {
        const int row0 = u.pm * 256 + wr * 64 + fr, col0 = u.pn * 128 + wc * 32 + 8 * fq;
        f32x4 ba0 = *(const f32x4*)(bias + col0), ba1 = *(const f32x4*)(bias + col0 + 4), bb0 = *(const f32x4*)(bias + 512 + col0), bb1 = *(const f32x4*)(bias + 512 + col0 + 4);
        u32x4 zv[2][4];
#pragma unroll
        for (int ai = 0; ai < 2; ++ai)
#pragma unroll
            for (int m = 0; m < 4; ++m) zv[ai][m] = *(const u32x4*)(zs + (size_t)(row0 + ai * 128 + m * 16) * 512 + col0);
        __builtin_amdgcn_sched_barrier(0);
#pragma unroll
        for (int ai = 0; ai < 2; ++ai)
#pragma unroll
            for (int m = 0; m < 4; ++m) { bf16* p = zs + (size_t)(row0 + ai * 128 + m * 16) * 512 + col0;
                const u32x4 z = zv[ai][m]; float zf[8] = {bflo(z.x), bfhi(z.x), bflo(z.y), bfhi(z.y), bflo(z.z), bfhi(z.z), bflo(z.w), bfhi(z.w)}; float y[8];
#pragma unroll
                for (int e = 0; e < 4; ++e) { y[e] = (acc[ai][0][m][0][e] + ba0[e]) * sigm(acc[ai][1][m][0][e] + bb0[e]) * silu(zf[e]);
                                              y[4 + e] = (acc[ai][0][m][1][e] + ba1[e]) * sigm(acc[ai][1][m][1][e] + bb1[e]) * silu(zf[4 + e]); }
                u32x4 w; w.x = cvtpk(y[0], y[1]); w.y = cvtpk(y[2], y[3]); w.z = cvtpk(y[4], y[5]); w.w = cvtpk(y[6], y[7]); *(u32x4*)p = w; }
    }
};
template <int PASS> struct EpiBranch {
    static constexpr bool PERM = true, AFTER_DRAIN = false;
    bf16* G; const bf16* gate2;
    DI void operator()(const pg8::f32x4 (&acc)[2][2][4][2], const pg8::Unit& u, int wr, int wc, int fr, int fq) const {
        const int row0 = u.pm * 256 + wr * 64 + fr, col0 = u.pn * 256 + wc * 32 + 8 * fq;
#pragma unroll
        for (int ai = 0; ai < 2; ++ai)
#pragma unroll
          for (int mh = 0; mh < 2; ++mh) {
            u32x4 gv[2][2], hv[2][2];
#pragma unroll
            for (int mm = 0; mm < 2; ++mm)
#pragma unroll
                for (int bj = 0; bj < 2; ++bj) { const int m = 2 * mh + mm; const size_t off = (size_t)(row0 + ai * 128 + m * 16) * 1024 + col0 + bj * 128; gv[mm][bj] = *(const u32x4*)(G + off); if (PASS == 1) hv[mm][bj] = *(const u32x4*)(gate2 + off); }
            __builtin_amdgcn_sched_barrier(0);
#pragma unroll
            for (int mm = 0; mm < 2; ++mm)
#pragma unroll
                for (int bj = 0; bj < 2; ++bj) { const int m = 2 * mh + mm; const size_t off = (size_t)(row0 + ai * 128 + m * 16) * 1024 + col0 + bj * 128;
                    const u32x4 g = gv[mm][bj]; float gf[8] = {bflo(g.x), bfhi(g.x), bflo(g.y), bfhi(g.y), bflo(g.z), bfhi(g.z), bflo(g.w), bfhi(g.w)}; float y[8];
                    if (PASS == 0) {
#pragma unroll
                        for (int e = 0; e < 4; ++e) { y[e] = sigm(gf[e]) * acc[ai][bj][m][0][e]; y[4 + e] = sigm(gf[4 + e]) * acc[ai][bj][m][1][e]; }
                    } else {
                        const u32x4 h = hv[mm][bj]; float hf[8] = {bflo(h.x), bfhi(h.x), bflo(h.y), bfhi(h.y), bflo(h.z), bfhi(h.z), bflo(h.w), bfhi(h.w)};
#pragma unroll
                        for (int e = 0; e < 4; ++e) { y[e] = gf[e] + sigm(hf[e]) * acc[ai][bj][m][0][e]; y[4 + e] = gf[4 + e] + sigm(hf[4 + e]) * acc[ai][bj][m][1][e]; }
                    }
                    u32x4 w; w.x = cvtpk(y[0], y[1]); w.y = cvtpk(y[2], y[3]); w.z = cvtpk(y[4], y[5]); w.w = cvtpk(y[6], y[7]); *(u32x4*)(G + off) = w; }
            __builtin_amdgcn_sched_barrier(0);
          }
    }
};
struct EpiBranchBoth {
    static constexpr bool PERM = true, AFTER_DRAIN = false;
    bf16* G; const bf16* gate2;
    DI void operator()(const pg8::f32x4 (&acc)[2][2][4][2], const pg8::Unit& u, int wr, int wc, int fr, int fq) const {
        if (u.sel == 0) { EpiBranch<0> e{G, gate2}; e(acc, u, wr, wc, fr, fq); } else { EpiBranch<1> e{G, gate2}; e(acc, u, wr, wc, fr, fq); }
    }
};
struct EpiPlain {
    static constexpr bool PERM = true, AFTER_DRAIN = false;
    bf16* O;
    DI void operator()(const pg8::f32x4 (&acc)[2][2][4][2], const pg8::Unit& u, int wr, int wc, int fr, int fq) const {
        const int row0 = u.pm * 256 + wr * 64 + fr, col0 = u.pn * 256 + wc * 32 + 8 * fq;
#pragma unroll
        for (int ai = 0; ai < 2; ++ai)
#pragma unroll
            for (int m = 0; m < 4; ++m)
#pragma unroll
                for (int bj = 0; bj < 2; ++bj) { const pg8::f32x4 v0 = acc[ai][bj][m][0], v1 = acc[ai][bj][m][1];
                    u32x4 w; w.x = cvtpk(v0[0], v0[1]); w.y = cvtpk(v0[2], v0[3]); w.z = cvtpk(v1[0], v1[1]); w.w = cvtpk(v1[2], v1[3]);
                    *(u32x4*)(O + (size_t)(row0 + ai * 128 + m * 16) * 1024 + col0 + bj * 128) = w; }
    }
};

DI void norm_row(const float* xin, const bf16* o, const f32x4 (&gpo)[4], float* xout, bool has_pre, const f32x4 (&gpr)[4], bf16* h, int lane) {
    f32x4 v[4];
#pragma unroll
    for (int j = 0; j < 4; ++j) v[j] = *((const f32x4*)xin + lane + 64 * j);
    if (o) {
        f32x4 ov[4]; float ss = 0.f;
#pragma unroll
        for (int j = 0; j < 4; ++j) { const u32x2 w = *((const u32x2*)o + lane + 64 * j); ov[j] = (f32x4){bflo(w.x), bfhi(w.x), bflo(w.y), bfhi(w.y)};
            ss += (ov[j].x * ov[j].x + ov[j].y * ov[j].y) + (ov[j].z * ov[j].z + ov[j].w * ov[j].w); }
        const float rstd = 1.0f / sqrtf(wave_sum(ss) * (1.0f / DM) + EPS);
#pragma unroll
        for (int j = 0; j < 4; ++j) { v[j] = v[j] + ov[j] * rstd * gpo[j]; *((f32x4*)xout + lane + 64 * j) = v[j]; }
    }
    if (has_pre) {
        float ss = 0.f;
#pragma unroll
        for (int j = 0; j < 4; ++j) ss += (v[j].x * v[j].x + v[j].y * v[j].y) + (v[j].z * v[j].z + v[j].w * v[j].w);
        const float rstd = 1.0f / sqrtf(wave_sum(ss) * (1.0f / DM) + EPS);
#pragma unroll
        for (int j = 0; j < 4; ++j) { const f32x4 y = v[j] * rstd * gpr[j];
            u32x2 w; w.x = cvtpk(y.x, y.y); w.y = cvtpk(y.z, y.w); *((u32x2*)h + lane + 64 * j) = w; }
    }
}
DI void transpose_item(const float* W, int K, int N, bf16* WT, int k0, int n0, int dst_row0, LAS float* scr, int lane) {
#pragma unroll 8
    for (int i = 0; i < 32; ++i) { const int kk = 2 * i + (lane >> 5); scr[kk * 33 + (lane & 31)] = W[(size_t)(k0 + kk) * N + n0 + (lane & 31)]; }
    asm volatile("s_waitcnt lgkmcnt(0)" ::: "memory");
    const int c = lane & 7;
#pragma unroll
    for (int j = 0; j < 4; ++j) { const int n = (lane >> 3) + 8 * j; const LAS float* s = scr + (8 * c) * 33 + n;
        u32x4 o; o.x = cvtpk(s[0 * 33], s[1 * 33]); o.y = cvtpk(s[2 * 33], s[3 * 33]); o.z = cvtpk(s[4 * 33], s[5 * 33]); o.w = cvtpk(s[6 * 33], s[7 * 33]);
        *(u32x4*)(WT + (size_t)(dst_row0 + n) * K + k0 + 8 * c) = o; }
    asm volatile("s_waitcnt lgkmcnt(0)" ::: "memory");
}
DI f32x2 cpow_k(float are, float aim, float dt, int k) {
    const float mag = __expf(are * dt * (float)k);
    const double turns = (double)aim * (double)dt * (double)k * 0.15915494309189535;
    const float fr = (float)(turns - floor(turns));
    return (f32x2){mag * __builtin_amdgcn_cosf(fr), mag * __builtin_amdgcn_sinf(fr)};
}
DI f32x2 cmul(f32x2 a, f32x2 b) { return (f32x2){a.x * b.x - a.y * b.y, a.x * b.y + a.y * b.x}; }
DI f32x2 zoh_factor(float are, float aim, float dt) {
    const f32x2 ab = cpow_k(are, aim, dt, 1); const float nr = ab.x - 1.0f, ni = ab.y, den = are * are + aim * aim;
    return (f32x2){(nr * are + ni * aim) / den, (ni * are - nr * aim) / den};
}

struct LayerP { const float *a_re, *a_im, *log_dt, *b_re, *b_im, *c_re, *c_im; };

DI void ktab_block(const LayerP& P, bf16* KTAB, int g, int tb, LAS unsigned char* lds, int tid) {
    LAS f32x2* CL = (LAS f32x2*)lds;
    LAS f32x2* BB = (LAS f32x2*)(lds + 16384);
    const float dt = __expf(P.log_dt[g]);
    const int p = tid & 63, h0 = tid >> 6, h1 = h0 + 8;
    const float are = P.a_re[g * 64 + p], aim = P.a_im[g * 64 + p];
    const f32x2 c0 = {P.c_re[(g * 16 + h0) * 64 + p], P.c_im[(g * 16 + h0) * 64 + p]}, c1 = {P.c_re[(g * 16 + h1) * 64 + p], P.c_im[(g * 16 + h1) * 64 + p]};
    const int e0 = tid, e1 = tid + NTHR; const int pa = e0 >> 4, pb = e1 >> 4, hp = tid & 15;
    const float area = P.a_re[g * 64 + pa], aima = P.a_im[g * 64 + pa], areb = P.a_re[g * 64 + pb], aimb = P.a_im[g * 64 + pb];
    const f32x2 bva = {P.b_re[(g * 64 + pa) * 16 + hp], P.b_im[(g * 64 + pa) * 16 + hp]}, bvb = {P.b_re[(g * 64 + pb) * 16 + hp], P.b_im[(g * 64 + pb) * 16 + hp]};
    BB[pa * 16 + hp] = cmul(zoh_factor(area, aima, dt), bva); BB[pb * 16 + hp] = cmul(zoh_factor(areb, aimb, dt), bvb);
    if (tb == 0 && tid < 256) KTAB[((size_t)g * 65) * 256 + tid] = 0;
#pragma unroll 1
    for (int tp = 0; tp < 4; ++tp) { const int tau0 = tb * 8 + 2 * tp;
        const f32x2 l0 = cpow_k(are, aim, dt, tau0), l1 = cpow_k(are, aim, dt, tau0 + 1);
        CL[(0 * 16 + h0) * 64 + p] = cmul(c0, l0); CL[(0 * 16 + h1) * 64 + p] = cmul(c1, l0); CL[(1 * 16 + h0) * 64 + p] = cmul(c0, l1); CL[(1 * 16 + h1) * 64 + p] = cmul(c1, l1);
        __syncthreads();
        { const int ts = tid >> 8, h = (tid >> 4) & 15; float sacc = 0.f;
#pragma unroll 8
          for (int q = 0; q < 64; ++q) { const f32x2 c = CL[(ts * 16 + h) * 64 + q], bq = BB[q * 16 + hp]; sacc += c.x * bq.x - c.y * bq.y; }
          KTAB[((size_t)g * 65 + (tau0 + ts + 1)) * 256 + h * 16 + hp] = (bf16)(cvtpk(sacc, 0.f) & 0xffffu); }
        __syncthreads();
    }
}
DI void wv_item(const LayerP& P, bf16* WTAB, bf16* VTAB, float* LAM, int idx) {
    const int p = idx & 63, k = (idx >> 6) & 15, g = idx >> 10;
    const float dt = __expf(P.log_dt[g]), are = P.a_re[g * 64 + p], aim = P.a_im[g * 64 + p];
    f32x2 cv[16];
#pragma unroll
    for (int j = 0; j < 16; ++j) cv[j] = (f32x2){P.c_re[(g * 16 + j) * 64 + p], P.c_im[(g * 16 + j) * 64 + p]};
    const f32x2 lk1 = cpow_k(are, aim, dt, k + 1);
#pragma unroll
    for (int h = 0; h < 16; ++h) { const f32x2 c = cmul(cv[h], lk1); *(unsigned*)(VTAB + ((size_t)g * 256 + k * 16 + h) * 128 + 2 * p) = cvtpk(c.x, -c.y); }
    if (k == 15) { const f32x2 l64 = cpow_k(are, aim, dt, 64); *(f32x4*)(LAM + (g * 64 + p) * 4) = (f32x4){l64.x, l64.y, lk1.x, lk1.y}; }
}

#define MFMA16(a, b, c) __builtin_amdgcn_mfma_f32_16x16x32_bf16((a), (b), (c), 0, 0, 0)
#define MFMA32(a, b, c) __builtin_amdgcn_mfma_f32_32x32x16_bf16((a), (b), (c), 0, 0, 0)
DI void make_wfrag(const LayerP& P, int g, int wave, int lane, bf16x8 (&af)[8], f32x2& l16a, f32x2& l16b) {
    const int n = lane & 15, kg = lane >> 4, p = 8 * wave + (n >> 1), ri = n & 1;
    const float dt = __expf(P.log_dt[g]), are = P.a_re[g * 64 + p], aim = P.a_im[g * 64 + p];
    const int pa = 8 * wave + 2 * kg;
    const float area = P.a_re[g * 64 + pa], aima = P.a_im[g * 64 + pa], areb = P.a_re[g * 64 + pa + 1], aimb = P.a_im[g * 64 + pa + 1];
    const f32x4 br0 = *(const f32x4*)(P.b_re + (g * 64 + p) * 16 + 8 * (kg & 1)), br1 = *(const f32x4*)(P.b_re + (g * 64 + p) * 16 + 8 * (kg & 1) + 4);
    const f32x4 bi0 = *(const f32x4*)(P.b_im + (g * 64 + p) * 16 + 8 * (kg & 1)), bi1 = *(const f32x4*)(P.b_im + (g * 64 + p) * 16 + 8 * (kg & 1) + 4);
    const f32x2 f = zoh_factor(are, aim, dt);
    f32x2 fb[8];
#pragma unroll
    for (int i = 0; i < 4; ++i) { fb[i] = cmul(f, (f32x2){br0[i], bi0[i]}); fb[4 + i] = cmul(f, (f32x2){br1[i], bi1[i]}); }
#pragma unroll
    for (int ks = 0; ks < 8; ++ks) { const f32x2 lp = cpow_k(are, aim, dt, 15 - 2 * ks - (kg >> 1)); float v[8];
#pragma unroll
        for (int i = 0; i < 8; ++i) { const f32x2 c = cmul(lp, fb[i]); v[i] = ri ? c.y : c.x; }
        const u32x4 w = {cvtpk(v[0], v[1]), cvtpk(v[2], v[3]), cvtpk(v[4], v[5]), cvtpk(v[6], v[7])}; af[ks] = __builtin_bit_cast(bf16x8, w); }
    l16a = cpow_k(area, aima, dt, 16); l16b = cpow_k(areb, aimb, dt, 16);
}
DI void ssm_state_unit(const bf16* U, const bf16x8 (&af)[8], f32x2 l16a, f32x2 l16b, float* S, int b, int g, int cb, int wave, int lane) {
    const int n = lane & 15, kg = lane >> 4;
    const bf16* up = U + ((size_t)b * SEQ + (size_t)(cb * 16 + n) * 64 + (kg >> 1)) * 512 + g * 16 + 8 * (kg & 1);
    bf16x8 uf[4][8];
#pragma unroll
    for (int a = 0; a < 4; ++a)
#pragma unroll
        for (int ks = 0; ks < 8; ++ks) uf[a][ks] = *(const bf16x8*)(up + (size_t)(16 * a + 2 * ks) * 512);
    __builtin_amdgcn_sched_barrier(0);
    pg8::f32x4 acc4[4];
#pragma unroll
    for (int a = 0; a < 4; ++a) acc4[a] = (pg8::f32x4){0.f, 0.f, 0.f, 0.f};
#pragma unroll
    for (int ks = 0; ks < 8; ++ks)
#pragma unroll
        for (int a = 0; a < 4; ++a) acc4[a] = MFMA16(af[ks], uf[a][ks], acc4[a]);
    __builtin_amdgcn_sched_barrier(0);
    pg8::f32x4 st = acc4[0];
#pragma unroll
    for (int a = 1; a < 4; ++a) {
        const f32x2 s0 = cmul(l16a, (f32x2){st[0], st[1]}), s1 = cmul(l16b, (f32x2){st[2], st[3]});
        st = (pg8::f32x4){s0.x + acc4[a][0], s0.y + acc4[a][1], s1.x + acc4[a][2], s1.y + acc4[a][3]};
    }
    *(pg8::f32x4*)(S + (((size_t)b * NCH + cb * 16 + n) * NG + g) * 128 + 16 * wave + 4 * kg) = st;
}
constexpr int XIN_OFF = 33280, XIN_PITCH = 272, XIN_VAR = 16 * XIN_PITCH, TB_OFF = XIN_OFF + 4 * XIN_VAR, UL_OFF = 57344, UL_PITCH = 2064;
template <int S> DI void toe_stage(pg8::f32x4 (&acc)[8], const LAS unsigned char* ul, const LAS unsigned char* kt, int wave, int lo, int hi) {
#pragma unroll 1
    for (int ks = lo; ks <= hi; ++ks) {
        const bf16x8 uf0 = *(const LAS bf16x8*)(ul + ks * 64);
        bf16x8 a0[8 - S];
#pragma unroll
        for (int j = S; j < 8; ++j) a0[j - S] = *(const LAS bf16x8*)(kt + (wave + 8 * j - 2 * ks) * 512);
        __builtin_amdgcn_sched_barrier(0);
#pragma unroll
        for (int j = S; j < 8; ++j) acc[j] = MFMA16(a0[j - S], uf0, acc[j]);
    }
}
#ifdef PROBE_SEL
#define QS(sel) do { if (PROBE_SEL == (sel)) tq0 = __builtin_amdgcn_s_memrealtime(); } while (0)
#define QT(sel) do { if (PROBE_SEL == (sel)) tqacc += __builtin_amdgcn_s_memrealtime() - tq0; } while (0)
#else
#define QS(sel) do {} while (0)
#define QT(sel) do {} while (0)
#endif
DI void ssm_out_unit(unsigned long long& tqacc, bool load_ktab, const bf16* U, const bf16* KTAB, const bf16* VTAB, const float* S, const float* LAM, const float* dsk, bf16* YS, int b, int g, int cb, LAS unsigned char* lds, int tid, int wave, int lane) {
    unsigned long long tq0 = 0ull; (void)tq0;
    const int n = lane & 15, kg = lane >> 4;
    QS(51);
    const f32x4 lam4 = *(const f32x4*)(LAM + (g * 64 + lane) * 4); const f32x2 lam = {lam4.x, lam4.y}, l16 = {lam4.z, lam4.w};
    f32x2 sv[16];
    {
        const u32x4* src = (const u32x4*)((const unsigned char*)KTAB + (size_t)g * KTAB_BYTES);
        u32x4 kt4[4], kt5 = {0u, 0u, 0u, 0u}, ut4[4];
        if (load_ktab) {
#pragma unroll
            for (int j = 0; j < 4; ++j) kt4[j] = src[tid + NTHR * j];
            if (tid < 32) kt5 = src[2048 + tid];
        }
#pragma unroll
        for (int j = 0; j < 4; ++j) { const int idx = tid + NTHR * j, cn = idx >> 7, tok = (idx >> 1) & 63, half = idx & 1;
            ut4[j] = *(const u32x4*)(U + ((size_t)b * SEQ + (size_t)(cb * 16 + cn) * 64 + tok) * 512 + g * 16 + 8 * half); }
        if (wave <= cb) { const f32x2* sp = (const f32x2*)(S + (((size_t)b * NCH + wave * 16) * NG + g) * 128) + lane;
#pragma unroll
            for (int j = 0; j < 16; ++j) sv[j] = sp[(size_t)j * (NG * 64)]; }
        __builtin_amdgcn_sched_barrier(0);
        if (load_ktab) {
#pragma unroll
            for (int j = 0; j < 4; ++j) *(LAS u32x4*)(lds + 16 * (tid + NTHR * j)) = kt4[j];
            if (tid < 32) *(LAS u32x4*)(lds + 16 * (2048 + tid)) = kt5;
        }
#pragma unroll
        for (int j = 0; j < 4; ++j) { const int idx = tid + NTHR * j, cn = idx >> 7, tok = (idx >> 1) & 63, half = idx & 1; *(LAS u32x4*)(lds + UL_OFF + cn * UL_PITCH + tok * 32 + half * 16) = ut4[j]; }
    }
    bf16x8 vfr[4][2];
#pragma unroll
    for (int k2 = 0; k2 < 4; ++k2)
#pragma unroll
        for (int jj = 0; jj < 2; ++jj) vfr[k2][jj] = *(const bf16x8*)(VTAB + ((size_t)g * 256 + (wave + 8 * jj) * 16 + n) * 128 + 32 * k2 + 8 * kg);
    __builtin_amdgcn_sched_barrier(0);
    LAS f32x2* TB = (LAS f32x2*)(lds + TB_OFF);
    if (wave < cb) { f32x2 x = {0.f, 0.f};
#pragma unroll
        for (int j = 0; j < 16; ++j) { x = cmul(lam, x); x.x += sv[j].x; x.y += sv[j].y; }
        TB[wave * 64 + lane] = x; }
    __syncthreads();
    if (wave == cb) {
        f32x2 l1k = lam;
#pragma unroll
        for (int j = 0; j < 4; ++j) l1k = cmul(l1k, l1k);
        f32x2 x = {0.f, 0.f};
        for (int w = 0; w < cb; ++w) { const f32x2 t = TB[w * 64 + lane]; x = cmul(l1k, x); x.x += t.x; x.y += t.y; }
#pragma unroll
        for (int j = 0; j < 16; ++j) { f32x2 xa = x;
#pragma unroll
            for (int a = 0; a < 4; ++a) { *(LAS unsigned*)(lds + XIN_OFF + a * XIN_VAR + j * XIN_PITCH + 4 * lane) = cvtpk(xa.x, xa.y); xa = cmul(l16, xa); }
            x = cmul(lam, x); x.x += sv[j].x; x.y += sv[j].y; }
    }
    __syncthreads();
    QT(51); QS(52);
    pg8::f32x4 acc[8];
#pragma unroll
    for (int j = 0; j < 8; ++j) acc[j] = (pg8::f32x4){0.f, 0.f, 0.f, 0.f};
    const LAS unsigned char* ul = lds + UL_OFF + n * UL_PITCH + (kg >> 1) * 32 + (kg & 1) * 16;
    const LAS unsigned char* kt = lds + n * 32 + (kg & 1) * 16 + (1 - (kg >> 1)) * 512;
    { const int hw = wave >> 1;
      toe_stage<0>(acc, ul, kt, wave, 0, hw);            toe_stage<1>(acc, ul, kt, wave, hw + 1, hw + 4);   toe_stage<2>(acc, ul, kt, wave, hw + 5, hw + 8);   toe_stage<3>(acc, ul, kt, wave, hw + 9, hw + 12);
      toe_stage<4>(acc, ul, kt, wave, hw + 13, hw + 16); toe_stage<5>(acc, ul, kt, wave, hw + 17, hw + 20); toe_stage<6>(acc, ul, kt, wave, hw + 21, hw + 24); toe_stage<7>(acc, ul, kt, wave, hw + 25, hw + 28); }
#pragma unroll
    for (int k2 = 0; k2 < 4; ++k2) {
        bf16x8 xf[4];
#pragma unroll
        for (int a = 0; a < 4; ++a) xf[a] = *(const LAS bf16x8*)(lds + XIN_OFF + a * XIN_VAR + n * XIN_PITCH + (32 * k2 + 8 * kg) * 2);
#pragma unroll
        for (int j = 0; j < 8; ++j) acc[j] = MFMA16(vfr[k2][j & 1], xf[j >> 1], acc[j]); }
    QT(52); QS(53);
    const f32x4 dv = *(const f32x4*)(dsk + g * 16 + 4 * kg);
#pragma unroll
    for (int j = 0; j < 8; ++j) { const int t = wave + 8 * j; const size_t off = ((size_t)b * SEQ + (size_t)(cb * 16 + n) * 64 + t) * 512 + g * 16 + 4 * kg;
        const u32x2 uu = *(const LAS u32x2*)(lds + UL_OFF + n * UL_PITCH + t * 32 + kg * 8);
        const float y0 = gelu_tanh(acc[j][0] + dv[0] * bflo(uu.x)), y1 = gelu_tanh(acc[j][1] + dv[1] * bfhi(uu.x)), y2 = gelu_tanh(acc[j][2] + dv[2] * bflo(uu.y)), y3 = gelu_tanh(acc[j][3] + dv[3] * bfhi(uu.y));
        u32x2 w; w.x = cvtpk(y0, y1); w.y = cvtpk(y2, y3); *(u32x2*)(YS + off) = w; }
    asm volatile("s_waitcnt lgkmcnt(0)\n\ts_barrier" ::: "memory");
    QT(53);
}

struct AttnSt { f32x16 o0, o1; float carry; };
DI bool attn_tile(AttnSt& st, const bf16x8 (&kf)[4], const bf16x8 (&vf)[4], const bf16x8 (&qf)[4], bool diag, int n, int hi) {
    f32x16 s;
#pragma unroll
    for (int r = 0; r < 16; ++r) s[r] = 0.f;
#pragma unroll
    for (int ks = 0; ks < 4; ++ks) s = MFMA32(kf[ks], qf[ks], s);
    float sp[16];
#pragma unroll
    for (int r = 0; r < 16; ++r) { const float z = s[r]; const float e = __builtin_amdgcn_exp2f(-fabsf(z)); sp[r] = fmaxf(z, 0.f) + __builtin_amdgcn_logf(1.0f + e);
        if (diag && (16 * (r >> 3) + 8 * hi + (r & 7)) >= n) sp[r] = 0.f; }
    float cum[16]; float c0 = 0.f, c1 = 0.f;
#pragma unroll
    for (int r = 7; r >= 0; --r) { c0 -= sp[r]; cum[r] = c0; c1 -= sp[8 + r]; cum[8 + r] = c1; }
    const float p0 = __shfl_xor(c0, 32), p1 = __shfl_xor(c1, 32);
    const float base1 = st.carry + (hi ? 0.f : p1), base0 = st.carry + c1 + p1 + (hi ? 0.f : p0);
    float w[16];
#pragma unroll
    for (int r = 0; r < 16; ++r) { w[r] = __builtin_amdgcn_exp2f(s[r] + cum[r] + (r < 8 ? base0 : base1));
        if (diag && (16 * (r >> 3) + 8 * hi + (r & 7)) >= n) w[r] = 0.f; }
    st.carry += (c0 + c1) + (p0 + p1);
    const u32x4 pa = {cvtpk(w[0], w[1]), cvtpk(w[2], w[3]), cvtpk(w[4], w[5]), cvtpk(w[6], w[7])}, pb = {cvtpk(w[8], w[9]), cvtpk(w[10], w[11]), cvtpk(w[12], w[13]), cvtpk(w[14], w[15])};
    const bf16x8 pf0 = __builtin_bit_cast(bf16x8, pa), pf1 = __builtin_bit_cast(bf16x8, pb);
    st.o0 = MFMA32(pf0, vf[0], st.o0); st.o0 = MFMA32(pf1, vf[1], st.o0); st.o1 = MFMA32(pf0, vf[2], st.o1); st.o1 = MFMA32(pf1, vf[3], st.o1);
    return __ballot(st.carry >= -152.0f) == 0ull;
}
DI void attn_task(const bf16* Q, const bf16* Kb, const bf16* VT, const bf16* ZA, bf16* Y, int b, int h, int qt, int lane) {
    const int n = lane & 31, hi = lane >> 5;
    const size_t rowbase = (size_t)b * SEQ;
    bf16x8 qf[4];
    { const bf16* qp = Q + (rowbase + qt * 32 + n) * 512 + h * 64 + 8 * hi;
#pragma unroll
      for (int ks = 0; ks < 4; ++ks) qf[ks] = *(const bf16x8*)(qp + 16 * ks); }
    const int pm = (n & ~12) | (((n >> 2) & 1) << 3) | (((n >> 3) & 1) << 2);
    const bf16* kp = Kb + (rowbase + pm) * 512 + h * 64 + 8 * hi;
    const bf16* vp = VT + ((size_t)(b * 8 + h) * 64 + n) * SEQ + 8 * hi;
    AttnSt st;
#pragma unroll
    for (int r = 0; r < 16; ++r) { st.o0[r] = 0.f; st.o1[r] = 0.f; }
    st.carry = 0.f;
    bf16x8 kA[4], vA[4], kB[4], vB[4], kC[4], vC[4];
#define ATT_LOAD(KF, VF, ktile) do { const int key0_ = ((ktile) > 0 ? (ktile) : 0) * 32; \
        _Pragma("unroll") for (int ks = 0; ks < 4; ++ks) KF[ks] = *(const bf16x8*)(kp + (size_t)key0_ * 512 + 16 * ks); \
        VF[0] = *(const bf16x8*)(vp + key0_); VF[1] = *(const bf16x8*)(vp + key0_ + 16); VF[2] = *(const bf16x8*)(vp + (size_t)32 * SEQ + key0_); VF[3] = *(const bf16x8*)(vp + (size_t)32 * SEQ + key0_ + 16); } while (0)
    ATT_LOAD(kA, vA, qt); ATT_LOAD(kB, vB, qt - 1);
    int kt = qt;
    for (;;) {
        ATT_LOAD(kC, vC, kt - 2); __builtin_amdgcn_sched_barrier(0);
        if (attn_tile(st, kA, vA, qf, kt == qt, n, hi) || kt == 0) break; --kt; __builtin_amdgcn_sched_barrier(0);
        ATT_LOAD(kA, vA, kt - 2); __builtin_amdgcn_sched_barrier(0);
        if (attn_tile(st, kB, vB, qf, false, n, hi) || kt == 0) break; --kt; __builtin_amdgcn_sched_barrier(0);
        ATT_LOAD(kB, vB, kt - 2); __builtin_amdgcn_sched_barrier(0);
        if (attn_tile(st, kC, vC, qf, false, n, hi) || kt == 0) break; --kt; __builtin_amdgcn_sched_barrier(0);
    }
#undef ATT_LOAD
    float za0[16], za1[16];
#pragma unroll
    for (int r = 0; r < 16; ++r) { const int i = (r & 3) + 8 * (r >> 2) + 4 * hi; const size_t off = (rowbase + qt * 32 + i) * 512 + h * 64 + n; za0[r] = bf1(ZA[off]); za1[r] = bf1(ZA[off + 32]); }
    __builtin_amdgcn_sched_barrier(0);
#pragma unroll
    for (int r = 0; r < 16; ++r) { const int i = (r & 3) + 8 * (r >> 2) + 4 * hi; const size_t off = (rowbase + qt * 32 + i) * 512 + h * 64 + n;
        Y[off] = (bf16)(cvtpk(st.o0[r] * silu(za0[r]), 0.f) & 0xffffu); Y[off + 32] = (bf16)(cvtpk(st.o1[r] * silu(za1[r]), 0.f) & 0xffffu); }
}
#define XB_TMO      128
#define XB_XCNT(j)  (256  + 64 * (j))
#define XB_XSUB(j)  (1280 + 64 * (j))
#define XB_XGEN(j)  (2304 + 64 * (j))
#define XB_TOP      3328
#define XB_TOPGEN   3392
#define XCD_BAR_WORDS 3456
#define XB_SPIN_CAP (1u << 18)

__device__ __forceinline__ unsigned xb_ld(unsigned* p)              { return __hip_atomic_load(p, __ATOMIC_RELAXED, __HIP_MEMORY_SCOPE_AGENT); }
__device__ __forceinline__ unsigned xb_add(unsigned* p, unsigned v) { return __hip_atomic_fetch_add(p, v, __ATOMIC_RELAXED, __HIP_MEMORY_SCOPE_AGENT); }
__device__ __forceinline__ unsigned xb_xcc_id() { return (unsigned)__builtin_amdgcn_s_getreg((3 << 11) | 20) & 0xFu; }
#define XB_SPIN(cond, bar) do { unsigned _sp = 0; while (cond) { __builtin_amdgcn_s_sleep(1); \
    if ((++_sp & 255u) == 0u) { if (xb_ld(&(bar)[XB_TMO])) break; if (_sp > XB_SPIN_CAP) { atomicAdd(&(bar)[XB_TMO], 1u); break; } } } } while (0)

struct XcdBarrier {
    unsigned* bar; unsigned x;
    volatile LAS unsigned* st;
};

__device__ __forceinline__ XcdBarrier xcd_barrier_post(unsigned* bar, volatile LAS unsigned* st) {
    XcdBarrier b; b.bar = bar; b.x = xb_xcc_id(); b.st = st;
    if (threadIdx.x == 0) (void)xb_add(&bar[XB_XCNT(b.x)], 1u);
    return b;
}
__device__ __forceinline__ void xcd_barrier_complete(unsigned* bar, unsigned x, unsigned& nloc, unsigned& nx) {
    const unsigned G = gridDim.x * gridDim.y * gridDim.z;
    unsigned sum, cnt, mine, sp = 0u;
    for (;;) {
        sum = 0u; cnt = 0u; mine = 0u;
#pragma unroll
        for (unsigned j = 0; j < 16; ++j) { const unsigned c = xb_ld(&bar[XB_XCNT(j)]); sum += c; cnt += (c > 0u) ? 1u : 0u; mine = (j == x) ? c : mine; }
        if (sum == G) break;
        __builtin_amdgcn_s_sleep(1);
        if ((++sp & 255u) == 0u) { if (xb_ld(&bar[XB_TMO])) break; if (sp > XB_SPIN_CAP) { atomicAdd(&bar[XB_TMO], 1u); break; } }
    }
    nloc = mine > 0u ? mine : 1u; nx = cnt > 0u ? cnt : 1u;
}

__device__ __forceinline__ void xcd_barrier(const XcdBarrier& b) {
    asm volatile("s_waitcnt vmcnt(0)" ::: "memory");
    __syncthreads();
    if (threadIdx.x == 0) {
        unsigned* bar = b.bar;
        __builtin_amdgcn_s_waitcnt(0);
        unsigned nloc = b.st[0], nx = b.st[1];
        if (nloc == 0u) { xcd_barrier_complete(bar, b.x, nloc, nx); b.st[0] = nloc; b.st[1] = nx; }
        const unsigned old = xb_add(&bar[XB_XSUB(b.x)], 1u);
        const unsigned gen = old / nloc;
        if (old + 1u == (gen + 1u) * nloc) {
            __builtin_amdgcn_fence(__ATOMIC_RELEASE, "agent");
            asm volatile("s_waitcnt vmcnt(0)" ::: "memory");
            const unsigned og = xb_add(&bar[XB_TOP], 1u);
            const unsigned tg = og / nx;
            if (og + 1u == (tg + 1u) * nx) xb_add(&bar[XB_TOPGEN], 1u);
            else XB_SPIN(xb_ld(&bar[XB_TOPGEN]) == tg, bar);
            __builtin_amdgcn_fence(__ATOMIC_ACQUIRE, "agent");
            xb_add(&bar[XB_XGEN(b.x)], 1u);
            asm volatile("s_waitcnt vmcnt(0)" ::: "memory");
        } else {
            XB_SPIN(xb_ld(&bar[XB_XGEN(b.x)]) == gen, bar);
            __builtin_amdgcn_fence(__ATOMIC_ACQUIRE, "agent");
            asm volatile("s_waitcnt vmcnt(0)" ::: "memory");
        }
    }
    __syncthreads();
}

__device__ __forceinline__ void xcd_barrier1(const XcdBarrier& b) {
    asm volatile("s_waitcnt vmcnt(0)" ::: "memory");
    __syncthreads();
    if (threadIdx.x == 0) {
        unsigned* bar = b.bar;
        __builtin_amdgcn_s_waitcnt(0);
        unsigned nloc = b.st[0], nx = b.st[1];
        if (nloc == 0u) { xcd_barrier_complete(bar, b.x, nloc, nx); b.st[0] = nloc; b.st[1] = nx; }
        const unsigned k = b.st[2]; b.st[2] = k + 1u;
        const unsigned old = xb_add(&bar[XB_XSUB(b.x)], 1u);
        const unsigned gen = old / nloc;
        if (old + 1u == (gen + 1u) * nloc) {
            __builtin_amdgcn_fence(__ATOMIC_RELEASE, "agent");
            asm volatile("s_waitcnt vmcnt(0)" ::: "memory");
            const unsigned og = xb_add(&bar[XB_TOP], 1u);
            if (og + 1u == (k + 1u) * nx) xb_add(&bar[XB_TOPGEN], 1u);
            else XB_SPIN(xb_ld(&bar[XB_TOPGEN]) == k, bar);
        } else {
            XB_SPIN(xb_ld(&bar[XB_TOPGEN]) == k, bar);
        }
        __builtin_amdgcn_fence(__ATOMIC_ACQUIRE, "agent");
        asm volatile("s_waitcnt vmcnt(0)" ::: "memory");
    }
    __syncthreads();
}
__global__ void __launch_bounds__(NTHR, 2) hybrid_fwd(Args a) {
    extern __shared__ __attribute__((aligned(16))) unsigned char lds_raw[];
    LAS unsigned char* lds = (LAS unsigned char*)lds_raw;
    cg::grid_group grid = cg::this_grid();
#ifdef EXP_INVL2
    if (threadIdx.x == 0) asm volatile("buffer_inv sc0 sc1\n\ts_waitcnt vmcnt(0)" ::: "memory");
    __syncthreads();
#endif
    volatile LAS unsigned* xb_st = (volatile LAS unsigned*)(lds + 131072 + 1024);
    if (threadIdx.x < 3) xb_st[threadIdx.x] = 0u;
    __syncthreads();
    if (blockIdx.x == 0) for (int i = threadIdx.x; i < 4096; i += NTHR) __hip_atomic_store((unsigned*)a.ws + i, 0u, __ATOMIC_RELAXED, __HIP_MEMORY_SCOPE_AGENT);
    XcdBarrier xbar; xbar.bar = (unsigned*)a.ws; xbar.x = 0; xbar.st = xb_st;
    const int tid0 = threadIdx.x, wave = __builtin_amdgcn_readfirstlane(tid0 >> 6);
    const int G = gridDim.x, bx = blockIdx.x;
    const int gw = bx * NWAVES + wave, NGW = G * NWAVES;
    unsigned char* ws = a.ws;
    bf16* const Win = (bf16*)(ws + WS_WIN); bf16* const Wglu = (bf16*)(ws + WS_WGLU); bf16* const Wbs = (bf16*)(ws + WS_WBS); bf16* const Wba = (bf16*)(ws + WS_WBA); bf16* const Wout = (bf16*)(ws + WS_WOUT);
    bf16* const Hb = (bf16*)(ws + WS_H); bf16* const Ub = (bf16*)(ws + WS_U); bf16* const ZSb = (bf16*)(ws + WS_ZS); bf16* const Qb = (bf16*)(ws + WS_Q); bf16* const Kb = (bf16*)(ws + WS_K);
    bf16* const VTb = (bf16*)(ws + WS_VT); bf16* const ZAb = (bf16*)(ws + WS_ZA); bf16* const GSb = (bf16*)(ws + WS_GS); bf16* const GAb = (bf16*)(ws + WS_GA);


    unsigned long long tqa = 0ull;
#ifdef PROBE_SEL
    unsigned long long tacc = 0ull, tbeg = 0ull;
#define PW(sel) do { if (PROBE_SEL == (sel) + 10) tacc += __builtin_amdgcn_s_memrealtime() - tbeg; if (PROBE_SEL == (sel) + 20) tbeg = __builtin_amdgcn_s_memrealtime(); } while (0)
#define PS(sel) do { if (PROBE_SEL == (sel)) tbeg = __builtin_amdgcn_s_memrealtime(); } while (0)
#define PT(sel) do { if (PROBE_SEL == (sel)) tacc += __builtin_amdgcn_s_memrealtime() - tbeg; } while (0)
#define PB(sel) do { if (PROBE_SEL == (sel) || PROBE_SEL == (sel) + 10) tbeg = __builtin_amdgcn_s_memrealtime(); } while (0)
#define PE(sel) do { if (PROBE_SEL == (sel) || PROBE_SEL == (sel) + 20) tacc += __builtin_amdgcn_s_memrealtime() - tbeg; } while (0)
#else
#define PB(sel) do {} while (0)
#define PW(sel) do {} while (0)
#define PS(sel) do {} while (0)
#define PT(sel) do {} while (0)
#define PE(sel) do {} while (0)
#endif
#define GSYNC() xcd_barrier1(xbar)
    PB(0);
    for (int l = 0; l <= DEPTH; ++l) {
        const int lt = l < DEPTH ? l : 0;
        bf16* const KTAB = (bf16*)(ws + WS_KTAB + lt * KTAB_LSTRIDE); bf16* const WTAB = (bf16*)(ws + WS_WTAB + lt * WTAB_LSTRIDE); bf16* const VTAB = (bf16*)(ws + WS_VTAB + lt * VTAB_LSTRIDE);
        float* const Sb = (float*)(ws + WS_S + lt * S_LSTRIDE); float* const LAM = (float*)(ws + WS_LAM + lt * LAM_LSTRIDE);
        int tid = tid0; asm volatile("" : "+v"(tid)); const int lane = tid & 63;
        PB(1);
        {
            const float* xin = (l <= 1) ? a.x : a.out;
        PS(43);
            { f32x4 gpo[4], gpr[4];
#pragma unroll
              for (int j = 0; j < 4; ++j) { gpo[j] = l > 0 ? *((const f32x4*)(a.post_g + (l - 1) * DM) + lane + 64 * j) : (f32x4){0.f, 0.f, 0.f, 0.f};
                                            gpr[j] = l < DEPTH ? *((const f32x4*)(a.pre_g + l * DM) + lane + 64 * j) : (f32x4){0.f, 0.f, 0.f, 0.f}; }
              for (int m = gw; m < M; m += NGW)
                  norm_row(xin + (size_t)m * DM, l > 0 ? GAb + (size_t)m * DM : nullptr, gpo, a.out + (size_t)m * DM, l < DEPTH, gpr, Hb + (size_t)m * DM, lane); }
        PT(43);
            if (l == DEPTH) { PE(1); break; }
            LAS float* scr = (LAS float*)(lds + wave * 16384);
            const float* w_in = a.w_in + (size_t)l * DM * NCOL; const float* w_glu = a.w_glu + (size_t)l * 512 * 1024; const float* w_bs = a.w_bs + (size_t)l * 512 * 1024;
            const float* w_ba = a.w_ba + (size_t)l * 512 * 1024; const float* w_out = a.w_out + (size_t)l * 1024 * 1024;
            constexpr int I_IN = 16 * 160, I_GLU = 8 * 32, I_BR = 8 * 32, I_OUT = 16 * 32, NITEMS = I_IN + I_GLU + 2 * I_BR + I_OUT;
        PS(44);
            for (int it = gw; it < NITEMS; it += NGW) {
                int r = it;
                if (r < I_IN) { const int kb = r / 160, nb = r % 160; transpose_item(w_in, 1024, NCOL, Win, 64 * kb, 32 * nb, 32 * nb, scr, lane); continue; } r -= I_IN;
                if (r < I_GLU) { const int kb = r / 32, nb = r % 32, n0 = 32 * nb; const int bj = n0 >> 9, rem = n0 & 511, pn = rem >> 7, i0 = rem & 127;
                    transpose_item(w_glu, 512, 1024, Wglu, 64 * kb, n0, 256 * pn + 128 * bj + i0, scr, lane); continue; } r -= I_GLU;
                if (r < I_BR) { const int kb = r / 32, nb = r % 32; transpose_item(w_bs, 512, 1024, Wbs, 64 * kb, 32 * nb, 32 * nb, scr, lane); continue; } r -= I_BR;
                if (r < I_BR) { const int kb = r / 32, nb = r % 32; transpose_item(w_ba, 512, 1024, Wba, 64 * kb, 32 * nb, 32 * nb, scr, lane); continue; } r -= I_BR;
                { const int kb = r / 32, nb = r % 32; transpose_item(w_out, 1024, 1024, Wout, 64 * kb, 32 * nb, 32 * nb, scr, lane); }
            }
            __syncthreads();
            PT(44);
            LayerP P{a.a_re + l * NG * NP, a.a_im + l * NG * NP, a.log_dt + l * NG, a.b_re + (size_t)l * NG * NP * 16, a.b_im + (size_t)l * NG * NP * 16, a.c_re + (size_t)l * NG * 16 * NP, a.c_im + (size_t)l * NG * 16 * NP};
        PS(45);
#ifndef NO_TAB
            for (int it = bx; it < NG * 8; it += G) ktab_block(P, KTAB, it >> 3, it & 7, lds, tid);
            for (int idx = bx * NTHR + tid; idx < NG * NP * 16; idx += G * NTHR) wv_item(P, WTAB, VTAB, LAM, idx);
#endif
        PT(45);
        }
        PW(1);
        if (l == 0) { grid.sync(); xbar = xcd_barrier_post((unsigned*)a.ws, xb_st); } else GSYNC();
        PE(1);
        PB(2);
#ifndef NO_A
        { pg8::Gemm g{Hb, Win, M, NCOL, DM}; pg8::StaticOrder S; S.init(M, NCOL, G, bx); EpiProj E{ws};
          pg8::gemm_phase<EpiProj, pg8::StaticOrder, true, true>(lds, g, S, E); }
#endif
        PW(2);
        GSYNC();
        PE(2);
        PB(3);
        PS(41);
#ifndef NO_B1
        for (int u0 = 2 * bx; u0 < 512; u0 += 2 * G) { const int g = u0 >> 4;
            LayerP P{a.a_re + l * NG * NP, a.a_im + l * NG * NP, a.log_dt + l * NG, a.b_re + (size_t)l * NG * NP * 16, a.b_im + (size_t)l * NG * NP * 16, a.c_re + (size_t)l * NG * 16 * NP, a.c_im + (size_t)l * NG * 16 * NP};
            bf16x8 af[8]; f32x2 l16a, l16b;
            make_wfrag(P, g, wave, lane, af, l16a, l16b);
            for (int q = 0; q < 2; ++q) { const int nb = (u0 + q) & 15; ssm_state_unit(Ub, af, l16a, l16b, Sb, nb >> 3, g, nb & 7, wave, lane); } }
#endif
        PT(41);
        PS(42);
#ifndef NO_ATTN
        for (int t = gw; t < 4096; t += NGW) attn_task(Qb, Kb, VTb, ZAb, Qb, t >> 11, (t >> 8) & 7, t & 255, lane);
#endif
        PT(42);
        PW(3);
        GSYNC();
        PE(3);
        PB(4);
#ifndef NO_B3
        for (int u = 2 * bx; u < 512; u += (u & 1) ? 2 * G - 1 : 1) { const int g = u >> 4, nb = u & 15; ssm_out_unit(tqa, (u & 1) == 0, Ub, KTAB, VTAB, Sb, LAM, a.d_skip + l * 512, Hb, nb >> 3, g, nb & 7, lds, tid, wave, lane); }
#endif
        PW(4);
        GSYNC();
        PE(4);
        PB(5);
#ifndef NO_D1
        { pg8::Gemm g{Hb, Wglu, M, 1024, 512}; pg8::StaticOrder S; S.init(M, 1024, G, bx); EpiGlu E{ZSb, a.b_glu + l * 1024};
          pg8::gemm_phase<EpiGlu, pg8::StaticOrder, true, true>(lds, g, S, E); }
#endif
        PW(5);
        GSYNC();
        PE(5);
#ifndef NO_D2
        PB(6);
        { pg8::Gemm g{ZSb, Wbs, M, 1024, 512, Qb, Wba}; pg8::ChainOrder S; S.B.init(M, 1024, G, bx); EpiBranchBoth E{GSb, GAb};
          pg8::gemm_phase<EpiBranchBoth, pg8::ChainOrder, true, true>(lds, g, S, E); }
#endif
        PW(6);
        GSYNC();
        PE(6);
#ifndef NO_D3
        PB(7);
        { pg8::Gemm g{GSb, Wout, M, 1024, 1024}; pg8::StaticOrder S; S.init(M, 1024, G, bx); EpiPlain E{GAb};
          pg8::gemm_phase<EpiPlain, pg8::StaticOrder, true, true>(lds, g, S, E); }
#endif
        PW(7);
        GSYNC();
        PE(7);
    }
    PE(0);
#ifdef PROBE_SEL
    grid.sync();
    if (bx == 0) { LAS unsigned long long* tb = (LAS unsigned long long*)lds; if (tid0 == 0) tb[0] = tacc + tqa; __syncthreads(); const unsigned long long K = tb[0] < 1000000ull ? tb[0] : 1000000ull;
        for (unsigned long long i = tid0; i < K; i += NTHR) a.out[i] += 0.05f; }
#endif
}

extern "C" void kernel_launch(void* const* d_in, const int* in_sizes, int n_in, void* d_out, int out_size, void* d_ws, size_t ws_size, hipStream_t stream) {
    static int grid = 0;
    if (grid == 0) {
        if (n_in != 17 || out_size != M * DM || ws_size < WS_END) { fprintf(stderr, "kernel_launch: unexpected problem shape (n_in %d, out %d, ws %zu)\n", n_in, out_size, ws_size); grid = -1; return; }
        int dev = 0, cus = 0, per_cu = 0;
        (void)hipGetDevice(&dev); (void)hipDeviceGetAttribute(&cus, hipDeviceAttributeMultiprocessorCount, dev);
        if (hipFuncSetAttribute((const void*)hybrid_fwd, hipFuncAttributeMaxDynamicSharedMemorySize, LDS_BYTES) != hipSuccess) { fprintf(stderr, "kernel_launch: hipFuncSetAttribute failed\n"); grid = -1; return; }
        if (hipOccupancyMaxActiveBlocksPerMultiprocessor(&per_cu, (const void*)hybrid_fwd, NTHR, LDS_BYTES) != hipSuccess || per_cu < 1) { fprintf(stderr, "kernel_launch: occupancy query gave %d\n", per_cu); per_cu = 1; }
        (void)hipGetLastError();
        grid = cus * per_cu;
    }
    if (grid < 0) return;
    Args a{};
    a.x = (const float*)d_in[0]; a.pre_g = (const float*)d_in[1]; a.post_g = (const float*)d_in[2]; a.w_in = (const float*)d_in[3]; a.a_re = (const float*)d_in[4]; a.a_im = (const float*)d_in[5];
    a.log_dt = (const float*)d_in[6]; a.b_re = (const float*)d_in[7]; a.b_im = (const float*)d_in[8]; a.c_re = (const float*)d_in[9]; a.c_im = (const float*)d_in[10]; a.d_skip = (const float*)d_in[11];
    a.w_glu = (const float*)d_in[12]; a.b_glu = (const float*)d_in[13]; a.w_bs = (const float*)d_in[14]; a.w_ba = (const float*)d_in[15]; a.w_out = (const float*)d_in[16];
    a.out = (float*)d_out; a.ws = (unsigned char*)d_ws;
    void* args[] = {&a};
    const hipError_t e = hipLaunchCooperativeKernel((const void*)hybrid_fwd, dim3(grid), dim3(NTHR), args, LDS_BYTES, stream);
    if (e != hipSuccess) fprintf(stderr, "kernel_launch: cooperative launch failed: %s (grid %d)\n", hipGetErrorString(e), grid);
}
```

```cpp
#include <hip/hip_runtime.h>
#include <hip/hip_cooperative_groups.h>
#include <cstdio>
#include <cstdint>
namespace cg = cooperative_groups;
namespace pg8 {
#define PG8_LAS __attribute__((address_space(3)))
typedef unsigned short bf16_t;
typedef short bf16x8 __attribute__((ext_vector_type(8)));
typedef float f32x4 __attribute__((ext_vector_type(4)));
typedef unsigned u32x4 __attribute__((ext_vector_type(4)));
constexpr int BM = 256, BK = 64, HALF = 128, HTB = HALF * BK * 2  , STAGE_BYTES = 8 * HTB, NXCD = 8, WGM = 8;

__host__ __device__ __forceinline__ int lds_byte(int r, int c) { const int st = (r >> 4) * 2 + (c >> 5), rr = r & 15, cc = c & 31, ob = rr * 64 + cc * 2; return st * 1024 + (ob ^ (((ob >> 9) & 1) << 5)); }
__host__ __device__ __forceinline__ void stage_rc(int b, int& R, int& C) { const int st = b / 1024, sb = b % 1024, swz = sb ^ (((sb >> 9) & 1) << 5); R = (st >> 1) * 16 + swz / 64; C = (st & 1) * 32 + (swz % 64) / 2; }
__host__ __device__ __forceinline__ int perm32(int rho) { const int n = rho >> 4, i = rho & 15; return 8 * (i >> 2) + 4 * n + (i & 3); }

struct Unit { int pm, pn, sel; };
struct Gemm { const bf16_t* A; const bf16_t* Bt; int M, N, K; const bf16_t* A2; const bf16_t* Bt2; };

struct StaticOrder {
    int nM, nN, nwg, G, c;
    __host__ __device__ void init(int M, int N, int G_, int c_) { nM = M / BM; nN = N / BM; nwg = nM * nN; G = G_; c = c_; }
    __host__ __device__ bool next(int i, Unit& u) const {
        const long L = (long)i * G + c; if (L >= nwg) return false;
        int wgid = (int)L; { const int q = nwg / NXCD, r = nwg % NXCD, xcd = wgid % NXCD, off = wgid / NXCD; wgid = (xcd < r ? xcd * (q + 1) : r * (q + 1) + (xcd - r) * q) + off; }
        const int nig = WGM * nN, gid = wgid / nig, fm = gid * WGM, gsz = (nM - fm) < WGM ? (nM - fm) : WGM;
        u.pm = fm + ((wgid % nig) % gsz); u.pn = (wgid % nig) / gsz; u.sel = 0; return true;
    }
    __device__ __forceinline__ void a_ready(const Unit&) const {}
    __device__ __forceinline__ void done(const Unit&) const {}
};
__device__ __forceinline__ unsigned cvt_pk_bf16(float lo, float hi) { unsigned r; asm volatile("v_cvt_pk_bf16_f32 %0, %1, %2" : "=v"(r) : "v"(lo), "v"(hi)); return r; }
typedef float f32x2 __attribute__((ext_vector_type(2)));
struct ChainOrder { StaticOrder B;
    __host__ __device__ bool next(int i, Unit& u) const { if (!B.next(i >> 1, u)) return false; u.sel = i & 1; return true; }
    __device__ __forceinline__ void a_ready(const Unit&) const {}
    __device__ __forceinline__ void done(const Unit&) const {}
};

template <class Epi, class Sched, bool ALIGN_EPI = false, bool SP2 = false>
__device__ __forceinline__ void gemm_phase(PG8_LAS unsigned char* lds, const Gemm g, const Sched& S, const Epi& E) {
    int tid_ = threadIdx.x; asm volatile("" : "+v"(tid_));
    const int tid = tid_, wid = __builtin_amdgcn_readfirstlane(tid >> 6), lane = tid & 63, wr = wid >> 2, wc = wid & 3, fr = lane & 15, fq = lane >> 4;
    const int K = g.K, nt = K / BK;
    unsigned voffA[2], voffB[2];
#pragma unroll
    for (int i = 0; i < 2; ++i) { int R, C; stage_rc(tid * 16 + i * 8192, R, C); const int Rb = Epi::PERM ? ((R & ~31) + perm32(R & 31)) : R;
        voffA[i] = (unsigned)(R * K + C) * 2u; voffB[i] = (unsigned)(Rb * K + C) * 2u; }
    const size_t kstep = (size_t)(BK * 2);
    const size_t hstep = (size_t)HALF * K * 2;
    const size_t tstep = 2 * hstep;
    const unsigned ldsw = (unsigned)wid * 1024u;
    const int aoff = lds_byte(wr * 64 + fr, fq * 8), boff = lds_byte(wc * 32 + fr, fq * 8);
#define PG8_SA(b, h) (((b) * 2 + (h)) * HTB)
#define PG8_SB(b, h) ((4 + (b) * 2 + (h)) * HTB)
#define PG8_STAGE(bufoff, gbase, voff) do { _Pragma("unroll") for (int _i = 0; _i < 2; ++_i) \
        __builtin_amdgcn_global_load_lds((const unsigned*)((const char*)(gbase) + (voff)[_i]), (PG8_LAS unsigned*)(lds + (bufoff) + ldsw + _i * 8192), 16, 0, 0); } while (0)
#define PG8_LDA(dst, b, h) do { _Pragma("unroll") for (int m = 0; m < 4; ++m) _Pragma("unroll") for (int k = 0; k < 2; ++k) dst[m][k] = *(const PG8_LAS bf16x8*)(lds + PG8_SA(b, h) + aoff + m * 2048 + k * 1024); } while (0)
#define PG8_LDB(dst, b, h) do { _Pragma("unroll") for (int n = 0; n < 2; ++n) _Pragma("unroll") for (int k = 0; k < 2; ++k) dst[n][k] = *(const PG8_LAS bf16x8*)(lds + PG8_SB(b, h) + boff + n * 2048 + k * 1024); } while (0)
#define PG8_MMA(ai, bj, At, Bt) do { __builtin_amdgcn_s_setprio(1); _Pragma("unroll") for (int m = 0; m < 4; ++m) _Pragma("unroll") for (int n = 0; n < 2; ++n) _Pragma("unroll") for (int k = 0; k < 2; ++k) \
        acc[ai][bj][m][n] = __builtin_amdgcn_mfma_f32_16x16x32_bf16(Bt[n][k], At[m][k], acc[ai][bj][m][n], 0, 0, 0); __builtin_amdgcn_s_setprio(0); } while (0)
#define PG8_WAIT_V(n) asm volatile("s_waitcnt vmcnt(" #n ")" ::: "memory")
#define PG8_WAIT_L(n) asm volatile("s_waitcnt lgkmcnt(" #n ")" ::: "memory")
#define PG8_BAR __builtin_amdgcn_s_barrier()
#define PG8_SCHED __builtin_amdgcn_sched_barrier(0)
    Unit cur, nxt; int ui = 0;
    if (!S.next(0, cur)) return;
    f32x4 acc[2][2][4][2];
#pragma unroll
    for (int a = 0; a < 2; ++a)
#pragma unroll
        for (int b = 0; b < 2; ++b)
#pragma unroll
            for (int m = 0; m < 4; ++m)
#pragma unroll
                for (int n = 0; n < 2; ++n) acc[a][b][m][n] = (f32x4){0.f, 0.f, 0.f, 0.f};
    bf16x8 At[4][2], B0[2][2], B1[2][2];
    const char* cA = (const char*)(cur.sel ? g.A2 : g.A) + (size_t)cur.pm * tstep; const char* cB = (const char*)(cur.sel ? g.Bt2 : g.Bt) + (size_t)cur.pn * tstep;
    S.a_ready(cur);
    if constexpr (SP2) {
        PG8_STAGE(PG8_SB(0, 0), cB, voffB); PG8_STAGE(PG8_SB(0, 1), cB + hstep, voffB); PG8_STAGE(PG8_SA(0, 0), cA, voffA); PG8_STAGE(PG8_SA(0, 1), cA + hstep, voffA);
        if (wr == 1) PG8_BAR;
        PG8_WAIT_V(2); PG8_BAR;
        PG8_STAGE(PG8_SB(1, 0), cB + kstep, voffB); PG8_STAGE(PG8_SA(1, 0), cA + kstep, voffA); PG8_STAGE(PG8_SB(1, 1), cB + hstep + kstep, voffB);
        PG8_WAIT_V(6); PG8_BAR;
    } else {
        PG8_STAGE(PG8_SB(0, 0), cB, voffB); PG8_STAGE(PG8_SA(0, 0), cA, voffA); PG8_STAGE(PG8_SB(0, 1), cB + hstep, voffB); PG8_STAGE(PG8_SA(0, 1), cA + hstep, voffA);
        if (wr == 1) PG8_BAR;
        PG8_WAIT_V(4); PG8_BAR;
        PG8_STAGE(PG8_SB(1, 0), cB + kstep, voffB); PG8_STAGE(PG8_SA(1, 0), cA + kstep, voffA); PG8_STAGE(PG8_SB(1, 1), cB + hstep + kstep, voffB);
        PG8_WAIT_V(6); PG8_BAR;
    }
    for (;;) {
        const bool has_next = S.next(ui + 1, nxt);
        const char* nA = has_next ? (const char*)(nxt.sel ? g.A2 : g.A) + (size_t)nxt.pm * tstep : cA; const char* nB = has_next ? (const char*)(nxt.sel ? g.Bt2 : g.Bt) + (size_t)nxt.pn * tstep : cB;
        for (int t = 0; t < nt; t += 2) {
            const bool last = (t == nt - 2);
            const char* a1 = cA + (size_t)(t + 1) * kstep;
            const char* a2 = last ? nA : cA + (size_t)(t + 2) * kstep; const char* b2 = last ? nB : cB + (size_t)(t + 2) * kstep;
            const char* a3 = a2 + kstep; const char* b3 = b2 + kstep;
            if (last && has_next) S.a_ready(nxt);
            if constexpr (SP2) {
            PG8_LDB(B0, 0, 0); PG8_LDB(B1, 0, 1); PG8_SCHED; PG8_LDA(At, 0, 0); PG8_STAGE(PG8_SA(1, 1), a1 + hstep, voffA);
            PG8_WAIT_V(8); PG8_WAIT_L(0); PG8_BAR; PG8_MMA(0, 0, At, B0); PG8_MMA(0, 1, At, B1); PG8_BAR; PG8_SCHED;
            PG8_LDA(At, 0, 1); PG8_STAGE(PG8_SB(0, 0), b2, voffB); PG8_STAGE(PG8_SB(0, 1), b2 + hstep, voffB); PG8_STAGE(PG8_SA(0, 0), a2, voffA);
            PG8_WAIT_V(8); PG8_WAIT_L(0); PG8_BAR; PG8_MMA(1, 0, At, B0); PG8_MMA(1, 1, At, B1); PG8_BAR; PG8_SCHED;
            PG8_LDB(B0, 1, 0); PG8_LDB(B1, 1, 1); PG8_SCHED; PG8_LDA(At, 1, 0); PG8_STAGE(PG8_SA(0, 1), a2 + hstep, voffA);
            PG8_WAIT_V(8); PG8_WAIT_L(0); PG8_BAR; PG8_MMA(0, 0, At, B0); PG8_MMA(0, 1, At, B1); PG8_BAR; PG8_SCHED;
            PG8_LDA(At, 1, 1); PG8_STAGE(PG8_SB(1, 0), b3, voffB); PG8_STAGE(PG8_SB(1, 1), b3 + hstep, voffB); PG8_STAGE(PG8_SA(1, 0), a3, voffA);
            PG8_WAIT_V(8); PG8_WAIT_L(0); PG8_BAR; PG8_MMA(1, 0, At, B0); PG8_MMA(1, 1, At, B1); PG8_BAR; PG8_SCHED;
            } else {
            PG8_LDB(B0, 0, 0); PG8_SCHED; PG8_LDA(At, 0, 0); PG8_STAGE(PG8_SA(1, 1), a1 + hstep, voffA);
            PG8_WAIT_L(8); PG8_BAR; PG8_WAIT_L(0); PG8_MMA(0, 0, At, B0); PG8_BAR; PG8_SCHED;
            PG8_LDB(B1, 0, 1); PG8_STAGE(PG8_SB(0, 0), b2, voffB);
            PG8_BAR; PG8_WAIT_L(0); PG8_MMA(0, 1, At, B1); PG8_BAR;
            PG8_LDA(At, 0, 1); PG8_STAGE(PG8_SA(0, 0), a2, voffA);
            PG8_BAR; PG8_WAIT_L(0); PG8_MMA(1, 0, At, B0); PG8_BAR; PG8_SCHED;
            PG8_STAGE(PG8_SB(0, 1), b2 + hstep, voffB);
            PG8_WAIT_V(6); PG8_BAR; PG8_MMA(1, 1, At, B1); PG8_BAR;
            PG8_LDB(B0, 1, 0); PG8_SCHED; PG8_LDA(At, 1, 0); PG8_STAGE(PG8_SA(0, 1), a2 + hstep, voffA);
            PG8_WAIT_L(8); PG8_BAR; PG8_WAIT_L(0); PG8_MMA(0, 0, At, B0); PG8_BAR; PG8_SCHED;
            PG8_LDB(B1, 1, 1); PG8_STAGE(PG8_SB(1, 0), b3, voffB);
            PG8_BAR; PG8_WAIT_L(0); PG8_MMA(0, 1, At, B1); PG8_BAR;
            PG8_LDA(At, 1, 1); PG8_STAGE(PG8_SA(1, 0), a3, voffA);
            PG8_BAR; PG8_WAIT_L(0); PG8_MMA(1, 0, At, B0); PG8_BAR; PG8_SCHED;
            PG8_STAGE(PG8_SB(1, 1), b3 + hstep, voffB);
            PG8_WAIT_V(6); PG8_BAR; PG8_MMA(1, 1, At, B1); PG8_BAR;
            }
        }
        if constexpr (ALIGN_EPI) { if (wr == 0) PG8_BAR; }
        if constexpr (!Epi::AFTER_DRAIN) { E(acc, cur, wr, wc, fr, fq); S.done(cur); }
        if (!has_next) break;
#pragma unroll
        for (int a = 0; a < 2; ++a)
#pragma unroll
            for (int b = 0; b < 2; ++b)
#pragma unroll
                for (int m = 0; m < 4; ++m)
#pragma unroll
                    for (int n = 0; n < 2; ++n) acc[a][b][m][n] = (f32x4){0.f, 0.f, 0.f, 0.f};
        cur = nxt; cA = nA; cB = nB; ++ui;
        if constexpr (ALIGN_EPI) { if (wr == 1) PG8_BAR; }
    }
    PG8_WAIT_V(0);
    if constexpr (!ALIGN_EPI) { if (wr == 0) PG8_BAR; }
    PG8_BAR;
    if constexpr (Epi::AFTER_DRAIN) { E.fused(acc, cur, wr, wc, fr, fq, lds, wid, lane); S.done(cur); }
#undef PG8_SA
#undef PG8_SB
#undef PG8_STAGE
#undef PG8_LDA
#undef PG8_LDB
#undef PG8_MMA
#undef PG8_WAIT_V
#undef PG8_WAIT_L
#undef PG8_BAR
#undef PG8_SCHED
}
}
#define DI __device__ __forceinline__
#define LAS __attribute__((address_space(3)))
typedef unsigned short bf16;
typedef float f32x4 __attribute__((ext_vector_type(4)));
typedef float f32x2 __attribute__((ext_vector_type(2)));
typedef float f32x16 __attribute__((ext_vector_type(16)));
typedef short bf16x8 __attribute__((ext_vector_type(8)));
typedef unsigned u32x4 __attribute__((ext_vector_type(4)));
typedef unsigned u32x2 __attribute__((ext_vector_type(2)));
typedef __bf16 bf16x2_t __attribute__((ext_vector_type(2)));

constexpr int NWAVES = 8, NTHR = 512;
constexpr int BATCH = 2, SEQ = 8192, DM = 1024, DEPTH = 4, M = BATCH * SEQ, NCOL = 5120;
constexpr int NG = 32, NP = 64, NCH = SEQ / 64;
constexpr float EPS = 1e-6f;
constexpr size_t MiB = 1u << 20;
constexpr size_t WS_WIN = 1 * MiB, WS_WGLU = 11 * MiB, WS_WBS = 12 * MiB, WS_WBA = 13 * MiB, WS_WOUT = 14 * MiB;
constexpr size_t WS_H = 16 * MiB;
constexpr size_t WS_U = 48 * MiB, WS_ZS = 64 * MiB, WS_Q = 80 * MiB, WS_K = 96 * MiB, WS_VT = 112 * MiB, WS_ZA = 128 * MiB;
constexpr size_t WS_GS = 144 * MiB, WS_GA = 176 * MiB;
constexpr size_t WS_KTAB = 208 * MiB, KTAB_LSTRIDE = 1280 * 1024;
constexpr size_t WS_WTAB = 213 * MiB, WTAB_LSTRIDE = 2 * MiB;
constexpr size_t WS_VTAB = 221 * MiB, VTAB_LSTRIDE = 2 * MiB;
constexpr size_t WS_S = 229 * MiB, S_LSTRIDE = 4 * MiB;
constexpr size_t WS_LAM = 245 * MiB, LAM_LSTRIDE = 64 * 1024;
constexpr size_t WS_END = 246 * MiB;
constexpr int KTAB_BYTES = 65 * 512;
constexpr int LDS_BYTES = 147456;
constexpr float QSCALE = 0.125f * 1.4426950408889634f;

struct Args {
    const float* x; const float* pre_g; const float* post_g; const float* w_in; const float* a_re; const float* a_im; const float* log_dt;
    const float* b_re; const float* b_im; const float* c_re; const float* c_im; const float* d_skip; const float* w_glu; const float* b_glu;
    const float* w_bs; const float* w_ba; const float* w_out; float* out; unsigned char* ws;
};

DI unsigned cvtpk(float lo, float hi) { f32x2 v = {lo, hi}; bf16x2_t b = __builtin_convertvector(v, bf16x2_t); return __builtin_bit_cast(unsigned, b); }
DI float bflo(unsigned w) { return __uint_as_float(w << 16); }
DI float bfhi(unsigned w) { return __uint_as_float(w & 0xffff0000u); }
DI float bf1(bf16 b) { return __uint_as_float((unsigned)b << 16); }
DI float sigm(float x) { return __builtin_amdgcn_rcpf(1.0f + __expf(-x)); }
DI float silu(float x) { return x * sigm(x); }
DI float gelu_tanh(float x) { const float u = 1.5957691216057308f * (x + 0.044715f * x * x * x); return x * sigm(u); }
template <int CTRL> DI float dpp_step(float v) { return v + __builtin_bit_cast(float, __builtin_amdgcn_update_dpp(0, __builtin_bit_cast(int, v), CTRL, 0xf, 0xf, true)); }
DI float wave_sum(float v) {
    v = dpp_step<0xB1>(v); v = dpp_step<0x4E>(v); v = dpp_step<0x141>(v); v = dpp_step<0x140>(v);
    return ((__builtin_bit_cast(float, __builtin_amdgcn_readlane(__builtin_bit_cast(int, v), 0)) + __builtin_bit_cast(float, __builtin_amdgcn_readlane(__builtin_bit_cast(int, v), 16))) +
            (__builtin_bit_cast(float, __builtin_amdgcn_readlane(__builtin_bit_cast(int, v), 32)) + __builtin_bit_cast(float, __builtin_amdgcn_readlane(__builtin_bit_cast(int, v), 48))));
}

struct EpiProj {
    static constexpr bool PERM = true, AFTER_DRAIN = false;
    unsigned char* ws;
    DI void operator()(const pg8::f32x4 (&acc)[2][2][4][2], const pg8::Unit& u, int wr, int wc, int fr, int fq) const {
        const int pn = u.pn;
        bf16* base; int ld, colt; float sc = 1.f;
        if (pn < 12) { base = (bf16*)(ws + WS_U + (size_t)(pn >> 1) * (16 * MiB)); ld = 512; colt = (pn & 1) * 256; if ((pn >> 1) == 2) sc = QSCALE; }
        else if (pn < 16) { base = (bf16*)(ws + WS_GS); ld = 1024; colt = (pn - 12) * 256; }
        else { base = (bf16*)(ws + WS_GA); ld = 1024; colt = (pn - 16) * 256; }
        const int row0 = u.pm * 256 + wr * 64 + fr, col0 = colt + wc * 32 + 8 * fq;
        if ((pn >> 1) == 4) {
            bf16* vt = (bf16*)(ws + WS_VT);
#pragma unroll
            for (int ai = 0; ai < 2; ++ai)
#pragma unroll
                for (int m = 0; m < 4; ++m) { const int r = row0 + ai * 128 + m * 16; const int bb = r >> 13, t = r & 8191;
#pragma unroll
                    for (int bj = 0; bj < 2; ++bj) { bf16* p = vt + ((size_t)(bb * 512 + col0 + bj * 128)) * 8192 + t;
#pragma unroll
                        for (int n = 0; n < 2; ++n)
#pragma unroll
                            for (int e = 0; e < 4; ++e) { *p = (bf16)(cvtpk(acc[ai][bj][m][n][e], 0.f) & 0xffffu); p += 8192; asm volatile("" : "+v"(p)); } }
                    __builtin_amdgcn_sched_barrier(0); }
            return;
        }
#pragma unroll
        for (int ai = 0; ai < 2; ++ai)
#pragma unroll
            for (int m = 0; m < 4; ++m) { bf16* rowp = base + (size_t)(row0 + ai * 128 + m * 16) * ld + col0;
#pragma unroll
                for (int bj = 0; bj < 2; ++bj) { const pg8::f32x4 v0 = acc[ai][bj][m][0] * sc, v1 = acc[ai][bj][m][1] * sc;
                    u32x4 w; w.x = cvtpk(v0[0], v0[1]); w.y = cvtpk(v0[2], v0[3]); w.z = cvtpk(v1[0], v1[1]); w.w = cvtpk(v1[2], v1[3]);
                    *(u32x4*)(rowp + bj * 128) = w; } }
    }
};
struct EpiGlu {
    static constexpr bool PERM = true, AFTER_DRAIN = false;
    bf16* zs; const float* bias;
    DI void operator()(const pg8::f32x4 (&acc)[2][2][4][2], const pg8::Unit& u, int wr, int wc, int fr, int fq) const {
        const int row0 = u.pm * 256 + wr * 64 + fr, col0 = u.pn * 128 + wc * 32 + 8 * fq;
        f32x4 ba0 = *(const f32x4*)(bias + col0), ba1 = *(const f32x4*)(bias + col0 + 4), bb0 = *(const f32x4*)(bias + 512 + col0), bb1 = *(const f32x4*)(bias + 512 + col0 + 4);
        u32x4 zv[2][4];
#pragma unroll
        for (int ai = 0; ai < 2; ++ai)
#pragma unroll
            for (int m = 0; m < 4; ++m) zv[ai][m] = *(const u32x4*)(zs + (size_t)(row0 + ai * 128 + m * 16) * 512 + col0);
        __builtin_amdgcn_sched_barrier(0);
#pragma unroll
        for (int ai = 0; ai < 2; ++ai)
#pragma unroll
            for (int m = 0; m < 4; ++m) { bf16* p = zs + (size_t)(row0 + ai * 128 + m * 16) * 512 + col0;
                const u32x4 z = zv[ai][m]; float zf[8] = {bflo(z.x), bfhi(z.x), bflo(z.y), bfhi(z.y), bflo(z.z), bfhi(z.z), bflo(z.w), bfhi(z.w)}; float y[8];
#pragma unroll
                for (int e = 0; e < 4; ++e) { y[e] = (acc[ai][0][m][0][e] + ba0[e]) * sigm(acc[ai][1][m][0][e] + bb0[e]) * silu(zf[e]);
                                              y[4 + e] = (acc[ai][0][m][1][e] + ba1[e]) * sigm(acc[ai][1][m][1][e] + bb1[e]) * silu(zf[4 + e]); }
                u32x4 w; w.x = cvtpk(y[0], y[1]); w.y = cvtpk(y[2], y[3]); w.z = cvtpk(y[4], y[5]); w.w = cvtpk(y[6], y[7]); *(u32x4*)p = w; }
    }
};
template <int PASS> struct EpiBranch {
    static constexpr bool PERM = true, AFTER_DRAIN = false;
    bf16* G; const bf16* gate2;
    DI void operator()(const pg8::f32x4 (&acc)[2][2][4][2], const pg8::Unit& u, int wr, int wc, int fr, int fq) const {
        const int row0 = u.pm * 256 + wr * 64 + fr, col0 = u.pn * 256 + wc * 32 + 8 * fq;
#pragma unroll
        for (int ai = 0; ai < 2; ++ai)
#pragma unroll
          for (int mh = 0; mh < 2; ++mh) {
            u32x4 gv[2][2], hv[2][2];
#pragma unroll
            for (int mm = 0; mm < 2; ++mm)
#pragma unroll
                for (int bj = 0; bj < 2; ++bj) { const int m = 2 * mh + mm; const size_t off = (size_t)(row0 + ai * 128 + m * 16) * 1024 + col0 + bj * 128; gv[mm][bj] = *(const u32x4*)(G + off); if (PASS == 1) hv[mm][bj] = *(const u32x4*)(gate2 + off); }
            __builtin_amdgcn_sched_barrier(0);
#pragma unroll
            for (int mm = 0; mm < 2; ++mm)
#pragma unroll
                for (int bj = 0; bj < 2; ++bj) { const int m = 2 * mh + mm; const size_t off = (size_t)(row0 + ai * 128 + m * 16) * 1024 + col0 + bj * 128;
                    const u32x4 g = gv[mm][bj]; float gf[8] = {bflo(g.x), bfhi(g.x), bflo(g.y), bfhi(g.y), bflo(g.z), bfhi(g.z), bflo(g.w), bfhi(g.w)}; float y[8];
                    if (PASS == 0) {
#pragma unroll
                        for (int e = 0; e < 4; ++e) { y[e] = sigm(gf[e]) * acc[ai][bj][m][0][e]; y[4 + e] = sigm(gf[4 + e]) * acc[ai][bj][m][1][e]; }
                    } else {
                        const u32x4 h = hv[mm][bj]; float hf[8] = {bflo(h.x), bfhi(h.x), bflo(h.y), bfhi(h.y), bflo(h.z), bfhi(h.z), bflo(h.w), bfhi(h.w)};
#pragma unroll
                        for (int e = 0; e < 4; ++e) { y[e] = gf[e] + sigm(hf[e]) * acc[ai][bj][m][0][e]; y[4 + e] = gf[4 + e] + sigm(hf[4 + e]) * acc[ai][bj][m][1][e]; }
                    }
                    u32x4 w; w.x = cvtpk(y[0], y[1]); w.y = cvtpk(y[2], y[3]); w.z = cvtpk(y[4], y[5]); w.w = cvtpk(y[6], y[7]); *(u32x4*)(G + off) = w; }
            __builtin_amdgcn_sched_barrier(0);
          }
    }
};
struct EpiBranchBoth {
    static constexpr bool PERM = true, AFTER_DRAIN = false;
    bf16* G; const bf16* gate2;
    DI void operator()(const pg8::f32x4 (&acc)[2][2][4][2], const pg8::Unit& u, int wr, int wc, int fr, int fq) const {
        if (u.sel == 0) { EpiBranch<0> e{G, gate2}; e(acc, u, wr, wc, fr, fq); } else { EpiBranch<1> e{G, gate2}; e(acc, u, wr, wc, fr, fq); }
    }
};
struct EpiPlain {
    static constexpr bool PERM = true, AFTER_DRAIN = false;
    bf16* O;
    DI void operator()(const pg8::f32x4 (&acc)[2][2][4][2], const pg8::Unit& u, int wr, int wc, int fr, int fq) const {
        const int row0 = u.pm * 256 + wr * 64 + fr, col0 = u.pn * 256 + wc * 32 + 8 * fq;
#pragma unroll
        for (int ai = 0; ai < 2; ++ai)
#pragma unroll
            for (int m = 0; m < 4; ++m)
#pragma unroll
                for (int bj = 0; bj < 2; ++bj) { const pg8::f32x4 v0 = acc[ai][bj][m][0], v1 = acc[ai][bj][m][1];
                    u32x4 w; w.x = cvtpk(v0[0], v0[1]); w.y = cvtpk(v0[2], v0[3]); w.z = cvtpk(v1[0], v1[1]); w.w = cvtpk(v1[2], v1[3]);
                    *(u32x4*)(O + (size_t)(row0 + ai * 128 + m * 16) * 1024 + col0 + bj * 128) = w; }
    }
};

DI void norm_row(const float* xin, const bf16* o, const f32x4 (&gpo)[4], float* xout, bool has_pre, const f32x4 (&gpr)[4], bf16* h, int lane) {
    f32x4 v[4];
#pragma unroll
    for (int j = 0; j < 4; ++j) v[j] = *((const f32x4*)xin + lane + 64 * j);
    if (o) {
        f32x4 ov[4]; float ss = 0.f;
#pragma unroll
        for (int j = 0; j < 4; ++j) { const u32x2 w = *((const u32x2*)o + lane + 64 * j); ov[j] = (f32x4){bflo(w.x), bfhi(w.x), bflo(w.y), bfhi(w.y)};
            ss += (ov[j].x * ov[j].x + ov[j].y * ov[j].y) + (ov[j].z * ov[j].z + ov[j].w * ov[j].w); }
        const float rstd = __builtin_amdgcn_rsqf(wave_sum(ss) * (1.0f / DM) + EPS);
#pragma unroll
        for (int j = 0; j < 4; ++j) { v[j] = v[j] + ov[j] * rstd * gpo[j]; *((f32x4*)xout + lane + 64 * j) = v[j]; }
    }
    if (has_pre) {
        float ss = 0.f;
#pragma unroll
        for (int j = 0; j < 4; ++j) ss += (v[j].x * v[j].x + v[j].y * v[j].y) + (v[j].z * v[j].z + v[j].w * v[j].w);
        const float rstd = __builtin_amdgcn_rsqf(wave_sum(ss) * (1.0f / DM) + EPS);
#pragma unroll
        for (int j = 0; j < 4; ++j) { const f32x4 y = v[j] * rstd * gpr[j];
            u32x2 w; w.x = cvtpk(y.x, y.y); w.y = cvtpk(y.z, y.w); *((u32x2*)h + lane + 64 * j) = w; }
    }
}
DI void transpose_item(const float* W, int K, int N, bf16* WT, int k0, int n0, int dst_row0, LAS float* scr, int lane) {
#pragma unroll 8
    for (int i = 0; i < 32; ++i) { const int kk = 2 * i + (lane >> 5); scr[kk * 33 + (lane & 31)] = W[(size_t)(k0 + kk) * N + n0 + (lane & 31)]; }
    asm volatile("s_waitcnt lgkmcnt(0)" ::: "memory");
    const int c = lane & 7;
#pragma unroll
    for (int j = 0; j < 4; ++j) { const int n = (lane >> 3) + 8 * j; const LAS float* s = scr + (8 * c) * 33 + n;
        u32x4 o; o.x = cvtpk(s[0 * 33], s[1 * 33]); o.y = cvtpk(s[2 * 33], s[3 * 33]); o.z = cvtpk(s[4 * 33], s[5 * 33]); o.w = cvtpk(s[6 * 33], s[7 * 33]);
        *(u32x4*)(WT + (size_t)(dst_row0 + n) * K + k0 + 8 * c) = o; }
    asm volatile("s_waitcnt lgkmcnt(0)" ::: "memory");
}
DI f32x2 cpow_k(float are, float aim, float dt, int k) {
    const float mag = __expf(are * dt * (float)k);
    const double turns = (double)aim * (double)dt * (double)k * 0.15915494309189535;
    const float fr = (float)(turns - floor(turns));
    return (f32x2){mag * __builtin_amdgcn_cosf(fr), mag * __builtin_amdgcn_sinf(fr)};
}
DI f32x2 cmul(f32x2 a, f32x2 b) { return (f32x2){a.x * b.x - a.y * b.y, a.x * b.y + a.y * b.x}; }
DI f32x2 zoh_factor(float are, float aim, float dt) {
    const f32x2 ab = cpow_k(are, aim, dt, 1); const float nr = ab.x - 1.0f, ni = ab.y, den = are * are + aim * aim;
    return (f32x2){(nr * are + ni * aim) / den, (ni * are - nr * aim) / den};
}

struct LayerP { const float *a_re, *a_im, *log_dt, *b_re, *b_im, *c_re, *c_im; };

DI void ktab_block(const LayerP& P, bf16* KTAB, int g, int tb, LAS unsigned char* lds, int tid) {
    LAS f32x2* CL = (LAS f32x2*)lds;
    LAS f32x2* BB = (LAS f32x2*)(lds + 16384);
    const float dt = __expf(P.log_dt[g]);
    const int p = tid & 63, h0 = tid >> 6, h1 = h0 + 8;
    const float are = P.a_re[g * 64 + p], aim = P.a_im[g * 64 + p];
    const f32x2 c0 = {P.c_re[(g * 16 + h0) * 64 + p], P.c_im[(g * 16 + h0) * 64 + p]}, c1 = {P.c_re[(g * 16 + h1) * 64 + p], P.c_im[(g * 16 + h1) * 64 + p]};
    const int e0 = tid, e1 = tid + NTHR; const int pa = e0 >> 4, pb = e1 >> 4, hp = tid & 15;
    const float area = P.a_re[g * 64 + pa], aima = P.a_im[g * 64 + pa], areb = P.a_re[g * 64 + pb], aimb = P.a_im[g * 64 + pb];
    const f32x2 bva = {P.b_re[(g * 64 + pa) * 16 + hp], P.b_im[(g * 64 + pa) * 16 + hp]}, bvb = {P.b_re[(g * 64 + pb) * 16 + hp], P.b_im[(g * 64 + pb) * 16 + hp]};
    BB[pa * 16 + hp] = cmul(zoh_factor(area, aima, dt), bva); BB[pb * 16 + hp] = cmul(zoh_factor(areb, aimb, dt), bvb);
    if (tb == 0 && tid < 256) KTAB[((size_t)g * 65) * 256 + tid] = 0;
#pragma unroll 1
    for (int tp = 0; tp < 4; ++tp) { const int tau0 = tb * 8 + 2 * tp;
        const f32x2 l0 = cpow_k(are, aim, dt, tau0), l1 = cpow_k(are, aim, dt, tau0 + 1);
        CL[(0 * 16 + h0) * 64 + p] = cmul(c0, l0); CL[(0 * 16 + h1) * 64 + p] = cmul(c1, l0); CL[(1 * 16 + h0) * 64 + p] = cmul(c0, l1); CL[(1 * 16 + h1) * 64 + p] = cmul(c1, l1);
        __syncthreads();
        { const int ts = tid >> 8, h = (tid >> 4) & 15; float sacc = 0.f;
#pragma unroll 8
          for (int q = 0; q < 64; ++q) { const f32x2 c = CL[(ts * 16 + h) * 64 + q], bq = BB[q * 16 + hp]; sacc += c.x * bq.x - c.y * bq.y; }
          KTAB[((size_t)g * 65 + (tau0 + ts + 1)) * 256 + h * 16 + hp] = (bf16)(cvtpk(sacc, 0.f) & 0xffffu); }
        __syncthreads();
    }
}
DI void wv_item(const LayerP& P, bf16* WTAB, bf16* VTAB, float* LAM, int idx) {
    const int p = idx & 63, k = (idx >> 6) & 15, g = idx >> 10;
    const float dt = __expf(P.log_dt[g]), are = P.a_re[g * 64 + p], aim = P.a_im[g * 64 + p];
    f32x2 cv[16];
#pragma unroll
    for (int j = 0; j < 16; ++j) cv[j] = (f32x2){P.c_re[(g * 16 + j) * 64 + p], P.c_im[(g * 16 + j) * 64 + p]};
    const f32x2 lk1 = cpow_k(are, aim, dt, k + 1);
#pragma unroll
    for (int h = 0; h < 16; ++h) { const f32x2 c = cmul(cv[h], lk1); *(unsigned*)(VTAB + ((size_t)g * 256 + k * 16 + h) * 128 + 2 * p) = cvtpk(c.x, -c.y); }
    if (k == 15) { const f32x2 l64 = cpow_k(are, aim, dt, 64); *(f32x4*)(LAM + (g * 64 + p) * 4) = (f32x4){l64.x, l64.y, lk1.x, lk1.y}; }
}

#define MFMA16(a, b, c) __builtin_amdgcn_mfma_f32_16x16x32_bf16((a), (b), (c), 0, 0, 0)
#define MFMA32(a, b, c) __builtin_amdgcn_mfma_f32_32x32x16_bf16((a), (b), (c), 0, 0, 0)
DI void make_wfrag(const LayerP& P, int g, int wave, int lane, bf16x8 (&af)[8], f32x2& l16a, f32x2& l16b) {
    const int n = lane & 15, kg = lane >> 4, p = 8 * wave + (n >> 1), ri = n & 1;
    const float dt = __expf(P.log_dt[g]), are = P.a_re[g * 64 + p], aim = P.a_im[g * 64 + p];
    const int pa = 8 * wave + 2 * kg;
    const float area = P.a_re[g * 64 + pa], aima = P.a_im[g * 64 + pa], areb = P.a_re[g * 64 + pa + 1], aimb = P.a_im[g * 64 + pa + 1];
    const f32x4 br0 = *(const f32x4*)(P.b_re + (g * 64 + p) * 16 + 8 * (kg & 1)), br1 = *(const f32x4*)(P.b_re + (g * 64 + p) * 16 + 8 * (kg & 1) + 4);
    const f32x4 bi0 = *(const f32x4*)(P.b_im + (g * 64 + p) * 16 + 8 * (kg & 1)), bi1 = *(const f32x4*)(P.b_im + (g * 64 + p) * 16 + 8 * (kg & 1) + 4);
    const f32x2 f = zoh_factor(are, aim, dt);
    f32x2 fb[8];
#pragma unroll
    for (int i = 0; i < 4; ++i) { fb[i] = cmul(f, (f32x2){br0[i], bi0[i]}); fb[4 + i] = cmul(f, (f32x2){br1[i], bi1[i]}); }
#pragma unroll
    for (int ks = 0; ks < 8; ++ks) { const f32x2 lp = cpow_k(are, aim, dt, 15 - 2 * ks - (kg >> 1)); float v[8];
#pragma unroll
        for (int i = 0; i < 8; ++i) { const f32x2 c = cmul(lp, fb[i]); v[i] = ri ? c.y : c.x; }
        const u32x4 w = {cvtpk(v[0], v[1]), cvtpk(v[2], v[3]), cvtpk(v[4], v[5]), cvtpk(v[6], v[7])}; af[ks] = __builtin_bit_cast(bf16x8, w); }
    l16a = cpow_k(area, aima, dt, 16); l16b = cpow_k(areb, aimb, dt, 16);
}
DI void ssm_state_unit(const bf16* U, const bf16x8 (&af)[8], f32x2 l16a, f32x2 l16b, float* S, int b, int g, int cb, int wave, int lane) {
    const int n = lane & 15, kg = lane >> 4;
    const bf16* up = U + ((size_t)b * SEQ + (size_t)(cb * 16 + n) * 64 + (kg >> 1)) * 512 + g * 16 + 8 * (kg & 1);
    bf16x8 uf[4][8];
#pragma unroll
    for (int a = 0; a < 4; ++a)
#pragma unroll
        for (int ks = 0; ks < 8; ++ks) uf[a][ks] = *(const bf16x8*)(up + (size_t)(16 * a + 2 * ks) * 512);
    __builtin_amdgcn_sched_barrier(0);
    pg8::f32x4 acc4[4];
#pragma unroll
    for (int a = 0; a < 4; ++a) acc4[a] = (pg8::f32x4){0.f, 0.f, 0.f, 0.f};
#pragma unroll
    for (int ks = 0; ks < 8; ++ks)
#pragma unroll
        for (int a = 0; a < 4; ++a) acc4[a] = MFMA16(af[ks], uf[a][ks], acc4[a]);
    __builtin_amdgcn_sched_barrier(0);
    pg8::f32x4 st = acc4[0];
#pragma unroll
    for (int a = 1; a < 4; ++a) {
        const f32x2 s0 = cmul(l16a, (f32x2){st[0], st[1]}), s1 = cmul(l16b, (f32x2){st[2], st[3]});
        st = (pg8::f32x4){s0.x + acc4[a][0], s0.y + acc4[a][1], s1.x + acc4[a][2], s1.y + acc4[a][3]};
    }
    *(pg8::f32x4*)(S + (((size_t)b * NCH + cb * 16 + n) * NG + g) * 128 + 16 * wave + 4 * kg) = st;
}
constexpr int XIN_OFF = 33280, XIN_PITCH = 272, XIN_VAR = 16 * XIN_PITCH, TB_OFF = XIN_OFF + 4 * XIN_VAR, UL_OFF = 57344, UL_PITCH = 2064;
template <int S> DI void toe_stage(pg8::f32x4 (&acc)[8], const LAS unsigned char* ul, const LAS unsigned char* kt, int wave, int lo, int hi) {
#pragma unroll 1
    for (int ks = lo; ks <= hi; ++ks) {
        const bf16x8 uf0 = *(const LAS bf16x8*)(ul + ks * 64);
        bf16x8 a0[8 - S];
#pragma unroll
        for (int j = S; j < 8; ++j) a0[j - S] = *(const LAS bf16x8*)(kt + (wave + 8 * j - 2 * ks) * 512);
        __builtin_amdgcn_sched_barrier(0);
#pragma unroll
        for (int j = S; j < 8; ++j) acc[j] = MFMA16(a0[j - S], uf0, acc[j]);
    }
}
#ifdef PROBE_SEL
#define QS(sel) do { if (PROBE_SEL == (sel)) tq0 = __builtin_amdgcn_s_memrealtime(); } while (0)
#define QT(sel) do { if (PROBE_SEL == (sel)) tqacc += __builtin_amdgcn_s_memrealtime() - tq0; } while (0)
#else
#define QS(sel) do {} while (0)
#define QT(sel) do {} while (0)
#endif
DI void ssm_out_unit(unsigned long long& tqacc, bool load_ktab, const bf16* U, const bf16* KTAB, const bf16* VTAB, const float* S, const float* LAM, const float* dsk, bf16* YS, int b, int g, int cb, LAS unsigned char* lds, int tid, int wave, int lane) {
    unsigned long long tq0 = 0ull; (void)tq0;
    const int n = lane & 15, kg = lane >> 4;
    QS(51);
    const f32x4 lam4 = *(const f32x4*)(LAM + (g * 64 + lane) * 4); const f32x2 lam = {lam4.x, lam4.y}, l16 = {lam4.z, lam4.w};
    f32x2 sv[16];
    {
        const u32x4* src = (const u32x4*)((const unsigned char*)KTAB + (size_t)g * KTAB_BYTES);
        u32x4 kt4[4], kt5 = {0u, 0u, 0u, 0u}, ut4[4];
        if (load_ktab) {
#pragma unroll
            for (int j = 0; j < 4; ++j) kt4[j] = src[tid + NTHR * j];
            if (tid < 32) kt5 = src[2048 + tid];
        }
#pragma unroll
        for (int j = 0; j < 4; ++j) { const int idx = tid + NTHR * j, cn = idx >> 7, tok = (idx >> 1) & 63, half = idx & 1;
            ut4[j] = *(const u32x4*)(U + ((size_t)b * SEQ + (size_t)(cb * 16 + cn) * 64 + tok) * 512 + g * 16 + 8 * half); }
        if (wave <= cb) { const f32x2* sp = (const f32x2*)(S + (((size_t)b * NCH + wave * 16) * NG + g) * 128) + lane;
#pragma unroll
            for (int j = 0; j < 16; ++j) sv[j] = sp[(size_t)j * (NG * 64)]; }
        __builtin_amdgcn_sched_barrier(0);
        if (load_ktab) {
#pragma unroll
            for (int j = 0; j < 4; ++j) *(LAS u32x4*)(lds + 16 * (tid + NTHR * j)) = kt4[j];
            if (tid < 32) *(LAS u32x4*)(lds + 16 * (2048 + tid)) = kt5;
        }
#pragma unroll
        for (int j = 0; j < 4; ++j) { const int idx = tid + NTHR * j, cn = idx >> 7, tok = (idx >> 1) & 63, half = idx & 1; *(LAS u32x4*)(lds + UL_OFF + cn * UL_PITCH + tok * 32 + half * 16) = ut4[j]; }
    }
    bf16x8 vfr[4][2];
#pragma unroll
    for (int k2 = 0; k2 < 4; ++k2)
#pragma unroll
        for (int jj = 0; jj < 2; ++jj) vfr[k2][jj] = *(const bf16x8*)(VTAB + ((size_t)g * 256 + (wave + 8 * jj) * 16 + n) * 128 + 32 * k2 + 8 * kg);
    __builtin_amdgcn_sched_barrier(0);
    LAS f32x2* TB = (LAS f32x2*)(lds + TB_OFF);
    if (wave < cb) { f32x2 x = {0.f, 0.f};
#pragma unroll
        for (int j = 0; j < 16; ++j) { x = cmul(lam, x); x.x += sv[j].x; x.y += sv[j].y; }
        TB[wave * 64 + lane] = x; }
    __syncthreads();
    if (wave == cb) {
        f32x2 l1k = lam;
#pragma unroll
        for (int j = 0; j < 4; ++j) l1k = cmul(l1k, l1k);
        f32x2 x = {0.f, 0.f};
        for (int w = 0; w < cb; ++w) { const f32x2 t = TB[w * 64 + lane]; x = cmul(l1k, x); x.x += t.x; x.y += t.y; }
#pragma unroll
        for (int j = 0; j < 16; ++j) { f32x2 xa = x;
#pragma unroll
            for (int a = 0; a < 4; ++a) { *(LAS unsigned*)(lds + XIN_OFF + a * XIN_VAR + j * XIN_PITCH + 4 * lane) = cvtpk(xa.x, xa.y); xa = cmul(l16, xa); }
            x = cmul(lam, x); x.x += sv[j].x; x.y += sv[j].y; }
    }
    __syncthreads();
    QT(51); QS(52);
    pg8::f32x4 acc[8];
#pragma unroll
    for (int j = 0; j < 8; ++j) acc[j] = (pg8::f32x4){0.f, 0.f, 0.f, 0.f};
    const LAS unsigned char* ul = lds + UL_OFF + n * UL_PITCH + (kg >> 1) * 32 + (kg & 1) * 16;
    const LAS unsigned char* kt = lds + n * 32 + (kg & 1) * 16 + (1 - (kg >> 1)) * 512;
    { const int hw = wave >> 1;
      toe_stage<0>(acc, ul, kt, wave, 0, hw);            toe_stage<1>(acc, ul, kt, wave, hw + 1, hw + 4);   toe_stage<2>(acc, ul, kt, wave, hw + 5, hw + 8);   toe_stage<3>(acc, ul, kt, wave, hw + 9, hw + 12);
      toe_stage<4>(acc, ul, kt, wave, hw + 13, hw + 16); toe_stage<5>(acc, ul, kt, wave, hw + 17, hw + 20); toe_stage<6>(acc, ul, kt, wave, hw + 21, hw + 24); toe_stage<7>(acc, ul, kt, wave, hw + 25, hw + 28); }
#pragma unroll
    for (int k2 = 0; k2 < 4; ++k2) {
        bf16x8 xf[4];
#pragma unroll
        for (int a = 0; a < 4; ++a) xf[a] = *(const LAS bf16x8*)(lds + XIN_OFF + a * XIN_VAR + n * XIN_PITCH + (32 * k2 + 8 * kg) * 2);
#pragma unroll
        for (int j = 0; j < 8; ++j) acc[j] = MFMA16(vfr[k2][j & 1], xf[j >> 1], acc[j]); }
    QT(52); QS(53);
    const f32x4 dv = *(const f32x4*)(dsk + g * 16 + 4 * kg);
#pragma unroll
    for (int j = 0; j < 8; ++j) { const int t = wave + 8 * j; const size_t off = ((size_t)b * SEQ + (size_t)(cb * 16 + n) * 64 + t) * 512 + g * 16 + 4 * kg;
        const u32x2 uu = *(const LAS u32x2*)(lds + UL_OFF + n * UL_PITCH + t * 32 + kg * 8);
        const float y0 = gelu_tanh(acc[j][0] + dv[0] * bflo(uu.x)), y1 = gelu_tanh(acc[j][1] + dv[1] * bfhi(uu.x)), y2 = gelu_tanh(acc[j][2] + dv[2] * bflo(uu.y)), y3 = gelu_tanh(acc[j][3] + dv[3] * bfhi(uu.y));
        u32x2 w; w.x = cvtpk(y0, y1); w.y = cvtpk(y2, y3); *(u32x2*)(YS + off) = w; }
    asm volatile("s_waitcnt lgkmcnt(0)\n\ts_barrier" ::: "memory");
    QT(53);
}

struct AttnSt { f32x16 o0, o1; float carry; };
DI bool attn_tile(AttnSt& st, const bf16x8 (&kf)[4], const bf16x8 (&vf)[4], const bf16x8 (&qf)[4], bool diag, int n, int hi) {
    f32x16 s;
#pragma unroll
    for (int r = 0; r < 16; ++r) s[r] = 0.f;
#pragma unroll
    for (int ks = 0; ks < 4; ++ks) s = MFMA32(kf[ks], qf[ks], s);
    float sp[16];
#pragma unroll
    for (int r = 0; r < 16; ++r) { const float z = s[r]; const float e = __builtin_amdgcn_exp2f(-fabsf(z)); sp[r] = fmaxf(z, 0.f) + __builtin_amdgcn_logf(1.0f + e);
        if (diag && (16 * (r >> 3) + 8 * hi + (r & 7)) >= n) sp[r] = 0.f; }
    float cum[16]; float c0 = 0.f, c1 = 0.f;
#pragma unroll
    for (int r = 7; r >= 0; --r) { c0 -= sp[r]; cum[r] = c0; c1 -= sp[8 + r]; cum[8 + r] = c1; }
    const float p0 = __shfl_xor(c0, 32), p1 = __shfl_xor(c1, 32);
    const float base1 = st.carry + (hi ? 0.f : p1), base0 = st.carry + c1 + p1 + (hi ? 0.f : p0);
    float w[16];
#pragma unroll
    for (int r = 0; r < 16; ++r) { w[r] = __builtin_amdgcn_exp2f(s[r] + cum[r] + (r < 8 ? base0 : base1));
        if (diag && (16 * (r >> 3) + 8 * hi + (r & 7)) >= n) w[r] = 0.f; }
    st.carry += (c0 + c1) + (p0 + p1);
    const u32x4 pa = {cvtpk(w[0], w[1]), cvtpk(w[2], w[3]), cvtpk(w[4], w[5]), cvtpk(w[6], w[7])}, pb = {cvtpk(w[8], w[9]), cvtpk(w[10], w[11]), cvtpk(w[12], w[13]), cvtpk(w[14], w[15])};
    const bf16x8 pf0 = __builtin_bit_cast(bf16x8, pa), pf1 = __builtin_bit_cast(bf16x8, pb);
    st.o0 = MFMA32(pf0, vf[0], st.o0); st.o0 = MFMA32(pf1, vf[1], st.o0); st.o1 = MFMA32(pf0, vf[2], st.o1); st.o1 = MFMA32(pf1, vf[3], st.o1);
    return __ballot(st.carry >= -152.0f) == 0ull;
}
DI void attn_task(const bf16* Q, const bf16* Kb, const bf16* VT, const bf16* ZA, bf16* Y, int b, int h, int qt, int lane) {
    const int n = lane & 31, hi = lane >> 5;
    const size_t rowbase = (size_t)b * SEQ;
    bf16x8 qf[4];
    { const bf16* qp = Q + (rowbase + qt * 32 + n) * 512 + h * 64 + 8 * hi;
#pragma unroll
      for (int ks = 0; ks < 4; ++ks) qf[ks] = *(const bf16x8*)(qp + 16 * ks); }
    const int pm = (n & ~12) | (((n >> 2) & 1) << 3) | (((n >> 3) & 1) << 2);
    const bf16* kp = Kb + (rowbase + pm) * 512 + h * 64 + 8 * hi;
    const bf16* vp = VT + ((size_t)(b * 8 + h) * 64 + n) * SEQ + 8 * hi;
    AttnSt st;
#pragma unroll
    for (int r = 0; r < 16; ++r) { st.o0[r] = 0.f; st.o1[r] = 0.f; }
    st.carry = 0.f;
    bf16x8 kA[4], vA[4], kB[4], vB[4], kC[4], vC[4];
#define ATT_LOAD(KF, VF, ktile) do { const int key0_ = ((ktile) > 0 ? (ktile) : 0) * 32; \
        _Pragma("unroll") for (int ks = 0; ks < 4; ++ks) KF[ks] = *(const bf16x8*)(kp + (size_t)key0_ * 512 + 16 * ks); \
        VF[0] = *(const bf16x8*)(vp + key0_); VF[1] = *(const bf16x8*)(vp + key0_ + 16); VF[2] = *(const bf16x8*)(vp + (size_t)32 * SEQ + key0_); VF[3] = *(const bf16x8*)(vp + (size_t)32 * SEQ + key0_ + 16); } while (0)
    ATT_LOAD(kA, vA, qt); ATT_LOAD(kB, vB, qt - 1);
    int kt = qt;
    for (;;) {
        ATT_LOAD(kC, vC, kt - 2); __builtin_amdgcn_sched_barrier(0);
        if (attn_tile(st, kA, vA, qf, kt == qt, n, hi) || kt == 0) break; --kt; __builtin_amdgcn_sched_barrier(0);
        ATT_LOAD(kA, vA, kt - 2); __builtin_amdgcn_sched_barrier(0);
        if (attn_tile(st, kB, vB, qf, false, n, hi) || kt == 0) break; --kt; __builtin_amdgcn_sched_barrier(0);
        ATT_LOAD(kB, vB, kt - 2); __builtin_amdgcn_sched_barrier(0);
        if (attn_tile(st, kC, vC, qf, false, n, hi) || kt == 0) break; --kt; __builtin_amdgcn_sched_barrier(0);
    }
#undef ATT_LOAD
    float za0[16], za1[16];
#pragma unroll
    for (int r = 0; r < 16; ++r) { const int i = (r & 3) + 8 * (r >> 2) + 4 * hi; const size_t off = (rowbase + qt * 32 + i) * 512 + h * 64 + n; za0[r] = bf1(ZA[off]); za1[r] = bf1(ZA[off + 32]); }
    __builtin_amdgcn_sched_barrier(0);
#pragma unroll
    for (int r = 0; r < 16; ++r) { const int i = (r & 3) + 8 * (r >> 2) + 4 * hi; const size_t off = (rowbase + qt * 32 + i) * 512 + h * 64 + n;
        Y[off] = (bf16)(cvtpk(st.o0[r] * silu(za0[r]), 0.f) & 0xffffu); Y[off + 32] = (bf16)(cvtpk(st.o1[r] * silu(za1[r]), 0.f) & 0xffffu); }
}
#define XB_TMO      128
#define XB_XCNT(j)  (256  + 64 * (j))
#define XB_XSUB(j)  (1280 + 64 * (j))
#define XB_XGEN(j)  (2304 + 64 * (j))
#define XB_TOP      3328
#define XB_TOPGEN   3392
#define XCD_BAR_WORDS 3456
#define XB_SPIN_CAP (1u << 18)

__device__ __forceinline__ unsigned xb_ld(unsigned* p)              { return __hip_atomic_load(p, __ATOMIC_RELAXED, __HIP_MEMORY_SCOPE_AGENT); }
__device__ __forceinline__ unsigned xb_add(unsigned* p, unsigned v) { return __hip_atomic_fetch_add(p, v, __ATOMIC_RELAXED, __HIP_MEMORY_SCOPE_AGENT); }
__device__ __forceinline__ unsigned xb_xcc_id() { return (unsigned)__builtin_amdgcn_s_getreg((3 << 11) | 20) & 0xFu; }
#define XB_SPIN(cond, bar) do { unsigned _sp = 0; while (cond) { __builtin_amdgcn_s_sleep(1); \
    if ((++_sp & 255u) == 0u) { if (xb_ld(&(bar)[XB_TMO])) break; if (_sp > XB_SPIN_CAP) { atomicAdd(&(bar)[XB_TMO], 1u); break; } } } } while (0)

struct XcdBarrier {
    unsigned* bar; unsigned x;
    volatile LAS unsigned* st;
};

__device__ __forceinline__ XcdBarrier xcd_barrier_post(unsigned* bar, volatile LAS unsigned* st) {
    XcdBarrier b; b.bar = bar; b.x = xb_xcc_id(); b.st = st;
    if (threadIdx.x == 0) (void)xb_add(&bar[XB_XCNT(b.x)], 1u);
    return b;
}
__device__ __forceinline__ void xcd_barrier_complete(unsigned* bar, unsigned x, unsigned& nloc, unsigned& nx) {
    const unsigned G = gridDim.x * gridDim.y * gridDim.z;
    unsigned sum, cnt, mine, sp = 0u;
    for (;;) {
        sum = 0u; cnt = 0u; mine = 0u;
#pragma unroll
        for (unsigned j = 0; j < 16; ++j) { const unsigned c = xb_ld(&bar[XB_XCNT(j)]); sum += c; cnt += (c > 0u) ? 1u : 0u; mine = (j == x) ? c : mine; }
        if (sum == G) break;
        __builtin_amdgcn_s_sleep(1);
        if ((++sp & 255u) == 0u) { if (xb_ld(&bar[XB_TMO])) break; if (sp > XB_SPIN_CAP) { atomicAdd(&bar[XB_TMO], 1u); break; } }
    }
    nloc = mine > 0u ? mine : 1u; nx = cnt > 0u ? cnt : 1u;
}

__device__ __forceinline__ void xcd_barrier(const XcdBarrier& b) {
    asm volatile("s_waitcnt vmcnt(0)" ::: "memory");
    __syncthreads();
    if (threadIdx.x == 0) {
        unsigned* bar = b.bar;
        __builtin_amdgcn_s_waitcnt(0);
        unsigned nloc = b.st[0], nx = b.st[1];
        if (nloc == 0u) { xcd_barrier_complete(bar, b.x, nloc, nx); b.st[0] = nloc; b.st[1] = nx; }
        const unsigned old = xb_add(&bar[XB_XSUB(b.x)], 1u);
        const unsigned gen = old / nloc;
        if (old + 1u == (gen + 1u) * nloc) {
            __builtin_amdgcn_fence(__ATOMIC_RELEASE, "agent");
            asm volatile("s_waitcnt vmcnt(0)" ::: "memory");
            const unsigned og = xb_add(&bar[XB_TOP], 1u);
            const unsigned tg = og / nx;
            if (og + 1u == (tg + 1u) * nx) xb_add(&bar[XB_TOPGEN], 1u);
            else XB_SPIN(xb_ld(&bar[XB_TOPGEN]) == tg, bar);
            __builtin_amdgcn_fence(__ATOMIC_ACQUIRE, "agent");
            xb_add(&bar[XB_XGEN(b.x)], 1u);
            asm volatile("s_waitcnt vmcnt(0)" ::: "memory");
        } else {
            XB_SPIN(xb_ld(&bar[XB_XGEN(b.x)]) == gen, bar);
            __builtin_amdgcn_fence(__ATOMIC_ACQUIRE, "agent");
            asm volatile("s_waitcnt vmcnt(0)" ::: "memory");
        }
    }
    __syncthreads();
}

__device__ __forceinline__ void xcd_barrier1(const XcdBarrier& b) {
    asm volatile("s_waitcnt vmcnt(0)" ::: "memory");
    __syncthreads();
    if (threadIdx.x == 0) {
        unsigned* bar = b.bar;
        __builtin_amdgcn_s_waitcnt(0);
        unsigned nloc = b.st[0], nx = b.st[1];
        if (nloc == 0u) { xcd_barrier_complete(bar, b.x, nloc, nx); b.st[0] = nloc; b.st[1] = nx; }
        const unsigned k = b.st[2]; b.st[2] = k + 1u;
        const unsigned old = xb_add(&bar[XB_XSUB(b.x)], 1u);
        const unsigned gen = old / nloc;
        if (old + 1u == (gen + 1u) * nloc) {
            __builtin_amdgcn_fence(__ATOMIC_RELEASE, "agent");
            asm volatile("s_waitcnt vmcnt(0)" ::: "memory");
            const unsigned og = xb_add(&bar[XB_TOP], 1u);
            if (og + 1u == (k + 1u) * nx) xb_add(&bar[XB_TOPGEN], 1u);
            else XB_SPIN(xb_ld(&bar[XB_TOPGEN]) == k, bar);
        } else {
            XB_SPIN(xb_ld(&bar[XB_TOPGEN]) == k, bar);
        }
        __builtin_amdgcn_fence(__ATOMIC_ACQUIRE, "agent");
        asm volatile("s_waitcnt vmcnt(0)" ::: "memory");
    }
    __syncthreads();
}
__global__ void __launch_bounds__(NTHR, 2) hybrid_fwd(Args a) {
    extern __shared__ __attribute__((aligned(16))) unsigned char lds_raw[];
    LAS unsigned char* lds = (LAS unsigned char*)lds_raw;
    cg::grid_group grid = cg::this_grid();
#ifdef EXP_INVL2
    if (threadIdx.x == 0) asm volatile("buffer_inv sc0 sc1\n\ts_waitcnt vmcnt(0)" ::: "memory");
    __syncthreads();
#endif
    volatile LAS unsigned* xb_st = (volatile LAS unsigned*)(lds + 131072 + 1024);
    if (threadIdx.x < 3) xb_st[threadIdx.x] = 0u;
    __syncthreads();
    if (blockIdx.x == 0) for (int i = threadIdx.x; i < 4096; i += NTHR) __hip_atomic_store((unsigned*)a.ws + i, 0u, __ATOMIC_RELAXED, __HIP_MEMORY_SCOPE_AGENT);
    XcdBarrier xbar; xbar.bar = (unsigned*)a.ws; xbar.x = 0; xbar.st = xb_st;
    const int tid0 = threadIdx.x, wave = __builtin_amdgcn_readfirstlane(tid0 >> 6);
    const int G = gridDim.x, bx = blockIdx.x;
    const int gw = bx * NWAVES + wave, NGW = G * NWAVES;
    unsigned char* ws = a.ws;
    bf16* const Win = (bf16*)(ws + WS_WIN); bf16* const Wglu = (bf16*)(ws + WS_WGLU); bf16* const Wbs = (bf16*)(ws + WS_WBS); bf16* const Wba = (bf16*)(ws + WS_WBA); bf16* const Wout = (bf16*)(ws + WS_WOUT);
    bf16* const Hb = (bf16*)(ws + WS_H); bf16* const Ub = (bf16*)(ws + WS_U); bf16* const ZSb = (bf16*)(ws + WS_ZS); bf16* const Qb = (bf16*)(ws + WS_Q); bf16* const Kb = (bf16*)(ws + WS_K);
    bf16* const VTb = (bf16*)(ws + WS_VT); bf16* const ZAb = (bf16*)(ws + WS_ZA); bf16* const GSb = (bf16*)(ws + WS_GS); bf16* const GAb = (bf16*)(ws + WS_GA);


    unsigned long long tqa = 0ull;
#ifdef PROBE_SEL
    unsigned long long tacc = 0ull, tbeg = 0ull;
#define PW(sel) do { if (PROBE_SEL == (sel) + 10) tacc += __builtin_amdgcn_s_memrealtime() - tbeg; if (PROBE_SEL == (sel) + 20) tbeg = __builtin_amdgcn_s_memrealtime(); } while (0)
#define PS(sel) do { if (PROBE_SEL == (sel)) tbeg = __builtin_amdgcn_s_memrealtime(); } while (0)
#define PT(sel) do { if (PROBE_SEL == (sel)) tacc += __builtin_amdgcn_s_memrealtime() - tbeg; } while (0)
#define PB(sel) do { if (PROBE_SEL == (sel) || PROBE_SEL == (sel) + 10) tbeg = __builtin_amdgcn_s_memrealtime(); } while (0)
#define PE(sel) do { if (PROBE_SEL == (sel) || PROBE_SEL == (sel) + 20) tacc += __builtin_amdgcn_s_memrealtime() - tbeg; } while (0)
#else
#define PB(sel) do {} while (0)
#define PW(sel) do {} while (0)
#define PS(sel) do {} while (0)
#define PT(sel) do {} while (0)
#define PE(sel) do {} while (0)
#endif
#define GSYNC() xcd_barrier1(xbar)
    PB(0);
    for (int l = 0; l <= DEPTH; ++l) {
        const int lt = l < DEPTH ? l : 0;
        bf16* const KTAB = (bf16*)(ws + WS_KTAB + lt * KTAB_LSTRIDE); bf16* const WTAB = (bf16*)(ws + WS_WTAB + lt * WTAB_LSTRIDE); bf16* const VTAB = (bf16*)(ws + WS_VTAB + lt * VTAB_LSTRIDE);
        float* const Sb = (float*)(ws + WS_S + lt * S_LSTRIDE); float* const LAM = (float*)(ws + WS_LAM + lt * LAM_LSTRIDE);
        int tid = tid0; asm volatile("" : "+v"(tid)); const int lane = tid & 63;
        PB(1);
        {
            const float* xin = (l <= 1) ? a.x : a.out;
        PS(43);
            { f32x4 gpo[4], gpr[4];
#pragma unroll
              for (int j = 0; j < 4; ++j) { gpo[j] = l > 0 ? *((const f32x4*)(a.post_g + (l - 1) * DM) + lane + 64 * j) : (f32x4){0.f, 0.f, 0.f, 0.f};
                                            gpr[j] = l < DEPTH ? *((const f32x4*)(a.pre_g + l * DM) + lane + 64 * j) : (f32x4){0.f, 0.f, 0.f, 0.f}; }
              for (int m = gw; m < M; m += NGW)
                  norm_row(xin + (size_t)m * DM, l > 0 ? GAb + (size_t)m * DM : nullptr, gpo, a.out + (size_t)m * DM, l < DEPTH, gpr, Hb + (size_t)m * DM, lane); }
        PT(43);
            if (l == DEPTH) { PE(1); break; }
            LAS float* scr = (LAS float*)(lds + wave * 16384);
            const float* w_in = a.w_in + (size_t)l * DM * NCOL; const float* w_glu = a.w_glu + (size_t)l * 512 * 1024; const float* w_bs = a.w_bs + (size_t)l * 512 * 1024;
            const float* w_ba = a.w_ba + (size_t)l * 512 * 1024; const float* w_out = a.w_out + (size_t)l * 1024 * 1024;
            constexpr int I_IN = 16 * 160, I_GLU = 8 * 32, I_BR = 8 * 32, I_OUT = 16 * 32, NITEMS = I_IN + I_GLU + 2 * I_BR + I_OUT;
        PS(44);
            for (int it = gw; it < NITEMS; it += NGW) {
                int r = it;
                if (r < I_IN) { const int kb = r / 160, nb = r % 160; transpose_item(w_in, 1024, NCOL, Win, 64 * kb, 32 * nb, 32 * nb, scr, lane); continue; } r -= I_IN;
                if (r < I_GLU) { const int kb = r / 32, nb = r % 32, n0 = 32 * nb; const int bj = n0 >> 9, rem = n0 & 511, pn = rem >> 7, i0 = rem & 127;
                    transpose_item(w_glu, 512, 1024, Wglu, 64 * kb, n0, 256 * pn + 128 * bj + i0, scr, lane); continue; } r -= I_GLU;
                if (r < I_BR) { const int kb = r / 32, nb = r % 32; transpose_item(w_bs, 512, 1024, Wbs, 64 * kb, 32 * nb, 32 * nb, scr, lane); continue; } r -= I_BR;
                if (r < I_BR) { const int kb = r / 32, nb = r % 32; transpose_item(w_ba, 512, 1024, Wba, 64 * kb, 32 * nb, 32 * nb, scr, lane); continue; } r -= I_BR;
                { const int kb = r / 32, nb = r % 32; transpose_item(w_out, 1024, 1024, Wout, 64 * kb, 32 * nb, 32 * nb, scr, lane); }
            }
            __syncthreads();
            PT(44);
            LayerP P{a.a_re + l * NG * NP, a.a_im + l * NG * NP, a.log_dt + l * NG, a.b_re + (size_t)l * NG * NP * 16, a.b_im + (size_t)l * NG * NP * 16, a.c_re + (size_t)l * NG * 16 * NP, a.c_im + (size_t)l * NG * 16 * NP};
        PS(45);
#ifndef NO_TAB
            for (int it = bx; it < NG * 8; it += G) ktab_block(P, KTAB, it >> 3, it & 7, lds, tid);
            for (int idx = bx * NTHR + tid; idx < NG * NP * 16; idx += G * NTHR) wv_item(P, WTAB, VTAB, LAM, idx);
#endif
        PT(45);
        }
        PW(1);
        if (l == 0) { grid.sync(); xbar = xcd_barrier_post((unsigned*)a.ws, xb_st); } else GSYNC();
        PE(1);
        PB(2);
#ifndef NO_A
        { pg8::Gemm g{Hb, Win, M, NCOL, DM}; pg8::StaticOrder S; S.init(M, NCOL, G, bx); EpiProj E{ws};
          pg8::gemm_phase<EpiProj, pg8::StaticOrder, true, true>(lds, g, S, E); }
#endif
        PW(2);
        GSYNC();
        PE(2);
        PB(3);
        PS(41);
#ifndef NO_B1
        for (int u0 = 2 * bx; u0 < 512; u0 += 2 * G) { const int g = u0 >> 4;
            LayerP P{a.a_re + l * NG * NP, a.a_im + l * NG * NP, a.log_dt + l * NG, a.b_re + (size_t)l * NG * NP * 16, a.b_im + (size_t)l * NG * NP * 16, a.c_re + (size_t)l * NG * 16 * NP, a.c_im + (size_t)l * NG * 16 * NP};
            bf16x8 af[8]; f32x2 l16a, l16b;
            make_wfrag(P, g, wave, lane, af, l16a, l16b);
            for (int q = 0; q < 2; ++q) { const int nb = (u0 + q) & 15; ssm_state_unit(Ub, af, l16a, l16b, Sb, nb >> 3, g, nb & 7, wave, lane); } }
#endif
        PT(41);
        PS(42);
#ifndef NO_ATTN
        for (int t = gw; t < 4096; t += NGW) attn_task(Qb, Kb, VTb, ZAb, Qb, t >> 11, (t >> 8) & 7, t & 255, lane);
#endif
        PT(42);
        PW(3);
        GSYNC();
        PE(3);
        PB(4);
#ifndef NO_B3
        for (int u = 2 * bx; u < 512; u += (u & 1) ? 2 * G - 1 : 1) { const int g = u >> 4, nb = u & 15; ssm_out_unit(tqa, (u & 1) == 0, Ub, KTAB, VTAB, Sb, LAM, a.d_skip + l * 512, Hb, nb >> 3, g, nb & 7, lds, tid, wave, lane); }
#endif
        PW(4);
        GSYNC();
        PE(4);
        PB(5);
#ifndef NO_D1
        { pg8::Gemm g{Hb, Wglu, M, 1024, 512}; pg8::StaticOrder S; S.init(M, 1024, G, bx); EpiGlu E{ZSb, a.b_glu + l * 1024};
          pg8::gemm_phase<EpiGlu, pg8::StaticOrder, true, true>(lds, g, S, E); }
#endif
        PW(5);
        GSYNC();
        PE(5);
#ifndef NO_D2
        PB(6);
        { pg8::Gemm g{ZSb, Wbs, M, 1024, 512, Qb, Wba}; pg8::ChainOrder S; S.B.init(M, 1024, G, bx); EpiBranchBoth E{GSb, GAb};
          pg8::gemm_phase<EpiBranchBoth, pg8::ChainOrder, true, true>(lds, g, S, E); }
#endif
        PW(6);
        GSYNC();
        PE(6);
#ifndef NO_D3
        PB(7);
        { pg8::Gemm g{GSb, Wout, M, 1024, 1024}; pg8::StaticOrder S; S.init(M, 1024, G, bx); EpiPlain E{GAb};
          pg8::gemm_phase<EpiPlain, pg8::StaticOrder, true, true>(lds, g, S, E); }
#endif
        PW(7);
        GSYNC();
        PE(7);
    }
    PE(0);
#ifdef PROBE_SEL
    grid.sync();
    if (bx == 0) { LAS unsigned long long* tb = (LAS unsigned long long*)lds; if (tid0 == 0) tb[0] = tacc + tqa; __syncthreads(); const unsigned long long K = tb[0] < 1000000ull ? tb[0] : 1000000ull;
        for (unsigned long long i = tid0; i < K; i += NTHR) a.out[i] += 0.05f; }
#endif
}

extern "C" void kernel_launch(void* const* d_in, const int* in_sizes, int n_in, void* d_out, int out_size, void* d_ws, size_t ws_size, hipStream_t stream) {
    static int grid = 0;
    if (grid == 0) {
        if (n_in != 17 || out_size != M * DM || ws_size < WS_END) { fprintf(stderr, "kernel_launch: unexpected problem shape (n_in %d, out %d, ws %zu)\n", n_in, out_size, ws_size); grid = -1; return; }
        int dev = 0, cus = 0, per_cu = 0;
        (void)hipGetDevice(&dev); (void)hipDeviceGetAttribute(&cus, hipDeviceAttributeMultiprocessorCount, dev);
        if (hipFuncSetAttribute((const void*)hybrid_fwd, hipFuncAttributeMaxDynamicSharedMemorySize, LDS_BYTES) != hipSuccess) { fprintf(stderr, "kernel_launch: hipFuncSetAttribute failed\n"); grid = -1; return; }
        if (hipOccupancyMaxActiveBlocksPerMultiprocessor(&per_cu, (const void*)hybrid_fwd, NTHR, LDS_BYTES) != hipSuccess || per_cu < 1) { fprintf(stderr, "kernel_launch: occupancy query gave %d\n", per_cu); per_cu = 1; }
        (void)hipGetLastError();
        grid = cus * per_cu;
    }
    if (grid < 0) return;
    Args a{};
    a.x = (const float*)d_in[0]; a.pre_g = (const float*)d_in[1]; a.post_g = (const float*)d_in[2]; a.w_in = (const float*)d_in[3]; a.a_re = (const float*)d_in[4]; a.a_im = (const float*)d_in[5];
    a.log_dt = (const float*)d_in[6]; a.b_re = (const float*)d_in[7]; a.b_im = (const float*)d_in[8]; a.c_re = (const float*)d_in[9]; a.c_im = (const float*)d_in[10]; a.d_skip = (const float*)d_in[11];
    a.w_glu = (const float*)d_in[12]; a.b_glu = (const float*)d_in[13]; a.w_bs = (const float*)d_in[14]; a.w_ba = (const float*)d_in[15]; a.w_out = (const float*)d_in[16];
    a.out = (float*)d_out; a.ws = (unsigned char*)d_ws;
    void* args[] = {&a};
    const hipError_t e = hipLaunchCooperativeKernel((const void*)hybrid_fwd, dim3(grid), dim3(NTHR), args, LDS_BYTES, stream);
    if (e != hipSuccess) fprintf(stderr, "kernel_launch: cooperative launch failed: %s (grid %d)\n", hipGetErrorString(e), grid);
}
```

```cpp
#include <hip/hip_runtime.h>
#include <hip/hip_cooperative_groups.h>
#include <cstdio>
#include <cstdint>
namespace cg = cooperative_groups;
namespace pg8 {
#define PG8_LAS __attribute__((address_space(3)))
typedef unsigned short bf16_t;
typedef short bf16x8 __attribute__((ext_vector_type(8)));
typedef float f32x4 __attribute__((ext_vector_type(4)));
typedef unsigned u32x4 __attribute__((ext_vector_type(4)));
constexpr int BM = 256, BK = 64, HALF = 128, HTB = HALF * BK * 2  , STAGE_BYTES = 8 * HTB, NXCD = 8, WGM = 8;

__host__ __device__ __forceinline__ int lds_byte(int r, int c) { const int st = (r >> 4) * 2 + (c >> 5), rr = r & 15, cc = c & 31, ob = rr * 64 + cc * 2; return st * 1024 + (ob ^ (((ob >> 9) & 1) << 5)); }
__host__ __device__ __forceinline__ void stage_rc(int b, int& R, int& C) { const int st = b / 1024, sb = b % 1024, swz = sb ^ (((sb >> 9) & 1) << 5); R = (st >> 1) * 16 + swz / 64; C = (st & 1) * 32 + (swz % 64) / 2; }
__host__ __device__ __forceinline__ int perm32(int rho) { const int n = rho >> 4, i = rho & 15; return 8 * (i >> 2) + 4 * n + (i & 3); }

struct Unit { int pm, pn, sel; };
struct Gemm { const bf16_t* A; const bf16_t* Bt; int M, N, K; const bf16_t* A2; const bf16_t* Bt2; };

struct StaticOrder {
    int nM, nN, nwg, G, c;
    __host__ __device__ void init(int M, int N, int G_, int c_) { nM = M / BM; nN = N / BM; nwg = nM * nN; G = G_; c = c_; }
    __host__ __device__ bool next(int i, Unit& u) const {
        const long L = (long)i * G + c; if (L >= nwg) return false;
        int wgid = (int)L; { const int q = nwg / NXCD, r = nwg % NXCD, xcd = wgid % NXCD, off = wgid / NXCD; wgid = (xcd < r ? xcd * (q + 1) : r * (q + 1) + (xcd - r) * q) + off; }
        const int nig = WGM * nN, gid = wgid / nig, fm = gid * WGM, gsz = (nM - fm) < WGM ? (nM - fm) : WGM;
        u.pm = fm + ((wgid % nig) % gsz); u.pn = (wgid % nig) / gsz; u.sel = 0; return true;
    }
    __device__ __forceinline__ void a_ready(const Unit&) const {}
    __device__ __forceinline__ void done(const Unit&) const {}
};
__device__ __forceinline__ unsigned cvt_pk_bf16(float lo, float hi) { unsigned r; asm volatile("v_cvt_pk_bf16_f32 %0, %1, %2" : "=v"(r) : "v"(lo), "v"(hi)); return r; }
typedef float f32x2 __attribute__((ext_vector_type(2)));
struct ChainOrder { StaticOrder B;
    __host__ __device__ bool next(int i, Unit& u) const { if (!B.next(i >> 1, u)) return false; u.sel = i & 1; return true; }
    __device__ __forceinline__ void a_ready(const Unit&) const {}
    __device__ __forceinline__ void done(const Unit&) const {}
};

template <class Epi, class Sched, bool ALIGN_EPI = false, bool SP2 = false>
__device__ __forceinline__ void gemm_phase(PG8_LAS unsigned char* lds, const Gemm g, const Sched& S, const Epi& E) {
    int tid_ = threadIdx.x; asm volatile("" : "+v"(tid_));
    const int tid = tid_, wid = __builtin_amdgcn_readfirstlane(tid >> 6), lane = tid & 63, wr = wid >> 2, wc = wid & 3, fr = lane & 15, fq = lane >> 4;
    const int K = g.K, nt = K / BK;
    unsigned voffA[2], voffB[2];
#pragma unroll
    for (int i = 0; i < 2; ++i) { int R, C; stage_rc(tid * 16 + i * 8192, R, C); const int Rb = Epi::PERM ? ((R & ~31) + perm32(R & 31)) : R;
        voffA[i] = (unsigned)(R * K + C) * 2u; voffB[i] = (unsigned)(Rb * K + C) * 2u; }
    const size_t kstep = (size_t)(BK * 2);
    const size_t hstep = (size_t)HALF * K * 2;
    const size_t tstep = 2 * hstep;
    const unsigned ldsw = (unsigned)wid * 1024u;
    const int aoff = lds_byte(wr * 64 + fr, fq * 8), boff = lds_byte(wc * 32 + fr, fq * 8);
#define PG8_SA(b, h) (((b) * 2 + (h)) * HTB)
#define PG8_SB(b, h) ((4 + (b) * 2 + (h)) * HTB)
#define PG8_STAGE(bufoff, gbase, voff) do { _Pragma("unroll") for (int _i = 0; _i < 2; ++_i) \
        __builtin_amdgcn_global_load_lds((const unsigned*)((const char*)(gbase) + (voff)[_i]), (PG8_LAS unsigned*)(lds + (bufoff) + ldsw + _i * 8192), 16, 0, 0); } while (0)
#define PG8_LDA(dst, b, h) do { _Pragma("unroll") for (int m = 0; m < 4; ++m) _Pragma("unroll") for (int k = 0; k < 2; ++k) dst[m][k] = *(const PG8_LAS bf16x8*)(lds + PG8_SA(b, h) + aoff + m * 2048 + k * 1024); } while (0)
#define PG8_LDB(dst, b, h) do { _Pragma("unroll") for (int n = 0; n < 2; ++n) _Pragma("unroll") for (int k = 0; k < 2; ++k) dst[n][k] = *(const PG8_LAS bf16x8*)(lds + PG8_SB(b, h) + boff + n * 2048 + k * 1024); } while (0)
#define PG8_MMA(ai, bj, At, Bt) do { __builtin_amdgcn_s_setprio(1); _Pragma("unroll") for (int m = 0; m < 4; ++m) _Pragma("unroll") for (int n = 0; n < 2; ++n) _Pragma("unroll") for (int k = 0; k < 2; ++k) \
        acc[ai][bj][m][n] = __builtin_amdgcn_mfma_f32_16x16x32_bf16(Bt[n][k], At[m][k], acc[ai][bj][m][n], 0, 0, 0); __builtin_amdgcn_s_setprio(0); } while (0)
#define PG8_WAIT_V(n) asm volatile("s_waitcnt vmcnt(" #n ")" ::: "memory")
#define PG8_WAIT_L(n) asm volatile("s_waitcnt lgkmcnt(" #n ")" ::: "memory")
#define PG8_BAR __builtin_amdgcn_s_barrier()
#define PG8_SCHED __builtin_amdgcn_sched_barrier(0)
    Unit cur, nxt; int ui = 0;
    if (!S.next(0, cur)) return;
    f32x4 acc[2][2][4][2];
#pragma unroll
    for (int a = 0; a < 2; ++a)
#pragma unroll
        for (int b = 0; b < 2; ++b)
#pragma unroll
            for (int m = 0; m < 4; ++m)
#pragma unroll
                for (int n = 0; n < 2; ++n) acc[a][b][m][n] = (f32x4){0.f, 0.f, 0.f, 0.f};
    bf16x8 At[4][2], B0[2][2], B1[2][2];
    const char* cA = (const char*)(cur.sel ? g.A2 : g.A) + (size_t)cur.pm * tstep; const char* cB = (const char*)(cur.sel ? g.Bt2 : g.Bt) + (size_t)cur.pn * tstep;
    S.a_ready(cur);
    if constexpr (SP2) {
        PG8_STAGE(PG8_SB(0, 0), cB, voffB); PG8_STAGE(PG8_SB(0, 1), cB + hstep, voffB); PG8_STAGE(PG8_SA(0, 0), cA, voffA); PG8_STAGE(PG8_SA(0, 1), cA + hstep, voffA);
        if (wr == 1) PG8_BAR;
        PG8_WAIT_V(2); PG8_BAR;
        PG8_STAGE(PG8_SB(1, 0), cB + kstep, voffB); PG8_STAGE(PG8_SA(1, 0), cA + kstep, voffA); PG8_STAGE(PG8_SB(1, 1), cB + hstep + kstep, voffB);
        PG8_WAIT_V(6); PG8_BAR;
    } else {
        PG8_STAGE(PG8_SB(0, 0), cB, voffB); PG8_STAGE(PG8_SA(0, 0), cA, voffA); PG8_STAGE(PG8_SB(0, 1), cB + hstep, voffB); PG8_STAGE(PG8_SA(0, 1), cA + hstep, voffA);
        if (wr == 1) PG8_BAR;
        PG8_WAIT_V(4); PG8_BAR;
        PG8_STAGE(PG8_SB(1, 0), cB + kstep, voffB); PG8_STAGE(PG8_SA(1, 0), cA + kstep, voffA); PG8_STAGE(PG8_SB(1, 1), cB + hstep + kstep, voffB);
        PG8_WAIT_V(6); PG8_BAR;
    }
    for (;;) {
        const bool has_next = S.next(ui + 1, nxt);
        const char* nA = has_next ? (const char*)(nxt.sel ? g.A2 : g.A) + (size_t)nxt.pm * tstep : cA; const char* nB = has_next ? (const char*)(nxt.sel ? g.Bt2 : g.Bt) + (size_t)nxt.pn * tstep : cB;
        for (int t = 0; t < nt; t += 2) {
            const bool last = (t == nt - 2);
            const char* a1 = cA + (size_t)(t + 1) * kstep;
            const char* a2 = last ? nA : cA + (size_t)(t + 2) * kstep; const char* b2 = last ? nB : cB + (size_t)(t + 2) * kstep;
            const char* a3 = a2 + kstep; const char* b3 = b2 + kstep;
            if (last && has_next) S.a_ready(nxt);
            if constexpr (SP2) {
            PG8_LDB(B0, 0, 0); PG8_LDB(B1, 0, 1); PG8_SCHED; PG8_LDA(At, 0, 0); PG8_STAGE(PG8_SA(1, 1), a1 + hstep, voffA);
            PG8_WAIT_V(8); PG8_WAIT_L(0); PG8_BAR; PG8_MMA(0, 0, At, B0); PG8_MMA(0, 1, At, B1); PG8_BAR; PG8_SCHED;
            PG8_LDA(At, 0, 1); PG8_STAGE(PG8_SB(0, 0), b2, voffB); PG8_STAGE(PG8_SB(0, 1), b2 + hstep, voffB); PG8_STAGE(PG8_SA(0, 0), a2, voffA);
            PG8_WAIT_V(8); PG8_WAIT_L(0); PG8_BAR; PG8_MMA(1, 0, At, B0); PG8_MMA(1, 1, At, B1); PG8_BAR; PG8_SCHED;
            PG8_LDB(B0, 1, 0); PG8_LDB(B1, 1, 1); PG8_SCHED; PG8_LDA(At, 1, 0); PG8_STAGE(PG8_SA(0, 1), a2 + hstep, voffA);
            PG8_WAIT_V(8); PG8_WAIT_L(0); PG8_BAR; PG8_MMA(0, 0, At, B0); PG8_MMA(0, 1, At, B1); PG8_BAR; PG8_SCHED;
            PG8_LDA(At, 1, 1); PG8_STAGE(PG8_SB(1, 0), b3, voffB); PG8_STAGE(PG8_SB(1, 1), b3 + hstep, voffB); PG8_STAGE(PG8_SA(1, 0), a3, voffA);
            PG8_WAIT_V(8); PG8_WAIT_L(0); PG8_BAR; PG8_MMA(1, 0, At, B0); PG8_MMA(1, 1, At, B1); PG8_BAR; PG8_SCHED;
            } else {
            PG8_LDB(B0, 0, 0); PG8_SCHED; PG8_LDA(At, 0, 0); PG8_STAGE(PG8_SA(1, 1), a1 + hstep, voffA);
            PG8_WAIT_L(8); PG8_BAR; PG8_WAIT_L(0); PG8_MMA(0, 0, At, B0); PG8_BAR; PG8_SCHED;
            PG8_LDB(B1, 0, 1); PG8_STAGE(PG8_SB(0, 0), b2, voffB);
            PG8_BAR; PG8_WAIT_L(0); PG8_MMA(0, 1, At, B1); PG8_BAR;
            PG8_LDA(At, 0, 1); PG8_STAGE(PG8_SA(0, 0), a2, voffA);
            PG8_BAR; PG8_WAIT_L(0); PG8_MMA(1, 0, At, B0); PG8_BAR; PG8_SCHED;
            PG8_STAGE(PG8_SB(0, 1), b2 + hstep, voffB);
            PG8_WAIT_V(6); PG8_BAR; PG8_MMA(1, 1, At, B1); PG8_BAR;
            PG8_LDB(B0, 1, 0); PG8_SCHED; PG8_LDA(At, 1, 0); PG8_STAGE(PG8_SA(0, 1), a2 + hstep, voffA);
            PG8_WAIT_L(8); PG8_BAR; PG8_WAIT_L(0); PG8_MMA(0, 0, At, B0); PG8_BAR; PG8_SCHED;
            PG8_LDB(B1, 1, 1); PG8_STAGE(PG8_SB(1, 0), b3, voffB);
            PG8_BAR; PG8_WAIT_L(0); PG8_MMA(0, 1, At, B1); PG8_BAR;
            PG8_LDA(At, 1, 1); PG8_STAGE(PG8_SA(1, 0), a3, voffA);
            PG8_BAR; PG8_WAIT_L(0); PG8_MMA(1, 0, At, B0); PG8_BAR; PG8_SCHED;
            PG8_STAGE(PG8_SB(1, 1), b3 + hstep, voffB);
            PG8_WAIT_V(6); PG8_BAR; PG8_MMA(1, 1, At, B1); PG8_BAR;
            }
        }
        if constexpr (ALIGN_EPI) { if (wr == 0) PG8_BAR; }
        if constexpr (!Epi::AFTER_DRAIN) { E(acc, cur, wr, wc, fr, fq); S.done(cur); }
        if (!has_next) break;
#pragma unroll
        for (int a = 0; a < 2; ++a)
#pragma unroll
            for (int b = 0; b < 2; ++b)
#pragma unroll
                for (int m = 0; m < 4; ++m)
#pragma unroll
                    for (int n = 0; n < 2; ++n) acc[a][b][m][n] = (f32x4){0.f, 0.f, 0.f, 0.f};
        cur = nxt; cA = nA; cB = nB; ++ui;
        if constexpr (ALIGN_EPI) { if (wr == 1) PG8_BAR; }
    }
    PG8_WAIT_V(0);
    if constexpr (!ALIGN_EPI) { if (wr == 0) PG8_BAR; }
    PG8_BAR;
    if constexpr (Epi::AFTER_DRAIN) { E.fused(acc, cur, wr, wc, fr, fq, lds, wid, lane); S.done(cur); }
#undef PG8_SA
#undef PG8_SB
#undef PG8_STAGE
#undef PG8_LDA
#undef PG8_LDB
#undef PG8_MMA
#undef PG8_WAIT_V
#undef PG8_WAIT_L
#undef PG8_BAR
#undef PG8_SCHED
}
}
#define DI __device__ __forceinline__
#define LAS __attribute__((address_space(3)))
typedef unsigned short bf16;
typedef float f32x4 __attribute__((ext_vector_type(4)));
typedef float f32x2 __attribute__((ext_vector_type(2)));
typedef float f32x16 __attribute__((ext_vector_type(16)));
typedef short bf16x8 __attribute__((ext_vector_type(8)));
typedef unsigned u32x4 __attribute__((ext_vector_type(4)));
typedef unsigned u32x2 __attribute__((ext_vector_type(2)));
typedef __bf16 bf16x2_t __attribute__((ext_vector_type(2)));

constexpr int NWAVES = 8, NTHR = 512;
constexpr int BATCH = 2, SEQ = 8192, DM = 1024, DEPTH = 4, M = BATCH * SEQ, NCOL = 5120;
constexpr int NG = 32, NP = 64, NCH = SEQ / 64;
constexpr float EPS = 1e-6f;
constexpr size_t MiB = 1u << 20;
constexpr size_t WS_WIN = 1 * MiB, WS_WGLU = 11 * MiB, WS_WBS = 12 * MiB, WS_WBA = 13 * MiB, WS_WOUT = 14 * MiB;
constexpr size_t WS_H = 16 * MiB;
constexpr size_t WS_U = 48 * MiB, WS_ZS = 64 * MiB, WS_Q = 80 * MiB, WS_K = 96 * MiB, WS_VT = 112 * MiB, WS_ZA = 128 * MiB;
constexpr size_t WS_GS = 144 * MiB, WS_GA = 176 * MiB;
constexpr size_t WS_KTAB = 208 * MiB, KTAB_LSTRIDE = 1280 * 1024;
constexpr size_t WS_WTAB = 213 * MiB, WTAB_LSTRIDE = 2 * MiB;
constexpr size_t WS_VTAB = 221 * MiB, VTAB_LSTRIDE = 2 * MiB;
constexpr size_t WS_S = 229 * MiB, S_LSTRIDE = 4 * MiB;
constexpr size_t WS_LAM = 245 * MiB, LAM_LSTRIDE = 64 * 1024;
constexpr size_t WS_END = 246 * MiB;
constexpr int KTAB_BYTES = 65 * 512;
constexpr int LDS_BYTES = 147456;
constexpr float QSCALE = 0.125f * 1.4426950408889634f;

struct Args {
    const float* x; const float* pre_g; const float* post_g; const float* w_in; const float* a_re; const float* a_im; const float* log_dt;
    const float* b_re; const float* b_im; const float* c_re; const float* c_im; const float* d_skip; const float* w_glu; const float* b_glu;
    const float* w_bs; const float* w_ba; const float* w_out; float* out; unsigned char* ws;
};

DI unsigned cvtpk(float lo, float hi) { f32x2 v = {lo, hi}; bf16x2_t b = __builtin_convertvector(v, bf16x2_t); return __builtin_bit_cast(unsigned, b); }
DI float bflo(unsigned w) { return __uint_as_float(w << 16); }
DI float bfhi(unsigned w) { return __uint_as_float(w & 0xffff0000u); }
DI float bf1(bf16 b) { return __uint_as_float((unsigned)b << 16); }
DI float sigm(float x) { return __builtin_amdgcn_rcpf(1.0f + __expf(-x)); }
DI float silu(float x) { return x * sigm(x); }
DI float gelu_tanh(float x) { const float u = 1.5957691216057308f * (x + 0.044715f * x * x * x); return x * sigm(u); }
template <int CTRL> DI float dpp_step(float v) { return v + __builtin_bit_cast(float, __builtin_amdgcn_update_dpp(0, __builtin_bit_cast(int, v), CTRL, 0xf, 0xf, true)); }
DI float wave_sum(float v) {
    v = dpp_step<0xB1>(v); v = dpp_step<0x4E>(v); v = dpp_step<0x141>(v); v = dpp_step<0x140>(v);
    return ((__builtin_bit_cast(float, __builtin_amdgcn_readlane(__builtin_bit_cast(int, v), 0)) + __builtin_bit_cast(float, __builtin_amdgcn_readlane(__builtin_bit_cast(int, v), 16))) +
            (__builtin_bit_cast(float, __builtin_amdgcn_readlane(__builtin_bit_cast(int, v), 32)) + __builtin_bit_cast(float, __builtin_amdgcn_readlane(__builtin_bit_cast(int, v), 48))));
}

struct EpiProj {
    static constexpr bool PERM = true, AFTER_DRAIN = false;
    unsigned char* ws;
    DI void operator()(const pg8::f32x4 (&acc)[2][2][4][2], const pg8::Unit& u, int wr, int wc, int fr, int fq) const {
        const int pn = u.pn;
        bf16* base; int ld, colt; float sc = 1.f;
        if (pn < 12) { base = (bf16*)(ws + WS_U + (size_t)(pn >> 1) * (16 * MiB)); ld = 512; colt = (pn & 1) * 256; if ((pn >> 1) == 2) sc = QSCALE; }
        else if (pn < 16) { base = (bf16*)(ws + WS_GS); ld = 1024; colt = (pn - 12) * 256; }
        else { base = (bf16*)(ws + WS_GA); ld = 1024; colt = (pn - 16) * 256; }
        const int row0 = u.pm * 256 + wr * 64 + fr, col0 = colt + wc * 32 + 8 * fq;
        if ((pn >> 1) == 4) {
            bf16* vt = (bf16*)(ws + WS_VT);
#pragma unroll
            for (int ai = 0; ai < 2; ++ai)
#pragma unroll
                for (int m = 0; m < 4; ++m) { const int r = row0 + ai * 128 + m * 16; const int bb = r >> 13, t = r & 8191;
#pragma unroll
                    for (int bj = 0; bj < 2; ++bj) { bf16* p = vt + ((size_t)(bb * 512 + col0 + bj * 128)) * 8192 + t;
#pragma unroll
                        for (int n = 0; n < 2; ++n)
#pragma unroll
                            for (int e = 0; e < 4; ++e) { *p = (bf16)(cvtpk(acc[ai][bj][m][n][e], 0.f) & 0xffffu); p += 8192; asm volatile("" : "+v"(p)); } }
                    __builtin_amdgcn_sched_barrier(0); }
            return;
        }
#pragma unroll
        for (int ai = 0; ai < 2; ++ai)
#pragma unroll
            for (int m = 0; m < 4; ++m) { bf16* rowp = base + (size_t)(row0 + ai * 128 + m * 16) * ld + col0;
#pragma unroll
                for (int bj = 0; bj < 2; ++bj) { const pg8::f32x4 v0 = acc[ai][bj][m][0] * sc, v1 = acc[ai][bj][m][1] * sc;
                    u32x4 w; w.x = cvtpk(v0[0], v0[1]); w.y = cvtpk(v0[2], v0[3]); w.z = cvtpk(v1[0], v1[1]); w.w = cvtpk(v1[2], v1[3]);
                    *(u32x4*)(rowp + bj * 128) = w; } }
    }
};
struct EpiGlu {
    static constexpr bool PERM = true, AFTER_DRAIN = false;
    bf16* zs; const float* bias;
    DI void operator()(const pg8::f32x4 (&acc)[2][2][4][2], const pg8::Unit& u, int wr, int wc, int fr, int fq) const {
        const int row0 = u.pm * 256 + wr * 64 + fr, col0 = u.pn * 128 + wc * 32 + 8 * fq;
        f32x4 ba0 = *(const f32x4*)(bias + col0), ba1 = *(const f32x4*)(bias + col0 + 4), bb0 = *(const f32x4*)(bias + 512 + col0), bb1 = *(const f32x4*)(bias + 512 + col0 + 4);
        u32x4 zv[2][4];
#pragma unroll
        for (int ai = 0; ai < 2; ++ai)
#pragma unroll
            for (int m = 0; m < 4; ++m) zv[ai][m] = *(const u32x4*)(zs + (size_t)(row0 + ai * 128 + m * 16) * 512 + col0);
        __builtin_amdgcn_sched_barrier(0);
#pragma unroll
        for (int ai = 0; ai < 2; ++ai)
#pragma unroll
            for (int m = 0; m < 4; ++m) { bf16* p = zs + (size_t)(row0 + ai * 128 + m * 16) * 512 + col0;
                const u32x4 z = zv[ai][m]; float zf[8] = {bflo(z.x), bfhi(z.x), bflo(z.y), bfhi(z.y), bflo(z.z), bfhi(z.z), bflo(z.w), bfhi(z.w)}; float y[8];
#pragma unroll
                for (int e = 0; e < 4; ++e) {
                    y[e] = (acc[ai][0][m][0][e] + ba0[e]) * zf[e] * __builtin_amdgcn_rcpf((1.0f + __expf(-(acc[ai][1][m][0][e] + bb0[e]))) * (1.0f + __expf(-zf[e])));
                    y[4 + e] = (acc[ai][0][m][1][e] + ba1[e]) * zf[4 + e] * __builtin_amdgcn_rcpf((1.0f + __expf(-(acc[ai][1][m][1][e] + bb1[e]))) * (1.0f + __expf(-zf[4 + e]))); }
                u32x4 w; w.x = cvtpk(y[0], y[1]); w.y = cvtpk(y[2], y[3]); w.z = cvtpk(y[4], y[5]); w.w = cvtpk(y[6], y[7]); *(u32x4*)p = w; }
    }
};
template <int PASS> struct EpiBranch {
    static constexpr bool PERM = true, AFTER_DRAIN = false;
    bf16* G; const bf16* gate2;
    DI void operator()(const pg8::f32x4 (&acc)[2][2][4][2], const pg8::Unit& u, int wr, int wc, int fr, int fq) const {
        const int row0 = u.pm * 256 + wr * 64 + fr, col0 = u.pn * 256 + wc * 32 + 8 * fq;
#pragma unroll
        for (int ai = 0; ai < 2; ++ai)
#pragma unroll
          for (int mh = 0; mh < 2; ++mh) {
            u32x4 gv[2][2], hv[2][2];
#pragma unroll
            for (int mm = 0; mm < 2; ++mm)
#pragma unroll
                for (int bj = 0; bj < 2; ++bj) { const int m = 2 * mh + mm; const size_t off = (size_t)(row0 + ai * 128 + m * 16) * 1024 + col0 + bj * 128; gv[mm][bj] = *(const u32x4*)(G + off); if (PASS == 1) hv[mm][bj] = *(const u32x4*)(gate2 + off); }
            __builtin_amdgcn_sched_barrier(0);
#pragma unroll
            for (int mm = 0; mm < 2; ++mm)
#pragma unroll
                for (int bj = 0; bj < 2; ++bj) { const int m = 2 * mh + mm; const size_t off = (size_t)(row0 + ai * 128 + m * 16) * 1024 + col0 + bj * 128;
                    const u32x4 g = gv[mm][bj]; float gf[8] = {bflo(g.x), bfhi(g.x), bflo(g.y), bfhi(g.y), bflo(g.z), bfhi(g.z), bflo(g.w), bfhi(g.w)}; float y[8];
                    if (PASS == 0) {
#pragma unroll
                        for (int e = 0; e < 4; ++e) { y[e] = sigm(gf[e]) * acc[ai][bj][m][0][e]; y[4 + e] = sigm(gf[4 + e]) * acc[ai][bj][m][1][e]; }
                    } else {
                        const u32x4 h = hv[mm][bj]; float hf[8] = {bflo(h.x), bfhi(h.x), bflo(h.y), bfhi(h.y), bflo(h.z), bfhi(h.z), bflo(h.w), bfhi(h.w)};
#pragma unroll
                        for (int e = 0; e < 4; ++e) { y[e] = gf[e] + sigm(hf[e]) * acc[ai][bj][m][0][e]; y[4 + e] = gf[4 + e] + sigm(hf[4 + e]) * acc[ai][bj][m][1][e]; }
                    }
                    u32x4 w; w.x = cvtpk(y[0], y[1]); w.y = cvtpk(y[2], y[3]); w.z = cvtpk(y[4], y[5]); w.w = cvtpk(y[6], y[7]); *(u32x4*)(G + off) = w; }
            __builtin_amdgcn_sched_barrier(0);
          }
    }
};
struct EpiBranchBoth {
    static constexpr bool PERM = true, AFTER_DRAIN = false;
    bf16* G; const bf16* gate2;
    DI void operator()(const pg8::f32x4 (&acc)[2][2][4][2], const pg8::Unit& u, int wr, int wc, int fr, int fq) const {
        if (u.sel == 0) { EpiBranch<0> e{G, gate2}; e(acc, u, wr, wc, fr, fq); } else { EpiBranch<1> e{G, gate2}; e(acc, u, wr, wc, fr, fq); }
    }
};
struct EpiPlain {
    static constexpr bool PERM = true, AFTER_DRAIN = false;
    bf16* O;
    DI void operator()(const pg8::f32x4 (&acc)[2][2][4][2], const pg8::Unit& u, int wr, int wc, int fr, int fq) const {
        const int row0 = u.pm * 256 + wr * 64 + fr, col0 = u.pn * 256 + wc * 32 + 8 * fq;
#pragma unroll
        for (int ai = 0; ai < 2; ++ai)
#pragma unroll
            for (int m = 0; m < 4; ++m)
#pragma unroll
                for (int bj = 0; bj < 2; ++bj) { const pg8::f32x4 v0 = acc[ai][bj][m][0], v1 = acc[ai][bj][m][1];
                    u32x4 w; w.x = cvtpk(v0[0], v0[1]); w.y = cvtpk(v0[2], v0[3]); w.z = cvtpk(v1[0], v1[1]); w.w = cvtpk(v1[2], v1[3]);
                    *(u32x4*)(O + (size_t)(row0 + ai * 128 + m * 16) * 1024 + col0 + bj * 128) = w; }
    }
};

DI void norm_row(const float* xin, const bf16* o, const f32x4 (&gpo)[4], float* xout, bool has_pre, const f32x4 (&gpr)[4], bf16* h, int lane) {
    f32x4 v[4];
#pragma unroll
    for (int j = 0; j < 4; ++j) v[j] = *((const f32x4*)xin + lane + 64 * j);
    if (o) {
        f32x4 ov[4]; float ss = 0.f;
#pragma unroll
        for (int j = 0; j < 4; ++j) { const u32x2 w = *((const u32x2*)o + lane + 64 * j); ov[j] = (f32x4){bflo(w.x), bfhi(w.x), bflo(w.y), bfhi(w.y)};
            ss += (ov[j].x * ov[j].x + ov[j].y * ov[j].y) + (ov[j].z * ov[j].z + ov[j].w * ov[j].w); }
        const float rstd = __builtin_amdgcn_rsqf(wave_sum(ss) * (1.0f / DM) + EPS);
#pragma unroll
        for (int j = 0; j < 4; ++j) { v[j] = v[j] + ov[j] * rstd * gpo[j]; *((f32x4*)xout + lane + 64 * j) = v[j]; }
    }
    if (has_pre) {
        float ss = 0.f;
#pragma unroll
        for (int j = 0; j < 4; ++j) ss += (v[j].x * v[j].x + v[j].y * v[j].y) + (v[j].z * v[j].z + v[j].w * v[j].w);
        const float rstd = __builtin_amdgcn_rsqf(wave_sum(ss) * (1.0f / DM) + EPS);
#pragma unroll
        for (int j = 0; j < 4; ++j) { const f32x4 y = v[j] * rstd * gpr[j];
            u32x2 w; w.x = cvtpk(y.x, y.y); w.y = cvtpk(y.z, y.w); *((u32x2*)h + lane + 64 * j) = w; }
    }
}
DI void transpose_item(const float* W, int K, int N, bf16* WT, int k0, int n0, int dst_row0, LAS float* scr, int lane) {
#pragma unroll 8
    for (int i = 0; i < 32; ++i) { const int kk = 2 * i + (lane >> 5); scr[kk * 33 + (lane & 31)] = W[(size_t)(k0 + kk) * N + n0 + (lane & 31)]; }
    asm volatile("s_waitcnt lgkmcnt(0)" ::: "memory");
    const int c = lane & 7;
#pragma unroll
    for (int j = 0; j < 4; ++j) { const int n = (lane >> 3) + 8 * j; const LAS float* s = scr + (8 * c) * 33 + n;
        u32x4 o; o.x = cvtpk(s[0 * 33], s[1 * 33]); o.y = cvtpk(s[2 * 33], s[3 * 33]); o.z = cvtpk(s[4 * 33], s[5 * 33]); o.w = cvtpk(s[6 * 33], s[7 * 33]);
        *(u32x4*)(WT + (size_t)(dst_row0 + n) * K + k0 + 8 * c) = o; }
    asm volatile("s_waitcnt lgkmcnt(0)" ::: "memory");
}
DI f32x2 cpow_k(float are, float aim, float dt, int k) {
    const float mag = __expf(are * dt * (float)k);
    const double turns = (double)aim * (double)dt * (double)k * 0.15915494309189535;
    const float fr = (float)(turns - floor(turns));
    return (f32x2){mag * __builtin_amdgcn_cosf(fr), mag * __builtin_amdgcn_sinf(fr)};
}
DI f32x2 cmul(f32x2 a, f32x2 b) { return (f32x2){a.x * b.x - a.y * b.y, a.x * b.y + a.y * b.x}; }
DI f32x2 zoh_factor(float are, float aim, float dt) {
    const f32x2 ab = cpow_k(are, aim, dt, 1); const float nr = ab.x - 1.0f, ni = ab.y, den = are * are + aim * aim;
    return (f32x2){(nr * are + ni * aim) / den, (ni * are - nr * aim) / den};
}

struct LayerP { const float *a_re, *a_im, *log_dt, *b_re, *b_im, *c_re, *c_im; };

DI void ktab_block(const LayerP& P, bf16* KTAB, int g, int tb, LAS unsigned char* lds, int tid) {
    LAS f32x2* CL = (LAS f32x2*)lds;
    LAS f32x2* BB = (LAS f32x2*)(lds + 16384);
    const float dt = __expf(P.log_dt[g]);
    const int p = tid & 63, h0 = tid >> 6, h1 = h0 + 8;
    const float are = P.a_re[g * 64 + p], aim = P.a_im[g * 64 + p];
    const f32x2 c0 = {P.c_re[(g * 16 + h0) * 64 + p], P.c_im[(g * 16 + h0) * 64 + p]}, c1 = {P.c_re[(g * 16 + h1) * 64 + p], P.c_im[(g * 16 + h1) * 64 + p]};
    const int e0 = tid, e1 = tid + NTHR; const int pa = e0 >> 4, pb = e1 >> 4, hp = tid & 15;
    const float area = P.a_re[g * 64 + pa], aima = P.a_im[g * 64 + pa], areb = P.a_re[g * 64 + pb], aimb = P.a_im[g * 64 + pb];
    const f32x2 bva = {P.b_re[(g * 64 + pa) * 16 + hp], P.b_im[(g * 64 + pa) * 16 + hp]}, bvb = {P.b_re[(g * 64 + pb) * 16 + hp], P.b_im[(g * 64 + pb) * 16 + hp]};
    BB[pa * 16 + hp] = cmul(zoh_factor(area, aima, dt), bva); BB[pb * 16 + hp] = cmul(zoh_factor(areb, aimb, dt), bvb);
    if (tb == 0 && tid < 256) KTAB[((size_t)g * 65) * 256 + tid] = 0;
#pragma unroll 1
    for (int tp = 0; tp < 4; ++tp) { const int tau0 = tb * 8 + 2 * tp;
        const f32x2 l0 = cpow_k(are, aim, dt, tau0), l1 = cpow_k(are, aim, dt, tau0 + 1);
        CL[(0 * 16 + h0) * 64 + p] = cmul(c0, l0); CL[(0 * 16 + h1) * 64 + p] = cmul(c1, l0); CL[(1 * 16 + h0) * 64 + p] = cmul(c0, l1); CL[(1 * 16 + h1) * 64 + p] = cmul(c1, l1);
        __syncthreads();
        { const int ts = tid >> 8, h = (tid >> 4) & 15; float sacc = 0.f;
#pragma unroll 8
          for (int q = 0; q < 64; ++q) { const f32x2 c = CL[(ts * 16 + h) * 64 + q], bq = BB[q * 16 + hp]; sacc += c.x * bq.x - c.y * bq.y; }
          KTAB[((size_t)g * 65 + (tau0 + ts + 1)) * 256 + h * 16 + hp] = (bf16)(cvtpk(sacc, 0.f) & 0xffffu); }
        __syncthreads();
    }
}
DI void wv_item(const LayerP& P, bf16* WTAB, bf16* VTAB, float* LAM, int idx) {
    const int p = idx & 63, k = (idx >> 6) & 15, g = idx >> 10;
    const float dt = __expf(P.log_dt[g]), are = P.a_re[g * 64 + p], aim = P.a_im[g * 64 + p];
    f32x2 cv[16];
#pragma unroll
    for (int j = 0; j < 16; ++j) cv[j] = (f32x2){P.c_re[(g * 16 + j) * 64 + p], P.c_im[(g * 16 + j) * 64 + p]};
    const f32x2 lk1 = cpow_k(are, aim, dt, k + 1);
#pragma unroll
    for (int h = 0; h < 16; ++h) { const f32x2 c = cmul(cv[h], lk1); *(unsigned*)(VTAB + ((size_t)g * 256 + k * 16 + h) * 128 + 2 * p) = cvtpk(c.x, -c.y); }
    if (k == 15) { const f32x2 l64 = cpow_k(are, aim, dt, 64); *(f32x4*)(LAM + (g * 64 + p) * 4) = (f32x4){l64.x, l64.y, lk1.x, lk1.y}; }
}

#define MFMA16(a, b, c) __builtin_amdgcn_mfma_f32_16x16x32_bf16((a), (b), (c), 0, 0, 0)
#define MFMA32(a, b, c) __builtin_amdgcn_mfma_f32_32x32x16_bf16((a), (b), (c), 0, 0, 0)
DI void make_wfrag(const LayerP& P, int g, int wave, int lane, bf16x8 (&af)[8], f32x2& l16a, f32x2& l16b) {
    const int n = lane & 15, kg = lane >> 4, p = 8 * wave + (n >> 1), ri = n & 1;
    const float dt = __expf(P.log_dt[g]), are = P.a_re[g * 64 + p], aim = P.a_im[g * 64 + p];
    const int pa = 8 * wave + 2 * kg;
    const float area = P.a_re[g * 64 + pa], aima = P.a_im[g * 64 + pa], areb = P.a_re[g * 64 + pa + 1], aimb = P.a_im[g * 64 + pa + 1];
    const f32x4 br0 = *(const f32x4*)(P.b_re + (g * 64 + p) * 16 + 8 * (kg & 1)), br1 = *(const f32x4*)(P.b_re + (g * 64 + p) * 16 + 8 * (kg & 1) + 4);
    const f32x4 bi0 = *(const f32x4*)(P.b_im + (g * 64 + p) * 16 + 8 * (kg & 1)), bi1 = *(const f32x4*)(P.b_im + (g * 64 + p) * 16 + 8 * (kg & 1) + 4);
    const f32x2 f = zoh_factor(are, aim, dt);
    f32x2 fb[8];
#pragma unroll
    for (int i = 0; i < 4; ++i) { fb[i] = cmul(f, (f32x2){br0[i], bi0[i]}); fb[4 + i] = cmul(f, (f32x2){br1[i], bi1[i]}); }
#pragma unroll
    for (int ks = 0; ks < 8; ++ks) { const f32x2 lp = cpow_k(are, aim, dt, 15 - 2 * ks - (kg >> 1)); float v[8];
#pragma unroll
        for (int i = 0; i < 8; ++i) { const f32x2 c = cmul(lp, fb[i]); v[i] = ri ? c.y : c.x; }
        const u32x4 w = {cvtpk(v[0], v[1]), cvtpk(v[2], v[3]), cvtpk(v[4], v[5]), cvtpk(v[6], v[7])}; af[ks] = __builtin_bit_cast(bf16x8, w); }
    l16a = cpow_k(area, aima, dt, 16); l16b = cpow_k(areb, aimb, dt, 16);
}
DI void ssm_state_unit(const bf16* U, const bf16x8 (&af)[8], f32x2 l16a, f32x2 l16b, float* S, int b, int g, int cb, int wave, int lane) {
    const int n = lane & 15, kg = lane >> 4;
    const bf16* up = U + ((size_t)b * SEQ + (size_t)(cb * 16 + n) * 64 + (kg >> 1)) * 512 + g * 16 + 8 * (kg & 1);
    bf16x8 uf[4][8];
#pragma unroll
    for (int a = 0; a < 4; ++a)
#pragma unroll
        for (int ks = 0; ks < 8; ++ks) uf[a][ks] = *(const bf16x8*)(up + (size_t)(16 * a + 2 * ks) * 512);
    __builtin_amdgcn_sched_barrier(0);
    pg8::f32x4 acc4[4];
#pragma unroll
    for (int a = 0; a < 4; ++a) acc4[a] = (pg8::f32x4){0.f, 0.f, 0.f, 0.f};
#pragma unroll
    for (int ks = 0; ks < 8; ++ks)
#pragma unroll
        for (int a = 0; a < 4; ++a) acc4[a] = MFMA16(af[ks], uf[a][ks], acc4[a]);
    __builtin_amdgcn_sched_barrier(0);
    pg8::f32x4 st = acc4[0];
#pragma unroll
    for (int a = 1; a < 4; ++a) {
        const f32x2 s0 = cmul(l16a, (f32x2){st[0], st[1]}), s1 = cmul(l16b, (f32x2){st[2], st[3]});
        st = (pg8::f32x4){s0.x + acc4[a][0], s0.y + acc4[a][1], s1.x + acc4[a][2], s1.y + acc4[a][3]};
    }
    *(pg8::f32x4*)(S + (((size_t)b * NCH + cb * 16 + n) * NG + g) * 128 + 16 * wave + 4 * kg) = st;
}
constexpr int XIN_OFF = 33280, XIN_PITCH = 272, XIN_VAR = 16 * XIN_PITCH, TB_OFF = XIN_OFF + 4 * XIN_VAR, UL_OFF = 57344, UL_PITCH = 2064;
template <int S> DI void toe_stage(pg8::f32x4 (&acc)[8], const LAS unsigned char* ul, const LAS unsigned char* kt, int wave, int lo, int hi) {
#pragma unroll 1
    for (int ks = lo; ks <= hi; ++ks) {
        const bf16x8 uf0 = *(const LAS bf16x8*)(ul + ks * 64);
        bf16x8 a0[8 - S];
#pragma unroll
        for (int j = S; j < 8; ++j) a0[j - S] = *(const LAS bf16x8*)(kt + (wave + 8 * j - 2 * ks) * 512);
        __builtin_amdgcn_sched_barrier(0);
#pragma unroll
        for (int j = S; j < 8; ++j) acc[j] = MFMA16(a0[j - S], uf0, acc[j]);
    }
}
#ifdef PROBE_SEL
#define QS(sel) do { if (PROBE_SEL == (sel)) tq0 = __builtin_amdgcn_s_memrealtime(); } while (0)
#define QT(sel) do { if (PROBE_SEL == (sel)) tqacc += __builtin_amdgcn_s_memrealtime() - tq0; } while (0)
#else
#define QS(sel) do {} while (0)
#define QT(sel) do {} while (0)
#endif
DI void ssm_out_unit(unsigned long long& tqacc, bool load_ktab, const bf16* U, const bf16* KTAB, const bf16* VTAB, const float* S, const float* LAM, const float* dsk, bf16* YS, int b, int g, int cb, LAS unsigned char* lds, int tid, int wave, int lane) {
    unsigned long long tq0 = 0ull; (void)tq0;
    const int n = lane & 15, kg = lane >> 4;
    QS(51);
    const f32x4 lam4 = *(const f32x4*)(LAM + (g * 64 + lane) * 4); const f32x2 lam = {lam4.x, lam4.y}, l16 = {lam4.z, lam4.w};
    f32x2 sv[16];
    {
        const u32x4* src = (const u32x4*)((const unsigned char*)KTAB + (size_t)g * KTAB_BYTES);
        u32x4 kt4[4], kt5 = {0u, 0u, 0u, 0u}, ut4[4];
        if (load_ktab) {
#pragma unroll
            for (int j = 0; j < 4; ++j) kt4[j] = src[tid + NTHR * j];
            if (tid < 32) kt5 = src[2048 + tid];
        }
#pragma unroll
        for (int j = 0; j < 4; ++j) { const int idx = tid + NTHR * j, cn = idx >> 7, tok = (idx >> 1) & 63, half = idx & 1;
            ut4[j] = *(const u32x4*)(U + ((size_t)b * SEQ + (size_t)(cb * 16 + cn) * 64 + tok) * 512 + g * 16 + 8 * half); }
        if (wave <= cb) { const f32x2* sp = (const f32x2*)(S + (((size_t)b * NCH + wave * 16) * NG + g) * 128) + lane;
#pragma unroll
            for (int j = 0; j < 16; ++j) sv[j] = sp[(size_t)j * (NG * 64)]; }
        __builtin_amdgcn_sched_barrier(0);
        if (load_ktab) {
#pragma unroll
            for (int j = 0; j < 4; ++j) *(LAS u32x4*)(lds + 16 * (tid + NTHR * j)) = kt4[j];
            if (tid < 32) *(LAS u32x4*)(lds + 16 * (2048 + tid)) = kt5;
        }
#pragma unroll
        for (int j = 0; j < 4; ++j) { const int idx = tid + NTHR * j, cn = idx >> 7, tok = (idx >> 1) & 63, half = idx & 1; *(LAS u32x4*)(lds + UL_OFF + cn * UL_PITCH + tok * 32 + half * 16) = ut4[j]; }
    }
    bf16x8 vfr[4][2];
#pragma unroll
    for (int k2 = 0; k2 < 4; ++k2)
#pragma unroll
        for (int jj = 0; jj < 2; ++jj) vfr[k2][jj] = *(const bf16x8*)(VTAB + ((size_t)g * 256 + (wave + 8 * jj) * 16 + n) * 128 + 32 * k2 + 8 * kg);
    __builtin_amdgcn_sched_barrier(0);
    LAS f32x2* TB = (LAS f32x2*)(lds + TB_OFF);
    if (wave < cb) { f32x2 x = {0.f, 0.f};
#pragma unroll
        for (int j = 0; j < 16; ++j) { x = cmul(lam, x); x.x += sv[j].x; x.y += sv[j].y; }
        TB[wave * 64 + lane] = x; }
    __syncthreads();
    if (wave == cb) {
        f32x2 l1k = lam;
#pragma unroll
        for (int j = 0; j < 4; ++j) l1k = cmul(l1k, l1k);
        f32x2 x = {0.f, 0.f};
        for (int w = 0; w < cb; ++w) { const f32x2 t = TB[w * 64 + lane]; x = cmul(l1k, x); x.x += t.x; x.y += t.y; }
#pragma unroll
        for (int j = 0; j < 16; ++j) { f32x2 xa = x;
#pragma unroll
            for (int a = 0; a < 4; ++a) { *(LAS unsigned*)(lds + XIN_OFF + a * XIN_VAR + j * XIN_PITCH + 4 * lane) = cvtpk(xa.x, xa.y); xa = cmul(l16, xa); }
            x = cmul(lam, x); x.x += sv[j].x; x.y += sv[j].y; }
    }
    __syncthreads();
    QT(51); QS(52);
    pg8::f32x4 acc[8];
#pragma unroll
    for (int j = 0; j < 8; ++j) acc[j] = (pg8::f32x4){0.f, 0.f, 0.f, 0.f};
    const LAS unsigned char* ul = lds + UL_OFF + n * UL_PITCH + (kg >> 1) * 32 + (kg & 1) * 16;
    const LAS unsigned char* kt = lds + n * 32 + (kg & 1) * 16 + (1 - (kg >> 1)) * 512;
    { const int hw = wave >> 1;
      toe_stage<0>(acc, ul, kt, wave, 0, hw);            toe_stage<1>(acc, ul, kt, wave, hw + 1, hw + 4);   toe_stage<2>(acc, ul, kt, wave, hw + 5, hw + 8);   toe_stage<3>(acc, ul, kt, wave, hw + 9, hw + 12);
      toe_stage<4>(acc, ul, kt, wave, hw + 13, hw + 16); toe_stage<5>(acc, ul, kt, wave, hw + 17, hw + 20); toe_stage<6>(acc, ul, kt, wave, hw + 21, hw + 24); toe_stage<7>(acc, ul, kt, wave, hw + 25, hw + 28); }
#pragma unroll
    for (int k2 = 0; k2 < 4; ++k2) {
        bf16x8 xf[4];
#pragma unroll
        for (int a = 0; a < 4; ++a) xf[a] = *(const LAS bf16x8*)(lds + XIN_OFF + a * XIN_VAR + n * XIN_PITCH + (32 * k2 + 8 * kg) * 2);
#pragma unroll
        for (int j = 0; j < 8; ++j) acc[j] = MFMA16(vfr[k2][j & 1], xf[j >> 1], acc[j]); }
    QT(52); QS(53);
    const f32x4 dv = *(const f32x4*)(dsk + g * 16 + 4 * kg);
#pragma unroll
    for (int j = 0; j < 8; ++j) { const int t = wave + 8 * j; const size_t off = ((size_t)b * SEQ + (size_t)(cb * 16 + n) * 64 + t) * 512 + g * 16 + 4 * kg;
        const u32x2 uu = *(const LAS u32x2*)(lds + UL_OFF + n * UL_PITCH + t * 32 + kg * 8);
        const float y0 = gelu_tanh(acc[j][0] + dv[0] * bflo(uu.x)), y1 = gelu_tanh(acc[j][1] + dv[1] * bfhi(uu.x)), y2 = gelu_tanh(acc[j][2] + dv[2] * bflo(uu.y)), y3 = gelu_tanh(acc[j][3] + dv[3] * bfhi(uu.y));
        u32x2 w; w.x = cvtpk(y0, y1); w.y = cvtpk(y2, y3); *(u32x2*)(YS + off) = w; }
    asm volatile("s_waitcnt lgkmcnt(0)\n\ts_barrier" ::: "memory");
    QT(53);
}

struct AttnSt { f32x16 o0, o1; float carry; };
DI bool attn_tile(AttnSt& st, const bf16x8 (&kf)[4], const bf16x8 (&vf)[4], const bf16x8 (&qf)[4], bool diag, int n, int hi) {
    f32x16 s;
#pragma unroll
    for (int r = 0; r < 16; ++r) s[r] = 0.f;
#pragma unroll
    for (int ks = 0; ks < 4; ++ks) s = MFMA32(kf[ks], qf[ks], s);
    float sp[16];
#pragma unroll
    for (int r = 0; r < 16; ++r) { const float z = s[r]; const float e = __builtin_amdgcn_exp2f(-fabsf(z)); sp[r] = fmaxf(z, 0.f) + __builtin_amdgcn_logf(1.0f + e);
        if (diag && (16 * (r >> 3) + 8 * hi + (r & 7)) >= n) sp[r] = 0.f; }
    float cum[16]; float c0 = 0.f, c1 = 0.f;
#pragma unroll
    for (int r = 7; r >= 0; --r) { c0 -= sp[r]; cum[r] = c0; c1 -= sp[8 + r]; cum[8 + r] = c1; }
    const float p0 = __shfl_xor(c0, 32), p1 = __shfl_xor(c1, 32);
    const float base1 = st.carry + (hi ? 0.f : p1), base0 = st.carry + c1 + p1 + (hi ? 0.f : p0);
    float w[16];
#pragma unroll
    for (int r = 0; r < 16; ++r) { w[r] = __builtin_amdgcn_exp2f(s[r] + cum[r] + (r < 8 ? base0 : base1));
        if (diag && (16 * (r >> 3) + 8 * hi + (r & 7)) >= n) w[r] = 0.f; }
    st.carry += (c0 + c1) + (p0 + p1);
    const u32x4 pa = {cvtpk(w[0], w[1]), cvtpk(w[2], w[3]), cvtpk(w[4], w[5]), cvtpk(w[6], w[7])}, pb = {cvtpk(w[8], w[9]), cvtpk(w[10], w[11]), cvtpk(w[12], w[13]), cvtpk(w[14], w[15])};
    const bf16x8 pf0 = __builtin_bit_cast(bf16x8, pa), pf1 = __builtin_bit_cast(bf16x8, pb);
    st.o0 = MFMA32(pf0, vf[0], st.o0); st.o0 = MFMA32(pf1, vf[1], st.o0); st.o1 = MFMA32(pf0, vf[2], st.o1); st.o1 = MFMA32(pf1, vf[3], st.o1);
    return __ballot(st.carry >= -152.0f) == 0ull;
}
DI void attn_task(const bf16* Q, const bf16* Kb, const bf16* VT, const bf16* ZA, bf16* Y, int b, int h, int qt, int lane) {
    const int n = lane & 31, hi = lane >> 5;
    const size_t rowbase = (size_t)b * SEQ;
    bf16x8 qf[4];
    { const bf16* qp = Q + (rowbase + qt * 32 + n) * 512 + h * 64 + 8 * hi;
#pragma unroll
      for (int ks = 0; ks < 4; ++ks) qf[ks] = *(const bf16x8*)(qp + 16 * ks); }
    const int pm = (n & ~12) | (((n >> 2) & 1) << 3) | (((n >> 3) & 1) << 2);
    const bf16* kp = Kb + (rowbase + pm) * 512 + h * 64 + 8 * hi;
    const bf16* vp = VT + ((size_t)(b * 8 + h) * 64 + n) * SEQ + 8 * hi;
    AttnSt st;
#pragma unroll
    for (int r = 0; r < 16; ++r) { st.o0[r] = 0.f; st.o1[r] = 0.f; }
    st.carry = 0.f;
    bf16x8 kA[4], vA[4], kB[4], vB[4], kC[4], vC[4];
#define ATT_LOAD(KF, VF, ktile) do { const int key0_ = ((ktile) > 0 ? (ktile) : 0) * 32; \
        _Pragma("unroll") for (int ks = 0; ks < 4; ++ks) KF[ks] = *(const bf16x8*)(kp + (size_t)key0_ * 512 + 16 * ks); \
        VF[0] = *(const bf16x8*)(vp + key0_); VF[1] = *(const bf16x8*)(vp + key0_ + 16); VF[2] = *(const bf16x8*)(vp + (size_t)32 * SEQ + key0_); VF[3] = *(const bf16x8*)(vp + (size_t)32 * SEQ + key0_ + 16); } while (0)
    ATT_LOAD(kA, vA, qt); ATT_LOAD(kB, vB, qt - 1);
    int kt = qt;
    for (;;) {
        ATT_LOAD(kC, vC, kt - 2); __builtin_amdgcn_sched_barrier(0);
        if (attn_tile(st, kA, vA, qf, kt == qt, n, hi) || kt == 0) break; --kt; __builtin_amdgcn_sched_barrier(0);
        ATT_LOAD(kA, vA, kt - 2); __builtin_amdgcn_sched_barrier(0);
        if (attn_tile(st, kB, vB, qf, false, n, hi) || kt == 0) break; --kt; __builtin_amdgcn_sched_barrier(0);
        ATT_LOAD(kB, vB, kt - 2); __builtin_amdgcn_sched_barrier(0);
        if (attn_tile(st, kC, vC, qf, false, n, hi) || kt == 0) break; --kt; __builtin_amdgcn_sched_barrier(0);
    }
#undef ATT_LOAD
    float za0[16], za1[16];
#pragma unroll
    for (int r = 0; r < 16; ++r) { const int i = (r & 3) + 8 * (r >> 2) + 4 * hi; const size_t off = (rowbase + qt * 32 + i) * 512 + h * 64 + n; za0[r] = bf1(ZA[off]); za1[r] = bf1(ZA[off + 32]); }
    __builtin_amdgcn_sched_barrier(0);
#pragma unroll
    for (int r = 0; r < 16; ++r) { const int i = (r & 3) + 8 * (r >> 2) + 4 * hi; const size_t off = (rowbase + qt * 32 + i) * 512 + h * 64 + n;
        Y[off] = (bf16)(cvtpk(st.o0[r] * silu(za0[r]), 0.f) & 0xffffu); Y[off + 32] = (bf16)(cvtpk(st.o1[r] * silu(za1[r]), 0.f) & 0xffffu); }
}
#define XB_TMO      128
#define XB_XCNT(j)  (256  + 64 * (j))
#define XB_XSUB(j)  (1280 + 64 * (j))
#define XB_XGEN(j)  (2304 + 64 * (j))
#define XB_TOP      3328
#define XB_TOPGEN   3392
#define XCD_BAR_WORDS 3456
#define XB_SPIN_CAP (1u << 18)

__device__ __forceinline__ unsigned xb_ld(unsigned* p)              { return __hip_atomic_load(p, __ATOMIC_RELAXED, __HIP_MEMORY_SCOPE_AGENT); }
__device__ __forceinline__ unsigned xb_add(unsigned* p, unsigned v) { return __hip_atomic_fetch_add(p, v, __ATOMIC_RELAXED, __HIP_MEMORY_SCOPE_AGENT); }
__device__ __forceinline__ unsigned xb_xcc_id() { return (unsigned)__builtin_amdgcn_s_getreg((3 << 11) | 20) & 0xFu; }
#define XB_SPIN(cond, bar) do { unsigned _sp = 0; while (cond) { __builtin_amdgcn_s_sleep(1); \
    if ((++_sp & 255u) == 0u) { if (xb_ld(&(bar)[XB_TMO])) break; if (_sp > XB_SPIN_CAP) { atomicAdd(&(bar)[XB_TMO], 1u); break; } } } } while (0)

struct XcdBarrier {
    unsigned* bar; unsigned x;
    volatile LAS unsigned* st;
};

__device__ __forceinline__ XcdBarrier xcd_barrier_post(unsigned* bar, volatile LAS unsigned* st) {
    XcdBarrier b; b.bar = bar; b.x = xb_xcc_id(); b.st = st;
    if (threadIdx.x == 0) (void)xb_add(&bar[XB_XCNT(b.x)], 1u);
    return b;
}
__device__ __forceinline__ void xcd_barrier_complete(unsigned* bar, unsigned x, unsigned& nloc, unsigned& nx) {
    const unsigned G = gridDim.x * gridDim.y * gridDim.z;
    unsigned sum, cnt, mine, sp = 0u;
    for (;;) {
        sum = 0u; cnt = 0u; mine = 0u;
#pragma unroll
        for (unsigned j = 0; j < 16; ++j) { const unsigned c = xb_ld(&bar[XB_XCNT(j)]); sum += c; cnt += (c > 0u) ? 1u : 0u; mine = (j == x) ? c : mine; }
        if (sum == G) break;
        __builtin_amdgcn_s_sleep(1);
        if ((++sp & 255u) == 0u) { if (xb_ld(&bar[XB_TMO])) break; if (sp > XB_SPIN_CAP) { atomicAdd(&bar[XB_TMO], 1u); break; } }
    }
    nloc = mine > 0u ? mine : 1u; nx = cnt > 0u ? cnt : 1u;
}

__device__ __forceinline__ void xcd_barrier(const XcdBarrier& b) {
    asm volatile("s_waitcnt vmcnt(0)" ::: "memory");
    __syncthreads();
    if (threadIdx.x == 0) {
        unsigned* bar = b.bar;
        __builtin_amdgcn_s_waitcnt(0);
        unsigned nloc = b.st[0], nx = b.st[1];
        if (nloc == 0u) { xcd_barrier_complete(bar, b.x, nloc, nx); b.st[0] = nloc; b.st[1] = nx; }
        const unsigned old = xb_add(&bar[XB_XSUB(b.x)], 1u);
        const unsigned gen = old / nloc;
        if (old + 1u == (gen + 1u) * nloc) {
            __builtin_amdgcn_fence(__ATOMIC_RELEASE, "agent");
            asm volatile("s_waitcnt vmcnt(0)" ::: "memory");
            const unsigned og = xb_add(&bar[XB_TOP], 1u);
            const unsigned tg = og / nx;
            if (og + 1u == (tg + 1u) * nx) xb_add(&bar[XB_TOPGEN], 1u);
            else XB_SPIN(xb_ld(&bar[XB_TOPGEN]) == tg, bar);
            __builtin_amdgcn_fence(__ATOMIC_ACQUIRE, "agent");
            xb_add(&bar[XB_XGEN(b.x)], 1u);
            asm volatile("s_waitcnt vmcnt(0)" ::: "memory");
        } else {
            XB_SPIN(xb_ld(&bar[XB_XGEN(b.x)]) == gen, bar);
            __builtin_amdgcn_fence(__ATOMIC_ACQUIRE, "agent");
            asm volatile("s_waitcnt vmcnt(0)" ::: "memory");
        }
    }
    __syncthreads();
}

__device__ __forceinline__ void xcd_barrier1(const XcdBarrier& b) {
    asm volatile("s_waitcnt vmcnt(0)" ::: "memory");
    __syncthreads();
    if (threadIdx.x == 0) {
        unsigned* bar = b.bar;
        __builtin_amdgcn_s_waitcnt(0);
        unsigned nloc = b.st[0], nx = b.st[1];
        if (nloc == 0u) { xcd_barrier_complete(bar, b.x, nloc, nx); b.st[0] = nloc; b.st[1] = nx; }
        const unsigned k = b.st[2]; b.st[2] = k + 1u;
        const unsigned old = xb_add(&bar[XB_XSUB(b.x)], 1u);
        const unsigned gen = old / nloc;
        if (old + 1u == (gen + 1u) * nloc) {
            __builtin_amdgcn_fence(__ATOMIC_RELEASE, "agent");
            asm volatile("s_waitcnt vmcnt(0)" ::: "memory");
            const unsigned og = xb_add(&bar[XB_TOP], 1u);
            if (og + 1u == (k + 1u) * nx) xb_add(&bar[XB_TOPGEN], 1u);
            else XB_SPIN(xb_ld(&bar[XB_TOPGEN]) == k, bar);
        } else {
            XB_SPIN(xb_ld(&bar[XB_TOPGEN]) == k, bar);
        }
        __builtin_amdgcn_fence(__ATOMIC_ACQUIRE, "agent");
        asm volatile("s_waitcnt vmcnt(0)" ::: "memory");
    }
    __syncthreads();
}
__global__ void __launch_bounds__(NTHR, 2) hybrid_fwd(Args a) {
    extern __shared__ __attribute__((aligned(16))) unsigned char lds_raw[];
    LAS unsigned char* lds = (LAS unsigned char*)lds_raw;
    cg::grid_group grid = cg::this_grid();
#ifdef EXP_INVL2
    if (threadIdx.x == 0) asm volatile("buffer_inv sc0 sc1\n\ts_waitcnt vmcnt(0)" ::: "memory");
    __syncthreads();
#endif
    volatile LAS unsigned* xb_st = (volatile LAS unsigned*)(lds + 131072 + 1024);
    if (threadIdx.x < 3) xb_st[threadIdx.x] = 0u;
    __syncthreads();
    if (blockIdx.x == 0) for (int i = threadIdx.x; i < 4096; i += NTHR) __hip_atomic_store((unsigned*)a.ws + i, 0u, __ATOMIC_RELAXED, __HIP_MEMORY_SCOPE_AGENT);
    XcdBarrier xbar; xbar.bar = (unsigned*)a.ws; xbar.x = 0; xbar.st = xb_st;
    const int tid0 = threadIdx.x, wave = __builtin_amdgcn_readfirstlane(tid0 >> 6);
    const int G = gridDim.x, bx = blockIdx.x;
    const int gw = bx * NWAVES + wave, NGW = G * NWAVES;
    unsigned char* ws = a.ws;
    bf16* const Win = (bf16*)(ws + WS_WIN); bf16* const Wglu = (bf16*)(ws + WS_WGLU); bf16* const Wbs = (bf16*)(ws + WS_WBS); bf16* const Wba = (bf16*)(ws + WS_WBA); bf16* const Wout = (bf16*)(ws + WS_WOUT);
    bf16* const Hb = (bf16*)(ws + WS_H); bf16* const Ub = (bf16*)(ws + WS_U); bf16* const ZSb = (bf16*)(ws + WS_ZS); bf16* const Qb = (bf16*)(ws + WS_Q); bf16* const Kb = (bf16*)(ws + WS_K);
    bf16* const VTb = (bf16*)(ws + WS_VT); bf16* const ZAb = (bf16*)(ws + WS_ZA); bf16* const GSb = (bf16*)(ws + WS_GS); bf16* const GAb = (bf16*)(ws + WS_GA);


    unsigned long long tqa = 0ull;
#ifdef PROBE_SEL
    unsigned long long tacc = 0ull, tbeg = 0ull;
#define PW(sel) do { if (PROBE_SEL == (sel) + 10) tacc += __builtin_amdgcn_s_memrealtime() - tbeg; if (PROBE_SEL == (sel) + 20) tbeg = __builtin_amdgcn_s_memrealtime(); } while (0)
#define PS(sel) do { if (PROBE_SEL == (sel)) tbeg = __builtin_amdgcn_s_memrealtime(); } while (0)
#define PT(sel) do { if (PROBE_SEL == (sel)) tacc += __builtin_amdgcn_s_memrealtime() - tbeg; } while (0)
#define PB(sel) do { if (PROBE_SEL == (sel) || PROBE_SEL == (sel) + 10) tbeg = __builtin_amdgcn_s_memrealtime(); } while (0)
#define PE(sel) do { if (PROBE_SEL == (sel) || PROBE_SEL == (sel) + 20) tacc += __builtin_amdgcn_s_memrealtime() - tbeg; } while (0)
#else
#define PB(sel) do {} while (0)
#define PW(sel) do {} while (0)
#define PS(sel) do {} while (0)
#define PT(sel) do {} while (0)
#define PE(sel) do {} while (0)
#endif
#define GSYNC() xcd_barrier1(xbar)
    PB(0);
    for (int l = 0; l <= DEPTH; ++l) {
        const int lt = l < DEPTH ? l : 0;
        bf16* const KTAB = (bf16*)(ws + WS_KTAB + lt * KTAB_LSTRIDE); bf16* const WTAB = (bf16*)(ws + WS_WTAB + lt * WTAB_LSTRIDE); bf16* const VTAB = (bf16*)(ws + WS_VTAB + lt * VTAB_LSTRIDE);
        float* const Sb = (float*)(ws + WS_S + lt * S_LSTRIDE); float* const LAM = (float*)(ws + WS_LAM + lt * LAM_LSTRIDE);
        int tid = tid0; asm volatile("" : "+v"(tid)); const int lane = tid & 63;
        PB(1);
        {
            const float* xin = (l <= 1) ? a.x : a.out;
        PS(43);
            { f32x4 gpo[4], gpr[4];
#pragma unroll
              for (int j = 0; j < 4; ++j) { gpo[j] = l > 0 ? *((const f32x4*)(a.post_g + (l - 1) * DM) + lane + 64 * j) : (f32x4){0.f, 0.f, 0.f, 0.f};
                                            gpr[j] = l < DEPTH ? *((const f32x4*)(a.pre_g + l * DM) + lane + 64 * j) : (f32x4){0.f, 0.f, 0.f, 0.f}; }
              for (int m = gw; m < M; m += NGW)
                  norm_row(xin + (size_t)m * DM, l > 0 ? GAb + (size_t)m * DM : nullptr, gpo, a.out + (size_t)m * DM, l < DEPTH, gpr, Hb + (size_t)m * DM, lane); }
        PT(43);
            if (l == DEPTH) { PE(1); break; }
            LAS float* scr = (LAS float*)(lds + wave * 16384);
            const float* w_in = a.w_in + (size_t)l * DM * NCOL; const float* w_glu = a.w_glu + (size_t)l * 512 * 1024; const float* w_bs = a.w_bs + (size_t)l * 512 * 1024;
            const float* w_ba = a.w_ba + (size_t)l * 512 * 1024; const float* w_out = a.w_out + (size_t)l * 1024 * 1024;
            constexpr int I_IN = 16 * 160, I_GLU = 8 * 32, I_BR = 8 * 32, I_OUT = 16 * 32, NITEMS = I_IN + I_GLU + 2 * I_BR + I_OUT;
        PS(44);
            for (int it = gw; it < NITEMS; it += NGW) {
                int r = it;
                if (r < I_IN) { const int kb = r / 160, nb = r % 160; transpose_item(w_in, 1024, NCOL, Win, 64 * kb, 32 * nb, 32 * nb, scr, lane); continue; } r -= I_IN;
                if (r < I_GLU) { const int kb = r / 32, nb = r % 32, n0 = 32 * nb; const int bj = n0 >> 9, rem = n0 & 511, pn = rem >> 7, i0 = rem & 127;
                    transpose_item(w_glu, 512, 1024, Wglu, 64 * kb, n0, 256 * pn + 128 * bj + i0, scr, lane); continue; } r -= I_GLU;
                if (r < I_BR) { const int kb = r / 32, nb = r % 32; transpose_item(w_bs, 512, 1024, Wbs, 64 * kb, 32 * nb, 32 * nb, scr, lane); continue; } r -= I_BR;
                if (r < I_BR) { const int kb = r / 32, nb = r % 32; transpose_item(w_ba, 512, 1024, Wba, 64 * kb, 32 * nb, 32 * nb, scr, lane); continue; } r -= I_BR;
                { const int kb = r / 32, nb = r % 32; transpose_item(w_out, 1024, 1024, Wout, 64 * kb, 32 * nb, 32 * nb, scr, lane); }
            }
            __syncthreads();
            PT(44);
            LayerP P{a.a_re + l * NG * NP, a.a_im + l * NG * NP, a.log_dt + l * NG, a.b_re + (size_t)l * NG * NP * 16, a.b_im + (size_t)l * NG * NP * 16, a.c_re + (size_t)l * NG * 16 * NP, a.c_im + (size_t)l * NG * 16 * NP};
        PS(45);
#ifndef NO_TAB
            for (int it = bx; it < NG * 8; it += G) ktab_block(P, KTAB, it >> 3, it & 7, lds, tid);
            for (int idx = bx * NTHR + tid; idx < NG * NP * 16; idx += G * NTHR) wv_item(P, WTAB, VTAB, LAM, idx);
#endif
        PT(45);
        }
        PW(1);
        if (l == 0) { grid.sync(); xbar = xcd_barrier_post((unsigned*)a.ws, xb_st); } else GSYNC();
        PE(1);
        PB(2);
#ifndef NO_A
        { pg8::Gemm g{Hb, Win, M, NCOL, DM}; pg8::StaticOrder S; S.init(M, NCOL, G, bx); EpiProj E{ws};
          pg8::gemm_phase<EpiProj, pg8::StaticOrder, true, true>(lds, g, S, E); }
#endif
        PW(2);
        GSYNC();
        PE(2);
        PB(3);
        PS(41);
#ifndef NO_B1
        for (int u0 = 2 * bx; u0 < 512; u0 += 2 * G) { const int g = u0 >> 4;
            LayerP P{a.a_re + l * NG * NP, a.a_im + l * NG * NP, a.log_dt + l * NG, a.b_re + (size_t)l * NG * NP * 16, a.b_im + (size_t)l * NG * NP * 16, a.c_re + (size_t)l * NG * 16 * NP, a.c_im + (size_t)l * NG * 16 * NP};
            bf16x8 af[8]; f32x2 l16a, l16b;
            make_wfrag(P, g, wave, lane, af, l16a, l16b);
            for (int q = 0; q < 2; ++q) { const int nb = (u0 + q) & 15; ssm_state_unit(Ub, af, l16a, l16b, Sb, nb >> 3, g, nb & 7, wave, lane); } }
#endif
        PT(41);
        PS(42);
#ifndef NO_ATTN
        for (int t = gw; t < 4096; t += NGW) attn_task(Qb, Kb, VTb, ZAb, Qb, t >> 11, (t >> 8) & 7, t & 255, lane);
#endif
        PT(42);
        PW(3);
        GSYNC();
        PE(3);
        PB(4);
#ifndef NO_B3
        for (int u = 2 * bx; u < 512; u += (u & 1) ? 2 * G - 1 : 1) { const int g = u >> 4, nb = u & 15; ssm_out_unit(tqa, (u & 1) == 0, Ub, KTAB, VTAB, Sb, LAM, a.d_skip + l * 512, Hb, nb >> 3, g, nb & 7, lds, tid, wave, lane); }
#endif
        PW(4);
        GSYNC();
        PE(4);
        PB(5);
#ifndef NO_D1
        { pg8::Gemm g{Hb, Wglu, M, 1024, 512}; pg8::StaticOrder S; S.init(M, 1024, G, bx); EpiGlu E{ZSb, a.b_glu + l * 1024};
          pg8::gemm_phase<EpiGlu, pg8::StaticOrder, true, true>(lds, g, S, E); }
#endif
        PW(5);
        GSYNC();
        PE(5);
#ifndef NO_D2
        PB(6);
        { pg8::Gemm g{ZSb, Wbs, M, 1024, 512, Qb, Wba}; pg8::ChainOrder S; S.B.init(M, 1024, G, bx); EpiBranchBoth E{GSb, GAb};
          pg8::gemm_phase<EpiBranchBoth, pg8::ChainOrder, true, true>(lds, g, S, E); }
#endif
        PW(6);
        GSYNC();
        PE(6);
#ifndef NO_D3
        PB(7);
        { pg8::Gemm g{GSb, Wout, M, 1024, 1024}; pg8::StaticOrder S; S.init(M, 1024, G, bx); EpiPlain E{GAb};
          pg8::gemm_phase<EpiPlain, pg8::StaticOrder, true, true>(lds, g, S, E); }
#endif
        PW(7);
        GSYNC();
        PE(7);
    }
    PE(0);
#ifdef PROBE_SEL
    grid.sync();
    if (bx == 0) { LAS unsigned long long* tb = (LAS unsigned long long*)lds; if (tid0 == 0) tb[0] = tacc + tqa; __syncthreads(); const unsigned long long K = tb[0] < 1000000ull ? tb[0] : 1000000ull;
        for (unsigned long long i = tid0; i < K; i += NTHR) a.out[i] += 0.05f; }
#endif
}

extern "C" void kernel_launch(void* const* d_in, const int* in_sizes, int n_in, void* d_out, int out_size, void* d_ws, size_t ws_size, hipStream_t stream) {
    static int grid = 0;
    if (grid == 0) {
        if (n_in != 17 || out_size != M * DM || ws_size < WS_END) { fprintf(stderr, "kernel_launch: unexpected problem shape (n_in %d, out %d, ws %zu)\n", n_in, out_size, ws_size); grid = -1; return; }
        int dev = 0, cus = 0, per_cu = 0;
        (void)hipGetDevice(&dev); (void)hipDeviceGetAttribute(&cus, hipDeviceAttributeMultiprocessorCount, dev);
        if (hipFuncSetAttribute((const void*)hybrid_fwd, hipFuncAttributeMaxDynamicSharedMemorySize, LDS_BYTES) != hipSuccess) { fprintf(stderr, "kernel_launch: hipFuncSetAttribute failed\n"); grid = -1; return; }
        if (hipOccupancyMaxActiveBlocksPerMultiprocessor(&per_cu, (const void*)hybrid_fwd, NTHR, LDS_BYTES) != hipSuccess || per_cu < 1) { fprintf(stderr, "kernel_launch: occupancy query gave %d\n", per_cu); per_cu = 1; }
        (void)hipGetLastError();
        grid = cus * per_cu;
    }
    if (grid < 0) return;
    Args a{};
    a.x = (const float*)d_in[0]; a.pre_g = (const float*)d_in[1]; a.post_g = (const float*)d_in[2]; a.w_in = (const float*)d_in[3]; a.a_re = (const float*)d_in[4]; a.a_im = (const float*)d_in[5];
    a.log_dt = (const float*)d_in[6]; a.b_re = (const float*)d_in[7]; a.b_im = (const float*)d_in[8]; a.c_re = (const float*)d_in[9]; a.c_im = (const float*)d_in[10]; a.d_skip = (const float*)d_in[11];
    a.w_glu = (const float*)d_in[12]; a.b_glu = (const float*)d_in[13]; a.w_bs = (const float*)d_in[14]; a.w_ba = (const float*)d_in[15]; a.w_out = (const float*)d_in[16];
    a.out = (float*)d_out; a.ws = (unsigned char*)d_ws;
    void* args[] = {&a};
    const hipError_t e = hipLaunchCooperativeKernel((const void*)hybrid_fwd, dim3(grid), dim3(NTHR), args, LDS_BYTES, stream);
    if (e != hipSuccess) fprintf(stderr, "kernel_launch: cooperative launch failed: %s (grid %d)\n", hipGetErrorString(e), grid);
}
```

```cpp
#include <hip/hip_runtime.h>
#include <hip/hip_cooperative_groups.h>
#include <cstdio>
#include <cstdint>
namespace cg = cooperative_groups;
namespace pg8 {
#define PG8_LAS __attribute__((address_space(3)))
typedef unsigned short bf16_t;
typedef short bf16x8 __attribute__((ext_vector_type(8)));
typedef float f32x4 __attribute__((ext_vector_type(4)));
typedef unsigned u32x4 __attribute__((ext_vector_type(4)));
constexpr int BM = 256, BK = 64, HALF = 128, HTB = HALF * BK * 2  , STAGE_BYTES = 8 * HTB, NXCD = 8, WGM = 8;

__host__ __device__ __forceinline__ int lds_byte(int r, int c) { const int st = (r >> 4) * 2 + (c >> 5), rr = r & 15, cc = c & 31, ob = rr * 64 + cc * 2; return st * 1024 + (ob ^ (((ob >> 9) & 1) << 5)); }
__host__ __device__ __forceinline__ void stage_rc(int b, int& R, int& C) { const int st = b / 1024, sb = b % 1024, swz = sb ^ (((sb >> 9) & 1) << 5); R = (st >> 1) * 16 + swz / 64; C = (st & 1) * 32 + (swz % 64) / 2; }
__host__ __device__ __forceinline__ int perm32(int rho) { const int n = rho >> 4, i = rho & 15; return 8 * (i >> 2) + 4 * n + (i & 3); }

struct Unit { int pm, pn, sel; };
struct Gemm { const bf16_t* A; const bf16_t* Bt; int M, N, K; const bf16_t* A2; const bf16_t* Bt2; };

struct StaticOrder {
    int nM, nN, nwg, G, c;
    __host__ __device__ void init(int M, int N, int G_, int c_) { nM = M / BM; nN = N / BM; nwg = nM * nN; G = G_; c = c_; }
    __host__ __device__ bool next(int i, Unit& u) const {
        const long L = (long)i * G + c; if (L >= nwg) return false;
        int wgid = (int)L; { const int q = nwg / NXCD, r = nwg % NXCD, xcd = wgid % NXCD, off = wgid / NXCD; wgid = (xcd < r ? xcd * (q + 1) : r * (q + 1) + (xcd - r) * q) + off; }
        const int nig = WGM * nN, gid = wgid / nig, fm = gid * WGM, gsz = (nM - fm) < WGM ? (nM - fm) : WGM;
        u.pm = fm + ((wgid % nig) % gsz); u.pn = (wgid % nig) / gsz; u.sel = 0; return true;
    }
    __device__ __forceinline__ void a_ready(const Unit&) const {}
    __device__ __forceinline__ void done(const Unit&) const {}
};
__device__ __forceinline__ unsigned cvt_pk_bf16(float lo, float hi) { unsigned r; asm volatile("v_cvt_pk_bf16_f32 %0, %1, %2" : "=v"(r) : "v"(lo), "v"(hi)); return r; }
typedef float f32x2 __attribute__((ext_vector_type(2)));
struct ChainOrder { StaticOrder B;
    __host__ __device__ bool next(int i, Unit& u) const { if (!B.next(i >> 1, u)) return false; u.sel = i & 1; return true; }
    __device__ __forceinline__ void a_ready(const Unit&) const {}
    __device__ __forceinline__ void done(const Unit&) const {}
};

template <class Epi, class Sched, bool ALIGN_EPI = false, bool SP2 = false>
__device__ __forceinline__ void gemm_phase(PG8_LAS unsigned char* lds, const Gemm g, const Sched& S, const Epi& E) {
    int tid_ = threadIdx.x; asm volatile("" : "+v"(tid_));
    const int tid = tid_, wid = __builtin_amdgcn_readfirstlane(tid >> 6), lane = tid & 63, wr = wid >> 2, wc = wid & 3, fr = lane & 15, fq = lane >> 4;
    const int K = g.K, nt = K / BK;
    unsigned voffA[2], voffB[2];
#pragma unroll
    for (int i = 0; i < 2; ++i) { int R, C; stage_rc(tid * 16 + i * 8192, R, C); const int Rb = Epi::PERM ? ((R & ~31) + perm32(R & 31)) : R;
        voffA[i] = (unsigned)(R * K + C) * 2u; voffB[i] = (unsigned)(Rb * K + C) * 2u; }
    const size_t kstep = (size_t)(BK * 2);
    const size_t hstep = (size_t)HALF * K * 2;
    const size_t tstep = 2 * hstep;
    const unsigned ldsw = (unsigned)wid * 1024u;
    const int aoff = lds_byte(wr * 64 + fr, fq * 8), boff = lds_byte(wc * 32 + fr, fq * 8);
#define PG8_SA(b, h) (((b) * 2 + (h)) * HTB)
#define PG8_SB(b, h) ((4 + (b) * 2 + (h)) * HTB)
#define PG8_STAGE(bufoff, gbase, voff) do { _Pragma("unroll") for (int _i = 0; _i < 2; ++_i) \
        __builtin_amdgcn_global_load_lds((const unsigned*)((const char*)(gbase) + (voff)[_i]), (PG8_LAS unsigned*)(lds + (bufoff) + ldsw + _i * 8192), 16, 0, 0); } while (0)
#define PG8_LDA(dst, b, h) do { _Pragma("unroll") for (int m = 0; m < 4; ++m) _Pragma("unroll") for (int k = 0; k < 2; ++k) dst[m][k] = *(const PG8_LAS bf16x8*)(lds + PG8_SA(b, h) + aoff + m * 2048 + k * 1024); } while (0)
#define PG8_LDB(dst, b, h) do { _Pragma("unroll") for (int n = 0; n < 2; ++n) _Pragma("unroll") for (int k = 0; k < 2; ++k) dst[n][k] = *(const PG8_LAS bf16x8*)(lds + PG8_SB(b, h) + boff + n * 2048 + k * 1024); } while (0)
#define PG8_MMA(ai, bj, At, Bt) do { __builtin_amdgcn_s_setprio(1); _Pragma("unroll") for (int m = 0; m < 4; ++m) _Pragma("unroll") for (int n = 0; n < 2; ++n) _Pragma("unroll") for (int k = 0; k < 2; ++k) \
        acc[ai][bj][m][n] = __builtin_amdgcn_mfma_f32_16x16x32_bf16(Bt[n][k], At[m][k], acc[ai][bj][m][n], 0, 0, 0); __builtin_amdgcn_s_setprio(0); } while (0)
#define PG8_WAIT_V(n) asm volatile("s_waitcnt vmcnt(" #n ")" ::: "memory")
#define PG8_WAIT_L(n) asm volatile("s_waitcnt lgkmcnt(" #n ")" ::: "memory")
#define PG8_BAR __builtin_amdgcn_s_barrier()
#define PG8_SCHED __builtin_amdgcn_sched_barrier(0)
    Unit cur, nxt; int ui = 0;
    if (!S.next(0, cur)) return;
    f32x4 acc[2][2][4][2];
#pragma unroll
    for (int a = 0; a < 2; ++a)
#pragma unroll
        for (int b = 0; b < 2; ++b)
#pragma unroll
            for (int m = 0; m < 4; ++m)
#pragma unroll
                for (int n = 0; n < 2; ++n) acc[a][b][m][n] = (f32x4){0.f, 0.f, 0.f, 0.f};
    bf16x8 At[4][2], B0[2][2], B1[2][2];
    const char* cA = (const char*)(cur.sel ? g.A2 : g.A) + (size_t)cur.pm * tstep; const char* cB = (const char*)(cur.sel ? g.Bt2 : g.Bt) + (size_t)cur.pn * tstep;
    S.a_ready(cur);
    if constexpr (SP2) {
        PG8_STAGE(PG8_SB(0, 0), cB, voffB); PG8_STAGE(PG8_SB(0, 1), cB + hstep, voffB); PG8_STAGE(PG8_SA(0, 0), cA, voffA); PG8_STAGE(PG8_SA(0, 1), cA + hstep, voffA);
        if (wr == 1) PG8_BAR;
        PG8_WAIT_V(2); PG8_BAR;
        PG8_STAGE(PG8_SB(1, 0), cB + kstep, voffB); PG8_STAGE(PG8_SA(1, 0), cA + kstep, voffA); PG8_STAGE(PG8_SB(1, 1), cB + hstep + kstep, voffB);
        PG8_WAIT_V(6); PG8_BAR;
    } else {
        PG8_STAGE(PG8_SB(0, 0), cB, voffB); PG8_STAGE(PG8_SA(0, 0), cA, voffA); PG8_STAGE(PG8_SB(0, 1), cB + hstep, voffB); PG8_STAGE(PG8_SA(0, 1), cA + hstep, voffA);
        if (wr == 1) PG8_BAR;
        PG8_WAIT_V(4); PG8_BAR;
        PG8_STAGE(PG8_SB(1, 0), cB + kstep, voffB); PG8_STAGE(PG8_SA(1, 0), cA + kstep, voffA); PG8_STAGE(PG8_SB(1, 1), cB + hstep + kstep, voffB);
        PG8_WAIT_V(6); PG8_BAR;
    }
    for (;;) {
        const bool has_next = S.next(ui + 1, nxt);
        const char* nA = has_next ? (const char*)(nxt.sel ? g.A2 : g.A) + (size_t)nxt.pm * tstep : cA; const char* nB = has_next ? (const char*)(nxt.sel ? g.Bt2 : g.Bt) + (size_t)nxt.pn * tstep : cB;
        for (int t = 0; t < nt; t += 2) {
            const bool last = (t == nt - 2);
            const char* a1 = cA + (size_t)(t + 1) * kstep;
            const char* a2 = last ? nA : cA + (size_t)(t + 2) * kstep; const char* b2 = last ? nB : cB + (size_t)(t + 2) * kstep;
            const char* a3 = a2 + kstep; const char* b3 = b2 + kstep;
            if (last && has_next) S.a_ready(nxt);
            if constexpr (SP2) {
            PG8_LDB(B0, 0, 0); PG8_LDB(B1, 0, 1); PG8_SCHED; PG8_LDA(At, 0, 0); PG8_STAGE(PG8_SA(1, 1), a1 + hstep, voffA);
            PG8_WAIT_V(8); PG8_WAIT_L(0); PG8_BAR; PG8_MMA(0, 0, At, B0); PG8_MMA(0, 1, At, B1); PG8_BAR; PG8_SCHED;
            PG8_LDA(At, 0, 1); PG8_STAGE(PG8_SB(0, 0), b2, voffB); PG8_STAGE(PG8_SB(0, 1), b2 + hstep, voffB); PG8_STAGE(PG8_SA(0, 0), a2, voffA);
            PG8_WAIT_V(8); PG8_WAIT_L(0); PG8_BAR; PG8_MMA(1, 0, At, B0); PG8_MMA(1, 1, At, B1); PG8_BAR; PG8_SCHED;
            PG8_LDB(B0, 1, 0); PG8_LDB(B1, 1, 1); PG8_SCHED; PG8_LDA(At, 1, 0); PG8_STAGE(PG8_SA(0, 1), a2 + hstep, voffA);
            PG8_WAIT_V(8); PG8_WAIT_L(0); PG8_BAR; PG8_MMA(0, 0, At, B0); PG8_MMA(0, 1, At, B1); PG8_BAR; PG8_SCHED;
            PG8_LDA(At, 1, 1); PG8_STAGE(PG8_SB(1, 0), b3, voffB); PG8_STAGE(PG8_SB(1, 1), b3 + hstep, voffB); PG8_STAGE(PG8_SA(1, 0), a3, voffA);
            PG8_WAIT_V(8); PG8_WAIT_L(0); PG8_BAR; PG8_MMA(1, 0, At, B0); PG8_MMA(1, 1, At, B1); PG8_BAR; PG8_SCHED;
            } else {
            PG8_LDB(B0, 0, 0); PG8_SCHED; PG8_LDA(At, 0, 0); PG8_STAGE(PG8_SA(1, 1), a1 + hstep, voffA);
            PG8_WAIT_L(8); PG8_BAR; PG8_WAIT_L(0); PG8_MMA(0, 0, At, B0); PG8_BAR; PG8_SCHED;
            PG8_LDB(B1, 0, 1); PG8_STAGE(PG8_SB(0, 0), b2, voffB);
            PG8_BAR; PG8_WAIT_L(0); PG8_MMA(0, 1, At, B1); PG8_BAR;
            PG8_LDA(At, 0, 1); PG8_STAGE(PG8_SA(0, 0), a2, voffA);
            PG8_BAR; PG8_WAIT_L(0); PG8_MMA(1, 0, At, B0); PG8_BAR; PG8_SCHED;
            PG8_STAGE(PG8_SB(0, 1), b2 + hstep, voffB);
            PG8_WAIT_V(6); PG8_BAR; PG8_MMA(1, 1, At, B1); PG8_BAR;
            PG8_LDB(B0, 1, 0); PG8_SCHED; PG8_LDA(At, 1, 0); PG8_STAGE(PG8_SA(0, 1), a2 + hstep, voffA);
            PG8_WAIT_L(8); PG8_BAR; PG8_WAIT_L(0); PG8_MMA(0, 0, At, B0); PG8_BAR; PG8_SCHED;
            PG8_LDB(B1, 1, 1); PG8_STAGE(PG8_SB(1, 0), b3, voffB);
            PG8_BAR; PG8_WAIT_L(0); PG8_MMA(0, 1, At, B1); PG8_BAR;
            PG8_LDA(At, 1, 1); PG8_STAGE(PG8_SA(1, 0), a3, voffA);
            PG8_BAR; PG8_WAIT_L(0); PG8_MMA(1, 0, At, B0); PG8_BAR; PG8_SCHED;
            PG8_STAGE(PG8_SB(1, 1), b3 + hstep, voffB);
            PG8_WAIT_V(6); PG8_BAR; PG8_MMA(1, 1, At, B1); PG8_BAR;
            }
        }
        if constexpr (ALIGN_EPI) { if (wr == 0) PG8_BAR; }
        if constexpr (!Epi::AFTER_DRAIN) { E(acc, cur, wr, wc, fr, fq); S.done(cur); }
        if (!has_next) break;
#pragma unroll
        for (int a = 0; a < 2; ++a)
#pragma unroll
            for (int b = 0; b < 2; ++b)
#pragma unroll
                for (int m = 0; m < 4; ++m)
#pragma unroll
                    for (int n = 0; n < 2; ++n) acc[a][b][m][n] = (f32x4){0.f, 0.f, 0.f, 0.f};
        cur = nxt; cA = nA; cB = nB; ++ui;
        if constexpr (ALIGN_EPI) { if (wr == 1) PG8_BAR; }
    }
    PG8_WAIT_V(0);
    if constexpr (!ALIGN_EPI) { if (wr == 0) PG8_BAR; }
    PG8_BAR;
    if constexpr (Epi::AFTER_DRAIN) { E.fused(acc, cur, wr, wc, fr, fq, lds, wid, lane); S.done(cur); }
#undef PG8_SA
#undef PG8_SB
#undef PG8_STAGE
#undef PG8_LDA
#undef PG8_LDB
#undef PG8_MMA
#undef PG8_WAIT_V
#undef PG8_WAIT_L
#undef PG8_BAR
#undef PG8_SCHED
}
}
#define DI __device__ __forceinline__
#define LAS __attribute__((address_space(3)))
typedef unsigned short bf16;
typedef float f32x4 __attribute__((ext_vector_type(4)));
typedef float f32x2 __attribute__((ext_vector_type(2)));
typedef float f32x16 __attribute__((ext_vector_type(16)));
typedef short bf16x8 __attribute__((ext_vector_type(8)));
typedef unsigned u32x4 __attribute__((ext_vector_type(4)));
typedef unsigned u32x2 __attribute__((ext_vector_type(2)));
typedef __bf16 bf16x2_t __attribute__((ext_vector_type(2)));

constexpr int NWAVES = 8, NTHR = 512;
constexpr int BATCH = 2, SEQ = 8192, DM = 1024, DEPTH = 4, M = BATCH * SEQ, NCOL = 5120;
constexpr int NG = 32, NP = 64, NCH = SEQ / 64;
constexpr float EPS = 1e-6f;
constexpr size_t MiB = 1u << 20;
constexpr size_t WS_WIN = 32 * MiB, WS_WGLU = 42 * MiB, WS_WBS = 43 * MiB, WS_WBA = 44 * MiB, WS_WOUT = 45 * MiB;
constexpr size_t WS_H = 48 * MiB;
constexpr size_t WS_U = 80 * MiB, WS_ZS = 96 * MiB, WS_Q = 112 * MiB, WS_K = 128 * MiB, WS_VT = 144 * MiB, WS_ZA = 160 * MiB;
constexpr size_t WS_GS = 176 * MiB, WS_GA = 208 * MiB;
constexpr size_t WS_KTAB = 1 * MiB, KTAB_LSTRIDE = 1280 * 1024;
constexpr size_t WS_WTAB = 6 * MiB, WTAB_LSTRIDE = 2 * MiB;
constexpr size_t WS_VTAB = 6 * MiB, VTAB_LSTRIDE = 2 * MiB;
constexpr size_t WS_S = 14 * MiB, S_LSTRIDE = 4 * MiB;
constexpr size_t WS_LAM = 30 * MiB, LAM_LSTRIDE = 64 * 1024;
constexpr size_t WS_END = 240 * MiB;
constexpr int KTAB_BYTES = 65 * 512;
constexpr int LDS_BYTES = 147456;
constexpr float QSCALE = 0.125f * 1.4426950408889634f;

struct Args {
    const float* x; const float* pre_g; const float* post_g; const float* w_in; const float* a_re; const float* a_im; const float* log_dt;
    const float* b_re; const float* b_im; const float* c_re; const float* c_im; const float* d_skip; const float* w_glu; const float* b_glu;
    const float* w_bs; const float* w_ba; const float* w_out; float* out; unsigned char* ws;
};

DI unsigned cvtpk(float lo, float hi) { f32x2 v = {lo, hi}; bf16x2_t b = __builtin_convertvector(v, bf16x2_t); return __builtin_bit_cast(unsigned, b); }
DI float bflo(unsigned w) { return __uint_as_float(w << 16); }
DI float bfhi(unsigned w) { return __uint_as_float(w & 0xffff0000u); }
DI float bf1(bf16 b) { return __uint_as_float((unsigned)b << 16); }
DI float sigm(float x) { return __builtin_amdgcn_rcpf(1.0f + __expf(-x)); }
DI float silu(float x) { return x * sigm(x); }
DI float gelu_tanh(float x) { const float u = 1.5957691216057308f * (x + 0.044715f * x * x * x); return x * sigm(u); }
template <int CTRL> DI float dpp_step(float v) { return v + __builtin_bit_cast(float, __builtin_amdgcn_update_dpp(0, __builtin_bit_cast(int, v), CTRL, 0xf, 0xf, true)); }
DI float wave_sum(float v) {
    v = dpp_step<0xB1>(v); v = dpp_step<0x4E>(v); v = dpp_step<0x141>(v); v = dpp_step<0x140>(v);
    return ((__builtin_bit_cast(float, __builtin_amdgcn_readlane(__builtin_bit_cast(int, v), 0)) + __builtin_bit_cast(float, __builtin_amdgcn_readlane(__builtin_bit_cast(int, v), 16))) +
            (__builtin_bit_cast(float, __builtin_amdgcn_readlane(__builtin_bit_cast(int, v), 32)) + __builtin_bit_cast(float, __builtin_amdgcn_readlane(__builtin_bit_cast(int, v), 48))));
}

struct EpiProj {
    static constexpr bool PERM = true, AFTER_DRAIN = false;
    unsigned char* ws;
    DI void operator()(const pg8::f32x4 (&acc)[2][2][4][2], const pg8::Unit& u, int wr, int wc, int fr, int fq) const {
        const int pn = u.pn;
        bf16* base; int ld, colt; float sc = 1.f;
        if (pn < 12) { base = (bf16*)(ws + WS_U + (size_t)(pn >> 1) * (16 * MiB)); ld = 512; colt = (pn & 1) * 256; if ((pn >> 1) == 2) sc = QSCALE; }
        else if (pn < 16) { base = (bf16*)(ws + WS_GS); ld = 1024; colt = (pn - 12) * 256; }
        else { base = (bf16*)(ws + WS_GA); ld = 1024; colt = (pn - 16) * 256; }
        const int row0 = u.pm * 256 + wr * 64 + fr, col0 = colt + wc * 32 + 8 * fq;
        if ((pn >> 1) == 4) {
            bf16* vt = (bf16*)(ws + WS_VT);
#pragma unroll
            for (int ai = 0; ai < 2; ++ai)
#pragma unroll
                for (int m = 0; m < 4; ++m) { const int r = row0 + ai * 128 + m * 16; const int bb = r >> 13, t = r & 8191;
#pragma unroll
                    for (int bj = 0; bj < 2; ++bj) { bf16* p = vt + ((size_t)(bb * 512 + col0 + bj * 128)) * 8192 + t;
#pragma unroll
                        for (int n = 0; n < 2; ++n)
#pragma unroll
                            for (int e = 0; e < 4; ++e) { *p = (bf16)(cvtpk(acc[ai][bj][m][n][e], 0.f) & 0xffffu); p += 8192; asm volatile("" : "+v"(p)); } }
                    __builtin_amdgcn_sched_barrier(0); }
            return;
        }
#pragma unroll
        for (int ai = 0; ai < 2; ++ai)
#pragma unroll
            for (int m = 0; m < 4; ++m) { bf16* rowp = base + (size_t)(row0 + ai * 128 + m * 16) * ld + col0;
#pragma unroll
                for (int bj = 0; bj < 2; ++bj) { const pg8::f32x4 v0 = acc[ai][bj][m][0] * sc, v1 = acc[ai][bj][m][1] * sc;
                    u32x4 w; w.x = cvtpk(v0[0], v0[1]); w.y = cvtpk(v0[2], v0[3]); w.z = cvtpk(v1[0], v1[1]); w.w = cvtpk(v1[2], v1[3]);
                    *(u32x4*)(rowp + bj * 128) = w; } }
    }
};
struct EpiGlu {
    static constexpr bool PERM = true, AFTER_DRAIN = false;
    bf16* zs; const float* bias;
    DI void operator()(const pg8::f32x4 (&acc)[2][2][4][2], const pg8::Unit& u, int wr, int wc, int fr, int fq) const {
        const int row0 = u.pm * 256 + wr * 64 + fr, col0 = u.pn * 128 + wc * 32 + 8 * fq;
        f32x4 ba0 = *(const f32x4*)(bias + col0), ba1 = *(const f32x4*)(bias + col0 + 4), bb0 = *(const f32x4*)(bias + 512 + col0), bb1 = *(const f32x4*)(bias + 512 + col0 + 4);
        u32x4 zv[2][4];
#pragma unroll
        for (int ai = 0; ai < 2; ++ai)
#pragma unroll
            for (int m = 0; m < 4; ++m) zv[ai][m] = *(const u32x4*)(zs + (size_t)(row0 + ai * 128 + m * 16) * 512 + col0);
        __builtin_amdgcn_sched_barrier(0);
#pragma unroll
        for (int ai = 0; ai < 2; ++ai)
#pragma unroll
            for (int m = 0; m < 4; ++m) { bf16* p = zs + (size_t)(row0 + ai * 128 + m * 16) * 512 + col0;
                const u32x4 z = zv[ai][m]; float zf[8] = {bflo(z.x), bfhi(z.x), bflo(z.y), bfhi(z.y), bflo(z.z), bfhi(z.z), bflo(z.w), bfhi(z.w)}; float y[8];
#pragma unroll
                for (int e = 0; e < 4; ++e) {
                    y[e] = (acc[ai][0][m][0][e] + ba0[e]) * zf[e] * __builtin_amdgcn_rcpf((1.0f + __expf(-(acc[ai][1][m][0][e] + bb0[e]))) * (1.0f + __expf(-zf[e])));
                    y[4 + e] = (acc[ai][0][m][1][e] + ba1[e]) * zf[4 + e] * __builtin_amdgcn_rcpf((1.0f + __expf(-(acc[ai][1][m][1][e] + bb1[e]))) * (1.0f + __expf(-zf[4 + e]))); }
                u32x4 w; w.x = cvtpk(y[0], y[1]); w.y = cvtpk(y[2], y[3]); w.z = cvtpk(y[4], y[5]); w.w = cvtpk(y[6], y[7]); *(u32x4*)p = w; }
    }
};
template <int PASS> struct EpiBranch {
    static constexpr bool PERM = true, AFTER_DRAIN = false;
    bf16* G; const bf16* gate2;
    DI void operator()(const pg8::f32x4 (&acc)[2][2][4][2], const pg8::Unit& u, int wr, int wc, int fr, int fq) const {
        const int row0 = u.pm * 256 + wr * 64 + fr, col0 = u.pn * 256 + wc * 32 + 8 * fq;
#pragma unroll
        for (int ai = 0; ai < 2; ++ai)
#pragma unroll
          for (int mh = 0; mh < 2; ++mh) {
            u32x4 gv[2][2], hv[2][2];
#pragma unroll
            for (int mm = 0; mm < 2; ++mm)
#pragma unroll
                for (int bj = 0; bj < 2; ++bj) { const int m = 2 * mh + mm; const size_t off = (size_t)(row0 + ai * 128 + m * 16) * 1024 + col0 + bj * 128; gv[mm][bj] = *(const u32x4*)(G + off); if (PASS == 1) hv[mm][bj] = *(const u32x4*)(gate2 + off); }
            __builtin_amdgcn_sched_barrier(0);
#pragma unroll
            for (int mm = 0; mm < 2; ++mm)
#pragma unroll
                for (int bj = 0; bj < 2; ++bj) { const int m = 2 * mh + mm; const size_t off = (size_t)(row0 + ai * 128 + m * 16) * 1024 + col0 + bj * 128;
                    const u32x4 g = gv[mm][bj]; float gf[8] = {bflo(g.x), bfhi(g.x), bflo(g.y), bfhi(g.y), bflo(g.z), bfhi(g.z), bflo(g.w), bfhi(g.w)}; float y[8];
                    if (PASS == 0) {
#pragma unroll
                        for (int e = 0; e < 4; ++e) { y[e] = sigm(gf[e]) * acc[ai][bj][m][0][e]; y[4 + e] = sigm(gf[4 + e]) * acc[ai][bj][m][1][e]; }
                    } else {
                        const u32x4 h = hv[mm][bj]; float hf[8] = {bflo(h.x), bfhi(h.x), bflo(h.y), bfhi(h.y), bflo(h.z), bfhi(h.z), bflo(h.w), bfhi(h.w)};
#pragma unroll
                        for (int e = 0; e < 4; ++e) { y[e] = gf[e] + sigm(hf[e]) * acc[ai][bj][m][0][e]; y[4 + e] = gf[4 + e] + sigm(hf[4 + e]) * acc[ai][bj][m][1][e]; }
                    }
                    u32x4 w; w.x = cvtpk(y[0], y[1]); w.y = cvtpk(y[2], y[3]); w.z = cvtpk(y[4], y[5]); w.w = cvtpk(y[6], y[7]); *(u32x4*)(G + off) = w; }
            __builtin_amdgcn_sched_barrier(0);
          }
    }
};
struct EpiBranchBoth {
    static constexpr bool PERM = true, AFTER_DRAIN = false;
    bf16* G; const bf16* gate2;
    DI void operator()(const pg8::f32x4 (&acc)[2][2][4][2], const pg8::Unit& u, int wr, int wc, int fr, int fq) const {
        if (u.sel == 0) { EpiBranch<0> e{G, gate2}; e(acc, u, wr, wc, fr, fq); } else { EpiBranch<1> e{G, gate2}; e(acc, u, wr, wc, fr, fq); }
    }
};
struct EpiPlain {
    static constexpr bool PERM = true, AFTER_DRAIN = false;
    bf16* O;
    DI void operator()(const pg8::f32x4 (&acc)[2][2][4][2], const pg8::Unit& u, int wr, int wc, int fr, int fq) const {
        const int row0 = u.pm * 256 + wr * 64 + fr, col0 = u.pn * 256 + wc * 32 + 8 * fq;
#pragma unroll
        for (int ai = 0; ai < 2; ++ai)
#pragma unroll
            for (int m = 0; m < 4; ++m)
#pragma unroll
                for (int bj = 0; bj < 2; ++bj) { const pg8::f32x4 v0 = acc[ai][bj][m][0], v1 = acc[ai][bj][m][1];
                    u32x4 w; w.x = cvtpk(v0[0], v0[1]); w.y = cvtpk(v0[2], v0[3]); w.z = cvtpk(v1[0], v1[1]); w.w = cvtpk(v1[2], v1[3]);
                    *(u32x4*)(O + (size_t)(row0 + ai * 128 + m * 16) * 1024 + col0 + bj * 128) = w; }
    }
};

DI void norm_row(const float* xin, const bf16* o, const f32x4 (&gpo)[4], float* xout, bool has_pre, const f32x4 (&gpr)[4], bf16* h, int lane) {
    f32x4 v[4];
#pragma unroll
    for (int j = 0; j < 4; ++j) v[j] = *((const f32x4*)xin + lane + 64 * j);
    if (o) {
        f32x4 ov[4]; float ss = 0.f;
#pragma unroll
        for (int j = 0; j < 4; ++j) { const u32x2 w = *((const u32x2*)o + lane + 64 * j); ov[j] = (f32x4){bflo(w.x), bfhi(w.x), bflo(w.y), bfhi(w.y)};
            ss += (ov[j].x * ov[j].x + ov[j].y * ov[j].y) + (ov[j].z * ov[j].z + ov[j].w * ov[j].w); }
        const float rstd = __builtin_amdgcn_rsqf(wave_sum(ss) * (1.0f / DM) + EPS);
#pragma unroll
        for (int j = 0; j < 4; ++j) { v[j] = v[j] + ov[j] * rstd * gpo[j]; *((f32x4*)xout + lane + 64 * j) = v[j]; }
    }
    if (has_pre) {
        float ss = 0.f;
#pragma unroll
        for (int j = 0; j < 4; ++j) ss += (v[j].x * v[j].x + v[j].y * v[j].y) + (v[j].z * v[j].z + v[j].w * v[j].w);
        const float rstd = __builtin_amdgcn_rsqf(wave_sum(ss) * (1.0f / DM) + EPS);
#pragma unroll
        for (int j = 0; j < 4; ++j) { const f32x4 y = v[j] * rstd * gpr[j];
            u32x2 w; w.x = cvtpk(y.x, y.y); w.y = cvtpk(y.z, y.w); *((u32x2*)h + lane + 64 * j) = w; }
    }
}
DI void transpose_item(const float* W, int K, int N, bf16* WT, int k0, int n0, int dst_row0, LAS float* scr, int lane) {
#pragma unroll 8
    for (int i = 0; i < 32; ++i) { const int kk = 2 * i + (lane >> 5); scr[kk * 33 + (lane & 31)] = W[(size_t)(k0 + kk) * N + n0 + (lane & 31)]; }
    asm volatile("s_waitcnt lgkmcnt(0)" ::: "memory");
    const int c = lane & 7;
#pragma unroll
    for (int j = 0; j < 4; ++j) { const int n = (lane >> 3) + 8 * j; const LAS float* s = scr + (8 * c) * 33 + n;
        u32x4 o; o.x = cvtpk(s[0 * 33], s[1 * 33]); o.y = cvtpk(s[2 * 33], s[3 * 33]); o.z = cvtpk(s[4 * 33], s[5 * 33]); o.w = cvtpk(s[6 * 33], s[7 * 33]);
        *(u32x4*)(WT + (size_t)(dst_row0 + n) * K + k0 + 8 * c) = o; }
    asm volatile("s_waitcnt lgkmcnt(0)" ::: "memory");
}
DI f32x2 cpow_k(float are, float aim, float dt, int k) {
    const float mag = __expf(are * dt * (float)k);
    const double turns = (double)aim * (double)dt * (double)k * 0.15915494309189535;
    const float fr = (float)(turns - floor(turns));
    return (f32x2){mag * __builtin_amdgcn_cosf(fr), mag * __builtin_amdgcn_sinf(fr)};
}
DI f32x2 cmul(f32x2 a, f32x2 b) { return (f32x2){a.x * b.x - a.y * b.y, a.x * b.y + a.y * b.x}; }
DI f32x2 zoh_factor(float are, float aim, float dt) {
    const f32x2 ab = cpow_k(are, aim, dt, 1); const float nr = ab.x - 1.0f, ni = ab.y, den = are * are + aim * aim;
    return (f32x2){(nr * are + ni * aim) / den, (ni * are - nr * aim) / den};
}

struct LayerP { const float *a_re, *a_im, *log_dt, *b_re, *b_im, *c_re, *c_im; };

DI void ktab_block(const LayerP& P, bf16* KTAB, int g, int tb, LAS unsigned char* lds, int tid) {
    LAS f32x2* CL = (LAS f32x2*)lds;
    LAS f32x2* BB = (LAS f32x2*)(lds + 16384);
    const float dt = __expf(P.log_dt[g]);
    const int p = tid & 63, h0 = tid >> 6, h1 = h0 + 8;
    const float are = P.a_re[g * 64 + p], aim = P.a_im[g * 64 + p];
    const f32x2 c0 = {P.c_re[(g * 16 + h0) * 64 + p], P.c_im[(g * 16 + h0) * 64 + p]}, c1 = {P.c_re[(g * 16 + h1) * 64 + p], P.c_im[(g * 16 + h1) * 64 + p]};
    const int e0 = tid, e1 = tid + NTHR; const int pa = e0 >> 4, pb = e1 >> 4, hp = tid & 15;
    const float area = P.a_re[g * 64 + pa], aima = P.a_im[g * 64 + pa], areb = P.a_re[g * 64 + pb], aimb = P.a_im[g * 64 + pb];
    const f32x2 bva = {P.b_re[(g * 64 + pa) * 16 + hp], P.b_im[(g * 64 + pa) * 16 + hp]}, bvb = {P.b_re[(g * 64 + pb) * 16 + hp], P.b_im[(g * 64 + pb) * 16 + hp]};
    BB[pa * 16 + hp] = cmul(zoh_factor(area, aima, dt), bva); BB[pb * 16 + hp] = cmul(zoh_factor(areb, aimb, dt), bvb);
    if (tb == 0 && tid < 256) KTAB[((size_t)g * 65) * 256 + tid] = 0;
#pragma unroll 1
    for (int tp = 0; tp < 4; ++tp) { const int tau0 = tb * 8 + 2 * tp;
        const f32x2 l0 = cpow_k(are, aim, dt, tau0), l1 = cpow_k(are, aim, dt, tau0 + 1);
        CL[(0 * 16 + h0) * 64 + p] = cmul(c0, l0); CL[(0 * 16 + h1) * 64 + p] = cmul(c1, l0); CL[(1 * 16 + h0) * 64 + p] = cmul(c0, l1); CL[(1 * 16 + h1) * 64 + p] = cmul(c1, l1);
        __syncthreads();
        { const int ts = tid >> 8, h = (tid >> 4) & 15; float sacc = 0.f;
#pragma unroll 8
          for (int q = 0; q < 64; ++q) { const f32x2 c = CL[(ts * 16 + h) * 64 + q], bq = BB[q * 16 + hp]; sacc += c.x * bq.x - c.y * bq.y; }
          KTAB[((size_t)g * 65 + (tau0 + ts + 1)) * 256 + h * 16 + hp] = (bf16)(cvtpk(sacc, 0.f) & 0xffffu); }
        __syncthreads();
    }
}
DI void wv_item(const LayerP& P, bf16* WTAB, bf16* VTAB, float* LAM, int idx) {
    const int p = idx & 63, k = (idx >> 6) & 15, g = idx >> 10;
    const float dt = __expf(P.log_dt[g]), are = P.a_re[g * 64 + p], aim = P.a_im[g * 64 + p];
    f32x2 cv[16];
#pragma unroll
    for (int j = 0; j < 16; ++j) cv[j] = (f32x2){P.c_re[(g * 16 + j) * 64 + p], P.c_im[(g * 16 + j) * 64 + p]};
    const f32x2 lk1 = cpow_k(are, aim, dt, k + 1);
#pragma unroll
    for (int h = 0; h < 16; ++h) { const f32x2 c = cmul(cv[h], lk1); *(unsigned*)(VTAB + ((size_t)g * 256 + k * 16 + h) * 128 + 2 * p) = cvtpk(c.x, -c.y); }
    if (k == 15) { const f32x2 l64 = cpow_k(are, aim, dt, 64); *(f32x4*)(LAM + (g * 64 + p) * 4) = (f32x4){l64.x, l64.y, lk1.x, lk1.y}; }
}

#define MFMA16(a, b, c) __builtin_amdgcn_mfma_f32_16x16x32_bf16((a), (b), (c), 0, 0, 0)
#define MFMA32(a, b, c) __builtin_amdgcn_mfma_f32_32x32x16_bf16((a), (b), (c), 0, 0, 0)
DI void make_wfrag(const LayerP& P, int g, int wave, int lane, bf16x8 (&af)[8], f32x2& l16a, f32x2& l16b) {
    const int n = lane & 15, kg = lane >> 4, p = 8 * wave + (n >> 1), ri = n & 1;
    const float dt = __expf(P.log_dt[g]), are = P.a_re[g * 64 + p], aim = P.a_im[g * 64 + p];
    const int pa = 8 * wave + 2 * kg;
    const float area = P.a_re[g * 64 + pa], aima = P.a_im[g * 64 + pa], areb = P.a_re[g * 64 + pa + 1], aimb = P.a_im[g * 64 + pa + 1];
    const f32x4 br0 = *(const f32x4*)(P.b_re + (g * 64 + p) * 16 + 8 * (kg & 1)), br1 = *(const f32x4*)(P.b_re + (g * 64 + p) * 16 + 8 * (kg & 1) + 4);
    const f32x4 bi0 = *(const f32x4*)(P.b_im + (g * 64 + p) * 16 + 8 * (kg & 1)), bi1 = *(const f32x4*)(P.b_im + (g * 64 + p) * 16 + 8 * (kg & 1) + 4);
    const f32x2 f = zoh_factor(are, aim, dt);
    f32x2 fb[8];
#pragma unroll
    for (int i = 0; i < 4; ++i) { fb[i] = cmul(f, (f32x2){br0[i], bi0[i]}); fb[4 + i] = cmul(f, (f32x2){br1[i], bi1[i]}); }
#pragma unroll
    for (int ks = 0; ks < 8; ++ks) { const f32x2 lp = cpow_k(are, aim, dt, 15 - 2 * ks - (kg >> 1)); float v[8];
#pragma unroll
        for (int i = 0; i < 8; ++i) { const f32x2 c = cmul(lp, fb[i]); v[i] = ri ? c.y : c.x; }
        const u32x4 w = {cvtpk(v[0], v[1]), cvtpk(v[2], v[3]), cvtpk(v[4], v[5]), cvtpk(v[6], v[7])}; af[ks] = __builtin_bit_cast(bf16x8, w); }
    l16a = cpow_k(area, aima, dt, 16); l16b = cpow_k(areb, aimb, dt, 16);
}
DI void ssm_state_unit(const bf16* U, const bf16x8 (&af)[8], f32x2 l16a, f32x2 l16b, float* S, int b, int g, int cb, int wave, int lane) {
    const int n = lane & 15, kg = lane >> 4;
    const bf16* up = U + ((size_t)b * SEQ + (size_t)(cb * 16 + n) * 64 + (kg >> 1)) * 512 + g * 16 + 8 * (kg & 1);
    bf16x8 uf[4][8];
#pragma unroll
    for (int a = 0; a < 4; ++a)
#pragma unroll
        for (int ks = 0; ks < 8; ++ks) uf[a][ks] = *(const bf16x8*)(up + (size_t)(16 * a + 2 * ks) * 512);
    __builtin_amdgcn_sched_barrier(0);
    pg8::f32x4 acc4[4];
#pragma unroll
    for (int a = 0; a < 4; ++a) acc4[a] = (pg8::f32x4){0.f, 0.f, 0.f, 0.f};
#pragma unroll
    for (int ks = 0; ks < 8; ++ks)
#pragma unroll
        for (int a = 0; a < 4; ++a) acc4[a] = MFMA16(af[ks], uf[a][ks], acc4[a]);
    __builtin_amdgcn_sched_barrier(0);
    pg8::f32x4 st = acc4[0];
#pragma unroll
    for (int a = 1; a < 4; ++a) {
        const f32x2 s0 = cmul(l16a, (f32x2){st[0], st[1]}), s1 = cmul(l16b, (f32x2){st[2], st[3]});
        st = (pg8::f32x4){s0.x + acc4[a][0], s0.y + acc4[a][1], s1.x + acc4[a][2], s1.y + acc4[a][3]};
    }
    *(pg8::f32x4*)(S + (((size_t)b * NCH + cb * 16 + n) * NG + g) * 128 + 16 * wave + 4 * kg) = st;
}
constexpr int XIN_OFF = 33280, XIN_PITCH = 272, XIN_VAR = 16 * XIN_PITCH, TB_OFF = XIN_OFF + 4 * XIN_VAR, UL_OFF = 57344, UL_PITCH = 2064;
template <int S> DI void toe_stage(pg8::f32x4 (&acc)[8], const LAS unsigned char* ul, const LAS unsigned char* kt, int wave, int lo, int hi) {
#pragma unroll 1
    for (int ks = lo; ks <= hi; ++ks) {
        const bf16x8 uf0 = *(const LAS bf16x8*)(ul + ks * 64);
        bf16x8 a0[8 - S];
#pragma unroll
        for (int j = S; j < 8; ++j) a0[j - S] = *(const LAS bf16x8*)(kt + (wave + 8 * j - 2 * ks) * 512);
        __builtin_amdgcn_sched_barrier(0);
#pragma unroll
        for (int j = S; j < 8; ++j) acc[j] = MFMA16(a0[j - S], uf0, acc[j]);
    }
}
#ifdef PROBE_SEL
#define QS(sel) do { if (PROBE_SEL == (sel)) tq0 = __builtin_amdgcn_s_memrealtime(); } while (0)
#define QT(sel) do { if (PROBE_SEL == (sel)) tqacc += __builtin_amdgcn_s_memrealtime() - tq0; } while (0)
#else
#define QS(sel) do {} while (0)
#define QT(sel) do {} while (0)
#endif
DI void ssm_out_unit(unsigned long long& tqacc, bool load_ktab, const bf16* U, const bf16* KTAB, const bf16* VTAB, const float* S, const float* LAM, const float* dsk, bf16* YS, int b, int g, int cb, LAS unsigned char* lds, int tid, int wave, int lane) {
    unsigned long long tq0 = 0ull; (void)tq0;
    const int n = lane & 15, kg = lane >> 4;
    QS(51);
    const f32x4 lam4 = *(const f32x4*)(LAM + (g * 64 + lane) * 4); const f32x2 lam = {lam4.x, lam4.y}, l16 = {lam4.z, lam4.w};
    f32x2 sv[16];
    {
        const u32x4* src = (const u32x4*)((const unsigned char*)KTAB + (size_t)g * KTAB_BYTES);
        u32x4 kt4[4], kt5 = {0u, 0u, 0u, 0u}, ut4[4];
        if (load_ktab) {
#pragma unroll
            for (int j = 0; j < 4; ++j) kt4[j] = src[tid + NTHR * j];
            if (tid < 32) kt5 = src[2048 + tid];
        }
#pragma unroll
        for (int j = 0; j < 4; ++j) { const int idx = tid + NTHR * j, cn = idx >> 7, tok = (idx >> 1) & 63, half = idx & 1;
            ut4[j] = *(const u32x4*)(U + ((size_t)b * SEQ + (size_t)(cb * 16 + cn) * 64 + tok) * 512 + g * 16 + 8 * half); }
        if (wave <= cb) { const f32x2* sp = (const f32x2*)(S + (((size_t)b * NCH + wave * 16) * NG + g) * 128) + lane;
#pragma unroll
            for (int j = 0; j < 16; ++j) sv[j] = sp[(size_t)j * (NG * 64)]; }
        __builtin_amdgcn_sched_barrier(0);
        if (load_ktab) {
#pragma unroll
            for (int j = 0; j < 4; ++j) *(LAS u32x4*)(lds + 16 * (tid + NTHR * j)) = kt4[j];
            if (tid < 32) *(LAS u32x4*)(lds + 16 * (2048 + tid)) = kt5;
        }
#pragma unroll
        for (int j = 0; j < 4; ++j) { const int idx = tid + NTHR * j, cn = idx >> 7, tok = (idx >> 1) & 63, half = idx & 1; *(LAS u32x4*)(lds + UL_OFF + cn * UL_PITCH + tok * 32 + half * 16) = ut4[j]; }
    }
    bf16x8 vfr[4][2];
#pragma unroll
    for (int k2 = 0; k2 < 4; ++k2)
#pragma unroll
        for (int jj = 0; jj < 2; ++jj) vfr[k2][jj] = *(const bf16x8*)(VTAB + ((size_t)g * 256 + (wave + 8 * jj) * 16 + n) * 128 + 32 * k2 + 8 * kg);
    __builtin_amdgcn_sched_barrier(0);
    LAS f32x2* TB = (LAS f32x2*)(lds + TB_OFF);
    if (wave < cb) { f32x2 x = {0.f, 0.f};
#pragma unroll
        for (int j = 0; j < 16; ++j) { x = cmul(lam, x); x.x += sv[j].x; x.y += sv[j].y; }
        TB[wave * 64 + lane] = x; }
    __syncthreads();
    if (wave == cb) {
        f32x2 l1k = lam;
#pragma unroll
        for (int j = 0; j < 4; ++j) l1k = cmul(l1k, l1k);
        f32x2 x = {0.f, 0.f};
        for (int w = 0; w < cb; ++w) { const f32x2 t = TB[w * 64 + lane]; x = cmul(l1k, x); x.x += t.x; x.y += t.y; }
#pragma unroll
        for (int j = 0; j < 16; ++j) { f32x2 xa = x;
#pragma unroll
            for (int a = 0; a < 4; ++a) { *(LAS unsigned*)(lds + XIN_OFF + a * XIN_VAR + j * XIN_PITCH + 4 * lane) = cvtpk(xa.x, xa.y); xa = cmul(l16, xa); }
            x = cmul(lam, x); x.x += sv[j].x; x.y += sv[j].y; }
    }
    __syncthreads();
    QT(51); QS(52);
    pg8::f32x4 acc[8];
#pragma unroll
    for (int j = 0; j < 8; ++j) acc[j] = (pg8::f32x4){0.f, 0.f, 0.f, 0.f};
    const LAS unsigned char* ul = lds + UL_OFF + n * UL_PITCH + (kg >> 1) * 32 + (kg & 1) * 16;
    const LAS unsigned char* kt = lds + n * 32 + (kg & 1) * 16 + (1 - (kg >> 1)) * 512;
    { const int hw = wave >> 1;
      toe_stage<0>(acc, ul, kt, wave, 0, hw);            toe_stage<1>(acc, ul, kt, wave, hw + 1, hw + 4);   toe_stage<2>(acc, ul, kt, wave, hw + 5, hw + 8);   toe_stage<3>(acc, ul, kt, wave, hw + 9, hw + 12);
      toe_stage<4>(acc, ul, kt, wave, hw + 13, hw + 16); toe_stage<5>(acc, ul, kt, wave, hw + 17, hw + 20); toe_stage<6>(acc, ul, kt, wave, hw + 21, hw + 24); toe_stage<7>(acc, ul, kt, wave, hw + 25, hw + 28); }
#pragma unroll
    for (int k2 = 0; k2 < 4; ++k2) {
        bf16x8 xf[4];
#pragma unroll
        for (int a = 0; a < 4; ++a) xf[a] = *(const LAS bf16x8*)(lds + XIN_OFF + a * XIN_VAR + n * XIN_PITCH + (32 * k2 + 8 * kg) * 2);
#pragma unroll
        for (int j = 0; j < 8; ++j) acc[j] = MFMA16(vfr[k2][j & 1], xf[j >> 1], acc[j]); }
    QT(52); QS(53);
    const f32x4 dv = *(const f32x4*)(dsk + g * 16 + 4 * kg);
#pragma unroll
    for (int j = 0; j < 8; ++j) { const int t = wave + 8 * j; const size_t off = ((size_t)b * SEQ + (size_t)(cb * 16 + n) * 64 + t) * 512 + g * 16 + 4 * kg;
        const u32x2 uu = *(const LAS u32x2*)(lds + UL_OFF + n * UL_PITCH + t * 32 + kg * 8);
        const float y0 = gelu_tanh(acc[j][0] + dv[0] * bflo(uu.x)), y1 = gelu_tanh(acc[j][1] + dv[1] * bfhi(uu.x)), y2 = gelu_tanh(acc[j][2] + dv[2] * bflo(uu.y)), y3 = gelu_tanh(acc[j][3] + dv[3] * bfhi(uu.y));
        u32x2 w; w.x = cvtpk(y0, y1); w.y = cvtpk(y2, y3); *(u32x2*)(YS + off) = w; }
    asm volatile("s_waitcnt lgkmcnt(0)\n\ts_barrier" ::: "memory");
    QT(53);
}

struct AttnSt { f32x16 o0, o1; float carry; };
DI bool attn_tile(AttnSt& st, const bf16x8 (&kf)[4], const bf16x8 (&vf)[4], const bf16x8 (&qf)[4], bool diag, int n, int hi) {
    f32x16 s;
#pragma unroll
    for (int r = 0; r < 16; ++r) s[r] = 0.f;
#pragma unroll
    for (int ks = 0; ks < 4; ++ks) s = MFMA32(kf[ks], qf[ks], s);
    float sp[16];
#pragma unroll
    for (int r = 0; r < 16; ++r) { const float z = s[r]; const float e = __builtin_amdgcn_exp2f(-fabsf(z)); sp[r] = fmaxf(z, 0.f) + __builtin_amdgcn_logf(1.0f + e);
        if (diag && (16 * (r >> 3) + 8 * hi + (r & 7)) >= n) sp[r] = 0.f; }
    float cum[16]; float c0 = 0.f, c1 = 0.f;
#pragma unroll
    for (int r = 7; r >= 0; --r) { c0 -= sp[r]; cum[r] = c0; c1 -= sp[8 + r]; cum[8 + r] = c1; }
    const float p0 = __shfl_xor(c0, 32), p1 = __shfl_xor(c1, 32);
    const float base1 = st.carry + (hi ? 0.f : p1), base0 = st.carry + c1 + p1 + (hi ? 0.f : p0);
    float w[16];
#pragma unroll
    for (int r = 0; r < 16; ++r) { w[r] = __builtin_amdgcn_exp2f(s[r] + cum[r] + (r < 8 ? base0 : base1));
        if (diag && (16 * (r >> 3) + 8 * hi + (r & 7)) >= n) w[r] = 0.f; }
    st.carry += (c0 + c1) + (p0 + p1);
    const u32x4 pa = {cvtpk(w[0], w[1]), cvtpk(w[2], w[3]), cvtpk(w[4], w[5]), cvtpk(w[6], w[7])}, pb = {cvtpk(w[8], w[9]), cvtpk(w[10], w[11]), cvtpk(w[12], w[13]), cvtpk(w[14], w[15])};
    const bf16x8 pf0 = __builtin_bit_cast(bf16x8, pa), pf1 = __builtin_bit_cast(bf16x8, pb);
    st.o0 = MFMA32(pf0, vf[0], st.o0); st.o0 = MFMA32(pf1, vf[1], st.o0); st.o1 = MFMA32(pf0, vf[2], st.o1); st.o1 = MFMA32(pf1, vf[3], st.o1);
    return __ballot(st.carry >= -152.0f) == 0ull;
}
DI void attn_task(const bf16* Q, const bf16* Kb, const bf16* VT, const bf16* ZA, bf16* Y, int b, int h, int qt, int lane) {
    const int n = lane & 31, hi = lane >> 5;
    const size_t rowbase = (size_t)b * SEQ;
    bf16x8 qf[4];
    { const bf16* qp = Q + (rowbase + qt * 32 + n) * 512 + h * 64 + 8 * hi;
#pragma unroll
      for (int ks = 0; ks < 4; ++ks) qf[ks] = *(const bf16x8*)(qp + 16 * ks); }
    const int pm = (n & ~12) | (((n >> 2) & 1) << 3) | (((n >> 3) & 1) << 2);
    const bf16* kp = Kb + (rowbase + pm) * 512 + h * 64 + 8 * hi;
    const bf16* vp = VT + ((size_t)(b * 8 + h) * 64 + n) * SEQ + 8 * hi;
    AttnSt st;
#pragma unroll
    for (int r = 0; r < 16; ++r) { st.o0[r] = 0.f; st.o1[r] = 0.f; }
    st.carry = 0.f;
    bf16x8 kA[4], vA[4], kB[4], vB[4], kC[4], vC[4];
#define ATT_LOAD(KF, VF, ktile) do { const int key0_ = ((ktile) > 0 ? (ktile) : 0) * 32; \
        _Pragma("unroll") for (int ks = 0; ks < 4; ++ks) KF[ks] = *(const bf16x8*)(kp + (size_t)key0_ * 512 + 16 * ks); \
        VF[0] = *(const bf16x8*)(vp + key0_); VF[1] = *(const bf16x8*)(vp + key0_ + 16); VF[2] = *(const bf16x8*)(vp + (size_t)32 * SEQ + key0_); VF[3] = *(const bf16x8*)(vp + (size_t)32 * SEQ + key0_ + 16); } while (0)
    ATT_LOAD(kA, vA, qt); ATT_LOAD(kB, vB, qt - 1);
    int kt = qt;
    for (;;) {
        ATT_LOAD(kC, vC, kt - 2); __builtin_amdgcn_sched_barrier(0);
        if (attn_tile(st, kA, vA, qf, kt == qt, n, hi) || kt == 0) break; --kt; __builtin_amdgcn_sched_barrier(0);
        ATT_LOAD(kA, vA, kt - 2); __builtin_amdgcn_sched_barrier(0);
        if (attn_tile(st, kB, vB, qf, false, n, hi) || kt == 0) break; --kt; __builtin_amdgcn_sched_barrier(0);
        ATT_LOAD(kB, vB, kt - 2); __builtin_amdgcn_sched_barrier(0);
        if (attn_tile(st, kC, vC, qf, false, n, hi) || kt == 0) break; --kt; __builtin_amdgcn_sched_barrier(0);
    }
#undef ATT_LOAD
    float za0[16], za1[16];
#pragma unroll
    for (int r = 0; r < 16; ++r) { const int i = (r & 3) + 8 * (r >> 2) + 4 * hi; const size_t off = (rowbase + qt * 32 + i) * 512 + h * 64 + n; za0[r] = bf1(ZA[off]); za1[r] = bf1(ZA[off + 32]); }
    __builtin_amdgcn_sched_barrier(0);
#pragma unroll
    for (int r = 0; r < 16; ++r) { const int i = (r & 3) + 8 * (r >> 2) + 4 * hi; const size_t off = (rowbase + qt * 32 + i) * 512 + h * 64 + n;
        Y[off] = (bf16)(cvtpk(st.o0[r] * silu(za0[r]), 0.f) & 0xffffu); Y[off + 32] = (bf16)(cvtpk(st.o1[r] * silu(za1[r]), 0.f) & 0xffffu); }
}
#define XB_TMO      128
#define XB_XCNT(j)  (256  + 64 * (j))
#define XB_XSUB(j)  (1280 + 64 * (j))
#define XB_XGEN(j)  (2304 + 64 * (j))
#define XB_TOP      3328
#define XB_TOPGEN   3392
#define XCD_BAR_WORDS 3456
#define XB_SPIN_CAP (1u << 18)

__device__ __forceinline__ unsigned xb_ld(unsigned* p)              { return __hip_atomic_load(p, __ATOMIC_RELAXED, __HIP_MEMORY_SCOPE_AGENT); }
__device__ __forceinline__ unsigned xb_add(unsigned* p, unsigned v) { return __hip_atomic_fetch_add(p, v, __ATOMIC_RELAXED, __HIP_MEMORY_SCOPE_AGENT); }
__device__ __forceinline__ unsigned xb_xcc_id() { return (unsigned)__builtin_amdgcn_s_getreg((3 << 11) | 20) & 0xFu; }
#define XB_SPIN(cond, bar) do { unsigned _sp = 0; while (cond) { __builtin_amdgcn_s_sleep(1); \
    if ((++_sp & 255u) == 0u) { if (xb_ld(&(bar)[XB_TMO])) break; if (_sp > XB_SPIN_CAP) { atomicAdd(&(bar)[XB_TMO], 1u); break; } } } } while (0)

struct XcdBarrier {
    unsigned* bar; unsigned x;
    volatile LAS unsigned* st;
};

__device__ __forceinline__ XcdBarrier xcd_barrier_post(unsigned* bar, volatile LAS unsigned* st) {
    XcdBarrier b; b.bar = bar; b.x = xb_xcc_id(); b.st = st;
    if (threadIdx.x == 0) (void)xb_add(&bar[XB_XCNT(b.x)], 1u);
    return b;
}
__device__ __forceinline__ void xcd_barrier_complete(unsigned* bar, unsigned x, unsigned& nloc, unsigned& nx) {
    const unsigned G = gridDim.x * gridDim.y * gridDim.z;
    unsigned sum, cnt, mine, sp = 0u;
    for (;;) {
        sum = 0u; cnt = 0u; mine = 0u;
#pragma unroll
        for (unsigned j = 0; j < 16; ++j) { const unsigned c = xb_ld(&bar[XB_XCNT(j)]); sum += c; cnt += (c > 0u) ? 1u : 0u; mine = (j == x) ? c : mine; }
        if (sum == G) break;
        __builtin_amdgcn_s_sleep(1);
        if ((++sp & 255u) == 0u) { if (xb_ld(&bar[XB_TMO])) break; if (sp > XB_SPIN_CAP) { atomicAdd(&bar[XB_TMO], 1u); break; } }
    }
    nloc = mine > 0u ? mine : 1u; nx = cnt > 0u ? cnt : 1u;
}

__device__ __forceinline__ void xcd_barrier(const XcdBarrier& b) {
    asm volatile("s_waitcnt vmcnt(0)" ::: "memory");
    __syncthreads();
    if (threadIdx.x == 0) {
        unsigned* bar = b.bar;
        __builtin_amdgcn_s_waitcnt(0);
        unsigned nloc = b.st[0], nx = b.st[1];
        if (nloc == 0u) { xcd_barrier_complete(bar, b.x, nloc, nx); b.st[0] = nloc; b.st[1] = nx; }
        const unsigned old = xb_add(&bar[XB_XSUB(b.x)], 1u);
        const unsigned gen = old / nloc;
        if (old + 1u == (gen + 1u) * nloc) {
            __builtin_amdgcn_fence(__ATOMIC_RELEASE, "agent");
            asm volatile("s_waitcnt vmcnt(0)" ::: "memory");
            const unsigned og = xb_add(&bar[XB_TOP], 1u);
            const unsigned tg = og / nx;
            if (og + 1u == (tg + 1u) * nx) xb_add(&bar[XB_TOPGEN], 1u);
            else XB_SPIN(xb_ld(&bar[XB_TOPGEN]) == tg, bar);
            __builtin_amdgcn_fence(__ATOMIC_ACQUIRE, "agent");
            xb_add(&bar[XB_XGEN(b.x)], 1u);
            asm volatile("s_waitcnt vmcnt(0)" ::: "memory");
        } else {
            XB_SPIN(xb_ld(&bar[XB_XGEN(b.x)]) == gen, bar);
            __builtin_amdgcn_fence(__ATOMIC_ACQUIRE, "agent");
            asm volatile("s_waitcnt vmcnt(0)" ::: "memory");
        }
    }
    __syncthreads();
}

__device__ __forceinline__ void xcd_barrier1(const XcdBarrier& b) {
    asm volatile("s_waitcnt vmcnt(0)" ::: "memory");
    __syncthreads();
    if (threadIdx.x == 0) {
        unsigned* bar = b.bar;
        __builtin_amdgcn_s_waitcnt(0);
        unsigned nloc = b.st[0], nx = b.st[1];
        if (nloc == 0u) { xcd_barrier_complete(bar, b.x, nloc, nx); b.st[0] = nloc; b.st[1] = nx; }
        const unsigned k = b.st[2]; b.st[2] = k + 1u;
        const unsigned old = xb_add(&bar[XB_XSUB(b.x)], 1u);
        const unsigned gen = old / nloc;
        if (old + 1u == (gen + 1u) * nloc) {
            __builtin_amdgcn_fence(__ATOMIC_RELEASE, "agent");
            asm volatile("s_waitcnt vmcnt(0)" ::: "memory");
            const unsigned og = xb_add(&bar[XB_TOP], 1u);
            if (og + 1u == (k + 1u) * nx) xb_add(&bar[XB_TOPGEN], 1u);
            else XB_SPIN(xb_ld(&bar[XB_TOPGEN]) == k, bar);
        } else {
            XB_SPIN(xb_ld(&bar[XB_TOPGEN]) == k, bar);
        }
        __builtin_amdgcn_fence(__ATOMIC_ACQUIRE, "agent");
        asm volatile("s_waitcnt vmcnt(0)" ::: "memory");
    }
    __syncthreads();
}
__global__ void __launch_bounds__(NTHR, 2) hybrid_fwd(Args a) {
    extern __shared__ __attribute__((aligned(16))) unsigned char lds_raw[];
    LAS unsigned char* lds = (LAS unsigned char*)lds_raw;
    cg::grid_group grid = cg::this_grid();
#ifdef EXP_INVL2
    if (threadIdx.x == 0) asm volatile("buffer_inv sc0 sc1\n\ts_waitcnt vmcnt(0)" ::: "memory");
    __syncthreads();
#endif
    volatile LAS unsigned* xb_st = (volatile LAS unsigned*)(lds + 131072 + 1024);
    if (threadIdx.x < 3) xb_st[threadIdx.x] = 0u;
    __syncthreads();
    if (blockIdx.x == 0) for (int i = threadIdx.x; i < 4096; i += NTHR) __hip_atomic_store((unsigned*)a.ws + i, 0u, __ATOMIC_RELAXED, __HIP_MEMORY_SCOPE_AGENT);
    XcdBarrier xbar; xbar.bar = (unsigned*)a.ws; xbar.x = 0; xbar.st = xb_st;
    const int tid0 = threadIdx.x, wave = __builtin_amdgcn_readfirstlane(tid0 >> 6);
    const int G = gridDim.x, bx = blockIdx.x;
    const int gw = bx * NWAVES + wave, NGW = G * NWAVES;
    unsigned char* ws = a.ws;
    bf16* const Win = (bf16*)(ws + WS_WIN); bf16* const Wglu = (bf16*)(ws + WS_WGLU); bf16* const Wbs = (bf16*)(ws + WS_WBS); bf16* const Wba = (bf16*)(ws + WS_WBA); bf16* const Wout = (bf16*)(ws + WS_WOUT);
    bf16* const Hb = (bf16*)(ws + WS_H); bf16* const Ub = (bf16*)(ws + WS_U); bf16* const ZSb = (bf16*)(ws + WS_ZS); bf16* const Qb = (bf16*)(ws + WS_Q); bf16* const Kb = (bf16*)(ws + WS_K);
    bf16* const VTb = (bf16*)(ws + WS_VT); bf16* const ZAb = (bf16*)(ws + WS_ZA); bf16* const GSb = (bf16*)(ws + WS_GS); bf16* const GAb = (bf16*)(ws + WS_GA);


    unsigned long long tqa = 0ull;
#ifdef PROBE_SEL
    unsigned long long tacc = 0ull, tbeg = 0ull;
#define PW(sel) do { if (PROBE_SEL == (sel) + 10) tacc += __builtin_amdgcn_s_memrealtime() - tbeg; if (PROBE_SEL == (sel) + 20) tbeg = __builtin_amdgcn_s_memrealtime(); } while (0)
#define PS(sel) do { if (PROBE_SEL == (sel)) tbeg = __builtin_amdgcn_s_memrealtime(); } while (0)
#define PT(sel) do { if (PROBE_SEL == (sel)) tacc += __builtin_amdgcn_s_memrealtime() - tbeg; } while (0)
#define PB(sel) do { if (PROBE_SEL == (sel) || PROBE_SEL == (sel) + 10) tbeg = __builtin_amdgcn_s_memrealtime(); } while (0)
#define PE(sel) do { if (PROBE_SEL == (sel) || PROBE_SEL == (sel) + 20) tacc += __builtin_amdgcn_s_memrealtime() - tbeg; } while (0)
#else
#define PB(sel) do {} while (0)
#define PW(sel) do {} while (0)
#define PS(sel) do {} while (0)
#define PT(sel) do {} while (0)
#define PE(sel) do {} while (0)
#endif
#define GSYNC() xcd_barrier1(xbar)
    PB(0);
    for (int l = 0; l <= DEPTH; ++l) {
        const int lt = l < DEPTH ? l : 0;
        bf16* const KTAB = (bf16*)(ws + WS_KTAB + lt * KTAB_LSTRIDE); bf16* const WTAB = (bf16*)(ws + WS_WTAB + lt * WTAB_LSTRIDE); bf16* const VTAB = (bf16*)(ws + WS_VTAB + lt * VTAB_LSTRIDE);
        float* const Sb = (float*)(ws + WS_S + lt * S_LSTRIDE); float* const LAM = (float*)(ws + WS_LAM + lt * LAM_LSTRIDE);
        int tid = tid0; asm volatile("" : "+v"(tid)); const int lane = tid & 63;
        PB(1);
        {
            const float* xin = (l <= 1) ? a.x : a.out;
        PS(43);
            { f32x4 gpo[4], gpr[4];
#pragma unroll
              for (int j = 0; j < 4; ++j) { gpo[j] = l > 0 ? *((const f32x4*)(a.post_g + (l - 1) * DM) + lane + 64 * j) : (f32x4){0.f, 0.f, 0.f, 0.f};
                                            gpr[j] = l < DEPTH ? *((const f32x4*)(a.pre_g + l * DM) + lane + 64 * j) : (f32x4){0.f, 0.f, 0.f, 0.f}; }
              for (int m = gw; m < M; m += NGW)
                  norm_row(xin + (size_t)m * DM, l > 0 ? GAb + (size_t)m * DM : nullptr, gpo, a.out + (size_t)m * DM, l < DEPTH, gpr, Hb + (size_t)m * DM, lane); }
        PT(43);
            if (l == DEPTH) { PE(1); break; }
            LAS float* scr = (LAS float*)(lds + wave * 16384);
            const float* w_in = a.w_in + (size_t)l * DM * NCOL; const float* w_glu = a.w_glu + (size_t)l * 512 * 1024; const float* w_bs = a.w_bs + (size_t)l * 512 * 1024;
            const float* w_ba = a.w_ba + (size_t)l * 512 * 1024; const float* w_out = a.w_out + (size_t)l * 1024 * 1024;
            constexpr int I_IN = 16 * 160, I_GLU = 8 * 32, I_BR = 8 * 32, I_OUT = 16 * 32, NITEMS = I_IN + I_GLU + 2 * I_BR + I_OUT;
        PS(44);
            for (int it = gw; it < NITEMS; it += NGW) {
                int r = it;
                if (r < I_IN) { const int kb = r / 160, nb = r % 160; transpose_item(w_in, 1024, NCOL, Win, 64 * kb, 32 * nb, 32 * nb, scr, lane); continue; } r -= I_IN;
                if (r < I_GLU) { const int kb = r / 32, nb = r % 32, n0 = 32 * nb; const int bj = n0 >> 9, rem = n0 & 511, pn = rem >> 7, i0 = rem & 127;
                    transpose_item(w_glu, 512, 1024, Wglu, 64 * kb, n0, 256 * pn + 128 * bj + i0, scr, lane); continue; } r -= I_GLU;
                if (r < I_BR) { const int kb = r / 32, nb = r % 32; transpose_item(w_bs, 512, 1024, Wbs, 64 * kb, 32 * nb, 32 * nb, scr, lane); continue; } r -= I_BR;
                if (r < I_BR) { const int kb = r / 32, nb = r % 32; transpose_item(w_ba, 512, 1024, Wba, 64 * kb, 32 * nb, 32 * nb, scr, lane); continue; } r -= I_BR;
                { const int kb = r / 32, nb = r % 32; transpose_item(w_out, 1024, 1024, Wout, 64 * kb, 32 * nb, 32 * nb, scr, lane); }
            }
            __syncthreads();
            PT(44);
            LayerP P{a.a_re + l * NG * NP, a.a_im + l * NG * NP, a.log_dt + l * NG, a.b_re + (size_t)l * NG * NP * 16, a.b_im + (size_t)l * NG * NP * 16, a.c_re + (size_t)l * NG * 16 * NP, a.c_im + (size_t)l * NG * 16 * NP};
        PS(45);
#ifndef NO_TAB
            for (int it = bx; it < NG * 8; it += G) ktab_block(P, KTAB, it >> 3, it & 7, lds, tid);
            for (int idx = bx * NTHR + tid; idx < NG * NP * 16; idx += G * NTHR) wv_item(P, WTAB, VTAB, LAM, idx);
#endif
        PT(45);
        }
        PW(1);
        if (l == 0) { grid.sync(); xbar = xcd_barrier_post((unsigned*)a.ws, xb_st); } else GSYNC();
        PE(1);
        PB(2);
#ifndef NO_A
        { pg8::Gemm g{Hb, Win, M, NCOL, DM}; pg8::StaticOrder S; S.init(M, NCOL, G, bx); EpiProj E{ws};
          pg8::gemm_phase<EpiProj, pg8::StaticOrder, true, true>(lds, g, S, E); }
#endif
        PW(2);
        GSYNC();
        PE(2);
        PB(3);
        PS(41);
#ifndef NO_B1
        for (int u0 = 2 * bx; u0 < 512; u0 += 2 * G) { const int g = u0 >> 4;
            LayerP P{a.a_re + l * NG * NP, a.a_im + l * NG * NP, a.log_dt + l * NG, a.b_re + (size_t)l * NG * NP * 16, a.b_im + (size_t)l * NG * NP * 16, a.c_re + (size_t)l * NG * 16 * NP, a.c_im + (size_t)l * NG * 16 * NP};
            bf16x8 af[8]; f32x2 l16a, l16b;
            make_wfrag(P, g, wave, lane, af, l16a, l16b);
            for (int q = 0; q < 2; ++q) { const int nb = (u0 + q) & 15; ssm_state_unit(Ub, af, l16a, l16b, Sb, nb >> 3, g, nb & 7, wave, lane); } }
#endif
        PT(41);
        PS(42);
#ifndef NO_ATTN
        for (int t = gw; t < 4096; t += NGW) attn_task(Qb, Kb, VTb, ZAb, Qb, t >> 11, (t >> 8) & 7, t & 255, lane);
#endif
        PT(42);
        PW(3);
        GSYNC();
        PE(3);
        PB(4);
#ifndef NO_B3
        for (int u = 2 * bx; u < 512; u += (u & 1) ? 2 * G - 1 : 1) { const int g = u >> 4, nb = u & 15; ssm_out_unit(tqa, (u & 1) == 0, Ub, KTAB, VTAB, Sb, LAM, a.d_skip + l * 512, Hb, nb >> 3, g, nb & 7, lds, tid, wave, lane); }
#endif
        PW(4);
        GSYNC();
        PE(4);
        PB(5);
#ifndef NO_D1
        { pg8::Gemm g{Hb, Wglu, M, 1024, 512}; pg8::StaticOrder S; S.init(M, 1024, G, bx); EpiGlu E{ZSb, a.b_glu + l * 1024};
          pg8::gemm_phase<EpiGlu, pg8::StaticOrder, true, true>(lds, g, S, E); }
#endif
        PW(5);
        GSYNC();
        PE(5);
#ifndef NO_D2
        PB(6);
        { pg8::Gemm g{ZSb, Wbs, M, 1024, 512, Qb, Wba}; pg8::ChainOrder S; S.B.init(M, 1024, G, bx); EpiBranchBoth E{GSb, GAb};
          pg8::gemm_phase<EpiBranchBoth, pg8::ChainOrder, true, true>(lds, g, S, E); }
#endif
        PW(6);
        GSYNC();
        PE(6);
#ifndef NO_D3
        PB(7);
        { pg8::Gemm g{GSb, Wout, M, 1024, 1024}; pg8::StaticOrder S; S.init(M, 1024, G, bx); EpiPlain E{GAb};
          pg8::gemm_phase<EpiPlain, pg8::StaticOrder, true, true>(lds, g, S, E); }
#endif
        PW(7);
        GSYNC();
        PE(7);
    }
    PE(0);
#ifdef PROBE_SEL
    grid.sync();
    if (bx == 0) { LAS unsigned long long* tb = (LAS unsigned long long*)lds; if (tid0 == 0) tb[0] = tacc + tqa; __syncthreads(); const unsigned long long K = tb[0] < 1000000ull ? tb[0] : 1000000ull;
        for (unsigned long long i = tid0; i < K; i += NTHR) a.out[i] += 0.05f; }
#endif
}

extern "C" void kernel_launch(void* const* d_in, const int* in_sizes, int n_in, void* d_out, int out_size, void* d_ws, size_t ws_size, hipStream_t stream) {
    static int grid = 0;
    if (grid == 0) {
        if (n_in != 17 || out_size != M * DM || ws_size < WS_END) { fprintf(stderr, "kernel_launch: unexpected problem shape (n_in %d, out %d, ws %zu)\n", n_in, out_size, ws_size); grid = -1; return; }
        int dev = 0, cus = 0, per_cu = 0;
        (void)hipGetDevice(&dev); (void)hipDeviceGetAttribute(&cus, hipDeviceAttributeMultiprocessorCount, dev);
        if (hipFuncSetAttribute((const void*)hybrid_fwd, hipFuncAttributeMaxDynamicSharedMemorySize, LDS_BYTES) != hipSuccess) { fprintf(stderr, "kernel_launch: hipFuncSetAttribute failed\n"); grid = -1; return; }
        if (hipOccupancyMaxActiveBlocksPerMultiprocessor(&per_cu, (const void*)hybrid_fwd, NTHR, LDS_BYTES) != hipSuccess || per_cu < 1) { fprintf(stderr, "kernel_launch: occupancy query gave %d\n", per_cu); per_cu = 1; }
        (void)hipGetLastError();
        grid = cus * per_cu;
    }
    if (grid < 0) return;
    Args a{};
    a.x = (const float*)d_in[0]; a.pre_g = (const float*)d_in[1]; a.post_g = (const float*)d_in[2]; a.w_in = (const float*)d_in[3]; a.a_re = (const float*)d_in[4]; a.a_im = (const float*)d_in[5];
    a.log_dt = (const float*)d_in[6]; a.b_re = (const float*)d_in[7]; a.b_im = (const float*)d_in[8]; a.c_re = (const float*)d_in[9]; a.c_im = (const float*)d_in[10]; a.d_skip = (const float*)d_in[11];
    a.w_glu = (const float*)d_in[12]; a.b_glu = (const float*)d_in[13]; a.w_bs = (const float*)d_in[14]; a.w_ba = (const float*)d_in[15]; a.w_out = (const float*)d_in[16];
    a.out = (float*)d_out; a.ws = (unsigned char*)d_ws;
    void* args[] = {&a};
    const hipError_t e = hipLaunchCooperativeKernel((const void*)hybrid_fwd, dim3(grid), dim3(NTHR), args, LDS_BYTES, stream);
    if (e != hipSuccess) fprintf(stderr, "kernel_launch: cooperative launch failed: %s (grid %d)\n", hipGetErrorString(e), grid);
}
```

```cpp
#include <hip/hip_runtime.h>
#include <hip/hip_cooperative_groups.h>
#include <cstdio>
#include <cstdint>
namespace cg = cooperative_groups;
namespace pg8 {
#define PG8_LAS __attribute__((address_space(3)))
typedef unsigned short bf16_t;
typedef short bf16x8 __attribute__((ext_vector_type(8)));
typedef float f32x4 __attribute__((ext_vector_type(4)));
typedef unsigned u32x4 __attribute__((ext_vector_type(4)));
constexpr int BM = 256, BK = 64, HALF = 128, HTB = HALF * BK * 2  , STAGE_BYTES = 8 * HTB, NXCD = 8, WGM = 8;

__host__ __device__ __forceinline__ int lds_byte(int r, int c) { const int st = (r >> 4) * 2 + (c >> 5), rr = r & 15, cc = c & 31, ob = rr * 64 + cc * 2; return st * 1024 + (ob ^ (((ob >> 9) & 1) << 5)); }
__host__ __device__ __forceinline__ void stage_rc(int b, int& R, int& C) { const int st = b / 1024, sb = b % 1024, swz = sb ^ (((sb >> 9) & 1) << 5); R = (st >> 1) * 16 + swz / 64; C = (st & 1) * 32 + (swz % 64) / 2; }
__host__ __device__ __forceinline__ int perm32(int rho) { const int n = rho >> 4, i = rho & 15; return 8 * (i >> 2) + 4 * n + (i & 3); }

struct Unit { int pm, pn, sel; };
struct Gemm { const bf16_t* A; const bf16_t* Bt; int M, N, K; const bf16_t* A2; const bf16_t* Bt2; };

struct StaticOrder {
    int nM, nN, nwg, G, c;
    __host__ __device__ void init(int M, int N, int G_, int c_) { nM = M / BM; nN = N / BM; nwg = nM * nN; G = G_; c = c_; }
    __host__ __device__ bool next(int i, Unit& u) const {
        const long L = (long)i * G + c; if (L >= nwg) return false;
        int wgid = (int)L; { const int q = nwg / NXCD, r = nwg % NXCD, xcd = wgid % NXCD, off = wgid / NXCD; wgid = (xcd < r ? xcd * (q + 1) : r * (q + 1) + (xcd - r) * q) + off; }
        const int nig = WGM * nN, gid = wgid / nig, fm = gid * WGM, gsz = (nM - fm) < WGM ? (nM - fm) : WGM;
        u.pm = fm + ((wgid % nig) % gsz); u.pn = (wgid % nig) / gsz; u.sel = 0; return true;
    }
    __device__ __forceinline__ void a_ready(const Unit&) const {}
    __device__ __forceinline__ void done(const Unit&) const {}
};
__device__ __forceinline__ unsigned cvt_pk_bf16(float lo, float hi) { unsigned r; asm volatile("v_cvt_pk_bf16_f32 %0, %1, %2" : "=v"(r) : "v"(lo), "v"(hi)); return r; }
typedef float f32x2 __attribute__((ext_vector_type(2)));
struct ChainOrder { StaticOrder B;
    __host__ __device__ bool next(int i, Unit& u) const { if (!B.next(i >> 1, u)) return false; u.sel = i & 1; return true; }
    __device__ __forceinline__ void a_ready(const Unit&) const {}
    __device__ __forceinline__ void done(const Unit&) const {}
};

template <class Epi, class Sched, bool ALIGN_EPI = false, bool SP2 = false>
__device__ __forceinline__ void gemm_phase(PG8_LAS unsigned char* lds, const Gemm g, const Sched& S, const Epi& E) {
    int tid_ = threadIdx.x; asm volatile("" : "+v"(tid_));
    const int tid = tid_, wid = __builtin_amdgcn_readfirstlane(tid >> 6), lane = tid & 63, wr = wid >> 2, wc = wid & 3, fr = lane & 15, fq = lane >> 4;
    const int K = g.K, nt = K / BK;
    unsigned voffA[2], voffB[2];
#pragma unroll
    for (int i = 0; i < 2; ++i) { int R, C; stage_rc(tid * 16 + i * 8192, R, C); const int Rb = Epi::PERM ? ((R & ~31) + perm32(R & 31)) : R;
        voffA[i] = (unsigned)(R * K + C) * 2u; voffB[i] = (unsigned)(Rb * K + C) * 2u; }
    const size_t kstep = (size_t)(BK * 2);
    const size_t hstep = (size_t)HALF * K * 2;
    const size_t tstep = 2 * hstep;
    const unsigned ldsw = (unsigned)wid * 1024u;
    const int aoff = lds_byte(wr * 64 + fr, fq * 8), boff = lds_byte(wc * 32 + fr, fq * 8);
#define PG8_SA(b, h) (((b) * 2 + (h)) * HTB)
#define PG8_SB(b, h) ((4 + (b) * 2 + (h)) * HTB)
#define PG8_STAGE(bufoff, gbase, voff) do { _Pragma("unroll") for (int _i = 0; _i < 2; ++_i) \
        __builtin_amdgcn_global_load_lds((const unsigned*)((const char*)(gbase) + (voff)[_i]), (PG8_LAS unsigned*)(lds + (bufoff) + ldsw + _i * 8192), 16, 0, 0); } while (0)
#define PG8_LDA(dst, b, h) do { _Pragma("unroll") for (int m = 0; m < 4; ++m) _Pragma("unroll") for (int k = 0; k < 2; ++k) dst[m][k] = *(const PG8_LAS bf16x8*)(lds + PG8_SA(b, h) + aoff + m * 2048 + k * 1024); } while (0)
#define PG8_LDB(dst, b, h) do { _Pragma("unroll") for (int n = 0; n < 2; ++n) _Pragma("unroll") for (int k = 0; k < 2; ++k) dst[n][k] = *(const PG8_LAS bf16x8*)(lds + PG8_SB(b, h) + boff + n * 2048 + k * 1024); } while (0)
#define PG8_MMA(ai, bj, At, Bt) do { __builtin_amdgcn_s_setprio(1); _Pragma("unroll") for (int m = 0; m < 4; ++m) _Pragma("unroll") for (int n = 0; n < 2; ++n) _Pragma("unroll") for (int k = 0; k < 2; ++k) \
        acc[ai][bj][m][n] = __builtin_amdgcn_mfma_f32_16x16x32_bf16(Bt[n][k], At[m][k], acc[ai][bj][m][n], 0, 0, 0); __builtin_amdgcn_s_setprio(0); } while (0)
#define PG8_WAIT_V(n) asm volatile("s_waitcnt vmcnt(" #n ")" ::: "memory")
#define PG8_WAIT_L(n) asm volatile("s_waitcnt lgkmcnt(" #n ")" ::: "memory")
#define PG8_BAR __builtin_amdgcn_s_barrier()
#define PG8_SCHED __builtin_amdgcn_sched_barrier(0)
    Unit cur, nxt; int ui = 0;
    if (!S.next(0, cur)) return;
    f32x4 acc[2][2][4][2];
#pragma unroll
    for (int a = 0; a < 2; ++a)
#pragma unroll
        for (int b = 0; b < 2; ++b)
#pragma unroll
            for (int m = 0; m < 4; ++m)
#pragma unroll
                for (int n = 0; n < 2; ++n) acc[a][b][m][n] = (f32x4){0.f, 0.f, 0.f, 0.f};
    bf16x8 At[4][2], B0[2][2], B1[2][2];
    const char* cA = (const char*)(cur.sel ? g.A2 : g.A) + (size_t)cur.pm * tstep; const char* cB = (const char*)(cur.sel ? g.Bt2 : g.Bt) + (size_t)cur.pn * tstep;
    S.a_ready(cur);
    if constexpr (SP2) {
        PG8_STAGE(PG8_SB(0, 0), cB, voffB); PG8_STAGE(PG8_SB(0, 1), cB + hstep, voffB); PG8_STAGE(PG8_SA(0, 0), cA, voffA); PG8_STAGE(PG8_SA(0, 1), cA + hstep, voffA);
        if (wr == 1) PG8_BAR;
        PG8_WAIT_V(2); PG8_BAR;
        PG8_STAGE(PG8_SB(1, 0), cB + kstep, voffB); PG8_STAGE(PG8_SA(1, 0), cA + kstep, voffA); PG8_STAGE(PG8_SB(1, 1), cB + hstep + kstep, voffB);
        PG8_WAIT_V(6); PG8_BAR;
    } else {
        PG8_STAGE(PG8_SB(0, 0), cB, voffB); PG8_STAGE(PG8_SA(0, 0), cA, voffA); PG8_STAGE(PG8_SB(0, 1), cB + hstep, voffB); PG8_STAGE(PG8_SA(0, 1), cA + hstep, voffA);
        if (wr == 1) PG8_BAR;
        PG8_WAIT_V(4); PG8_BAR;
        PG8_STAGE(PG8_SB(1, 0), cB + kstep, voffB); PG8_STAGE(PG8_SA(1, 0), cA + kstep, voffA); PG8_STAGE(PG8_SB(1, 1), cB + hstep + kstep, voffB);
        PG8_WAIT_V(6); PG8_BAR;
    }
    for (;;) {
        const bool has_next = S.next(ui + 1, nxt);
        const char* nA = has_next ? (const char*)(nxt.sel ? g.A2 : g.A) + (size_t)nxt.pm * tstep : cA; const char* nB = has_next ? (const char*)(nxt.sel ? g.Bt2 : g.Bt) + (size_t)nxt.pn * tstep : cB;
        for (int t = 0; t < nt; t += 2) {
            const bool last = (t == nt - 2);
            const char* a1 = cA + (size_t)(t + 1) * kstep;
            const char* a2 = last ? nA : cA + (size_t)(t + 2) * kstep; const char* b2 = last ? nB : cB + (size_t)(t + 2) * kstep;
            const char* a3 = a2 + kstep; const char* b3 = b2 + kstep;
            if (last && has_next) S.a_ready(nxt);
            if constexpr (SP2) {
            PG8_LDB(B0, 0, 0); PG8_LDB(B1, 0, 1); PG8_SCHED; PG8_LDA(At, 0, 0); PG8_STAGE(PG8_SA(1, 1), a1 + hstep, voffA);
            PG8_WAIT_V(8); PG8_WAIT_L(0); PG8_BAR; PG8_MMA(0, 0, At, B0); PG8_MMA(0, 1, At, B1); PG8_BAR; PG8_SCHED;
            PG8_LDA(At, 0, 1); PG8_STAGE(PG8_SB(0, 0), b2, voffB); PG8_STAGE(PG8_SB(0, 1), b2 + hstep, voffB); PG8_STAGE(PG8_SA(0, 0), a2, voffA);
            PG8_WAIT_V(8); PG8_WAIT_L(0); PG8_BAR; PG8_MMA(1, 0, At, B0); PG8_MMA(1, 1, At, B1); PG8_BAR; PG8_SCHED;
            PG8_LDB(B0, 1, 0); PG8_LDB(B1, 1, 1); PG8_SCHED; PG8_LDA(At, 1, 0); PG8_STAGE(PG8_SA(0, 1), a2 + hstep, voffA);
            PG8_WAIT_V(8); PG8_WAIT_L(0); PG8_BAR; PG8_MMA(0, 0, At, B0); PG8_MMA(0, 1, At, B1); PG8_BAR; PG8_SCHED;
            PG8_LDA(At, 1, 1); PG8_STAGE(PG8_SB(1, 0), b3, voffB); PG8_STAGE(PG8_SB(1, 1), b3 + hstep, voffB); PG8_STAGE(PG8_SA(1, 0), a3, voffA);
            PG8_WAIT_V(8); PG8_WAIT_L(0); PG8_BAR; PG8_MMA(1, 0, At, B0); PG8_MMA(1, 1, At, B1); PG8_BAR; PG8_SCHED;
            } else {
            PG8_LDB(B0, 0, 0); PG8_SCHED; PG8_LDA(At, 0, 0); PG8_STAGE(PG8_SA(1, 1), a1 + hstep, voffA);
            PG8_WAIT_L(8); PG8_BAR; PG8_WAIT_L(0); PG8_MMA(0, 0, At, B0); PG8_BAR; PG8_SCHED;
            PG8_LDB(B1, 0, 1); PG8_STAGE(PG8_SB(0, 0), b2, voffB);
            PG8_BAR; PG8_WAIT_L(0); PG8_MMA(0, 1, At, B1); PG8_BAR;
            PG8_LDA(At, 0, 1); PG8_STAGE(PG8_SA(0, 0), a2, voffA);
            PG8_BAR; PG8_WAIT_L(0); PG8_MMA(1, 0, At, B0); PG8_BAR; PG8_SCHED;
            PG8_STAGE(PG8_SB(0, 1), b2 + hstep, voffB);
            PG8_WAIT_V(6); PG8_BAR; PG8_MMA(1, 1, At, B1); PG8_BAR;
            PG8_LDB(B0, 1, 0); PG8_SCHED; PG8_LDA(At, 1, 0); PG8_STAGE(PG8_SA(0, 1), a2 + hstep, voffA);
            PG8_WAIT_L(8); PG8_BAR; PG8_WAIT_L(0); PG8_MMA(0, 0, At, B0); PG8_BAR; PG8_SCHED;
            PG8_LDB(B1, 1, 1); PG8_STAGE(PG8_SB(1, 0), b3, voffB);
            PG8_BAR; PG8_WAIT_L(0); PG8_MMA(0, 1, At, B1); PG8_BAR;
            PG8_LDA(At, 1, 1); PG8_STAGE(PG8_SA(1, 0), a3, voffA);
            PG8_BAR; PG8_WAIT_L(0); PG8_MMA(1, 0, At, B0); PG8_BAR; PG8_SCHED;
            PG8_STAGE(PG8_SB(1, 1), b3 + hstep, voffB);
            PG8_WAIT_V(6); PG8_BAR; PG8_MMA(1, 1, At, B1); PG8_BAR;
            }
        }
        if constexpr (ALIGN_EPI) { if (wr == 0) PG8_BAR; }
        if constexpr (!Epi::AFTER_DRAIN) { E(acc, cur, wr, wc, fr, fq); S.done(cur); }
        if (!has_next) break;
#pragma unroll
        for (int a = 0; a < 2; ++a)
#pragma unroll
            for (int b = 0; b < 2; ++b)
#pragma unroll
                for (int m = 0; m < 4; ++m)
#pragma unroll
                    for (int n = 0; n < 2; ++n) acc[a][b][m][n] = (f32x4){0.f, 0.f, 0.f, 0.f};
        cur = nxt; cA = nA; cB = nB; ++ui;
        if constexpr (ALIGN_EPI) { if (wr == 1) PG8_BAR; }
    }
    PG8_WAIT_V(0);
    if constexpr (!ALIGN_EPI) { if (wr == 0) PG8_BAR; }
    PG8_BAR;
    if constexpr (Epi::AFTER_DRAIN) { E.fused(acc, cur, wr, wc, fr, fq, lds, wid, lane); S.done(cur); }
#undef PG8_SA
#undef PG8_SB
#undef PG8_STAGE
#undef PG8_LDA
#undef PG8_LDB
#undef PG8_MMA
#undef PG8_WAIT_V
#undef PG8_WAIT_L
#undef PG8_BAR
#undef PG8_SCHED
}
}
#define DI __device__ __forceinline__
#define LAS __attribute__((address_space(3)))
typedef unsigned short bf16;
typedef float f32x4 __attribute__((ext_vector_type(4)));
typedef float f32x2 __attribute__((ext_vector_type(2)));
typedef float f32x16 __attribute__((ext_vector_type(16)));
typedef short bf16x8 __attribute__((ext_vector_type(8)));
typedef unsigned u32x4 __attribute__((ext_vector_type(4)));
typedef unsigned u32x2 __attribute__((ext_vector_type(2)));
typedef __bf16 bf16x2_t __attribute__((ext_vector_type(2)));

constexpr int NWAVES = 8, NTHR = 512;
constexpr int BATCH = 2, SEQ = 8192, DM = 1024, DEPTH = 4, M = BATCH * SEQ, NCOL = 5120;
constexpr int NG = 32, NP = 64, NCH = SEQ / 64;
constexpr float EPS = 1e-6f;
constexpr size_t MiB = 1u << 20;
constexpr size_t WS_WIN = 32 * MiB, WS_WGLU = 42 * MiB, WS_WBS = 43 * MiB, WS_WBA = 44 * MiB, WS_WOUT = 45 * MiB;
constexpr size_t WS_H = 48 * MiB;
constexpr size_t WS_U = 80 * MiB, WS_ZS = 96 * MiB, WS_Q = 112 * MiB, WS_K = 128 * MiB, WS_VT = 144 * MiB, WS_ZA = 160 * MiB;
constexpr size_t WS_GS = 176 * MiB, WS_GA = 208 * MiB;
constexpr size_t WS_KTAB = 1 * MiB, KTAB_LSTRIDE = 1280 * 1024;
constexpr size_t WS_WTAB = 6 * MiB, WTAB_LSTRIDE = 2 * MiB;
constexpr size_t WS_VTAB = 6 * MiB, VTAB_LSTRIDE = 2 * MiB;
constexpr size_t WS_S = 14 * MiB, S_LSTRIDE = 4 * MiB;
constexpr size_t WS_LAM = 30 * MiB, LAM_LSTRIDE = 64 * 1024;
constexpr size_t WS_END = 240 * MiB;
constexpr int KTAB_BYTES = 65 * 512;
constexpr int LDS_BYTES = 147456;
constexpr float QSCALE = 0.125f * 1.4426950408889634f;

struct Args {
    const float* x; const float* pre_g; const float* post_g; const float* w_in; const float* a_re; const float* a_im; const float* log_dt;
    const float* b_re; const float* b_im; const float* c_re; const float* c_im; const float* d_skip; const float* w_glu; const float* b_glu;
    const float* w_bs; const float* w_ba; const float* w_out; float* out; unsigned char* ws;
};

DI unsigned cvtpk(float lo, float hi) { f32x2 v = {lo, hi}; bf16x2_t b = __builtin_convertvector(v, bf16x2_t); return __builtin_bit_cast(unsigned, b); }
DI float bflo(unsigned w) { return __uint_as_float(w << 16); }
DI float bfhi(unsigned w) { return __uint_as_float(w & 0xffff0000u); }
DI float bf1(bf16 b) { return __uint_as_float((unsigned)b << 16); }
DI float sigm(float x) { return __builtin_amdgcn_rcpf(1.0f + __expf(-x)); }
DI float silu(float x) { return x * sigm(x); }
DI float gelu_tanh(float x) { const float u = 1.5957691216057308f * (x + 0.044715f * x * x * x); return x * sigm(u); }
template <int CTRL> DI float dpp_step(float v) { return v + __builtin_bit_cast(float, __builtin_amdgcn_update_dpp(0, __builtin_bit_cast(int, v), CTRL, 0xf, 0xf, true)); }
DI float wave_sum(float v) {
    v = dpp_step<0xB1>(v); v = dpp_step<0x4E>(v); v = dpp_step<0x141>(v); v = dpp_step<0x140>(v);
    return ((__builtin_bit_cast(float, __builtin_amdgcn_readlane(__builtin_bit_cast(int, v), 0)) + __builtin_bit_cast(float, __builtin_amdgcn_readlane(__builtin_bit_cast(int, v), 16))) +
            (__builtin_bit_cast(float, __builtin_amdgcn_readlane(__builtin_bit_cast(int, v), 32)) + __builtin_bit_cast(float, __builtin_amdgcn_readlane(__builtin_bit_cast(int, v), 48))));
}

struct EpiProj {
    static constexpr bool PERM = true, AFTER_DRAIN = false;
    unsigned char* ws;
    DI void operator()(const pg8::f32x4 (&acc)[2][2][4][2], const pg8::Unit& u, int wr, int wc, int fr, int fq) const {
        const int pn = u.pn;
        bf16* base; int ld, colt; float sc = 1.f;
        if (pn < 12) { base = (bf16*)(ws + WS_U + (size_t)(pn >> 1) * (16 * MiB)); ld = 512; colt = (pn & 1) * 256; if ((pn >> 1) == 2) sc = QSCALE; }
        else if (pn < 16) { base = (bf16*)(ws + WS_GS); ld = 1024; colt = (pn - 12) * 256; }
        else { base = (bf16*)(ws + WS_GA); ld = 1024; colt = (pn - 16) * 256; }
        const int row0 = u.pm * 256 + wr * 64 + fr, col0 = colt + wc * 32 + 8 * fq;
        if ((pn >> 1) == 4) {
            bf16* vt = (bf16*)(ws + WS_VT);
#pragma unroll
            for (int ai = 0; ai < 2; ++ai)
#pragma unroll
                for (int m = 0; m < 4; ++m) { const int r = row0 + ai * 128 + m * 16; const int bb = r >> 13, t = r & 8191;
#pragma unroll
                    for (int bj = 0; bj < 2; ++bj) { bf16* p = vt + ((size_t)(bb * 512 + col0 + bj * 128)) * 8192 + t;
#pragma unroll
                        for (int n = 0; n < 2; ++n)
#pragma unroll
                            for (int e = 0; e < 4; ++e) { *p = (bf16)(cvtpk(acc[ai][bj][m][n][e], 0.f) & 0xffffu); p += 8192; asm volatile("" : "+v"(p)); } }
                    __builtin_amdgcn_sched_barrier(0); }
            return;
        }
#pragma unroll
        for (int ai = 0; ai < 2; ++ai)
#pragma unroll
            for (int m = 0; m < 4; ++m) { bf16* rowp = base + (size_t)(row0 + ai * 128 + m * 16) * ld + col0;
#pragma unroll
                for (int bj = 0; bj < 2; ++bj) { const pg8::f32x4 v0 = acc[ai][bj][m][0] * sc, v1 = acc[ai][bj][m][1] * sc;
                    u32x4 w; w.x = cvtpk(v0[0], v0[1]); w.y = cvtpk(v0[2], v0[3]); w.z = cvtpk(v1[0], v1[1]); w.w = cvtpk(v1[2], v1[3]);
                    *(u32x4*)(rowp + bj * 128) = w; } }
    }
};
struct EpiGlu {
    static constexpr bool PERM = true, AFTER_DRAIN = false;
    bf16* zs; const float* bias;
    DI void operator()(const pg8::f32x4 (&acc)[2][2][4][2], const pg8::Unit& u, int wr, int wc, int fr, int fq) const {
        const int row0 = u.pm * 256 + wr * 64 + fr, col0 = u.pn * 128 + wc * 32 + 8 * fq;
        f32x4 ba0 = *(const f32x4*)(bias + col0), ba1 = *(const f32x4*)(bias + col0 + 4), bb0 = *(const f32x4*)(bias + 512 + col0), bb1 = *(const f32x4*)(bias + 512 + col0 + 4);
        u32x4 zv[2][4];
#pragma unroll
        for (int ai = 0; ai < 2; ++ai)
#pragma unroll
            for (int m = 0; m < 4; ++m) zv[ai][m] = *(const u32x4*)(zs + (size_t)(row0 + ai * 128 + m * 16) * 512 + col0);
        __builtin_amdgcn_sched_barrier(0);
#pragma unroll
        for (int ai = 0; ai < 2; ++ai)
#pragma unroll
            for (int m = 0; m < 4; ++m) { bf16* p = zs + (size_t)(row0 + ai * 128 + m * 16) * 512 + col0;
                const u32x4 z = zv[ai][m]; float zf[8] = {bflo(z.x), bfhi(z.x), bflo(z.y), bfhi(z.y), bflo(z.z), bfhi(z.z), bflo(z.w), bfhi(z.w)}; float y[8];
#pragma unroll
                for (int e = 0; e < 4; ++e) {
                    y[e] = (acc[ai][0][m][0][e] + ba0[e]) * zf[e] * __builtin_amdgcn_rcpf((1.0f + __expf(-(acc[ai][1][m][0][e] + bb0[e]))) * (1.0f + __expf(-zf[e])));
                    y[4 + e] = (acc[ai][0][m][1][e] + ba1[e]) * zf[4 + e] * __builtin_amdgcn_rcpf((1.0f + __expf(-(acc[ai][1][m][1][e] + bb1[e]))) * (1.0f + __expf(-zf[4 + e]))); }
                u32x4 w; w.x = cvtpk(y[0], y[1]); w.y = cvtpk(y[2], y[3]); w.z = cvtpk(y[4], y[5]); w.w = cvtpk(y[6], y[7]); *(u32x4*)p = w; }
    }
};
template <int PASS> struct EpiBranch {
    static constexpr bool PERM = true, AFTER_DRAIN = false;
    bf16* G; const bf16* gate2;
    DI void operator()(const pg8::f32x4 (&acc)[2][2][4][2], const pg8::Unit& u, int wr, int wc, int fr, int fq) const {
        const int row0 = u.pm * 256 + wr * 64 + fr, col0 = u.pn * 256 + wc * 32 + 8 * fq;
#pragma unroll
        for (int ai = 0; ai < 2; ++ai)
#pragma unroll
          for (int mh = 0; mh < 2; ++mh) {
            u32x4 gv[2][2], hv[2][2];
#pragma unroll
            for (int mm = 0; mm < 2; ++mm)
#pragma unroll
                for (int bj = 0; bj < 2; ++bj) { const int m = 2 * mh + mm; const size_t off = (size_t)(row0 + ai * 128 + m * 16) * 1024 + col0 + bj * 128; gv[mm][bj] = *(const u32x4*)(G + off); if (PASS == 1) hv[mm][bj] = *(const u32x4*)(gate2 + off); }
            __builtin_amdgcn_sched_barrier(0);
#pragma unroll
            for (int mm = 0; mm < 2; ++mm)
#pragma unroll
                for (int bj = 0; bj < 2; ++bj) { const int m = 2 * mh + mm; const size_t off = (size_t)(row0 + ai * 128 + m * 16) * 1024 + col0 + bj * 128;
                    const u32x4 g = gv[mm][bj]; float gf[8] = {bflo(g.x), bfhi(g.x), bflo(g.y), bfhi(g.y), bflo(g.z), bfhi(g.z), bflo(g.w), bfhi(g.w)}; float y[8];
                    if (PASS == 0) {
#pragma unroll
                        for (int e = 0; e < 4; ++e) { y[e] = sigm(gf[e]) * acc[ai][bj][m][0][e]; y[4 + e] = sigm(gf[4 + e]) * acc[ai][bj][m][1][e]; }
                    } else {
                        const u32x4 h = hv[mm][bj]; float hf[8] = {bflo(h.x), bfhi(h.x), bflo(h.y), bfhi(h.y), bflo(h.z), bfhi(h.z), bflo(h.w), bfhi(h.w)};
#pragma unroll
                        for (int e = 0; e < 4; ++e) { y[e] = gf[e] + sigm(hf[e]) * acc[ai][bj][m][0][e]; y[4 + e] = gf[4 + e] + sigm(hf[4 + e]) * acc[ai][bj][m][1][e]; }
                    }
                    u32x4 w; w.x = cvtpk(y[0], y[1]); w.y = cvtpk(y[2], y[3]); w.z = cvtpk(y[4], y[5]); w.w = cvtpk(y[6], y[7]); *(u32x4*)(G + off) = w; }
            __builtin_amdgcn_sched_barrier(0);
          }
    }
};
struct EpiBranchBoth {
    static constexpr bool PERM = true, AFTER_DRAIN = false;
    bf16* G; const bf16* gate2;
    DI void operator()(const pg8::f32x4 (&acc)[2][2][4][2], const pg8::Unit& u, int wr, int wc, int fr, int fq) const {
        if (u.sel == 0) { EpiBranch<0> e{G, gate2}; e(acc, u, wr, wc, fr, fq); } else { EpiBranch<1> e{G, gate2}; e(acc, u, wr, wc, fr, fq); }
    }
};
struct EpiPlain {
    static constexpr bool PERM = true, AFTER_DRAIN = false;
    bf16* O;
    DI void operator()(const pg8::f32x4 (&acc)[2][2][4][2], const pg8::Unit& u, int wr, int wc, int fr, int fq) const {
        const int row0 = u.pm * 256 + wr * 64 + fr, col0 = u.pn * 256 + wc * 32 + 8 * fq;
#pragma unroll
        for (int ai = 0; ai < 2; ++ai)
#pragma unroll
            for (int m = 0; m < 4; ++m)
#pragma unroll
                for (int bj = 0; bj < 2; ++bj) { const pg8::f32x4 v0 = acc[ai][bj][m][0], v1 = acc[ai][bj][m][1];
                    u32x4 w; w.x = cvtpk(v0[0], v0[1]); w.y = cvtpk(v0[2], v0[3]); w.z = cvtpk(v1[0], v1[1]); w.w = cvtpk(v1[2], v1[3]);
                    *(u32x4*)(O + (size_t)(row0 + ai * 128 + m * 16) * 1024 + col0 + bj * 128) = w; }
    }
};

DI void norm_row(const float* xin, const bf16* o, const f32x4 (&gpo)[4], float* xout, bool has_pre, const f32x4 (&gpr)[4], bf16* h, int lane) {
    f32x4 v[4];
#pragma unroll
    for (int j = 0; j < 4; ++j) v[j] = __builtin_nontemporal_load((const f32x4*)xin + lane + 64 * j);
    if (o) {
        f32x4 ov[4]; float ss = 0.f;
#pragma unroll
        for (int j = 0; j < 4; ++j) { const u32x2 w = __builtin_nontemporal_load((const u32x2*)o + lane + 64 * j); ov[j] = (f32x4){bflo(w.x), bfhi(w.x), bflo(w.y), bfhi(w.y)};
            ss += (ov[j].x * ov[j].x + ov[j].y * ov[j].y) + (ov[j].z * ov[j].z + ov[j].w * ov[j].w); }
        const float rstd = __builtin_amdgcn_rsqf(wave_sum(ss) * (1.0f / DM) + EPS);
#pragma unroll
        for (int j = 0; j < 4; ++j) { v[j] = v[j] + ov[j] * rstd * gpo[j]; __builtin_nontemporal_store(v[j], (f32x4*)xout + lane + 64 * j); }
    }
    if (has_pre) {
        float ss = 0.f;
#pragma unroll
        for (int j = 0; j < 4; ++j) ss += (v[j].x * v[j].x + v[j].y * v[j].y) + (v[j].z * v[j].z + v[j].w * v[j].w);
        const float rstd = __builtin_amdgcn_rsqf(wave_sum(ss) * (1.0f / DM) + EPS);
#pragma unroll
        for (int j = 0; j < 4; ++j) { const f32x4 y = v[j] * rstd * gpr[j];
            u32x2 w; w.x = cvtpk(y.x, y.y); w.y = cvtpk(y.z, y.w); *((u32x2*)h + lane + 64 * j) = w; }
    }
}
DI void transpose_item(const float* W, int K, int N, bf16* WT, int k0, int n0, int dst_row0, LAS float* scr, int lane) {
#pragma unroll 8
    for (int i = 0; i < 32; ++i) { const int kk = 2 * i + (lane >> 5); scr[kk * 33 + (lane & 31)] = W[(size_t)(k0 + kk) * N + n0 + (lane & 31)]; }
    asm volatile("s_waitcnt lgkmcnt(0)" ::: "memory");
    const int c = lane & 7;
#pragma unroll
    for (int j = 0; j < 4; ++j) { const int n = (lane >> 3) + 8 * j; const LAS float* s = scr + (8 * c) * 33 + n;
        u32x4 o; o.x = cvtpk(s[0 * 33], s[1 * 33]); o.y = cvtpk(s[2 * 33], s[3 * 33]); o.z = cvtpk(s[4 * 33], s[5 * 33]); o.w = cvtpk(s[6 * 33], s[7 * 33]);
        *(u32x4*)(WT + (size_t)(dst_row0 + n) * K + k0 + 8 * c) = o; }
    asm volatile("s_waitcnt lgkmcnt(0)" ::: "memory");
}
DI f32x2 cpow_k(float are, float aim, float dt, int k) {
    const float mag = __expf(are * dt * (float)k);
    const double turns = (double)aim * (double)dt * (double)k * 0.15915494309189535;
    const float fr = (float)(turns - floor(turns));
    return (f32x2){mag * __builtin_amdgcn_cosf(fr), mag * __builtin_amdgcn_sinf(fr)};
}
DI f32x2 cmul(f32x2 a, f32x2 b) { return (f32x2){a.x * b.x - a.y * b.y, a.x * b.y + a.y * b.x}; }
DI f32x2 zoh_factor(float are, float aim, float dt) {
    const f32x2 ab = cpow_k(are, aim, dt, 1); const float nr = ab.x - 1.0f, ni = ab.y, den = are * are + aim * aim;
    return (f32x2){(nr * are + ni * aim) / den, (ni * are - nr * aim) / den};
}

struct LayerP { const float *a_re, *a_im, *log_dt, *b_re, *b_im, *c_re, *c_im; };

DI void ktab_block(const LayerP& P, bf16* KTAB, int g, int tb, LAS unsigned char* lds, int tid) {
    LAS f32x2* CL = (LAS f32x2*)lds;
    LAS f32x2* BB = (LAS f32x2*)(lds + 16384);
    const float dt = __expf(P.log_dt[g]);
    const int p = tid & 63, h0 = tid >> 6, h1 = h0 + 8;
    const float are = P.a_re[g * 64 + p], aim = P.a_im[g * 64 + p];
    const f32x2 c0 = {P.c_re[(g * 16 + h0) * 64 + p], P.c_im[(g * 16 + h0) * 64 + p]}, c1 = {P.c_re[(g * 16 + h1) * 64 + p], P.c_im[(g * 16 + h1) * 64 + p]};
    const int e0 = tid, e1 = tid + NTHR; const int pa = e0 >> 4, pb = e1 >> 4, hp = tid & 15;
    const float area = P.a_re[g * 64 + pa], aima = P.a_im[g * 64 + pa], areb = P.a_re[g * 64 + pb], aimb = P.a_im[g * 64 + pb];
    const f32x2 bva = {P.b_re[(g * 64 + pa) * 16 + hp], P.b_im[(g * 64 + pa) * 16 + hp]}, bvb = {P.b_re[(g * 64 + pb) * 16 + hp], P.b_im[(g * 64 + pb) * 16 + hp]};
    BB[pa * 16 + hp] = cmul(zoh_factor(area, aima, dt), bva); BB[pb * 16 + hp] = cmul(zoh_factor(areb, aimb, dt), bvb);
    if (tb == 0 && tid < 256) KTAB[((size_t)g * 65) * 256 + tid] = 0;
#pragma unroll 1
    for (int tp = 0; tp < 4; ++tp) { const int tau0 = tb * 8 + 2 * tp;
        const f32x2 l0 = cpow_k(are, aim, dt, tau0), l1 = cpow_k(are, aim, dt, tau0 + 1);
        CL[(0 * 16 + h0) * 64 + p] = cmul(c0, l0); CL[(0 * 16 + h1) * 64 + p] = cmul(c1, l0); CL[(1 * 16 + h0) * 64 + p] = cmul(c0, l1); CL[(1 * 16 + h1) * 64 + p] = cmul(c1, l1);
        __syncthreads();
        { const int ts = tid >> 8, h = (tid >> 4) & 15; float sacc = 0.f;
#pragma unroll 8
          for (int q = 0; q < 64; ++q) { const f32x2 c = CL[(ts * 16 + h) * 64 + q], bq = BB[q * 16 + hp]; sacc += c.x * bq.x - c.y * bq.y; }
          KTAB[((size_t)g * 65 + (tau0 + ts + 1)) * 256 + h * 16 + hp] = (bf16)(cvtpk(sacc, 0.f) & 0xffffu); }
        __syncthreads();
    }
}
DI void wv_item(const LayerP& P, bf16* WTAB, bf16* VTAB, float* LAM, int idx) {
    const int p = idx & 63, k = (idx >> 6) & 15, g = idx >> 10;
    const float dt = __expf(P.log_dt[g]), are = P.a_re[g * 64 + p], aim = P.a_im[g * 64 + p];
    f32x2 cv[16];
#pragma unroll
    for (int j = 0; j < 16; ++j) cv[j] = (f32x2){P.c_re[(g * 16 + j) * 64 + p], P.c_im[(g * 16 + j) * 64 + p]};
    const f32x2 lk1 = cpow_k(are, aim, dt, k + 1);
#pragma unroll
    for (int h = 0; h < 16; ++h) { const f32x2 c = cmul(cv[h], lk1); *(unsigned*)(VTAB + ((size_t)g * 256 + k * 16 + h) * 128 + 2 * p) = cvtpk(c.x, -c.y); }
    if (k == 15) { const f32x2 l64 = cpow_k(are, aim, dt, 64); *(f32x4*)(LAM + (g * 64 + p) * 4) = (f32x4){l64.x, l64.y, lk1.x, lk1.y}; }
}

#define MFMA16(a, b, c) __builtin_amdgcn_mfma_f32_16x16x32_bf16((a), (b), (c), 0, 0, 0)
#define MFMA32(a, b, c) __builtin_amdgcn_mfma_f32_32x32x16_bf16((a), (b), (c), 0, 0, 0)
DI void make_wfrag(const LayerP& P, int g, int wave, int lane, bf16x8 (&af)[8], f32x2& l16a, f32x2& l16b) {
    const int n = lane & 15, kg = lane >> 4, p = 8 * wave + (n >> 1), ri = n & 1;
    const float dt = __expf(P.log_dt[g]), are = P.a_re[g * 64 + p], aim = P.a_im[g * 64 + p];
    const int pa = 8 * wave + 2 * kg;
    const float area = P.a_re[g * 64 + pa], aima = P.a_im[g * 64 + pa], areb = P.a_re[g * 64 + pa + 1], aimb = P.a_im[g * 64 + pa + 1];
    const f32x4 br0 = *(const f32x4*)(P.b_re + (g * 64 + p) * 16 + 8 * (kg & 1)), br1 = *(const f32x4*)(P.b_re + (g * 64 + p) * 16 + 8 * (kg & 1) + 4);
    const f32x4 bi0 = *(const f32x4*)(P.b_im + (g * 64 + p) * 16 + 8 * (kg & 1)), bi1 = *(const f32x4*)(P.b_im + (g * 64 + p) * 16 + 8 * (kg & 1) + 4);
    const f32x2 f = zoh_factor(are, aim, dt);
    f32x2 fb[8];
#pragma unroll
    for (int i = 0; i < 4; ++i) { fb[i] = cmul(f, (f32x2){br0[i], bi0[i]}); fb[4 + i] = cmul(f, (f32x2){br1[i], bi1[i]}); }
#pragma unroll
    for (int ks = 0; ks < 8; ++ks) { const f32x2 lp = cpow_k(are, aim, dt, 15 - 2 * ks - (kg >> 1)); float v[8];
#pragma unroll
        for (int i = 0; i < 8; ++i) { const f32x2 c = cmul(lp, fb[i]); v[i] = ri ? c.y : c.x; }
        const u32x4 w = {cvtpk(v[0], v[1]), cvtpk(v[2], v[3]), cvtpk(v[4], v[5]), cvtpk(v[6], v[7])}; af[ks] = __builtin_bit_cast(bf16x8, w); }
    l16a = cpow_k(area, aima, dt, 16); l16b = cpow_k(areb, aimb, dt, 16);
}
DI void ssm_state_unit(const bf16* U, const bf16x8 (&af)[8], f32x2 l16a, f32x2 l16b, float* S, int b, int g, int cb, int wave, int lane) {
    const int n = lane & 15, kg = lane >> 4;
    const bf16* up = U + ((size_t)b * SEQ + (size_t)(cb * 16 + n) * 64 + (kg >> 1)) * 512 + g * 16 + 8 * (kg & 1);
    bf16x8 uf[4][8];
#pragma unroll
    for (int a = 0; a < 4; ++a)
#pragma unroll
        for (int ks = 0; ks < 8; ++ks) uf[a][ks] = *(const bf16x8*)(up + (size_t)(16 * a + 2 * ks) * 512);
    __builtin_amdgcn_sched_barrier(0);
    pg8::f32x4 acc4[4];
#pragma unroll
    for (int a = 0; a < 4; ++a) acc4[a] = (pg8::f32x4){0.f, 0.f, 0.f, 0.f};
#pragma unroll
    for (int ks = 0; ks < 8; ++ks)
#pragma unroll
        for (int a = 0; a < 4; ++a) acc4[a] = MFMA16(af[ks], uf[a][ks], acc4[a]);
    __builtin_amdgcn_sched_barrier(0);
    pg8::f32x4 st = acc4[0];
#pragma unroll
    for (int a = 1; a < 4; ++a) {
        const f32x2 s0 = cmul(l16a, (f32x2){st[0], st[1]}), s1 = cmul(l16b, (f32x2){st[2], st[3]});
        st = (pg8::f32x4){s0.x + acc4[a][0], s0.y + acc4[a][1], s1.x + acc4[a][2], s1.y + acc4[a][3]};
    }
    *(pg8::f32x4*)(S + (((size_t)b * NCH + cb * 16 + n) * NG + g) * 128 + 16 * wave + 4 * kg) = st;
}
constexpr int XIN_OFF = 33280, XIN_PITCH = 272, XIN_VAR = 16 * XIN_PITCH, TB_OFF = XIN_OFF + 4 * XIN_VAR, UL_OFF = 57344, UL_PITCH = 2064;
template <int S> DI void toe_stage(pg8::f32x4 (&acc)[8], const LAS unsigned char* ul, const LAS unsigned char* kt, int wave, int lo, int hi) {
#pragma unroll 1
    for (int ks = lo; ks <= hi; ++ks) {
        const bf16x8 uf0 = *(const LAS bf16x8*)(ul + ks * 64);
        bf16x8 a0[8 - S];
#pragma unroll
        for (int j = S; j < 8; ++j) a0[j - S] = *(const LAS bf16x8*)(kt + (wave + 8 * j - 2 * ks) * 512);
        __builtin_amdgcn_sched_barrier(0);
#pragma unroll
        for (int j = S; j < 8; ++j) acc[j] = MFMA16(a0[j - S], uf0, acc[j]);
    }
}
#ifdef PROBE_SEL
#define QS(sel) do { if (PROBE_SEL == (sel)) tq0 = __builtin_amdgcn_s_memrealtime(); } while (0)
#define QT(sel) do { if (PROBE_SEL == (sel)) tqacc += __builtin_amdgcn_s_memrealtime() - tq0; } while (0)
#else
#define QS(sel) do {} while (0)
#define QT(sel) do {} while (0)
#endif
DI void ssm_out_unit(unsigned long long& tqacc, bool load_ktab, const bf16* U, const bf16* KTAB, const bf16* VTAB, const float* S, const float* LAM, const float* dsk, bf16* YS, int b, int g, int cb, LAS unsigned char* lds, int tid, int wave, int lane) {
    unsigned long long tq0 = 0ull; (void)tq0;
    const int n = lane & 15, kg = lane >> 4;
    QS(51);
    const f32x4 lam4 = *(const f32x4*)(LAM + (g * 64 + lane) * 4); const f32x2 lam = {lam4.x, lam4.y}, l16 = {lam4.z, lam4.w};
    f32x2 sv[16];
    {
        const u32x4* src = (const u32x4*)((const unsigned char*)KTAB + (size_t)g * KTAB_BYTES);
        u32x4 kt4[4], kt5 = {0u, 0u, 0u, 0u}, ut4[4];
        if (load_ktab) {
#pragma unroll
            for (int j = 0; j < 4; ++j) kt4[j] = src[tid + NTHR * j];
            if (tid < 32) kt5 = src[2048 + tid];
        }
#pragma unroll
        for (int j = 0; j < 4; ++j) { const int idx = tid + NTHR * j, cn = idx >> 7, tok = (idx >> 1) & 63, half = idx & 1;
            ut4[j] = *(const u32x4*)(U + ((size_t)b * SEQ + (size_t)(cb * 16 + cn) * 64 + tok) * 512 + g * 16 + 8 * half); }
        if (wave <= cb) { const f32x2* sp = (const f32x2*)(S + (((size_t)b * NCH + wave * 16) * NG + g) * 128) + lane;
#pragma unroll
            for (int j = 0; j < 16; ++j) sv[j] = sp[(size_t)j * (NG * 64)]; }
        __builtin_amdgcn_sched_barrier(0);
        if (load_ktab) {
#pragma unroll
            for (int j = 0; j < 4; ++j) *(LAS u32x4*)(lds + 16 * (tid + NTHR * j)) = kt4[j];
            if (tid < 32) *(LAS u32x4*)(lds + 16 * (2048 + tid)) = kt5;
        }
#pragma unroll
        for (int j = 0; j < 4; ++j) { const int idx = tid + NTHR * j, cn = idx >> 7, tok = (idx >> 1) & 63, half = idx & 1; *(LAS u32x4*)(lds + UL_OFF + cn * UL_PITCH + tok * 32 + half * 16) = ut4[j]; }
    }
    bf16x8 vfr[4][2];
#pragma unroll
    for (int k2 = 0; k2 < 4; ++k2)
#pragma unroll
        for (int jj = 0; jj < 2; ++jj) vfr[k2][jj] = *(const bf16x8*)(VTAB + ((size_t)g * 256 + (wave + 8 * jj) * 16 + n) * 128 + 32 * k2 + 8 * kg);
    __builtin_amdgcn_sched_barrier(0);
    LAS f32x2* TB = (LAS f32x2*)(lds + TB_OFF);
    if (wave < cb) { f32x2 x = {0.f, 0.f};
#pragma unroll
        for (int j = 0; j < 16; ++j) { x = cmul(lam, x); x.x += sv[j].x; x.y += sv[j].y; }
        TB[wave * 64 + lane] = x; }
    __syncthreads();
    if (wave == cb) {
        f32x2 l1k = lam;
#pragma unroll
        for (int j = 0; j < 4; ++j) l1k = cmul(l1k, l1k);
        f32x2 x = {0.f, 0.f};
        for (int w = 0; w < cb; ++w) { const f32x2 t = TB[w * 64 + lane]; x = cmul(l1k, x); x.x += t.x; x.y += t.y; }
#pragma unroll
        for (int j = 0; j < 16; ++j) { f32x2 xa = x;
#pragma unroll
            for (int a = 0; a < 4; ++a) { *(LAS unsigned*)(lds + XIN_OFF + a * XIN_VAR + j * XIN_PITCH + 4 * lane) = cvtpk(xa.x, xa.y); xa = cmul(l16, xa); }
            x = cmul(lam, x); x.x += sv[j].x; x.y += sv[j].y; }
    }
    __syncthreads();
    QT(51); QS(52);
    pg8::f32x4 acc[8];
#pragma unroll
    for (int j = 0; j < 8; ++j) acc[j] = (pg8::f32x4){0.f, 0.f, 0.f, 0.f};
    const LAS unsigned char* ul = lds + UL_OFF + n * UL_PITCH + (kg >> 1) * 32 + (kg & 1) * 16;
    const LAS unsigned char* kt = lds + n * 32 + (kg & 1) * 16 + (1 - (kg >> 1)) * 512;
    { const int hw = wave >> 1;
      toe_stage<0>(acc, ul, kt, wave, 0, hw);            toe_stage<1>(acc, ul, kt, wave, hw + 1, hw + 4);   toe_stage<2>(acc, ul, kt, wave, hw + 5, hw + 8);   toe_stage<3>(acc, ul, kt, wave, hw + 9, hw + 12);
      toe_stage<4>(acc, ul, kt, wave, hw + 13, hw + 16); toe_stage<5>(acc, ul, kt, wave, hw + 17, hw + 20); toe_stage<6>(acc, ul, kt, wave, hw + 21, hw + 24); toe_stage<7>(acc, ul, kt, wave, hw + 25, hw + 28); }
#pragma unroll
    for (int k2 = 0; k2 < 4; ++k2) {
        bf16x8 xf[4];
#pragma unroll
        for (int a = 0; a < 4; ++a) xf[a] = *(const LAS bf16x8*)(lds + XIN_OFF + a * XIN_VAR + n * XIN_PITCH + (32 * k2 + 8 * kg) * 2);
#pragma unroll
        for (int j = 0; j < 8; ++j) acc[j] = MFMA16(vfr[k2][j & 1], xf[j >> 1], acc[j]); }
    QT(52); QS(53);
    const f32x4 dv = *(const f32x4*)(dsk + g * 16 + 4 * kg);
#pragma unroll
    for (int j = 0; j < 8; ++j) { const int t = wave + 8 * j; const size_t off = ((size_t)b * SEQ + (size_t)(cb * 16 + n) * 64 + t) * 512 + g * 16 + 4 * kg;
        const u32x2 uu = *(const LAS u32x2*)(lds + UL_OFF + n * UL_PITCH + t * 32 + kg * 8);
        const float y0 = gelu_tanh(acc[j][0] + dv[0] * bflo(uu.x)), y1 = gelu_tanh(acc[j][1] + dv[1] * bfhi(uu.x)), y2 = gelu_tanh(acc[j][2] + dv[2] * bflo(uu.y)), y3 = gelu_tanh(acc[j][3] + dv[3] * bfhi(uu.y));
        u32x2 w; w.x = cvtpk(y0, y1); w.y = cvtpk(y2, y3); *(u32x2*)(YS + off) = w; }
    asm volatile("s_waitcnt lgkmcnt(0)\n\ts_barrier" ::: "memory");
    QT(53);
}

struct AttnSt { f32x16 o0, o1; float carry; };
DI bool attn_tile(AttnSt& st, const bf16x8 (&kf)[4], const bf16x8 (&vf)[4], const bf16x8 (&qf)[4], bool diag, int n, int hi) {
    f32x16 s;
#pragma unroll
    for (int r = 0; r < 16; ++r) s[r] = 0.f;
#pragma unroll
    for (int ks = 0; ks < 4; ++ks) s = MFMA32(kf[ks], qf[ks], s);
    float sp[16];
#pragma unroll
    for (int r = 0; r < 16; ++r) { const float z = s[r]; const float e = __builtin_amdgcn_exp2f(-fabsf(z)); sp[r] = fmaxf(z, 0.f) + __builtin_amdgcn_logf(1.0f + e);
        if (diag && (16 * (r >> 3) + 8 * hi + (r & 7)) >= n) sp[r] = 0.f; }
    float cum[16]; float c0 = 0.f, c1 = 0.f;
#pragma unroll
    for (int r = 7; r >= 0; --r) { c0 -= sp[r]; cum[r] = c0; c1 -= sp[8 + r]; cum[8 + r] = c1; }
    const float p0 = __shfl_xor(c0, 32), p1 = __shfl_xor(c1, 32);
    const float base1 = st.carry + (hi ? 0.f : p1), base0 = st.carry + c1 + p1 + (hi ? 0.f : p0);
    float w[16];
#pragma unroll
    for (int r = 0; r < 16; ++r) { w[r] = __builtin_amdgcn_exp2f(s[r] + cum[r] + (r < 8 ? base0 : base1));
        if (diag && (16 * (r >> 3) + 8 * hi + (r & 7)) >= n) w[r] = 0.f; }
    st.carry += (c0 + c1) + (p0 + p1);
    const u32x4 pa = {cvtpk(w[0], w[1]), cvtpk(w[2], w[3]), cvtpk(w[4], w[5]), cvtpk(w[6], w[7])}, pb = {cvtpk(w[8], w[9]), cvtpk(w[10], w[11]), cvtpk(w[12], w[13]), cvtpk(w[14], w[15])};
    const bf16x8 pf0 = __builtin_bit_cast(bf16x8, pa), pf1 = __builtin_bit_cast(bf16x8, pb);
    st.o0 = MFMA32(pf0, vf[0], st.o0); st.o0 = MFMA32(pf1, vf[1], st.o0); st.o1 = MFMA32(pf0, vf[2], st.o1); st.o1 = MFMA32(pf1, vf[3], st.o1);
    return __ballot(st.carry >= -152.0f) == 0ull;
}
DI void attn_task(const bf16* Q, const bf16* Kb, const bf16* VT, const bf16* ZA, bf16* Y, int b, int h, int qt, int lane) {
    const int n = lane & 31, hi = lane >> 5;
    const size_t rowbase = (size_t)b * SEQ;
    bf16x8 qf[4];
    { const bf16* qp = Q + (rowbase + qt * 32 + n) * 512 + h * 64 + 8 * hi;
#pragma unroll
      for (int ks = 0; ks < 4; ++ks) qf[ks] = *(const bf16x8*)(qp + 16 * ks); }
    const int pm = (n & ~12) | (((n >> 2) & 1) << 3) | (((n >> 3) & 1) << 2);
    const bf16* kp = Kb + (rowbase + pm) * 512 + h * 64 + 8 * hi;
    const bf16* vp = VT + ((size_t)(b * 8 + h) * 64 + n) * SEQ + 8 * hi;
    AttnSt st;
#pragma unroll
    for (int r = 0; r < 16; ++r) { st.o0[r] = 0.f; st.o1[r] = 0.f; }
    st.carry = 0.f;
    bf16x8 kA[4], vA[4], kB[4], vB[4], kC[4], vC[4];
#define ATT_LOAD(KF, VF, ktile) do { const int key0_ = ((ktile) > 0 ? (ktile) : 0) * 32; \
        _Pragma("unroll") for (int ks = 0; ks < 4; ++ks) KF[ks] = *(const bf16x8*)(kp + (size_t)key0_ * 512 + 16 * ks); \
        VF[0] = *(const bf16x8*)(vp + key0_); VF[1] = *(const bf16x8*)(vp + key0_ + 16); VF[2] = *(const bf16x8*)(vp + (size_t)32 * SEQ + key0_); VF[3] = *(const bf16x8*)(vp + (size_t)32 * SEQ + key0_ + 16); } while (0)
    ATT_LOAD(kA, vA, qt); ATT_LOAD(kB, vB, qt - 1);
    int kt = qt;
    for (;;) {
        ATT_LOAD(kC, vC, kt - 2); __builtin_amdgcn_sched_barrier(0);
        if (attn_tile(st, kA, vA, qf, kt == qt, n, hi) || kt == 0) break; --kt; __builtin_amdgcn_sched_barrier(0);
        ATT_LOAD(kA, vA, kt - 2); __builtin_amdgcn_sched_barrier(0);
        if (attn_tile(st, kB, vB, qf, false, n, hi) || kt == 0) break; --kt; __builtin_amdgcn_sched_barrier(0);
        ATT_LOAD(kB, vB, kt - 2); __builtin_amdgcn_sched_barrier(0);
        if (attn_tile(st, kC, vC, qf, false, n, hi) || kt == 0) break; --kt; __builtin_amdgcn_sched_barrier(0);
    }
#undef ATT_LOAD
    float za0[16], za1[16];
#pragma unroll
    for (int r = 0; r < 16; ++r) { const int i = (r & 3) + 8 * (r >> 2) + 4 * hi; const size_t off = (rowbase + qt * 32 + i) * 512 + h * 64 + n; za0[r] = bf1(ZA[off]); za1[r] = bf1(ZA[off + 32]); }
    __builtin_amdgcn_sched_barrier(0);
#pragma unroll
    for (int r = 0; r < 16; ++r) { const int i = (r & 3) + 8 * (r >> 2) + 4 * hi; const size_t off = (rowbase + qt * 32 + i) * 512 + h * 64 + n;
        Y[off] = (bf16)(cvtpk(st.o0[r] * silu(za0[r]), 0.f) & 0xffffu); Y[off + 32] = (bf16)(cvtpk(st.o1[r] * silu(za1[r]), 0.f) & 0xffffu); }
}
#define XB_TMO      128
#define XB_XCNT(j)  (256  + 64 * (j))
#define XB_XSUB(j)  (1280 + 64 * (j))
#define XB_XGEN(j)  (2304 + 64 * (j))
#define XB_TOP      3328
#define XB_TOPGEN   3392
#define XCD_BAR_WORDS 3456
#define XB_SPIN_CAP (1u << 18)

__device__ __forceinline__ unsigned xb_ld(unsigned* p)              { return __hip_atomic_load(p, __ATOMIC_RELAXED, __HIP_MEMORY_SCOPE_AGENT); }
__device__ __forceinline__ unsigned xb_add(unsigned* p, unsigned v) { return __hip_atomic_fetch_add(p, v, __ATOMIC_RELAXED, __HIP_MEMORY_SCOPE_AGENT); }
__device__ __forceinline__ unsigned xb_xcc_id() { return (unsigned)__builtin_amdgcn_s_getreg((3 << 11) | 20) & 0xFu; }
#define XB_SPIN(cond, bar) do { unsigned _sp = 0; while (cond) { __builtin_amdgcn_s_sleep(1); \
    if ((++_sp & 255u) == 0u) { if (xb_ld(&(bar)[XB_TMO])) break; if (_sp > XB_SPIN_CAP) { atomicAdd(&(bar)[XB_TMO], 1u); break; } } } } while (0)

struct XcdBarrier {
    unsigned* bar; unsigned x;
    volatile LAS unsigned* st;
};

__device__ __forceinline__ XcdBarrier xcd_barrier_post(unsigned* bar, volatile LAS unsigned* st) {
    XcdBarrier b; b.bar = bar; b.x = xb_xcc_id(); b.st = st;
    if (threadIdx.x == 0) (void)xb_add(&bar[XB_XCNT(b.x)], 1u);
    return b;
}
__device__ __forceinline__ void xcd_barrier_complete(unsigned* bar, unsigned x, unsigned& nloc, unsigned& nx) {
    const unsigned G = gridDim.x * gridDim.y * gridDim.z;
    unsigned sum, cnt, mine, sp = 0u;
    for (;;) {
        sum = 0u; cnt = 0u; mine = 0u;
#pragma unroll
        for (unsigned j = 0; j < 16; ++j) { const unsigned c = xb_ld(&bar[XB_XCNT(j)]); sum += c; cnt += (c > 0u) ? 1u : 0u; mine = (j == x) ? c : mine; }
        if (sum == G) break;
        __builtin_amdgcn_s_sleep(1);
        if ((++sp & 255u) == 0u) { if (xb_ld(&bar[XB_TMO])) break; if (sp > XB_SPIN_CAP) { atomicAdd(&bar[XB_TMO], 1u); break; } }
    }
    nloc = mine > 0u ? mine : 1u; nx = cnt > 0u ? cnt : 1u;
}

__device__ __forceinline__ void xcd_barrier(const XcdBarrier& b) {
    asm volatile("s_waitcnt vmcnt(0)" ::: "memory");
    __syncthreads();
    if (threadIdx.x == 0) {
        unsigned* bar = b.bar;
        __builtin_amdgcn_s_waitcnt(0);
        unsigned nloc = b.st[0], nx = b.st[1];
        if (nloc == 0u) { xcd_barrier_complete(bar, b.x, nloc, nx); b.st[0] = nloc; b.st[1] = nx; }
        const unsigned old = xb_add(&bar[XB_XSUB(b.x)], 1u);
        const unsigned gen = old / nloc;
        if (old + 1u == (gen + 1u) * nloc) {
            __builtin_amdgcn_fence(__ATOMIC_RELEASE, "agent");
            asm volatile("s_waitcnt vmcnt(0)" ::: "memory");
            const unsigned og = xb_add(&bar[XB_TOP], 1u);
            const unsigned tg = og / nx;
            if (og + 1u == (tg + 1u) * nx) xb_add(&bar[XB_TOPGEN], 1u);
            else XB_SPIN(xb_ld(&bar[XB_TOPGEN]) == tg, bar);
            __builtin_amdgcn_fence(__ATOMIC_ACQUIRE, "agent");
            xb_add(&bar[XB_XGEN(b.x)], 1u);
            asm volatile("s_waitcnt vmcnt(0)" ::: "memory");
        } else {
            XB_SPIN(xb_ld(&bar[XB_XGEN(b.x)]) == gen, bar);
            __builtin_amdgcn_fence(__ATOMIC_ACQUIRE, "agent");
            asm volatile("s_waitcnt vmcnt(0)" ::: "memory");
        }
    }
    __syncthreads();
}

__device__ __forceinline__ void xcd_barrier1(const XcdBarrier& b) {
    asm volatile("s_waitcnt vmcnt(0)" ::: "memory");
    __syncthreads();
    if (threadIdx.x == 0) {
        unsigned* bar = b.bar;
        __builtin_amdgcn_s_waitcnt(0);
        unsigned nloc = b.st[0], nx = b.st[1];
        if (nloc == 0u) { xcd_barrier_complete(bar, b.x, nloc, nx); b.st[0] = nloc; b.st[1] = nx; }
        const unsigned k = b.st[2]; b.st[2] = k + 1u;
        const unsigned old = xb_add(&bar[XB_XSUB(b.x)], 1u);
        const unsigned gen = old / nloc;
        if (old + 1u == (gen + 1u) * nloc) {
            __builtin_amdgcn_fence(__ATOMIC_RELEASE, "agent");
            asm volatile("s_waitcnt vmcnt(0)" ::: "memory");
            const unsigned og = xb_add(&bar[XB_TOP], 1u);
            if (og + 1u == (k + 1u) * nx) xb_add(&bar[XB_TOPGEN], 1u);
            else XB_SPIN(xb_ld(&bar[XB_TOPGEN]) == k, bar);
        } else {
            XB_SPIN(xb_ld(&bar[XB_TOPGEN]) == k, bar);
        }
        __builtin_amdgcn_fence(__ATOMIC_ACQUIRE, "agent");
        asm volatile("s_waitcnt vmcnt(0)" ::: "memory");
    }
    __syncthreads();
}
__global__ void __launch_bounds__(NTHR, 2) hybrid_fwd(Args a) {
    extern __shared__ __attribute__((aligned(16))) unsigned char lds_raw[];
    LAS unsigned char* lds = (LAS unsigned char*)lds_raw;
    cg::grid_group grid = cg::this_grid();
#ifdef EXP_INVL2
    if (threadIdx.x == 0) asm volatile("buffer_inv sc0 sc1\n\ts_waitcnt vmcnt(0)" ::: "memory");
    __syncthreads();
#endif
    volatile LAS unsigned* xb_st = (volatile LAS unsigned*)(lds + 131072 + 1024);
    if (threadIdx.x < 3) xb_st[threadIdx.x] = 0u;
    __syncthreads();
    if (blockIdx.x == 0) for (int i = threadIdx.x; i < 4096; i += NTHR) __hip_atomic_store((unsigned*)a.ws + i, 0u, __ATOMIC_RELAXED, __HIP_MEMORY_SCOPE_AGENT);
    XcdBarrier xbar; xbar.bar = (unsigned*)a.ws; xbar.x = 0; xbar.st = xb_st;
    const int tid0 = threadIdx.x, wave = __builtin_amdgcn_readfirstlane(tid0 >> 6);
    const int G = gridDim.x, bx = blockIdx.x;
    const int gw = bx * NWAVES + wave, NGW = G * NWAVES;
    unsigned char* ws = a.ws;
    bf16* const Win = (bf16*)(ws + WS_WIN); bf16* const Wglu = (bf16*)(ws + WS_WGLU); bf16* const Wbs = (bf16*)(ws + WS_WBS); bf16* const Wba = (bf16*)(ws + WS_WBA); bf16* const Wout = (bf16*)(ws + WS_WOUT);
    bf16* const Hb = (bf16*)(ws + WS_H); bf16* const Ub = (bf16*)(ws + WS_U); bf16* const ZSb = (bf16*)(ws + WS_ZS); bf16* const Qb = (bf16*)(ws + WS_Q); bf16* const Kb = (bf16*)(ws + WS_K);
    bf16* const VTb = (bf16*)(ws + WS_VT); bf16* const ZAb = (bf16*)(ws + WS_ZA); bf16* const GSb = (bf16*)(ws + WS_GS); bf16* const GAb = (bf16*)(ws + WS_GA);


    unsigned long long tqa = 0ull;
#ifdef PROBE_SEL
    unsigned long long tacc = 0ull, tbeg = 0ull;
#define PW(sel) do { if (PROBE_SEL == (sel) + 10) tacc += __builtin_amdgcn_s_memrealtime() - tbeg; if (PROBE_SEL == (sel) + 20) tbeg = __builtin_amdgcn_s_memrealtime(); } while (0)
#define PS(sel) do { if (PROBE_SEL == (sel)) tbeg = __builtin_amdgcn_s_memrealtime(); } while (0)
#define PT(sel) do { if (PROBE_SEL == (sel)) tacc += __builtin_amdgcn_s_memrealtime() - tbeg; } while (0)
#define PB(sel) do { if (PROBE_SEL == (sel) || PROBE_SEL == (sel) + 10) tbeg = __builtin_amdgcn_s_memrealtime(); } while (0)
#define PE(sel) do { if (PROBE_SEL == (sel) || PROBE_SEL == (sel) + 20) tacc += __builtin_amdgcn_s_memrealtime() - tbeg; } while (0)
#else
#define PB(sel) do {} while (0)
#define PW(sel) do {} while (0)
#define PS(sel) do {} while (0)
#define PT(sel) do {} while (0)
#define PE(sel) do {} while (0)
#endif
#define GSYNC() xcd_barrier1(xbar)
    PB(0);
    for (int l = 0; l <= DEPTH; ++l) {
        const int lt = l < DEPTH ? l : 0;
        bf16* const KTAB = (bf16*)(ws + WS_KTAB + lt * KTAB_LSTRIDE); bf16* const WTAB = (bf16*)(ws + WS_WTAB + lt * WTAB_LSTRIDE); bf16* const VTAB = (bf16*)(ws + WS_VTAB + lt * VTAB_LSTRIDE);
        float* const Sb = (float*)(ws + WS_S + lt * S_LSTRIDE); float* const LAM = (float*)(ws + WS_LAM + lt * LAM_LSTRIDE);
        int tid = tid0; asm volatile("" : "+v"(tid)); const int lane = tid & 63;
        PB(1);
        {
            const float* xin = (l <= 1) ? a.x : a.out;
        PS(43);
            { f32x4 gpo[4], gpr[4];
#pragma unroll
              for (int j = 0; j < 4; ++j) { gpo[j] = l > 0 ? *((const f32x4*)(a.post_g + (l - 1) * DM) + lane + 64 * j) : (f32x4){0.f, 0.f, 0.f, 0.f};
                                            gpr[j] = l < DEPTH ? *((const f32x4*)(a.pre_g + l * DM) + lane + 64 * j) : (f32x4){0.f, 0.f, 0.f, 0.f}; }
              for (int m = gw; m < M; m += NGW)
                  norm_row(xin + (size_t)m * DM, l > 0 ? GAb + (size_t)m * DM : nullptr, gpo, a.out + (size_t)m * DM, l < DEPTH, gpr, Hb + (size_t)m * DM, lane); }
        PT(43);
            if (l == DEPTH) { PE(1); break; }
            LAS float* scr = (LAS float*)(lds + wave * 16384);
            const float* w_in = a.w_in + (size_t)l * DM * NCOL; const float* w_glu = a.w_glu + (size_t)l * 512 * 1024; const float* w_bs = a.w_bs + (size_t)l * 512 * 1024;
            const float* w_ba = a.w_ba + (size_t)l * 512 * 1024; const float* w_out = a.w_out + (size_t)l * 1024 * 1024;
            constexpr int I_IN = 16 * 160, I_GLU = 8 * 32, I_BR = 8 * 32, I_OUT = 16 * 32, NITEMS = I_IN + I_GLU + 2 * I_BR + I_OUT;
        PS(44);
            for (int it = gw; it < NITEMS; it += NGW) {
                int r = it;
                if (r < I_IN) { const int kb = r / 160, nb = r % 160; transpose_item(w_in, 1024, NCOL, Win, 64 * kb, 32 * nb, 32 * nb, scr, lane); continue; } r -= I_IN;
                if (r < I_GLU) { const int kb = r / 32, nb = r % 32, n0 = 32 * nb; const int bj = n0 >> 9, rem = n0 & 511, pn = rem >> 7, i0 = rem & 127;
                    transpose_item(w_glu, 512, 1024, Wglu, 64 * kb, n0, 256 * pn + 128 * bj + i0, scr, lane); continue; } r -= I_GLU;
                if (r < I_BR) { const int kb = r / 32, nb = r % 32; transpose_item(w_bs, 512, 1024, Wbs, 64 * kb, 32 * nb, 32 * nb, scr, lane); continue; } r -= I_BR;
                if (r < I_BR) { const int kb = r / 32, nb = r % 32; transpose_item(w_ba, 512, 1024, Wba, 64 * kb, 32 * nb, 32 * nb, scr, lane); continue; } r -= I_BR;
                { const int kb = r / 32, nb = r % 32; transpose_item(w_out, 1024, 1024, Wout, 64 * kb, 32 * nb, 32 * nb, scr, lane); }
            }
            __syncthreads();
            PT(44);
            LayerP P{a.a_re + l * NG * NP, a.a_im + l * NG * NP, a.log_dt + l * NG, a.b_re + (size_t)l * NG * NP * 16, a.b_im + (size_t)l * NG * NP * 16, a.c_re + (size_t)l * NG * 16 * NP, a.c_im + (size_t)l * NG * 16 * NP};
        PS(45);
#ifndef NO_TAB
            for (int it = bx; it < NG * 8; it += G) ktab_block(P, KTAB, it >> 3, it & 7, lds, tid);
            for (int idx = bx * NTHR + tid; idx < NG * NP * 16; idx += G * NTHR) wv_item(P, WTAB, VTAB, LAM, idx);
#endif
        PT(45);
        }
        PW(1);
        if (l == 0) { grid.sync(); xbar = xcd_barrier_post((unsigned*)a.ws, xb_st); } else GSYNC();
        PE(1);
        PB(2);
#ifndef NO_A
        { pg8::Gemm g{Hb, Win, M, NCOL, DM}; pg8::StaticOrder S; S.init(M, NCOL, G, bx); EpiProj E{ws};
          pg8::gemm_phase<EpiProj, pg8::StaticOrder, true, true>(lds, g, S, E); }
#endif
        PW(2);
        GSYNC();
        PE(2);
        PB(3);
        PS(41);
#ifndef NO_B1
        for (int u0 = 2 * bx; u0 < 512; u0 += 2 * G) { const int g = u0 >> 4;
            LayerP P{a.a_re + l * NG * NP, a.a_im + l * NG * NP, a.log_dt + l * NG, a.b_re + (size_t)l * NG * NP * 16, a.b_im + (size_t)l * NG * NP * 16, a.c_re + (size_t)l * NG * 16 * NP, a.c_im + (size_t)l * NG * 16 * NP};
            bf16x8 af[8]; f32x2 l16a, l16b;
            make_wfrag(P, g, wave, lane, af, l16a, l16b);
            for (int q = 0; q < 2; ++q) { const int nb = (u0 + q) & 15; ssm_state_unit(Ub, af, l16a, l16b, Sb, nb >> 3, g, nb & 7, wave, lane); } }
#endif
        PT(41);
        PS(42);
#ifndef NO_ATTN
        for (int t = gw; t < 4096; t += NGW) attn_task(Qb, Kb, VTb, ZAb, Qb, t >> 11, (t >> 8) & 7, t & 255, lane);
#endif
        PT(42);
        PW(3);
        GSYNC();
        PE(3);
        PB(4);
#ifndef NO_B3
        for (int u = 2 * bx; u < 512; u += (u & 1) ? 2 * G - 1 : 1) { const int g = u >> 4, nb = u & 15; ssm_out_unit(tqa, (u & 1) == 0, Ub, KTAB, VTAB, Sb, LAM, a.d_skip + l * 512, Hb, nb >> 3, g, nb & 7, lds, tid, wave, lane); }
#endif
        PW(4);
        GSYNC();
        PE(4);
        PB(5);
#ifndef NO_D1
        { pg8::Gemm g{Hb, Wglu, M, 1024, 512}; pg8::StaticOrder S; S.init(M, 1024, G, bx); EpiGlu E{ZSb, a.b_glu + l * 1024};
          pg8::gemm_phase<EpiGlu, pg8::StaticOrder, true, true>(lds, g, S, E); }
#endif
        PW(5);
        GSYNC();
        PE(5);
#ifndef NO_D2
        PB(6);
        { pg8::Gemm g{ZSb, Wbs, M, 1024, 512, Qb, Wba}; pg8::ChainOrder S; S.B.init(M, 1024, G, bx); EpiBranchBoth E{GSb, GAb};
          pg8::gemm_phase<EpiBranchBoth, pg8::ChainOrder, true, true>(lds, g, S, E); }
#endif
        PW(6);
        GSYNC();
        PE(6);
#ifndef NO_D3
        PB(7);
        { pg8::Gemm g{GSb, Wout, M, 1024, 1024}; pg8::StaticOrder S; S.init(M, 1024, G, bx); EpiPlain E{GAb};
          pg8::gemm_phase<EpiPlain, pg8::StaticOrder, true, true>(lds, g, S, E); }
#endif
        PW(7);
        GSYNC();
        PE(7);
    }
    PE(0);
#ifdef PROBE_SEL
    grid.sync();
    if (bx == 0) { LAS unsigned long long* tb = (LAS unsigned long long*)lds; if (tid0 == 0) tb[0] = tacc + tqa; __syncthreads(); const unsigned long long K = tb[0] < 1000000ull ? tb[0] : 1000000ull;
        for (unsigned long long i = tid0; i < K; i += NTHR) a.out[i] += 0.05f; }
#endif
}

extern "C" void kernel_launch(void* const* d_in, const int* in_sizes, int n_in, void* d_out, int out_size, void* d_ws, size_t ws_size, hipStream_t stream) {
    static int grid = 0;
    if (grid == 0) {
        if (n_in != 17 || out_size != M * DM || ws_size < WS_END) { fprintf(stderr, "kernel_launch: unexpected problem shape (n_in %d, out %d, ws %zu)\n", n_in, out_size, ws_size); grid = -1; return; }
        int dev = 0, cus = 0, per_cu = 0;
        (void)hipGetDevice(&dev); (void)hipDeviceGetAttribute(&cus, hipDeviceAttributeMultiprocessorCount, dev);
        if (hipFuncSetAttribute((const void*)hybrid_fwd, hipFuncAttributeMaxDynamicSharedMemorySize, LDS_BYTES) != hipSuccess) { fprintf(stderr, "kernel_launch: hipFuncSetAttribute failed\n"); grid = -1; return; }
        if (hipOccupancyMaxActiveBlocksPerMultiprocessor(&per_cu, (const void*)hybrid_fwd, NTHR, LDS_BYTES) != hipSuccess || per_cu < 1) { fprintf(stderr, "kernel_launch: occupancy query gave %d\n", per_cu); per_cu = 1; }
        (void)hipGetLastError();
        grid = cus * per_cu;
    }
    if (grid < 0) return;
    Args a{};
    a.x = (const float*)d_in[0]; a.pre_g = (const float*)d_in[1]; a.post_g = (const float*)d_in[2]; a.w_in = (const float*)d_in[3]; a.a_re = (const float*)d_in[4]; a.a_im = (const float*)d_in[5];
    a.log_dt = (const float*)d_in[6]; a.b_re = (const float*)d_in[7]; a.b_im = (const float*)d_in[8]; a.c_re = (const float*)d_in[9]; a.c_im = (const float*)d_in[10]; a.d_skip = (const float*)d_in[11];
    a.w_glu = (const float*)d_in[12]; a.b_glu = (const float*)d_in[13]; a.w_bs = (const float*)d_in[14]; a.w_ba = (const float*)d_in[15]; a.w_out = (const float*)d_in[16];
    a.out = (float*)d_out; a.ws = (unsigned char*)d_ws;
    void* args[] = {&a};
    const hipError_t e = hipLaunchCooperativeKernel((const void*)hybrid_fwd, dim3(grid), dim3(NTHR), args, LDS_BYTES, stream);
    if (e != hipSuccess) fprintf(stderr, "kernel_launch: cooperative launch failed: %s (grid %d)\n", hipGetErrorString(e), grid);
}
```

```cpp
#include <hip/hip_runtime.h>
#include <hip/hip_cooperative_groups.h>
#include <cstdio>
#include <cstdint>
namespace cg = cooperative_groups;
namespace pg8 {
#define PG8_LAS __attribute__((address_space(3)))
typedef unsigned short bf16_t;
typedef short bf16x8 __attribute__((ext_vector_type(8)));
typedef float f32x4 __attribute__((ext_vector_type(4)));
typedef unsigned u32x4 __attribute__((ext_vector_type(4)));
constexpr int BM = 256, BK = 64, HALF = 128, HTB = HALF * BK * 2  , STAGE_BYTES = 8 * HTB, NXCD = 8, WGM = 8;

__host__ __device__ __forceinline__ int lds_byte(int r, int c) { const int st = (r >> 4) * 2 + (c >> 5), rr = r & 15, cc = c & 31, ob = rr * 64 + cc * 2; return st * 1024 + (ob ^ (((ob >> 9) & 1) << 5)); }
__host__ __device__ __forceinline__ void stage_rc(int b, int& R, int& C) { const int st = b / 1024, sb = b % 1024, swz = sb ^ (((sb >> 9) & 1) << 5); R = (st >> 1) * 16 + swz / 64; C = (st & 1) * 32 + (swz % 64) / 2; }
__host__ __device__ __forceinline__ int perm32(int rho) { const int n = rho >> 4, i = rho & 15; return 8 * (i >> 2) + 4 * n + (i & 3); }

struct Unit { int pm, pn, sel; };
struct Gemm { const bf16_t* A; const bf16_t* Bt; int M, N, K; const bf16_t* A2; const bf16_t* Bt2; };

struct StaticOrder {
    int nM, nN, nwg, G, c;
    __host__ __device__ void init(int M, int N, int G_, int c_) { nM = M / BM; nN = N / BM; nwg = nM * nN; G = G_; c = c_; }
    __host__ __device__ bool next(int i, Unit& u) const {
        const long L = (long)i * G + c; if (L >= nwg) return false;
        int wgid = (int)L; { const int q = nwg / NXCD, r = nwg % NXCD, xcd = wgid % NXCD, off = wgid / NXCD; wgid = (xcd < r ? xcd * (q + 1) : r * (q + 1) + (xcd - r) * q) + off; }
        const int nig = WGM * nN, gid = wgid / nig, fm = gid * WGM, gsz = (nM - fm) < WGM ? (nM - fm) : WGM;
        u.pm = fm + ((wgid % nig) % gsz); u.pn = (wgid % nig) / gsz; u.sel = 0; return true;
    }
    __device__ __forceinline__ void a_ready(const Unit&) const {}
    __device__ __forceinline__ void done(const Unit&) const {}
};
__device__ __forceinline__ unsigned cvt_pk_bf16(float lo, float hi) { unsigned r; asm volatile("v_cvt_pk_bf16_f32 %0, %1, %2" : "=v"(r) : "v"(lo), "v"(hi)); return r; }
typedef float f32x2 __attribute__((ext_vector_type(2)));
struct ChainOrder { StaticOrder B;
    __host__ __device__ bool next(int i, Unit& u) const { if (!B.next(i >> 1, u)) return false; u.sel = i & 1; return true; }
    __device__ __forceinline__ void a_ready(const Unit&) const {}
    __device__ __forceinline__ void done(const Unit&) const {}
};

template <class Epi, class Sched, bool ALIGN_EPI = false, bool SP2 = false>
__device__ __forceinline__ void gemm_phase(PG8_LAS unsigned char* lds, const Gemm g, const Sched& S, const Epi& E) {
    int tid_ = threadIdx.x; asm volatile("" : "+v"(tid_));
    const int tid = tid_, wid = __builtin_amdgcn_readfirstlane(tid >> 6), lane = tid & 63, wr = wid >> 2, wc = wid & 3, fr = lane & 15, fq = lane >> 4;
    const int K = g.K, nt = K / BK;
    unsigned voffA[2], voffB[2];
#pragma unroll
    for (int i = 0; i < 2; ++i) { int R, C; stage_rc(tid * 16 + i * 8192, R, C); const int Rb = Epi::PERM ? ((R & ~31) + perm32(R & 31)) : R;
        voffA[i] = (unsigned)(R * K + C) * 2u; voffB[i] = (unsigned)(Rb * K + C) * 2u; }
    const size_t kstep = (size_t)(BK * 2);
    const size_t hstep = (size_t)HALF * K * 2;
    const size_t tstep = 2 * hstep;
    const unsigned ldsw = (unsigned)wid * 1024u;
    const int aoff = lds_byte(wr * 64 + fr, fq * 8), boff = lds_byte(wc * 32 + fr, fq * 8);
#define PG8_SA(b, h) (((b) * 2 + (h)) * HTB)
#define PG8_SB(b, h) ((4 + (b) * 2 + (h)) * HTB)
#define PG8_STAGE(bufoff, gbase, voff) do { _Pragma("unroll") for (int _i = 0; _i < 2; ++_i) \
        __builtin_amdgcn_global_load_lds((const unsigned*)((const char*)(gbase) + (voff)[_i]), (PG8_LAS unsigned*)(lds + (bufoff) + ldsw + _i * 8192), 16, 0, 0); } while (0)
#define PG8_LDA(dst, b, h) do { _Pragma("unroll") for (int m = 0; m < 4; ++m) _Pragma("unroll") for (int k = 0; k < 2; ++k) dst[m][k] = *(const PG8_LAS bf16x8*)(lds + PG8_SA(b, h) + aoff + m * 2048 + k * 1024); } while (0)
#define PG8_LDB(dst, b, h) do { _Pragma("unroll") for (int n = 0; n < 2; ++n) _Pragma("unroll") for (int k = 0; k < 2; ++k) dst[n][k] = *(const PG8_LAS bf16x8*)(lds + PG8_SB(b, h) + boff + n * 2048 + k * 1024); } while (0)
#define PG8_MMA(ai, bj, At, Bt) do { __builtin_amdgcn_s_setprio(1); _Pragma("unroll") for (int m = 0; m < 4; ++m) _Pragma("unroll") for (int n = 0; n < 2; ++n) _Pragma("unroll") for (int k = 0; k < 2; ++k) \
        acc[ai][bj][m][n] = __builtin_amdgcn_mfma_f32_16x16x32_bf16(Bt[n][k], At[m][k], acc[ai][bj][m][n], 0, 0, 0); __builtin_amdgcn_s_setprio(0); } while (0)
#define PG8_WAIT_V(n) asm volatile("s_waitcnt vmcnt(" #n ")" ::: "memory")
#define PG8_WAIT_L(n) asm volatile("s_waitcnt lgkmcnt(" #n ")" ::: "memory")
#define PG8_BAR __builtin_amdgcn_s_barrier()
#define PG8_SCHED __builtin_amdgcn_sched_barrier(0)
    Unit cur, nxt; int ui = 0;
    if (!S.next(0, cur)) return;
    f32x4 acc[2][2][4][2];
#pragma unroll
    for (int a = 0; a < 2; ++a)
#pragma unroll
        for (int b = 0; b < 2; ++b)
#pragma unroll
            for (int m = 0; m < 4; ++m)
#pragma unroll
                for (int n = 0; n < 2; ++n) acc[a][b][m][n] = (f32x4){0.f, 0.f, 0.f, 0.f};
    bf16x8 At[4][2], B0[2][2], B1[2][2];
    const char* cA = (const char*)(cur.sel ? g.A2 : g.A) + (size_t)cur.pm * tstep; const char* cB = (const char*)(cur.sel ? g.Bt2 : g.Bt) + (size_t)cur.pn * tstep;
    S.a_ready(cur);
    if constexpr (SP2) {
        PG8_STAGE(PG8_SB(0, 0), cB, voffB); PG8_STAGE(PG8_SB(0, 1), cB + hstep, voffB); PG8_STAGE(PG8_SA(0, 0), cA, voffA); PG8_STAGE(PG8_SA(0, 1), cA + hstep, voffA);
        if (wr == 1) PG8_BAR;
        PG8_WAIT_V(2); PG8_BAR;
        PG8_STAGE(PG8_SB(1, 0), cB + kstep, voffB); PG8_STAGE(PG8_SA(1, 0), cA + kstep, voffA); PG8_STAGE(PG8_SB(1, 1), cB + hstep + kstep, voffB);
        PG8_WAIT_V(6); PG8_BAR;
    } else {
        PG8_STAGE(PG8_SB(0, 0), cB, voffB); PG8_STAGE(PG8_SA(0, 0), cA, voffA); PG8_STAGE(PG8_SB(0, 1), cB + hstep, voffB); PG8_STAGE(PG8_SA(0, 1), cA + hstep, voffA);
        if (wr == 1) PG8_BAR;
        PG8_WAIT_V(4); PG8_BAR;
        PG8_STAGE(PG8_SB(1, 0), cB + kstep, voffB); PG8_STAGE(PG8_SA(1, 0), cA + kstep, voffA); PG8_STAGE(PG8_SB(1, 1), cB + hstep + kstep, voffB);
        PG8_WAIT_V(6); PG8_BAR;
    }
    for (;;) {
        const bool has_next = S.next(ui + 1, nxt);
        const char* nA = has_next ? (const char*)(nxt.sel ? g.A2 : g.A) + (size_t)nxt.pm * tstep : cA; const char* nB = has_next ? (const char*)(nxt.sel ? g.Bt2 : g.Bt) + (size_t)nxt.pn * tstep : cB;
        for (int t = 0; t < nt; t += 2) {
            const bool last = (t == nt - 2);
            const char* a1 = cA + (size_t)(t + 1) * kstep;
            const char* a2 = last ? nA : cA + (size_t)(t + 2) * kstep; const char* b2 = last ? nB : cB + (size_t)(t + 2) * kstep;
            const char* a3 = a2 + kstep; const char* b3 = b2 + kstep;
            if (last && has_next) S.a_ready(nxt);
            if constexpr (SP2) {
            PG8_LDB(B0, 0, 0); PG8_LDB(B1, 0, 1); PG8_SCHED; PG8_LDA(At, 0, 0); PG8_STAGE(PG8_SA(1, 1), a1 + hstep, voffA);
            PG8_WAIT_V(8); PG8_WAIT_L(0); PG8_BAR; PG8_MMA(0, 0, At, B0); PG8_MMA(0, 1, At, B1); PG8_BAR; PG8_SCHED;
            PG8_LDA(At, 0, 1); PG8_STAGE(PG8_SB(0, 0), b2, voffB); PG8_STAGE(PG8_SB(0, 1), b2 + hstep, voffB); PG8_STAGE(PG8_SA(0, 0), a2, voffA);
            PG8_WAIT_V(8); PG8_WAIT_L(0); PG8_BAR; PG8_MMA(1, 0, At, B0); PG8_MMA(1, 1, At, B1); PG8_BAR; PG8_SCHED;
            PG8_LDB(B0, 1, 0); PG8_LDB(B1, 1, 1); PG8_SCHED; PG8_LDA(At, 1, 0); PG8_STAGE(PG8_SA(0, 1), a2 + hstep, voffA);
            PG8_WAIT_V(8); PG8_WAIT_L(0); PG8_BAR; PG8_MMA(0, 0, At, B0); PG8_MMA(0, 1, At, B1); PG8_BAR; PG8_SCHED;
            PG8_LDA(At, 1, 1); PG8_STAGE(PG8_SB(1, 0), b3, voffB); PG8_STAGE(PG8_SB(1, 1), b3 + hstep, voffB); PG8_STAGE(PG8_SA(1, 0), a3, voffA);
            PG8_WAIT_V(8); PG8_WAIT_L(0); PG8_BAR; PG8_MMA(1, 0, At, B0); PG8_MMA(1, 1, At, B1); PG8_BAR; PG8_SCHED;
            } else {
            PG8_LDB(B0, 0, 0); PG8_SCHED; PG8_LDA(At, 0, 0); PG8_STAGE(PG8_SA(1, 1), a1 + hstep, voffA);
            PG8_WAIT_L(8); PG8_BAR; PG8_WAIT_L(0); PG8_MMA(0, 0, At, B0); PG8_BAR; PG8_SCHED;
            PG8_LDB(B1, 0, 1); PG8_STAGE(PG8_SB(0, 0), b2, voffB);
            PG8_BAR; PG8_WAIT_L(0); PG8_MMA(0, 1, At, B1); PG8_BAR;
            PG8_LDA(At, 0, 1); PG8_STAGE(PG8_SA(0, 0), a2, voffA);
            PG8_BAR; PG8_WAIT_L(0); PG8_MMA(1, 0, At, B0); PG8_BAR; PG8_SCHED;
            PG8_STAGE(PG8_SB(0, 1), b2 + hstep, voffB);
            PG8_WAIT_V(6); PG8_BAR; PG8_MMA(1, 1, At, B1); PG8_BAR;
            PG8_LDB(B0, 1, 0); PG8_SCHED; PG8_LDA(At, 1, 0); PG8_STAGE(PG8_SA(0, 1), a2 + hstep, voffA);
            PG8_WAIT_L(8); PG8_BAR; PG8_WAIT_L(0); PG8_MMA(0, 0, At, B0); PG8_BAR; PG8_SCHED;
            PG8_LDB(B1, 1, 1); PG8_STAGE(PG8_SB(1, 0), b3, voffB);
            PG8_BAR; PG8_WAIT_L(0); PG8_MMA(0, 1, At, B1); PG8_BAR;
            PG8_LDA(At, 1, 1); PG8_STAGE(PG8_SA(1, 0), a3, voffA);
            PG8_BAR; PG8_WAIT_L(0); PG8_MMA(1, 0, At, B0); PG8_BAR; PG8_SCHED;
            PG8_STAGE(PG8_SB(1, 1), b3 + hstep, voffB);
            PG8_WAIT_V(6); PG8_BAR; PG8_MMA(1, 1, At, B1); PG8_BAR;
            }
        }
        if constexpr (ALIGN_EPI) { if (wr == 0) PG8_BAR; }
        if constexpr (!Epi::AFTER_DRAIN) { E(acc, cur, wr, wc, fr, fq); S.done(cur); }
        if (!has_next) break;
#pragma unroll
        for (int a = 0; a < 2; ++a)
#pragma unroll
            for (int b = 0; b < 2; ++b)
#pragma unroll
                for (int m = 0; m < 4; ++m)
#pragma unroll
                    for (int n = 0; n < 2; ++n) acc[a][b][m][n] = (f32x4){0.f, 0.f, 0.f, 0.f};
        cur = nxt; cA = nA; cB = nB; ++ui;
        if constexpr (ALIGN_EPI) { if (wr == 1) PG8_BAR; }
    }
    PG8_WAIT_V(0);
    if constexpr (!ALIGN_EPI) { if (wr == 0) PG8_BAR; }
    PG8_BAR;
    if constexpr (Epi::AFTER_DRAIN) { E.fused(acc, cur, wr, wc, fr, fq, lds, wid, lane); S.done(cur); }
#undef PG8_SA
#undef PG8_SB
#undef PG8_STAGE
#undef PG8_LDA
#undef PG8_LDB
#undef PG8_MMA
#undef PG8_WAIT_V
#undef PG8_WAIT_L
#undef PG8_BAR
#undef PG8_SCHED
}
}
#define DI __device__ __forceinline__
#define LAS __attribute__((address_space(3)))
typedef unsigned short bf16;
typedef float f32x4 __attribute__((ext_vector_type(4)));
typedef float f32x2 __attribute__((ext_vector_type(2)));
typedef float f32x16 __attribute__((ext_vector_type(16)));
typedef short bf16x8 __attribute__((ext_vector_type(8)));
typedef unsigned u32x4 __attribute__((ext_vector_type(4)));
typedef unsigned u32x2 __attribute__((ext_vector_type(2)));
typedef __bf16 bf16x2_t __attribute__((ext_vector_type(2)));

constexpr int NWAVES = 8, NTHR = 512;
constexpr int BATCH = 2, SEQ = 8192, DM = 1024, DEPTH = 4, M = BATCH * SEQ, NCOL = 5120;
constexpr int NG = 32, NP = 64, NCH = SEQ / 64;
constexpr float EPS = 1e-6f;
constexpr size_t MiB = 1u << 20;
constexpr size_t WS_WIN = 32 * MiB, WS_WGLU = 42 * MiB, WS_WBS = 43 * MiB, WS_WBA = 44 * MiB, WS_WOUT = 45 * MiB;
constexpr size_t WS_H = 48 * MiB;
constexpr size_t WS_U = 80 * MiB, WS_ZS = 96 * MiB, WS_Q = 112 * MiB, WS_K = 128 * MiB, WS_VT = 144 * MiB, WS_ZA = 160 * MiB;
constexpr size_t WS_GS = 176 * MiB, WS_GA = 208 * MiB;
constexpr size_t WS_KTAB = 1 * MiB, KTAB_LSTRIDE = 1280 * 1024;
constexpr size_t WS_WTAB = 6 * MiB, WTAB_LSTRIDE = 2 * MiB;
constexpr size_t WS_VTAB = 6 * MiB, VTAB_LSTRIDE = 2 * MiB;
constexpr size_t WS_S = 14 * MiB, S_LSTRIDE = 4 * MiB;
constexpr size_t WS_LAM = 30 * MiB, LAM_LSTRIDE = 64 * 1024;
constexpr size_t WS_END = 240 * MiB;
constexpr int KTAB_BYTES = 65 * 512;
constexpr int LDS_BYTES = 147456;
constexpr float QSCALE = 0.125f * 1.4426950408889634f;

struct Args {
    const float* x; const float* pre_g; const float* post_g; const float* w_in; const float* a_re; const float* a_im; const float* log_dt;
    const float* b_re; const float* b_im; const float* c_re; const float* c_im; const float* d_skip; const float* w_glu; const float* b_glu;
    const float* w_bs; const float* w_ba; const float* w_out; float* out; unsigned char* ws;
};

DI unsigned cvtpk(float lo, float hi) { f32x2 v = {lo, hi}; bf16x2_t b = __builtin_convertvector(v, bf16x2_t); return __builtin_bit_cast(unsigned, b); }
DI float bflo(unsigned w) { return __uint_as_float(w << 16); }
DI float bfhi(unsigned w) { return __uint_as_float(w & 0xffff0000u); }
DI float bf1(bf16 b) { return __uint_as_float((unsigned)b << 16); }
DI float sigm(float x) { return __builtin_amdgcn_rcpf(1.0f + __expf(-x)); }
DI float silu(float x) { return x * sigm(x); }
DI float gelu_tanh(float x) { const float u = 1.5957691216057308f * (x + 0.044715f * x * x * x); return x * sigm(u); }
template <int CTRL> DI float dpp_step(float v) { return v + __builtin_bit_cast(float, __builtin_amdgcn_update_dpp(0, __builtin_bit_cast(int, v), CTRL, 0xf, 0xf, true)); }
DI float wave_sum(float v) {
    v = dpp_step<0xB1>(v); v = dpp_step<0x4E>(v); v = dpp_step<0x141>(v); v = dpp_step<0x140>(v);
    return ((__builtin_bit_cast(float, __builtin_amdgcn_readlane(__builtin_bit_cast(int, v), 0)) + __builtin_bit_cast(float, __builtin_amdgcn_readlane(__builtin_bit_cast(int, v), 16))) +
            (__builtin_bit_cast(float, __builtin_amdgcn_readlane(__builtin_bit_cast(int, v), 32)) + __builtin_bit_cast(float, __builtin_amdgcn_readlane(__builtin_bit_cast(int, v), 48))));
}

struct EpiProj {
    static constexpr bool PERM = true, AFTER_DRAIN = false;
    unsigned char* ws;
    DI void operator()(const pg8::f32x4 (&acc)[2][2][4][2], const pg8::Unit& u, int wr, int wc, int fr, int fq) const {
        const int pn = u.pn;
        bf16* base; int ld, colt; float sc = 1.f;
        if (pn < 12) { base = (bf16*)(ws + WS_U + (size_t)(pn >> 1) * (16 * MiB)); ld = 512; colt = (pn & 1) * 256; if ((pn >> 1) == 2) sc = QSCALE; }
        else if (pn < 16) { base = (bf16*)(ws + WS_GS); ld = 1024; colt = (pn - 12) * 256; }
        else { base = (bf16*)(ws + WS_GA); ld = 1024; colt = (pn - 16) * 256; }
        const int row0 = u.pm * 256 + wr * 64 + fr, col0 = colt + wc * 32 + 8 * fq;
        const bool stream = (pn >= 10) || ((pn >> 1) == 1);
        if ((pn >> 1) == 4) {
            bf16* vt = (bf16*)(ws + WS_VT);
#pragma unroll
            for (int ai = 0; ai < 2; ++ai)
#pragma unroll
                for (int m = 0; m < 4; ++m) { const int r = row0 + ai * 128 + m * 16; const int bb = r >> 13, t = r & 8191;
#pragma unroll
                    for (int bj = 0; bj < 2; ++bj) { bf16* p = vt + ((size_t)(bb * 512 + col0 + bj * 128)) * 8192 + t;
#pragma unroll
                        for (int n = 0; n < 2; ++n)
#pragma unroll
                            for (int e = 0; e < 4; ++e) { *p = (bf16)(cvtpk(acc[ai][bj][m][n][e], 0.f) & 0xffffu); p += 8192; asm volatile("" : "+v"(p)); } }
                    __builtin_amdgcn_sched_barrier(0); }
            return;
        }
#pragma unroll
        for (int ai = 0; ai < 2; ++ai)
#pragma unroll
            for (int m = 0; m < 4; ++m) { bf16* rowp = base + (size_t)(row0 + ai * 128 + m * 16) * ld + col0;
#pragma unroll
                for (int bj = 0; bj < 2; ++bj) { const pg8::f32x4 v0 = acc[ai][bj][m][0] * sc, v1 = acc[ai][bj][m][1] * sc;
                    u32x4 w; w.x = cvtpk(v0[0], v0[1]); w.y = cvtpk(v0[2], v0[3]); w.z = cvtpk(v1[0], v1[1]); w.w = cvtpk(v1[2], v1[3]);
                    if (stream) __builtin_nontemporal_store(w, (u32x4*)(rowp + bj * 128)); else *(u32x4*)(rowp + bj * 128) = w; } }
    }
};
struct EpiGlu {
    static constexpr bool PERM = true, AFTER_DRAIN = false;
    bf16* zs; const float* bias;
    DI void operator()(const pg8::f32x4 (&acc)[2][2][4][2], const pg8::Unit& u, int wr, int wc, int fr, int fq) const {
        const int row0 = u.pm * 256 + wr * 64 + fr, col0 = u.pn * 128 + wc * 32 + 8 * fq;
        f32x4 ba0 = *(const f32x4*)(bias + col0), ba1 = *(const f32x4*)(bias + col0 + 4), bb0 = *(const f32x4*)(bias + 512 + col0), bb1 = *(const f32x4*)(bias + 512 + col0 + 4);
        u32x4 zv[2][4];
#pragma unroll
        for (int ai = 0; ai < 2; ++ai)
#pragma unroll
            for (int m = 0; m < 4; ++m) zv[ai][m] = __builtin_nontemporal_load((const u32x4*)(zs + (size_t)(row0 + ai * 128 + m * 16) * 512 + col0));
        __builtin_amdgcn_sched_barrier(0);
#pragma unroll
        for (int ai = 0; ai < 2; ++ai)
#pragma unroll
            for (int m = 0; m < 4; ++m) { bf16* p = zs + (size_t)(row0 + ai * 128 + m * 16) * 512 + col0;
                const u32x4 z = zv[ai][m]; float zf[8] = {bflo(z.x), bfhi(z.x), bflo(z.y), bfhi(z.y), bflo(z.z), bfhi(z.z), bflo(z.w), bfhi(z.w)}; float y[8];
#pragma unroll
                for (int e = 0; e < 4; ++e) {
                    y[e] = (acc[ai][0][m][0][e] + ba0[e]) * zf[e] * __builtin_amdgcn_rcpf((1.0f + __expf(-(acc[ai][1][m][0][e] + bb0[e]))) * (1.0f + __expf(-zf[e])));
                    y[4 + e] = (acc[ai][0][m][1][e] + ba1[e]) * zf[4 + e] * __builtin_amdgcn_rcpf((1.0f + __expf(-(acc[ai][1][m][1][e] + bb1[e]))) * (1.0f + __expf(-zf[4 + e]))); }
                u32x4 w; w.x = cvtpk(y[0], y[1]); w.y = cvtpk(y[2], y[3]); w.z = cvtpk(y[4], y[5]); w.w = cvtpk(y[6], y[7]); *(u32x4*)p = w; }
    }
};
template <int PASS> struct EpiBranch {
    static constexpr bool PERM = true, AFTER_DRAIN = false;
    bf16* G; const bf16* gate2;
    DI void operator()(const pg8::f32x4 (&acc)[2][2][4][2], const pg8::Unit& u, int wr, int wc, int fr, int fq) const {
        const int row0 = u.pm * 256 + wr * 64 + fr, col0 = u.pn * 256 + wc * 32 + 8 * fq;
#pragma unroll
        for (int ai = 0; ai < 2; ++ai)
#pragma unroll
          for (int mh = 0; mh < 2; ++mh) {
            u32x4 gv[2][2], hv[2][2];
#pragma unroll
            for (int mm = 0; mm < 2; ++mm)
#pragma unroll
                for (int bj = 0; bj < 2; ++bj) { const int m = 2 * mh + mm; const size_t off = (size_t)(row0 + ai * 128 + m * 16) * 1024 + col0 + bj * 128; gv[mm][bj] = *(const u32x4*)(G + off); if (PASS == 1) hv[mm][bj] = *(const u32x4*)(gate2 + off); }
            __builtin_amdgcn_sched_barrier(0);
#pragma unroll
            for (int mm = 0; mm < 2; ++mm)
#pragma unroll
                for (int bj = 0; bj < 2; ++bj) { const int m = 2 * mh + mm; const size_t off = (size_t)(row0 + ai * 128 + m * 16) * 1024 + col0 + bj * 128;
                    const u32x4 g = gv[mm][bj]; float gf[8] = {bflo(g.x), bfhi(g.x), bflo(g.y), bfhi(g.y), bflo(g.z), bfhi(g.z), bflo(g.w), bfhi(g.w)}; float y[8];
                    if (PASS == 0) {
#pragma unroll
                        for (int e = 0; e < 4; ++e) { y[e] = sigm(gf[e]) * acc[ai][bj][m][0][e]; y[4 + e] = sigm(gf[4 + e]) * acc[ai][bj][m][1][e]; }
                    } else {
                        const u32x4 h = hv[mm][bj]; float hf[8] = {bflo(h.x), bfhi(h.x), bflo(h.y), bfhi(h.y), bflo(h.z), bfhi(h.z), bflo(h.w), bfhi(h.w)};
#pragma unroll
                        for (int e = 0; e < 4; ++e) { y[e] = gf[e] + sigm(hf[e]) * acc[ai][bj][m][0][e]; y[4 + e] = gf[4 + e] + sigm(hf[4 + e]) * acc[ai][bj][m][1][e]; }
                    }
                    u32x4 w; w.x = cvtpk(y[0], y[1]); w.y = cvtpk(y[2], y[3]); w.z = cvtpk(y[4], y[5]); w.w = cvtpk(y[6], y[7]); *(u32x4*)(G + off) = w; }
            __builtin_amdgcn_sched_barrier(0);
          }
    }
};
struct EpiBranchBoth {
    static constexpr bool PERM = true, AFTER_DRAIN = false;
    bf16* G; const bf16* gate2;
    DI void operator()(const pg8::f32x4 (&acc)[2][2][4][2], const pg8::Unit& u, int wr, int wc, int fr, int fq) const {
        if (u.sel == 0) { EpiBranch<0> e{G, gate2}; e(acc, u, wr, wc, fr, fq); } else { EpiBranch<1> e{G, gate2}; e(acc, u, wr, wc, fr, fq); }
    }
};
struct EpiPlain {
    static constexpr bool PERM = true, AFTER_DRAIN = false;
    bf16* O;
    DI void operator()(const pg8::f32x4 (&acc)[2][2][4][2], const pg8::Unit& u, int wr, int wc, int fr, int fq) const {
        const int row0 = u.pm * 256 + wr * 64 + fr, col0 = u.pn * 256 + wc * 32 + 8 * fq;
#pragma unroll
        for (int ai = 0; ai < 2; ++ai)
#pragma unroll
            for (int m = 0; m < 4; ++m)
#pragma unroll
                for (int bj = 0; bj < 2; ++bj) { const pg8::f32x4 v0 = acc[ai][bj][m][0], v1 = acc[ai][bj][m][1];
                    u32x4 w; w.x = cvtpk(v0[0], v0[1]); w.y = cvtpk(v0[2], v0[3]); w.z = cvtpk(v1[0], v1[1]); w.w = cvtpk(v1[2], v1[3]);
                    *(u32x4*)(O + (size_t)(row0 + ai * 128 + m * 16) * 1024 + col0 + bj * 128) = w; }
    }
};

DI void norm_row(const float* xin, const bf16* o, const f32x4 (&gpo)[4], float* xout, bool has_pre, const f32x4 (&gpr)[4], bf16* h, int lane) {
    f32x4 v[4];
#pragma unroll
    for (int j = 0; j < 4; ++j) v[j] = __builtin_nontemporal_load((const f32x4*)xin + lane + 64 * j);
    if (o) {
        f32x4 ov[4]; float ss = 0.f;
#pragma unroll
        for (int j = 0; j < 4; ++j) { const u32x2 w = __builtin_nontemporal_load((const u32x2*)o + lane + 64 * j); ov[j] = (f32x4){bflo(w.x), bfhi(w.x), bflo(w.y), bfhi(w.y)};
            ss += (ov[j].x * ov[j].x + ov[j].y * ov[j].y) + (ov[j].z * ov[j].z + ov[j].w * ov[j].w); }
        const float rstd = __builtin_amdgcn_rsqf(wave_sum(ss) * (1.0f / DM) + EPS);
#pragma unroll
        for (int j = 0; j < 4; ++j) { v[j] = v[j] + ov[j] * rstd * gpo[j]; __builtin_nontemporal_store(v[j], (f32x4*)xout + lane + 64 * j); }
    }
    if (has_pre) {
        float ss = 0.f;
#pragma unroll
        for (int j = 0; j < 4; ++j) ss += (v[j].x * v[j].x + v[j].y * v[j].y) + (v[j].z * v[j].z + v[j].w * v[j].w);
        const float rstd = __builtin_amdgcn_rsqf(wave_sum(ss) * (1.0f / DM) + EPS);
#pragma unroll
        for (int j = 0; j < 4; ++j) { const f32x4 y = v[j] * rstd * gpr[j];
            u32x2 w; w.x = cvtpk(y.x, y.y); w.y = cvtpk(y.z, y.w); *((u32x2*)h + lane + 64 * j) = w; }
    }
}
DI void transpose_item(const float* W, int K, int N, bf16* WT, int k0, int n0, int dst_row0, LAS float* scr, int lane) {
#pragma unroll 8
    for (int i = 0; i < 32; ++i) { const int kk = 2 * i + (lane >> 5); scr[kk * 33 + (lane & 31)] = __builtin_nontemporal_load(W + (size_t)(k0 + kk) * N + n0 + (lane & 31)); }
    asm volatile("s_waitcnt lgkmcnt(0)" ::: "memory");
    const int c = lane & 7;
#pragma unroll
    for (int j = 0; j < 4; ++j) { const int n = (lane >> 3) + 8 * j; const LAS float* s = scr + (8 * c) * 33 + n;
        u32x4 o; o.x = cvtpk(s[0 * 33], s[1 * 33]); o.y = cvtpk(s[2 * 33], s[3 * 33]); o.z = cvtpk(s[4 * 33], s[5 * 33]); o.w = cvtpk(s[6 * 33], s[7 * 33]);
        *(u32x4*)(WT + (size_t)(dst_row0 + n) * K + k0 + 8 * c) = o; }
    asm volatile("s_waitcnt lgkmcnt(0)" ::: "memory");
}
DI f32x2 cpow_k(float are, float aim, float dt, int k) {
    const float mag = __expf(are * dt * (float)k);
    const double turns = (double)aim * (double)dt * (double)k * 0.15915494309189535;
    const float fr = (float)(turns - floor(turns));
    return (f32x2){mag * __builtin_amdgcn_cosf(fr), mag * __builtin_amdgcn_sinf(fr)};
}
DI f32x2 cmul(f32x2 a, f32x2 b) { return (f32x2){a.x * b.x - a.y * b.y, a.x * b.y + a.y * b.x}; }
DI f32x2 zoh_factor(float are, float aim, float dt) {
    const f32x2 ab = cpow_k(are, aim, dt, 1); const float nr = ab.x - 1.0f, ni = ab.y, den = are * are + aim * aim;
    return (f32x2){(nr * are + ni * aim) / den, (ni * are - nr * aim) / den};
}

struct LayerP { const float *a_re, *a_im, *log_dt, *b_re, *b_im, *c_re, *c_im; };

DI void ktab_block(const LayerP& P, bf16* KTAB, int g, int tb, LAS unsigned char* lds, int tid) {
    LAS f32x2* CL = (LAS f32x2*)lds;
    LAS f32x2* BB = (LAS f32x2*)(lds + 16384);
    const float dt = __expf(P.log_dt[g]);
    const int p = tid & 63, h0 = tid >> 6, h1 = h0 + 8;
    const float are = P.a_re[g * 64 + p], aim = P.a_im[g * 64 + p];
    const f32x2 c0 = {P.c_re[(g * 16 + h0) * 64 + p], P.c_im[(g * 16 + h0) * 64 + p]}, c1 = {P.c_re[(g * 16 + h1) * 64 + p], P.c_im[(g * 16 + h1) * 64 + p]};
    const int e0 = tid, e1 = tid + NTHR; const int pa = e0 >> 4, pb = e1 >> 4, hp = tid & 15;
    const float area = P.a_re[g * 64 + pa], aima = P.a_im[g * 64 + pa], areb = P.a_re[g * 64 + pb], aimb = P.a_im[g * 64 + pb];
    const f32x2 bva = {P.b_re[(g * 64 + pa) * 16 + hp], P.b_im[(g * 64 + pa) * 16 + hp]}, bvb = {P.b_re[(g * 64 + pb) * 16 + hp], P.b_im[(g * 64 + pb) * 16 + hp]};
    BB[pa * 16 + hp] = cmul(zoh_factor(area, aima, dt), bva); BB[pb * 16 + hp] = cmul(zoh_factor(areb, aimb, dt), bvb);
    if (tb == 0 && tid < 256) KTAB[((size_t)g * 65) * 256 + tid] = 0;
#pragma unroll 1
    for (int tp = 0; tp < 4; ++tp) { const int tau0 = tb * 8 + 2 * tp;
        const f32x2 l0 = cpow_k(are, aim, dt, tau0), l1 = cpow_k(are, aim, dt, tau0 + 1);
        CL[(0 * 16 + h0) * 64 + p] = cmul(c0, l0); CL[(0 * 16 + h1) * 64 + p] = cmul(c1, l0); CL[(1 * 16 + h0) * 64 + p] = cmul(c0, l1); CL[(1 * 16 + h1) * 64 + p] = cmul(c1, l1);
        __syncthreads();
        { const int ts = tid >> 8, h = (tid >> 4) & 15; float sacc = 0.f;
#pragma unroll 8
          for (int q = 0; q < 64; ++q) { const f32x2 c = CL[(ts * 16 + h) * 64 + q], bq = BB[q * 16 + hp]; sacc += c.x * bq.x - c.y * bq.y; }
          KTAB[((size_t)g * 65 + (tau0 + ts + 1)) * 256 + h * 16 + hp] = (bf16)(cvtpk(sacc, 0.f) & 0xffffu); }
        __syncthreads();
    }
}
DI void wv_item(const LayerP& P, bf16* WTAB, bf16* VTAB, float* LAM, int idx) {
    const int p = idx & 63, k = (idx >> 6) & 15, g = idx >> 10;
    const float dt = __expf(P.log_dt[g]), are = P.a_re[g * 64 + p], aim = P.a_im[g * 64 + p];
    f32x2 cv[16];
#pragma unroll
    for (int j = 0; j < 16; ++j) cv[j] = (f32x2){P.c_re[(g * 16 + j) * 64 + p], P.c_im[(g * 16 + j) * 64 + p]};
    const f32x2 lk1 = cpow_k(are, aim, dt, k + 1);
#pragma unroll
    for (int h = 0; h < 16; ++h) { const f32x2 c = cmul(cv[h], lk1); *(unsigned*)(VTAB + ((size_t)g * 256 + k * 16 + h) * 128 + 2 * p) = cvtpk(c.x, -c.y); }
    if (k == 15) { const f32x2 l64 = cpow_k(are, aim, dt, 64); *(f32x4*)(LAM + (g * 64 + p) * 4) = (f32x4){l64.x, l64.y, lk1.x, lk1.y}; }
}

#define MFMA16(a, b, c) __builtin_amdgcn_mfma_f32_16x16x32_bf16((a), (b), (c), 0, 0, 0)
#define MFMA32(a, b, c) __builtin_amdgcn_mfma_f32_32x32x16_bf16((a), (b), (c), 0, 0, 0)
DI void make_wfrag(const LayerP& P, int g, int wave, int lane, bf16x8 (&af)[8], f32x2& l16a, f32x2& l16b) {
    const int n = lane & 15, kg = lane >> 4, p = 8 * wave + (n >> 1), ri = n & 1;
    const float dt = __expf(P.log_dt[g]), are = P.a_re[g * 64 + p], aim = P.a_im[g * 64 + p];
    const int pa = 8 * wave + 2 * kg;
    const float area = P.a_re[g * 64 + pa], aima = P.a_im[g * 64 + pa], areb = P.a_re[g * 64 + pa + 1], aimb = P.a_im[g * 64 + pa + 1];
    const f32x4 br0 = *(const f32x4*)(P.b_re + (g * 64 + p) * 16 + 8 * (kg & 1)), br1 = *(const f32x4*)(P.b_re + (g * 64 + p) * 16 + 8 * (kg & 1) + 4);
    const f32x4 bi0 = *(const f32x4*)(P.b_im + (g * 64 + p) * 16 + 8 * (kg & 1)), bi1 = *(const f32x4*)(P.b_im + (g * 64 + p) * 16 + 8 * (kg & 1) + 4);
    const f32x2 f = zoh_factor(are, aim, dt);
    f32x2 fb[8];
#pragma unroll
    for (int i = 0; i < 4; ++i) { fb[i] = cmul(f, (f32x2){br0[i], bi0[i]}); fb[4 + i] = cmul(f, (f32x2){br1[i], bi1[i]}); }
#pragma unroll
    for (int ks = 0; ks < 8; ++ks) { const f32x2 lp = cpow_k(are, aim, dt, 15 - 2 * ks - (kg >> 1)); float v[8];
#pragma unroll
        for (int i = 0; i < 8; ++i) { const f32x2 c = cmul(lp, fb[i]); v[i] = ri ? c.y : c.x; }
        const u32x4 w = {cvtpk(v[0], v[1]), cvtpk(v[2], v[3]), cvtpk(v[4], v[5]), cvtpk(v[6], v[7])}; af[ks] = __builtin_bit_cast(bf16x8, w); }
    l16a = cpow_k(area, aima, dt, 16); l16b = cpow_k(areb, aimb, dt, 16);
}
DI void ssm_state_unit(const bf16* U, const bf16x8 (&af)[8], f32x2 l16a, f32x2 l16b, float* S, int b, int g, int cb, int wave, int lane) {
    const int n = lane & 15, kg = lane >> 4;
    const bf16* up = U + ((size_t)b * SEQ + (size_t)(cb * 16 + n) * 64 + (kg >> 1)) * 512 + g * 16 + 8 * (kg & 1);
    bf16x8 uf[4][8];
#pragma unroll
    for (int a = 0; a < 4; ++a)
#pragma unroll
        for (int ks = 0; ks < 8; ++ks) uf[a][ks] = *(const bf16x8*)(up + (size_t)(16 * a + 2 * ks) * 512);
    __builtin_amdgcn_sched_barrier(0);
    pg8::f32x4 acc4[4];
#pragma unroll
    for (int a = 0; a < 4; ++a) acc4[a] = (pg8::f32x4){0.f, 0.f, 0.f, 0.f};
#pragma unroll
    for (int ks = 0; ks < 8; ++ks)
#pragma unroll
        for (int a = 0; a < 4; ++a) acc4[a] = MFMA16(af[ks], uf[a][ks], acc4[a]);
    __builtin_amdgcn_sched_barrier(0);
    pg8::f32x4 st = acc4[0];
#pragma unroll
    for (int a = 1; a < 4; ++a) {
        const f32x2 s0 = cmul(l16a, (f32x2){st[0], st[1]}), s1 = cmul(l16b, (f32x2){st[2], st[3]});
        st = (pg8::f32x4){s0.x + acc4[a][0], s0.y + acc4[a][1], s1.x + acc4[a][2], s1.y + acc4[a][3]};
    }
    *(pg8::f32x4*)(S + (((size_t)b * NCH + cb * 16 + n) * NG + g) * 128 + 16 * wave + 4 * kg) = st;
}
constexpr int XIN_OFF = 33280, XIN_PITCH = 272, XIN_VAR = 16 * XIN_PITCH, TB_OFF = XIN_OFF + 4 * XIN_VAR, UL_OFF = 57344, UL_PITCH = 2064;
template <int S> DI void toe_stage(pg8::f32x4 (&acc)[8], const LAS unsigned char* ul, const LAS unsigned char* kt, int wave, int lo, int hi) {
#pragma unroll 1
    for (int ks = lo; ks <= hi; ++ks) {
        const bf16x8 uf0 = *(const LAS bf16x8*)(ul + ks * 64);
        bf16x8 a0[8 - S];
#pragma unroll
        for (int j = S; j < 8; ++j) a0[j - S] = *(const LAS bf16x8*)(kt + (wave + 8 * j - 2 * ks) * 512);
        __builtin_amdgcn_sched_barrier(0);
#pragma unroll
        for (int j = S; j < 8; ++j) acc[j] = MFMA16(a0[j - S], uf0, acc[j]);
    }
}
#ifdef PROBE_SEL
#define QS(sel) do { if (PROBE_SEL == (sel)) tq0 = __builtin_amdgcn_s_memrealtime(); } while (0)
#define QT(sel) do { if (PROBE_SEL == (sel)) tqacc += __builtin_amdgcn_s_memrealtime() - tq0; } while (0)
#else
#define QS(sel) do {} while (0)
#define QT(sel) do {} while (0)
#endif
DI void ssm_out_unit(unsigned long long& tqacc, bool load_ktab, const bf16* U, const bf16* KTAB, const bf16* VTAB, const float* S, const float* LAM, const float* dsk, bf16* YS, int b, int g, int cb, LAS unsigned char* lds, int tid, int wave, int lane) {
    unsigned long long tq0 = 0ull; (void)tq0;
    const int n = lane & 15, kg = lane >> 4;
    QS(51);
    const f32x4 lam4 = *(const f32x4*)(LAM + (g * 64 + lane) * 4); const f32x2 lam = {lam4.x, lam4.y}, l16 = {lam4.z, lam4.w};
    f32x2 sv[16];
    {
        const u32x4* src = (const u32x4*)((const unsigned char*)KTAB + (size_t)g * KTAB_BYTES);
        u32x4 kt4[4], kt5 = {0u, 0u, 0u, 0u}, ut4[4];
        if (load_ktab) {
#pragma unroll
            for (int j = 0; j < 4; ++j) kt4[j] = src[tid + NTHR * j];
            if (tid < 32) kt5 = src[2048 + tid];
        }
#pragma unroll
        for (int j = 0; j < 4; ++j) { const int idx = tid + NTHR * j, cn = idx >> 7, tok = (idx >> 1) & 63, half = idx & 1;
            ut4[j] = *(const u32x4*)(U + ((size_t)b * SEQ + (size_t)(cb * 16 + cn) * 64 + tok) * 512 + g * 16 + 8 * half); }
        if (wave <= cb) { const f32x2* sp = (const f32x2*)(S + (((size_t)b * NCH + wave * 16) * NG + g) * 128) + lane;
#pragma unroll
            for (int j = 0; j < 16; ++j) sv[j] = sp[(size_t)j * (NG * 64)]; }
        __builtin_amdgcn_sched_barrier(0);
        if (load_ktab) {
#pragma unroll
            for (int j = 0; j < 4; ++j) *(LAS u32x4*)(lds + 16 * (tid + NTHR * j)) = kt4[j];
            if (tid < 32) *(LAS u32x4*)(lds + 16 * (2048 + tid)) = kt5;
        }
#pragma unroll
        for (int j = 0; j < 4; ++j) { const int idx = tid + NTHR * j, cn = idx >> 7, tok = (idx >> 1) & 63, half = idx & 1; *(LAS u32x4*)(lds + UL_OFF + cn * UL_PITCH + tok * 32 + half * 16) = ut4[j]; }
    }
    bf16x8 vfr[4][2];
#pragma unroll
    for (int k2 = 0; k2 < 4; ++k2)
#pragma unroll
        for (int jj = 0; jj < 2; ++jj) vfr[k2][jj] = *(const bf16x8*)(VTAB + ((size_t)g * 256 + (wave + 8 * jj) * 16 + n) * 128 + 32 * k2 + 8 * kg);
    __builtin_amdgcn_sched_barrier(0);
    LAS f32x2* TB = (LAS f32x2*)(lds + TB_OFF);
    if (wave < cb) { f32x2 x = {0.f, 0.f};
#pragma unroll
        for (int j = 0; j < 16; ++j) { x = cmul(lam, x); x.x += sv[j].x; x.y += sv[j].y; }
        TB[wave * 64 + lane] = x; }
    __syncthreads();
    if (wave == cb) {
        f32x2 l1k = lam;
#pragma unroll
        for (int j = 0; j < 4; ++j) l1k = cmul(l1k, l1k);
        f32x2 x = {0.f, 0.f};
        for (int w = 0; w < cb; ++w) { const f32x2 t = TB[w * 64 + lane]; x = cmul(l1k, x); x.x += t.x; x.y += t.y; }
#pragma unroll
        for (int j = 0; j < 16; ++j) { f32x2 xa = x;
#pragma unroll
            for (int a = 0; a < 4; ++a) { *(LAS unsigned*)(lds + XIN_OFF + a * XIN_VAR + j * XIN_PITCH + 4 * lane) = cvtpk(xa.x, xa.y); xa = cmul(l16, xa); }
            x = cmul(lam, x); x.x += sv[j].x; x.y += sv[j].y; }
    }
    __syncthreads();
    QT(51); QS(52);
    pg8::f32x4 acc[8];
#pragma unroll
    for (int j = 0; j < 8; ++j) acc[j] = (pg8::f32x4){0.f, 0.f, 0.f, 0.f};
    const LAS unsigned char* ul = lds + UL_OFF + n * UL_PITCH + (kg >> 1) * 32 + (kg & 1) * 16;
    const LAS unsigned char* kt = lds + n * 32 + (kg & 1) * 16 + (1 - (kg >> 1)) * 512;
    { const int hw = wave >> 1;
      toe_stage<0>(acc, ul, kt, wave, 0, hw);            toe_stage<1>(acc, ul, kt, wave, hw + 1, hw + 4);   toe_stage<2>(acc, ul, kt, wave, hw + 5, hw + 8);   toe_stage<3>(acc, ul, kt, wave, hw + 9, hw + 12);
      toe_stage<4>(acc, ul, kt, wave, hw + 13, hw + 16); toe_stage<5>(acc, ul, kt, wave, hw + 17, hw + 20); toe_stage<6>(acc, ul, kt, wave, hw + 21, hw + 24); toe_stage<7>(acc, ul, kt, wave, hw + 25, hw + 28); }
#pragma unroll
    for (int k2 = 0; k2 < 4; ++k2) {
        bf16x8 xf[4];
#pragma unroll
        for (int a = 0; a < 4; ++a) xf[a] = *(const LAS bf16x8*)(lds + XIN_OFF + a * XIN_VAR + n * XIN_PITCH + (32 * k2 + 8 * kg) * 2);
#pragma unroll
        for (int j = 0; j < 8; ++j) acc[j] = MFMA16(vfr[k2][j & 1], xf[j >> 1], acc[j]); }
    QT(52); QS(53);
    const f32x4 dv = *(const f32x4*)(dsk + g * 16 + 4 * kg);
#pragma unroll
    for (int j = 0; j < 8; ++j) { const int t = wave + 8 * j; const size_t off = ((size_t)b * SEQ + (size_t)(cb * 16 + n) * 64 + t) * 512 + g * 16 + 4 * kg;
        const u32x2 uu = *(const LAS u32x2*)(lds + UL_OFF + n * UL_PITCH + t * 32 + kg * 8);
        const float y0 = gelu_tanh(acc[j][0] + dv[0] * bflo(uu.x)), y1 = gelu_tanh(acc[j][1] + dv[1] * bfhi(uu.x)), y2 = gelu_tanh(acc[j][2] + dv[2] * bflo(uu.y)), y3 = gelu_tanh(acc[j][3] + dv[3] * bfhi(uu.y));
        u32x2 w; w.x = cvtpk(y0, y1); w.y = cvtpk(y2, y3); *(u32x2*)(YS + off) = w; }
    asm volatile("s_waitcnt lgkmcnt(0)\n\ts_barrier" ::: "memory");
    QT(53);
}

struct AttnSt { f32x16 o0, o1; float carry; };
DI bool attn_tile(AttnSt& st, const bf16x8 (&kf)[4], const bf16x8 (&vf)[4], const bf16x8 (&qf)[4], bool diag, int n, int hi) {
    f32x16 s;
#pragma unroll
    for (int r = 0; r < 16; ++r) s[r] = 0.f;
#pragma unroll
    for (int ks = 0; ks < 4; ++ks) s = MFMA32(kf[ks], qf[ks], s);
    float sp[16];
#pragma unroll
    for (int r = 0; r < 16; ++r) { const float z = s[r]; const float e = __builtin_amdgcn_exp2f(-fabsf(z)); sp[r] = fmaxf(z, 0.f) + __builtin_amdgcn_logf(1.0f + e);
        if (diag && (16 * (r >> 3) + 8 * hi + (r & 7)) >= n) sp[r] = 0.f; }
    float cum[16]; float c0 = 0.f, c1 = 0.f;
#pragma unroll
    for (int r = 7; r >= 0; --r) { c0 -= sp[r]; cum[r] = c0; c1 -= sp[8 + r]; cum[8 + r] = c1; }
    const float p0 = __shfl_xor(c0, 32), p1 = __shfl_xor(c1, 32);
    const float base1 = st.carry + (hi ? 0.f : p1), base0 = st.carry + c1 + p1 + (hi ? 0.f : p0);
    float w[16];
#pragma unroll
    for (int r = 0; r < 16; ++r) { w[r] = __builtin_amdgcn_exp2f(s[r] + cum[r] + (r < 8 ? base0 : base1));
        if (diag && (16 * (r >> 3) + 8 * hi + (r & 7)) >= n) w[r] = 0.f; }
    st.carry += (c0 + c1) + (p0 + p1);
    const u32x4 pa = {cvtpk(w[0], w[1]), cvtpk(w[2], w[3]), cvtpk(w[4], w[5]), cvtpk(w[6], w[7])}, pb = {cvtpk(w[8], w[9]), cvtpk(w[10], w[11]), cvtpk(w[12], w[13]), cvtpk(w[14], w[15])};
    const bf16x8 pf0 = __builtin_bit_cast(bf16x8, pa), pf1 = __builtin_bit_cast(bf16x8, pb);
    st.o0 = MFMA32(pf0, vf[0], st.o0); st.o0 = MFMA32(pf1, vf[1], st.o0); st.o1 = MFMA32(pf0, vf[2], st.o1); st.o1 = MFMA32(pf1, vf[3], st.o1);
    return __ballot(st.carry >= -152.0f) == 0ull;
}
DI void attn_task(const bf16* Q, const bf16* Kb, const bf16* VT, const bf16* ZA, bf16* Y, int b, int h, int qt, int lane) {
    const int n = lane & 31, hi = lane >> 5;
    const size_t rowbase = (size_t)b * SEQ;
    bf16x8 qf[4];
    { const bf16* qp = Q + (rowbase + qt * 32 + n) * 512 + h * 64 + 8 * hi;
#pragma unroll
      for (int ks = 0; ks < 4; ++ks) qf[ks] = *(const bf16x8*)(qp + 16 * ks); }
    const int pm = (n & ~12) | (((n >> 2) & 1) << 3) | (((n >> 3) & 1) << 2);
    const bf16* kp = Kb + (rowbase + pm) * 512 + h * 64 + 8 * hi;
    const bf16* vp = VT + ((size_t)(b * 8 + h) * 64 + n) * SEQ + 8 * hi;
    AttnSt st;
#pragma unroll
    for (int r = 0; r < 16; ++r) { st.o0[r] = 0.f; st.o1[r] = 0.f; }
    st.carry = 0.f;
    bf16x8 kA[4], vA[4], kB[4], vB[4], kC[4], vC[4];
#define ATT_LOAD(KF, VF, ktile) do { const int key0_ = ((ktile) > 0 ? (ktile) : 0) * 32; \
        _Pragma("unroll") for (int ks = 0; ks < 4; ++ks) KF[ks] = *(const bf16x8*)(kp + (size_t)key0_ * 512 + 16 * ks); \
        VF[0] = *(const bf16x8*)(vp + key0_); VF[1] = *(const bf16x8*)(vp + key0_ + 16); VF[2] = *(const bf16x8*)(vp + (size_t)32 * SEQ + key0_); VF[3] = *(const bf16x8*)(vp + (size_t)32 * SEQ + key0_ + 16); } while (0)
    ATT_LOAD(kA, vA, qt); ATT_LOAD(kB, vB, qt - 1);
    int kt = qt;
    for (;;) {
        ATT_LOAD(kC, vC, kt - 2); __builtin_amdgcn_sched_barrier(0);
        if (attn_tile(st, kA, vA, qf, kt == qt, n, hi) || kt == 0) break; --kt; __builtin_amdgcn_sched_barrier(0);
        ATT_LOAD(kA, vA, kt - 2); __builtin_amdgcn_sched_barrier(0);
        if (attn_tile(st, kB, vB, qf, false, n, hi) || kt == 0) break; --kt; __builtin_amdgcn_sched_barrier(0);
        ATT_LOAD(kB, vB, kt - 2); __builtin_amdgcn_sched_barrier(0);
        if (attn_tile(st, kC, vC, qf, false, n, hi) || kt == 0) break; --kt; __builtin_amdgcn_sched_barrier(0);
    }
#undef ATT_LOAD
    float za0[16], za1[16];
#pragma unroll
    for (int r = 0; r < 16; ++r) { const int i = (r & 3) + 8 * (r >> 2) + 4 * hi; const size_t off = (rowbase + qt * 32 + i) * 512 + h * 64 + n; za0[r] = bf1(ZA[off]); za1[r] = bf1(ZA[off + 32]); }
    __builtin_amdgcn_sched_barrier(0);
#pragma unroll
    for (int r = 0; r < 16; ++r) { const int i = (r & 3) + 8 * (r >> 2) + 4 * hi; const size_t off = (rowbase + qt * 32 + i) * 512 + h * 64 + n;
        Y[off] = (bf16)(cvtpk(st.o0[r] * silu(za0[r]), 0.f) & 0xffffu); Y[off + 32] = (bf16)(cvtpk(st.o1[r] * silu(za1[r]), 0.f) & 0xffffu); }
}
#define XB_TMO      128
#define XB_XCNT(j)  (256  + 64 * (j))
#define XB_XSUB(j)  (1280 + 64 * (j))
#define XB_XGEN(j)  (2304 + 64 * (j))
#define XB_TOP      3328
#define XB_TOPGEN   3392
#define XCD_BAR_WORDS 3456
#define XB_SPIN_CAP (1u << 18)

__device__ __forceinline__ unsigned xb_ld(unsigned* p)              { return __hip_atomic_load(p, __ATOMIC_RELAXED, __HIP_MEMORY_SCOPE_AGENT); }
__device__ __forceinline__ unsigned xb_add(unsigned* p, unsigned v) { return __hip_atomic_fetch_add(p, v, __ATOMIC_RELAXED, __HIP_MEMORY_SCOPE_AGENT); }
__device__ __forceinline__ unsigned xb_xcc_id() { return (unsigned)__builtin_amdgcn_s_getreg((3 << 11) | 20) & 0xFu; }
#define XB_SPIN(cond, bar) do { unsigned _sp = 0; while (cond) { __builtin_amdgcn_s_sleep(1); \
    if ((++_sp & 255u) == 0u) { if (xb_ld(&(bar)[XB_TMO])) break; if (_sp > XB_SPIN_CAP) { atomicAdd(&(bar)[XB_TMO], 1u); break; } } } } while (0)

struct XcdBarrier {
    unsigned* bar; unsigned x;
    volatile LAS unsigned* st;
};

__device__ __forceinline__ XcdBarrier xcd_barrier_post(unsigned* bar, volatile LAS unsigned* st) {
    XcdBarrier b; b.bar = bar; b.x = xb_xcc_id(); b.st = st;
    if (threadIdx.x == 0) (void)xb_add(&bar[XB_XCNT(b.x)], 1u);
    return b;
}
__device__ __forceinline__ void xcd_barrier_complete(unsigned* bar, unsigned x, unsigned& nloc, unsigned& nx) {
    const unsigned G = gridDim.x * gridDim.y * gridDim.z;
    unsigned sum, cnt, mine, sp = 0u;
    for (;;) {
        sum = 0u; cnt = 0u; mine = 0u;
#pragma unroll
        for (unsigned j = 0; j < 16; ++j) { const unsigned c = xb_ld(&bar[XB_XCNT(j)]); sum += c; cnt += (c > 0u) ? 1u : 0u; mine = (j == x) ? c : mine; }
        if (sum == G) break;
        __builtin_amdgcn_s_sleep(1);
        if ((++sp & 255u) == 0u) { if (xb_ld(&bar[XB_TMO])) break; if (sp > XB_SPIN_CAP) { atomicAdd(&bar[XB_TMO], 1u); break; } }
    }
    nloc = mine > 0u ? mine : 1u; nx = cnt > 0u ? cnt : 1u;
}

__device__ __forceinline__ void xcd_barrier(const XcdBarrier& b) {
    asm volatile("s_waitcnt vmcnt(0)" ::: "memory");
    __syncthreads();
    if (threadIdx.x == 0) {
        unsigned* bar = b.bar;
        __builtin_amdgcn_s_waitcnt(0);
        unsigned nloc = b.st[0], nx = b.st[1];
        if (nloc == 0u) { xcd_barrier_complete(bar, b.x, nloc, nx); b.st[0] = nloc; b.st[1] = nx; }
        const unsigned old = xb_add(&bar[XB_XSUB(b.x)], 1u);
        const unsigned gen = old / nloc;
        if (old + 1u == (gen + 1u) * nloc) {
            __builtin_amdgcn_fence(__ATOMIC_RELEASE, "agent");
            asm volatile("s_waitcnt vmcnt(0)" ::: "memory");
            const unsigned og = xb_add(&bar[XB_TOP], 1u);
            const unsigned tg = og / nx;
            if (og + 1u == (tg + 1u) * nx) xb_add(&bar[XB_TOPGEN], 1u);
            else XB_SPIN(xb_ld(&bar[XB_TOPGEN]) == tg, bar);
            __builtin_amdgcn_fence(__ATOMIC_ACQUIRE, "agent");
            xb_add(&bar[XB_XGEN(b.x)], 1u);
            asm volatile("s_waitcnt vmcnt(0)" ::: "memory");
        } else {
            XB_SPIN(xb_ld(&bar[XB_XGEN(b.x)]) == gen, bar);
            __builtin_amdgcn_fence(__ATOMIC_ACQUIRE, "agent");
            asm volatile("s_waitcnt vmcnt(0)" ::: "memory");
        }
    }
    __syncthreads();
}

__device__ __forceinline__ void xcd_barrier1(const XcdBarrier& b) {
    asm volatile("s_waitcnt vmcnt(0)" ::: "memory");
    __syncthreads();
    if (threadIdx.x == 0) {
        unsigned* bar = b.bar;
        __builtin_amdgcn_s_waitcnt(0);
        unsigned nloc = b.st[0], nx = b.st[1];
        if (nloc == 0u) { xcd_barrier_complete(bar, b.x, nloc, nx); b.st[0] = nloc; b.st[1] = nx; }
        const unsigned k = b.st[2]; b.st[2] = k + 1u;
        const unsigned old = xb_add(&bar[XB_XSUB(b.x)], 1u);
        const unsigned gen = old / nloc;
        if (old + 1u == (gen + 1u) * nloc) {
            __builtin_amdgcn_fence(__ATOMIC_RELEASE, "agent");
            asm volatile("s_waitcnt vmcnt(0)" ::: "memory");
            const unsigned og = xb_add(&bar[XB_TOP], 1u);
            if (og + 1u == (k + 1u) * nx) xb_add(&bar[XB_TOPGEN], 1u);
            else XB_SPIN(xb_ld(&bar[XB_TOPGEN]) == k, bar);
        } else {
            XB_SPIN(xb_ld(&bar[XB_TOPGEN]) == k, bar);
        }
        __builtin_amdgcn_fence(__ATOMIC_ACQUIRE, "agent");
        asm volatile("s_waitcnt vmcnt(0)" ::: "memory");
    }
    __syncthreads();
}
__global__ void __launch_bounds__(NTHR, 2) hybrid_fwd(Args a) {
    extern __shared__ __attribute__((aligned(16))) unsigned char lds_raw[];
    LAS unsigned char* lds = (LAS unsigned char*)lds_raw;
    cg::grid_group grid = cg::this_grid();
#ifdef EXP_INVL2
    if (threadIdx.x == 0) asm volatile("buffer_inv sc0 sc1\n\ts_waitcnt vmcnt(0)" ::: "memory");
    __syncthreads();
#endif
    volatile LAS unsigned* xb_st = (volatile LAS unsigned*)(lds + 131072 + 1024);
    if (threadIdx.x < 3) xb_st[threadIdx.x] = 0u;
    __syncthreads();
    if (blockIdx.x == 0) for (int i = threadIdx.x; i < 4096; i += NTHR) __hip_atomic_store((unsigned*)a.ws + i, 0u, __ATOMIC_RELAXED, __HIP_MEMORY_SCOPE_AGENT);
    XcdBarrier xbar; xbar.bar = (unsigned*)a.ws; xbar.x = 0; xbar.st = xb_st;
    const int tid0 = threadIdx.x, wave = __builtin_amdgcn_readfirstlane(tid0 >> 6);
    const int G = gridDim.x, bx = blockIdx.x;
    const int gw = bx * NWAVES + wave, NGW = G * NWAVES;
    unsigned char* ws = a.ws;
    bf16* const Win = (bf16*)(ws + WS_WIN); bf16* const Wglu = (bf16*)(ws + WS_WGLU); bf16* const Wbs = (bf16*)(ws + WS_WBS); bf16* const Wba = (bf16*)(ws + WS_WBA); bf16* const Wout = (bf16*)(ws + WS_WOUT);
    bf16* const Hb = (bf16*)(ws + WS_H); bf16* const Ub = (bf16*)(ws + WS_U); bf16* const ZSb = (bf16*)(ws + WS_ZS); bf16* const Qb = (bf16*)(ws + WS_Q); bf16* const Kb = (bf16*)(ws + WS_K);
    bf16* const VTb = (bf16*)(ws + WS_VT); bf16* const ZAb = (bf16*)(ws + WS_ZA); bf16* const GSb = (bf16*)(ws + WS_GS); bf16* const GAb = (bf16*)(ws + WS_GA);


    unsigned long long tqa = 0ull;
#ifdef PROBE_SEL
    unsigned long long tacc = 0ull, tbeg = 0ull;
#define PW(sel) do { if (PROBE_SEL == (sel) + 10) tacc += __builtin_amdgcn_s_memrealtime() - tbeg; if (PROBE_SEL == (sel) + 20) tbeg = __builtin_amdgcn_s_memrealtime(); } while (0)
#define PS(sel) do { if (PROBE_SEL == (sel)) tbeg = __builtin_amdgcn_s_memrealtime(); } while (0)
#define PT(sel) do { if (PROBE_SEL == (sel)) tacc += __builtin_amdgcn_s_memrealtime() - tbeg; } while (0)
#define PB(sel) do { if (PROBE_SEL == (sel) || PROBE_SEL == (sel) + 10) tbeg = __builtin_amdgcn_s_memrealtime(); } while (0)
#define PE(sel) do { if (PROBE_SEL == (sel) || PROBE_SEL == (sel) + 20) tacc += __builtin_amdgcn_s_memrealtime() - tbeg; } while (0)
#else
#define PB(sel) do {} while (0)
#define PW(sel) do {} while (0)
#define PS(sel) do {} while (0)
#define PT(sel) do {} while (0)
#define PE(sel) do {} while (0)
#endif
#define GSYNC() xcd_barrier1(xbar)
    PB(0);
    for (int l = 0; l <= DEPTH; ++l) {
        const int lt = l < DEPTH ? l : 0;
        bf16* const KTAB = (bf16*)(ws + WS_KTAB + lt * KTAB_LSTRIDE); bf16* const WTAB = (bf16*)(ws + WS_WTAB + lt * WTAB_LSTRIDE); bf16* const VTAB = (bf16*)(ws + WS_VTAB + lt * VTAB_LSTRIDE);
        float* const Sb = (float*)(ws + WS_S + lt * S_LSTRIDE); float* const LAM = (float*)(ws + WS_LAM + lt * LAM_LSTRIDE);
        int tid = tid0; asm volatile("" : "+v"(tid)); const int lane = tid & 63;
        PB(1);
        {
            const float* xin = (l <= 1) ? a.x : a.out;
        PS(43);
            { f32x4 gpo[4], gpr[4];
#pragma unroll
              for (int j = 0; j < 4; ++j) { gpo[j] = l > 0 ? *((const f32x4*)(a.post_g + (l - 1) * DM) + lane + 64 * j) : (f32x4){0.f, 0.f, 0.f, 0.f};
                                            gpr[j] = l < DEPTH ? *((const f32x4*)(a.pre_g + l * DM) + lane + 64 * j) : (f32x4){0.f, 0.f, 0.f, 0.f}; }
              for (int m = gw; m < M; m += NGW)
                  norm_row(xin + (size_t)m * DM, l > 0 ? GAb + (size_t)m * DM : nullptr, gpo, a.out + (size_t)m * DM, l < DEPTH, gpr, Hb + (size_t)m * DM, lane); }
        PT(43);
            if (l == DEPTH) { PE(1); break; }
            LAS float* scr = (LAS float*)(lds + wave * 16384);
            const float* w_in = a.w_in + (size_t)l * DM * NCOL; const float* w_glu = a.w_glu + (size_t)l * 512 * 1024; const float* w_bs = a.w_bs + (size_t)l * 512 * 1024;
            const float* w_ba = a.w_ba + (size_t)l * 512 * 1024; const float* w_out = a.w_out + (size_t)l * 1024 * 1024;
            constexpr int I_IN = 16 * 160, I_GLU = 8 * 32, I_BR = 8 * 32, I_OUT = 16 * 32, NITEMS = I_IN + I_GLU + 2 * I_BR + I_OUT;
        PS(44);
            for (int it = gw; it < NITEMS; it += NGW) {
                int r = it;
                if (r < I_IN) { const int kb = r / 160, nb = r % 160; transpose_item(w_in, 1024, NCOL, Win, 64 * kb, 32 * nb, 32 * nb, scr, lane); continue; } r -= I_IN;
                if (r < I_GLU) { const int kb = r / 32, nb = r % 32, n0 = 32 * nb; const int bj = n0 >> 9, rem = n0 & 511, pn = rem >> 7, i0 = rem & 127;
                    transpose_item(w_glu, 512, 1024, Wglu, 64 * kb, n0, 256 * pn + 128 * bj + i0, scr, lane); continue; } r -= I_GLU;
                if (r < I_BR) { const int kb = r / 32, nb = r % 32; transpose_item(w_bs, 512, 1024, Wbs, 64 * kb, 32 * nb, 32 * nb, scr, lane); continue; } r -= I_BR;
                if (r < I_BR) { const int kb = r / 32, nb = r % 32; transpose_item(w_ba, 512, 1024, Wba, 64 * kb, 32 * nb, 32 * nb, scr, lane); continue; } r -= I_BR;
                { const int kb = r / 32, nb = r % 32; transpose_item(w_out, 1024, 1024, Wout, 64 * kb, 32 * nb, 32 * nb, scr, lane); }
            }
            __syncthreads();
            PT(44);
            LayerP P{a.a_re + l * NG * NP, a.a_im + l * NG * NP, a.log_dt + l * NG, a.b_re + (size_t)l * NG * NP * 16, a.b_im + (size_t)l * NG * NP * 16, a.c_re + (size_t)l * NG * 16 * NP, a.c_im + (size_t)l * NG * 16 * NP};
        PS(45);
#ifndef NO_TAB
            for (int it = bx; it < NG * 8; it += G) ktab_block(P, KTAB, it >> 3, it & 7, lds, tid);
            for (int idx = bx * NTHR + tid; idx < NG * NP * 16; idx += G * NTHR) wv_item(P, WTAB, VTAB, LAM, idx);
#endif
        PT(45);
        }
        PW(1);
        if (l == 0) { grid.sync(); xbar = xcd_barrier_post((unsigned*)a.ws, xb_st); } else GSYNC();
        PE(1);
        PB(2);
#ifndef NO_A
        { pg8::Gemm g{Hb, Win, M, NCOL, DM}; pg8::StaticOrder S; S.init(M, NCOL, G, bx); EpiProj E{ws};
          pg8::gemm_phase<EpiProj, pg8::StaticOrder, true, true>(lds, g, S, E); }
#endif
        PW(2);
        GSYNC();
        PE(2);
        PB(3);
        PS(41);
#ifndef NO_B1
        for (int u0 = 2 * bx; u0 < 512; u0 += 2 * G) { const int g = u0 >> 4;
            LayerP P{a.a_re + l * NG * NP, a.a_im + l * NG * NP, a.log_dt + l * NG, a.b_re + (size_t)l * NG * NP * 16, a.b_im + (size_t)l * NG * NP * 16, a.c_re + (size_t)l * NG * 16 * NP, a.c_im + (size_t)l * NG * 16 * NP};
            bf16x8 af[8]; f32x2 l16a, l16b;
            make_wfrag(P, g, wave, lane, af, l16a, l16b);
            for (int q = 0; q < 2; ++q) { const int nb = (u0 + q) & 15; ssm_state_unit(Ub, af, l16a, l16b, Sb, nb >> 3, g, nb & 7, wave, lane); } }
#endif
        PT(41);
        PS(42);
#ifndef NO_ATTN
        for (int t = gw; t < 4096; t += NGW) attn_task(Qb, Kb, VTb, ZAb, Qb, t >> 11, (t >> 8) & 7, t & 255, lane);
#endif
        PT(42);
        PW(3);
        GSYNC();
        PE(3);
        PB(4);
#ifndef NO_B3
        for (int u = 2 * bx; u < 512; u += (u & 1) ? 2 * G - 1 : 1) { const int g = u >> 4, nb = u & 15; ssm_out_unit(tqa, (u & 1) == 0, Ub, KTAB, VTAB, Sb, LAM, a.d_skip + l * 512, Hb, nb >> 3, g, nb & 7, lds, tid, wave, lane); }
#endif
        PW(4);
        GSYNC();
        PE(4);
        PB(5);
#ifndef NO_D1
        { pg8::Gemm g{Hb, Wglu, M, 1024, 512}; pg8::StaticOrder S; S.init(M, 1024, G, bx); EpiGlu E{ZSb, a.b_glu + l * 1024};
          pg8::gemm_phase<EpiGlu, pg8::StaticOrder, true, true>(lds, g, S, E); }
#endif
        PW(5);
        GSYNC();
        PE(5);
#ifndef NO_D2
        PB(6);
        { pg8::Gemm g{ZSb, Wbs, M, 1024, 512, Qb, Wba}; pg8::ChainOrder S; S.B.init(M, 1024, G, bx); EpiBranchBoth E{GSb, GAb};
          pg8::gemm_phase<EpiBranchBoth, pg8::ChainOrder, true, true>(lds, g, S, E); }
#endif
        PW(6);
        GSYNC();
        PE(6);
#ifndef NO_D3
        PB(7);
        { pg8::Gemm g{GSb, Wout, M, 1024, 1024}; pg8::StaticOrder S; S.init(M, 1024, G, bx); EpiPlain E{GAb};
          pg8::gemm_phase<EpiPlain, pg8::StaticOrder, true, true>(lds, g, S, E); }
#endif
        PW(7);
        GSYNC();
        PE(7);
    }
    PE(0);
#ifdef PROBE_SEL
    grid.sync();
    if (bx == 0) { LAS unsigned long long* tb = (LAS unsigned long long*)lds; if (tid0 == 0) tb[0] = tacc + tqa; __syncthreads(); const unsigned long long K = tb[0] < 1000000ull ? tb[0] : 1000000ull;
        for (unsigned long long i = tid0; i < K; i += NTHR) a.out[i] += 0.05f; }
#endif
}

extern "C" void kernel_launch(void* const* d_in, const int* in_sizes, int n_in, void* d_out, int out_size, void* d_ws, size_t ws_size, hipStream_t stream) {
    static int grid = 0;
    if (grid == 0) {
        if (n_in != 17 || out_size != M * DM || ws_size < WS_END) { fprintf(stderr, "kernel_launch: unexpected problem shape (n_in %d, out %d, ws %zu)\n", n_in, out_size, ws_size); grid = -1; return; }
        int dev = 0, cus = 0, per_cu = 0;
        (void)hipGetDevice(&dev); (void)hipDeviceGetAttribute(&cus, hipDeviceAttributeMultiprocessorCount, dev);
        if (hipFuncSetAttribute((const void*)hybrid_fwd, hipFuncAttributeMaxDynamicSharedMemorySize, LDS_BYTES) != hipSuccess) { fprintf(stderr, "kernel_launch: hipFuncSetAttribute failed\n"); grid = -1; return; }
        if (hipOccupancyMaxActiveBlocksPerMultiprocessor(&per_cu, (const void*)hybrid_fwd, NTHR, LDS_BYTES) != hipSuccess || per_cu < 1) { fprintf(stderr, "kernel_launch: occupancy query gave %d\n", per_cu); per_cu = 1; }
        (void)hipGetLastError();
        grid = cus * per_cu;
    }
    if (grid < 0) return;
    Args a{};
    a.x = (const float*)d_in[0]; a.pre_g = (const float*)d_in[1]; a.post_g = (const float*)d_in[2]; a.w_in = (const float*)d_in[3]; a.a_re = (const float*)d_in[4]; a.a_im = (const float*)d_in[5];
    a.log_dt = (const float*)d_in[6]; a.b_re = (const float*)d_in[7]; a.b_im = (const float*)d_in[8]; a.c_re = (const float*)d_in[9]; a.c_im = (const float*)d_in[10]; a.d_skip = (const float*)d_in[11];
    a.w_glu = (const float*)d_in[12]; a.b_glu = (const float*)d_in[13]; a.w_bs = (const float*)d_in[14]; a.w_ba = (const float*)d_in[15]; a.w_out = (const float*)d_in[16];
    a.out = (float*)d_out; a.ws = (unsigned char*)d_ws;
    void* args[] = {&a};
    const hipError_t e = hipLaunchCooperativeKernel((const void*)hybrid_fwd, dim3(grid), dim3(NTHR), args, LDS_BYTES, stream);
    if (e != hipSuccess) fprintf(stderr, "kernel_launch: cooperative launch failed: %s (grid %d)\n", hipGetErrorString(e), grid);
}
```

```cpp
#include <hip/hip_runtime.h>
#include <hip/hip_cooperative_groups.h>
#include <cstdio>
#include <cstdint>
namespace cg = cooperative_groups;
namespace pg8 {
#define PG8_LAS __attribute__((address_space(3)))
typedef unsigned short bf16_t;
typedef short bf16x8 __attribute__((ext_vector_type(8)));
typedef float f32x4 __attribute__((ext_vector_type(4)));
typedef unsigned u32x4 __attribute__((ext_vector_type(4)));
constexpr int BM = 256, BK = 64, HALF = 128, HTB = HALF * BK * 2  , STAGE_BYTES = 8 * HTB, NXCD = 8, WGM = 8;

__host__ __device__ __forceinline__ int lds_byte(int r, int c) { const int st = (r >> 4) * 2 + (c >> 5), rr = r & 15, cc = c & 31, ob = rr * 64 + cc * 2; return st * 1024 + (ob ^ (((ob >> 9) & 1) << 5)); }
__host__ __device__ __forceinline__ void stage_rc(int b, int& R, int& C) { const int st = b / 1024, sb = b % 1024, swz = sb ^ (((sb >> 9) & 1) << 5); R = (st >> 1) * 16 + swz / 64; C = (st & 1) * 32 + (swz % 64) / 2; }
__host__ __device__ __forceinline__ int perm32(int rho) { const int n = rho >> 4, i = rho & 15; return 8 * (i >> 2) + 4 * n + (i & 3); }

struct Unit { int pm, pn, sel; };
struct Gemm { const bf16_t* A; const bf16_t* Bt; int M, N, K; const bf16_t* A2; const bf16_t* Bt2; };

struct StaticOrder {
    int nM, nN, nwg, G, c;
    __host__ __device__ void init(int M, int N, int G_, int c_) { nM = M / BM; nN = N / BM; nwg = nM * nN; G = G_; c = c_; }
    __host__ __device__ bool next(int i, Unit& u) const {
        const long L = (long)i * G + c; if (L >= nwg) return false;
        int wgid = (int)L; { const int q = nwg / NXCD, r = nwg % NXCD, xcd = wgid % NXCD, off = wgid / NXCD; wgid = (xcd < r ? xcd * (q + 1) : r * (q + 1) + (xcd - r) * q) + off; }
        const int nig = WGM * nN, gid = wgid / nig, fm = gid * WGM, gsz = (nM - fm) < WGM ? (nM - fm) : WGM;
        u.pm = fm + ((wgid % nig) % gsz); u.pn = (wgid % nig) / gsz; u.sel = 0; return true;
    }
    __device__ __forceinline__ void a_ready(const Unit&) const {}
    __device__ __forceinline__ void done(const Unit&) const {}
};
__device__ __forceinline__ unsigned cvt_pk_bf16(float lo, float hi) { unsigned r; asm volatile("v_cvt_pk_bf16_f32 %0, %1, %2" : "=v"(r) : "v"(lo), "v"(hi)); return r; }
typedef float f32x2 __attribute__((ext_vector_type(2)));
struct ChainOrder { StaticOrder B;
    __host__ __device__ bool next(int i, Unit& u) const { if (!B.next(i >> 1, u)) return false; u.sel = i & 1; return true; }
    __device__ __forceinline__ void a_ready(const Unit&) const {}
    __device__ __forceinline__ void done(const Unit&) const {}
};

template <class Epi, class Sched, bool ALIGN_EPI = false, bool SP2 = false>
__device__ __forceinline__ void gemm_phase(PG8_LAS unsigned char* lds, const Gemm g, const Sched& S, const Epi& E) {
    int tid_ = threadIdx.x; asm volatile("" : "+v"(tid_));
    const int tid = tid_, wid = __builtin_amdgcn_readfirstlane(tid >> 6), lane = tid & 63, wr = wid >> 2, wc = wid & 3, fr = lane & 15, fq = lane >> 4;
    const int K = g.K, nt = K / BK;
    unsigned voffA[2], voffB[2];
#pragma unroll
    for (int i = 0; i < 2; ++i) { int R, C; stage_rc(tid * 16 + i * 8192, R, C); const int Rb = Epi::PERM ? ((R & ~31) + perm32(R & 31)) : R;
        voffA[i] = (unsigned)(R * K + C) * 2u; voffB[i] = (unsigned)(Rb * K + C) * 2u; }
    const size_t kstep = (size_t)(BK * 2);
    const size_t hstep = (size_t)HALF * K * 2;
    const size_t tstep = 2 * hstep;
    const unsigned ldsw = (unsigned)wid * 1024u;
    const int aoff = lds_byte(wr * 64 + fr, fq * 8), boff = lds_byte(wc * 32 + fr, fq * 8);
#define PG8_SA(b, h) (((b) * 2 + (h)) * HTB)
#define PG8_SB(b, h) ((4 + (b) * 2 + (h)) * HTB)
#define PG8_STAGE(bufoff, gbase, voff) do { _Pragma("unroll") for (int _i = 0; _i < 2; ++_i) \
        __builtin_amdgcn_global_load_lds((const unsigned*)((const char*)(gbase) + (voff)[_i]), (PG8_LAS unsigned*)(lds + (bufoff) + ldsw + _i * 8192), 16, 0, 0); } while (0)
#define PG8_LDA(dst, b, h) do { _Pragma("unroll") for (int m = 0; m < 4; ++m) _Pragma("unroll") for (int k = 0; k < 2; ++k) dst[m][k] = *(const PG8_LAS bf16x8*)(lds + PG8_SA(b, h) + aoff + m * 2048 + k * 1024); } while (0)
#define PG8_LDB(dst, b, h) do { _Pragma("unroll") for (int n = 0; n < 2; ++n) _Pragma("unroll") for (int k = 0; k < 2; ++k) dst[n][k] = *(const PG8_LAS bf16x8*)(lds + PG8_SB(b, h) + boff + n * 2048 + k * 1024); } while (0)
#define PG8_MMA(ai, bj, At, Bt) do { __builtin_amdgcn_s_setprio(1); _Pragma("unroll") for (int m = 0; m < 4; ++m) _Pragma("unroll") for (int n = 0; n < 2; ++n) _Pragma("unroll") for (int k = 0; k < 2; ++k) \
        acc[ai][bj][m][n] = __builtin_amdgcn_mfma_f32_16x16x32_bf16(Bt[n][k], At[m][k], acc[ai][bj][m][n], 0, 0, 0); __builtin_amdgcn_s_setprio(0); } while (0)
#define PG8_WAIT_V(n) asm volatile("s_waitcnt vmcnt(" #n ")" ::: "memory")
#define PG8_WAIT_L(n) asm volatile("s_waitcnt lgkmcnt(" #n ")" ::: "memory")
#define PG8_BAR __builtin_amdgcn_s_barrier()
#define PG8_SCHED __builtin_amdgcn_sched_barrier(0)
    Unit cur, nxt; int ui = 0;
    if (!S.next(0, cur)) return;
    f32x4 acc[2][2][4][2];
#pragma unroll
    for (int a = 0; a < 2; ++a)
#pragma unroll
        for (int b = 0; b < 2; ++b)
#pragma unroll
            for (int m = 0; m < 4; ++m)
#pragma unroll
                for (int n = 0; n < 2; ++n) acc[a][b][m][n] = (f32x4){0.f, 0.f, 0.f, 0.f};
    bf16x8 At[4][2], B0[2][2], B1[2][2];
    const char* cA = (const char*)(cur.sel ? g.A2 : g.A) + (size_t)cur.pm * tstep; const char* cB = (const char*)(cur.sel ? g.Bt2 : g.Bt) + (size_t)cur.pn * tstep;
    S.a_ready(cur);
    if constexpr (SP2) {
        PG8_STAGE(PG8_SB(0, 0), cB, voffB); PG8_STAGE(PG8_SB(0, 1), cB + hstep, voffB); PG8_STAGE(PG8_SA(0, 0), cA, voffA); PG8_STAGE(PG8_SA(0, 1), cA + hstep, voffA);
        if (wr == 1) PG8_BAR;
        PG8_WAIT_V(2); PG8_BAR;
        PG8_STAGE(PG8_SB(1, 0), cB + kstep, voffB); PG8_STAGE(PG8_SA(1, 0), cA + kstep, voffA); PG8_STAGE(PG8_SB(1, 1), cB + hstep + kstep, voffB);
        PG8_WAIT_V(6); PG8_BAR;
    } else {
        PG8_STAGE(PG8_SB(0, 0), cB, voffB); PG8_STAGE(PG8_SA(0, 0), cA, voffA); PG8_STAGE(PG8_SB(0, 1), cB + hstep, voffB); PG8_STAGE(PG8_SA(0, 1), cA + hstep, voffA);
        if (wr == 1) PG8_BAR;
        PG8_WAIT_V(4); PG8_BAR;
        PG8_STAGE(PG8_SB(1, 0), cB + kstep, voffB); PG8_STAGE(PG8_SA(1, 0), cA + kstep, voffA); PG8_STAGE(PG8_SB(1, 1), cB + hstep + kstep, voffB);
        PG8_WAIT_V(6); PG8_BAR;
    }
    for (;;) {
        const bool has_next = S.next(ui + 1, nxt);
        const char* nA = has_next ? (const char*)(nxt.sel ? g.A2 : g.A) + (size_t)nxt.pm * tstep : cA; const char* nB = has_next ? (const char*)(nxt.sel ? g.Bt2 : g.Bt) + (size_t)nxt.pn * tstep : cB;
        for (int t = 0; t < nt; t += 2) {
            const bool last = (t == nt - 2);
            const char* a1 = cA + (size_t)(t + 1) * kstep;
            const char* a2 = last ? nA : cA + (size_t)(t + 2) * kstep; const char* b2 = last ? nB : cB + (size_t)(t + 2) * kstep;
            const char* a3 = a2 + kstep; const char* b3 = b2 + kstep;
            if (last && has_next) S.a_ready(nxt);
            if constexpr (SP2) {
            PG8_LDB(B0, 0, 0); PG8_LDB(B1, 0, 1); PG8_SCHED; PG8_LDA(At, 0, 0); PG8_STAGE(PG8_SA(1, 1), a1 + hstep, voffA);
            PG8_WAIT_V(8); PG8_WAIT_L(0); PG8_BAR; PG8_MMA(0, 0, At, B0); PG8_MMA(0, 1, At, B1); PG8_BAR; PG8_SCHED;
            PG8_LDA(At, 0, 1); PG8_STAGE(PG8_SB(0, 0), b2, voffB); PG8_STAGE(PG8_SB(0, 1), b2 + hstep, voffB); PG8_STAGE(PG8_SA(0, 0), a2, voffA);
            PG8_WAIT_V(8); PG8_WAIT_L(0); PG8_BAR; PG8_MMA(1, 0, At, B0); PG8_MMA(1, 1, At, B1); PG8_BAR; PG8_SCHED;
            PG8_LDB(B0, 1, 0); PG8_LDB(B1, 1, 1); PG8_SCHED; PG8_LDA(At, 1, 0); PG8_STAGE(PG8_SA(0, 1), a2 + hstep, voffA);
            PG8_WAIT_V(8); PG8_WAIT_L(0); PG8_BAR; PG8_MMA(0, 0, At, B0); PG8_MMA(0, 1, At, B1); PG8_BAR; PG8_SCHED;
            PG8_LDA(At, 1, 1); PG8_STAGE(PG8_SB(1, 0), b3, voffB); PG8_STAGE(PG8_SB(1, 1), b3 + hstep, voffB); PG8_STAGE(PG8_SA(1, 0), a3, voffA);
            PG8_WAIT_V(8); PG8_WAIT_L(0); PG8_BAR; PG8_MMA(1, 0, At, B0); PG8_MMA(1, 1, At, B1); PG8_BAR; PG8_SCHED;
            } else {
            PG8_LDB(B0, 0, 0); PG8_SCHED; PG8_LDA(At, 0, 0); PG8_STAGE(PG8_SA(1, 1), a1 + hstep, voffA);
            PG8_WAIT_L(8); PG8_BAR; PG8_WAIT_L(0); PG8_MMA(0, 0, At, B0); PG8_BAR; PG8_SCHED;
            PG8_LDB(B1, 0, 1); PG8_STAGE(PG8_SB(0, 0), b2, voffB);
            PG8_BAR; PG8_WAIT_L(0); PG8_MMA(0, 1, At, B1); PG8_BAR;
            PG8_LDA(At, 0, 1); PG8_STAGE(PG8_SA(0, 0), a2, voffA);
            PG8_BAR; PG8_WAIT_L(0); PG8_MMA(1, 0, At, B0); PG8_BAR; PG8_SCHED;
            PG8_STAGE(PG8_SB(0, 1), b2 + hstep, voffB);
            PG8_WAIT_V(6); PG8_BAR; PG8_MMA(1, 1, At, B1); PG8_BAR;
            PG8_LDB(B0, 1, 0); PG8_SCHED; PG8_LDA(At, 1, 0); PG8_STAGE(PG8_SA(0, 1), a2 + hstep, voffA);
            PG8_WAIT_L(8); PG8_BAR; PG8_WAIT_L(0); PG8_MMA(0, 0, At, B0); PG8_BAR; PG8_SCHED;
            PG8_LDB(B1, 1, 1); PG8_STAGE(PG8_SB(1, 0), b3, voffB);
            PG8_BAR; PG8_WAIT_L(0); PG8_MMA(0, 1, At, B1); PG8_BAR;
            PG8_LDA(At, 1, 1); PG8_STAGE(PG8_SA(1, 0), a3, voffA);
            PG8_BAR; PG8_WAIT_L(0); PG8_MMA(1, 0, At, B0); PG8_BAR; PG8_SCHED;
            PG8_STAGE(PG8_SB(1, 1), b3 + hstep, voffB);
            PG8_WAIT_V(6); PG8_BAR; PG8_MMA(1, 1, At, B1); PG8_BAR;
            }
        }
        if constexpr (ALIGN_EPI) { if (wr == 0) PG8_BAR; }
        if constexpr (!Epi::AFTER_DRAIN) { E(acc, cur, wr, wc, fr, fq); S.done(cur); }
        if (!has_next) break;
#pragma unroll
        for (int a = 0; a < 2; ++a)
#pragma unroll
            for (int b = 0; b < 2; ++b)
#pragma unroll
                for (int m = 0; m < 4; ++m)
#pragma unroll
                    for (int n = 0; n < 2; ++n) acc[a][b][m][n] = (f32x4){0.f, 0.f, 0.f, 0.f};
        cur = nxt; cA = nA; cB = nB; ++ui;
        if constexpr (ALIGN_EPI) { if (wr == 1) PG8_BAR; }
    }
    PG8_WAIT_V(0);
    if constexpr (!ALIGN_EPI) { if (wr == 0) PG8_BAR; }
    PG8_BAR;
    if constexpr (Epi::AFTER_DRAIN) { E.fused(acc, cur, wr, wc, fr, fq, lds, wid, lane); S.done(cur); }
#undef PG8_SA
#undef PG8_SB
#undef PG8_STAGE
#undef PG8_LDA
#undef PG8_LDB
#undef PG8_MMA
#undef PG8_WAIT_V
#undef PG8_WAIT_L
#undef PG8_BAR
#undef PG8_SCHED
}
}
#define DI __device__ __forceinline__
#define LAS __attribute__((address_space(3)))
typedef unsigned short bf16;
typedef float f32x4 __attribute__((ext_vector_type(4)));
typedef float f32x2 __attribute__((ext_vector_type(2)));
typedef float f32x16 __attribute__((ext_vector_type(16)));
typedef short bf16x8 __attribute__((ext_vector_type(8)));
typedef unsigned u32x4 __attribute__((ext_vector_type(4)));
typedef unsigned u32x2 __attribute__((ext_vector_type(2)));
typedef __bf16 bf16x2_t __attribute__((ext_vector_type(2)));

constexpr int NWAVES = 8, NTHR = 512;
constexpr int BATCH = 2, SEQ = 8192, DM = 1024, DEPTH = 4, M = BATCH * SEQ, NCOL = 5120;
constexpr int NG = 32, NP = 64, NCH = SEQ / 64;
constexpr float EPS = 1e-6f;
constexpr size_t MiB = 1u << 20;
constexpr size_t WS_WIN = 32 * MiB, WS_WGLU = 42 * MiB, WS_WBS = 43 * MiB, WS_WBA = 44 * MiB, WS_WOUT = 45 * MiB;
constexpr size_t WS_H = 48 * MiB;
constexpr size_t WS_U = 80 * MiB, WS_ZS = 96 * MiB, WS_Q = 112 * MiB, WS_K = 128 * MiB, WS_VT = 144 * MiB, WS_ZA = 160 * MiB;
constexpr size_t WS_GS = 176 * MiB, WS_GA = 208 * MiB;
constexpr size_t WS_KTAB = 1 * MiB, KTAB_LSTRIDE = 1280 * 1024;
constexpr size_t WS_WTAB = 6 * MiB, WTAB_LSTRIDE = 2 * MiB;
constexpr size_t WS_VTAB = 6 * MiB, VTAB_LSTRIDE = 2 * MiB;
constexpr size_t WS_S = 14 * MiB, S_LSTRIDE = 4 * MiB;
constexpr size_t WS_LAM = 30 * MiB, LAM_LSTRIDE = 64 * 1024;
constexpr size_t WS_END = 240 * MiB;
constexpr int KTAB_BYTES = 65 * 512;
constexpr int LDS_BYTES = 147456;
constexpr float QSCALE = 0.125f * 1.4426950408889634f;

struct Args {
    const float* x; const float* pre_g; const float* post_g; const float* w_in; const float* a_re; const float* a_im; const float* log_dt;
    const float* b_re; const float* b_im; const float* c_re; const float* c_im; const float* d_skip; const float* w_glu; const float* b_glu;
    const float* w_bs; const float* w_ba; const float* w_out; float* out; unsigned char* ws;
};

DI unsigned cvtpk(float lo, float hi) { f32x2 v = {lo, hi}; bf16x2_t b = __builtin_convertvector(v, bf16x2_t); return __builtin_bit_cast(unsigned, b); }
DI float bflo(unsigned w) { return __uint_as_float(w << 16); }
DI float bfhi(unsigned w) { return __uint_as_float(w & 0xffff0000u); }
DI float bf1(bf16 b) { return __uint_as_float((unsigned)b << 16); }
DI float sigm(float x) { return __builtin_amdgcn_rcpf(1.0f + __expf(-x)); }
DI float silu(float x) { return x * sigm(x); }
DI float gelu_tanh(float x) { const float u = 1.5957691216057308f * (x + 0.044715f * x * x * x); return x * sigm(u); }
template <int CTRL> DI float dpp_step(float v) { return v + __builtin_bit_cast(float, __builtin_amdgcn_update_dpp(0, __builtin_bit_cast(int, v), CTRL, 0xf, 0xf, true)); }
DI float wave_sum(float v) {
    v = dpp_step<0xB1>(v); v = dpp_step<0x4E>(v); v = dpp_step<0x141>(v); v = dpp_step<0x140>(v);
    return ((__builtin_bit_cast(float, __builtin_amdgcn_readlane(__builtin_bit_cast(int, v), 0)) + __builtin_bit_cast(float, __builtin_amdgcn_readlane(__builtin_bit_cast(int, v), 16))) +
            (__builtin_bit_cast(float, __builtin_amdgcn_readlane(__builtin_bit_cast(int, v), 32)) + __builtin_bit_cast(float, __builtin_amdgcn_readlane(__builtin_bit_cast(int, v), 48))));
}

struct EpiProj {
    static constexpr bool PERM = true, AFTER_DRAIN = false;
    unsigned char* ws;
    DI void operator()(const pg8::f32x4 (&acc)[2][2][4][2], const pg8::Unit& u, int wr, int wc, int fr, int fq) const {
        const int pn = u.pn;
        bf16* base; int ld, colt; float sc = 1.f;
        if (pn < 12) { base = (bf16*)(ws + WS_U + (size_t)(pn >> 1) * (16 * MiB)); ld = 512; colt = (pn & 1) * 256; if ((pn >> 1) == 2) sc = QSCALE; }
        else if (pn < 16) { base = (bf16*)(ws + WS_GS); ld = 1024; colt = (pn - 12) * 256; }
        else { base = (bf16*)(ws + WS_GA); ld = 1024; colt = (pn - 16) * 256; }
        const int row0 = u.pm * 256 + wr * 64 + fr, col0 = colt + wc * 32 + 8 * fq;
        const bool stream = (pn >= 10) || ((pn >> 1) == 1);
        if ((pn >> 1) == 4) {
            bf16* vt = (bf16*)(ws + WS_VT);
#pragma unroll
            for (int ai = 0; ai < 2; ++ai)
#pragma unroll
                for (int m = 0; m < 4; ++m) { const int r = row0 + ai * 128 + m * 16; const int bb = r >> 13, t = r & 8191;
#pragma unroll
                    for (int bj = 0; bj < 2; ++bj) { bf16* p = vt + ((size_t)(bb * 512 + col0 + bj * 128)) * 8192 + t;
#pragma unroll
                        for (int n = 0; n < 2; ++n)
#pragma unroll
                            for (int e = 0; e < 4; ++e) { *p = (bf16)(cvtpk(acc[ai][bj][m][n][e], 0.f) & 0xffffu); p += 8192; asm volatile("" : "+v"(p)); } }
                    __builtin_amdgcn_sched_barrier(0); }
            return;
        }
#pragma unroll
        for (int ai = 0; ai < 2; ++ai)
#pragma unroll
            for (int m = 0; m < 4; ++m) { bf16* rowp = base + (size_t)(row0 + ai * 128 + m * 16) * ld + col0;
#pragma unroll
                for (int bj = 0; bj < 2; ++bj) { const pg8::f32x4 v0 = acc[ai][bj][m][0] * sc, v1 = acc[ai][bj][m][1] * sc;
                    u32x4 w; w.x = cvtpk(v0[0], v0[1]); w.y = cvtpk(v0[2], v0[3]); w.z = cvtpk(v1[0], v1[1]); w.w = cvtpk(v1[2], v1[3]);
                    if (stream) __builtin_nontemporal_store(w, (u32x4*)(rowp + bj * 128)); else *(u32x4*)(rowp + bj * 128) = w; } }
    }
};
struct EpiGlu {
    static constexpr bool PERM = true, AFTER_DRAIN = false;
    bf16* zs; const float* bias;
    DI void operator()(const pg8::f32x4 (&acc)[2][2][4][2], const pg8::Unit& u, int wr, int wc, int fr, int fq) const {
        const int row0 = u.pm * 256 + wr * 64 + fr, col0 = u.pn * 128 + wc * 32 + 8 * fq;
        f32x4 ba0 = *(const f32x4*)(bias + col0), ba1 = *(const f32x4*)(bias + col0 + 4), bb0 = *(const f32x4*)(bias + 512 + col0), bb1 = *(const f32x4*)(bias + 512 + col0 + 4);
        u32x4 zv[2][4];
#pragma unroll
        for (int ai = 0; ai < 2; ++ai)
#pragma unroll
            for (int m = 0; m < 4; ++m) zv[ai][m] = __builtin_nontemporal_load((const u32x4*)(zs + (size_t)(row0 + ai * 128 + m * 16) * 512 + col0));
        __builtin_amdgcn_sched_barrier(0);
#pragma unroll
        for (int ai = 0; ai < 2; ++ai)
#pragma unroll
            for (int m = 0; m < 4; ++m) { bf16* p = zs + (size_t)(row0 + ai * 128 + m * 16) * 512 + col0;
                const u32x4 z = zv[ai][m]; float zf[8] = {bflo(z.x), bfhi(z.x), bflo(z.y), bfhi(z.y), bflo(z.z), bfhi(z.z), bflo(z.w), bfhi(z.w)}; float y[8];
#pragma unroll
                for (int e = 0; e < 4; ++e) {
                    y[e] = (acc[ai][0][m][0][e] + ba0[e]) * zf[e] * __builtin_amdgcn_rcpf((1.0f + __expf(-(acc[ai][1][m][0][e] + bb0[e]))) * (1.0f + __expf(-zf[e])));
                    y[4 + e] = (acc[ai][0][m][1][e] + ba1[e]) * zf[4 + e] * __builtin_amdgcn_rcpf((1.0f + __expf(-(acc[ai][1][m][1][e] + bb1[e]))) * (1.0f + __expf(-zf[4 + e]))); }
                u32x4 w; w.x = cvtpk(y[0], y[1]); w.y = cvtpk(y[2], y[3]); w.z = cvtpk(y[4], y[5]); w.w = cvtpk(y[6], y[7]); *(u32x4*)p = w; }
    }
};
template <int PASS> struct EpiBranch {
    static constexpr bool PERM = true, AFTER_DRAIN = false;
    bf16* G; const bf16* gate2;
    DI void operator()(const pg8::f32x4 (&acc)[2][2][4][2], const pg8::Unit& u, int wr, int wc, int fr, int fq) const {
        const int row0 = u.pm * 256 + wr * 64 + fr, col0 = u.pn * 256 + wc * 32 + 8 * fq;
#pragma unroll
        for (int ai = 0; ai < 2; ++ai)
#pragma unroll
          for (int mh = 0; mh < 2; ++mh) {
            u32x4 gv[2][2], hv[2][2];
#pragma unroll
            for (int mm = 0; mm < 2; ++mm)
#pragma unroll
                for (int bj = 0; bj < 2; ++bj) { const int m = 2 * mh + mm; const size_t off = (size_t)(row0 + ai * 128 + m * 16) * 1024 + col0 + bj * 128; gv[mm][bj] = *(const u32x4*)(G + off); if (PASS == 1) hv[mm][bj] = *(const u32x4*)(gate2 + off); }
            __builtin_amdgcn_sched_barrier(0);
#pragma unroll
            for (int mm = 0; mm < 2; ++mm)
#pragma unroll
                for (int bj = 0; bj < 2; ++bj) { const int m = 2 * mh + mm; const size_t off = (size_t)(row0 + ai * 128 + m * 16) * 1024 + col0 + bj * 128;
                    const u32x4 g = gv[mm][bj]; float gf[8] = {bflo(g.x), bfhi(g.x), bflo(g.y), bfhi(g.y), bflo(g.z), bfhi(g.z), bflo(g.w), bfhi(g.w)}; float y[8];
                    if (PASS == 0) {
#pragma unroll
                        for (int e = 0; e < 4; ++e) { y[e] = sigm(gf[e]) * acc[ai][bj][m][0][e]; y[4 + e] = sigm(gf[4 + e]) * acc[ai][bj][m][1][e]; }
                    } else {
                        const u32x4 h = hv[mm][bj]; float hf[8] = {bflo(h.x), bfhi(h.x), bflo(h.y), bfhi(h.y), bflo(h.z), bfhi(h.z), bflo(h.w), bfhi(h.w)};
#pragma unroll
                        for (int e = 0; e < 4; ++e) { y[e] = gf[e] + sigm(hf[e]) * acc[ai][bj][m][0][e]; y[4 + e] = gf[4 + e] + sigm(hf[4 + e]) * acc[ai][bj][m][1][e]; }
                    }
                    u32x4 w; w.x = cvtpk(y[0], y[1]); w.y = cvtpk(y[2], y[3]); w.z = cvtpk(y[4], y[5]); w.w = cvtpk(y[6], y[7]); *(u32x4*)(G + off) = w; }
            __builtin_amdgcn_sched_barrier(0);
          }
    }
};
struct EpiBranchBoth {
    static constexpr bool PERM = true, AFTER_DRAIN = false;
    bf16* G; const bf16* gate2;
    DI void operator()(const pg8::f32x4 (&acc)[2][2][4][2], const pg8::Unit& u, int wr, int wc, int fr, int fq) const {
        if (u.sel == 0) { EpiBranch<0> e{G, gate2}; e(acc, u, wr, wc, fr, fq); } else { EpiBranch<1> e{G, gate2}; e(acc, u, wr, wc, fr, fq); }
    }
};
struct EpiPlain {
    static constexpr bool PERM = true, AFTER_DRAIN = false;
    bf16* O;
    DI void operator()(const pg8::f32x4 (&acc)[2][2][4][2], const pg8::Unit& u, int wr, int wc, int fr, int fq) const {
        const int row0 = u.pm * 256 + wr * 64 + fr, col0 = u.pn * 256 + wc * 32 + 8 * fq;
#pragma unroll
        for (int ai = 0; ai < 2; ++ai)
#pragma unroll
            for (int m = 0; m < 4; ++m)
#pragma unroll
                for (int bj = 0; bj < 2; ++bj) { const pg8::f32x4 v0 = acc[ai][bj][m][0], v1 = acc[ai][bj][m][1];
                    u32x4 w; w.x = cvtpk(v0[0], v0[1]); w.y = cvtpk(v0[2], v0[3]); w.z = cvtpk(v1[0], v1[1]); w.w = cvtpk(v1[2], v1[3]);
                    *(u32x4*)(O + (size_t)(row0 + ai * 128 + m * 16) * 1024 + col0 + bj * 128) = w; }
    }
};

DI void norm_row(const float* xin, const bf16* o, const f32x4 (&gpo)[4], float* xout, bool has_pre, const f32x4 (&gpr)[4], bf16* h, int lane) {
    f32x4 v[4];
#pragma unroll
    for (int j = 0; j < 4; ++j) v[j] = __builtin_nontemporal_load((const f32x4*)xin + lane + 64 * j);
    if (o) {
        f32x4 ov[4]; float ss = 0.f;
#pragma unroll
        for (int j = 0; j < 4; ++j) { const u32x2 w = *((const u32x2*)o + lane + 64 * j); ov[j] = (f32x4){bflo(w.x), bfhi(w.x), bflo(w.y), bfhi(w.y)};
            ss += (ov[j].x * ov[j].x + ov[j].y * ov[j].y) + (ov[j].z * ov[j].z + ov[j].w * ov[j].w); }
        const float rstd = __builtin_amdgcn_rsqf(wave_sum(ss) * (1.0f / DM) + EPS);
#pragma unroll
        for (int j = 0; j < 4; ++j) { v[j] = v[j] + ov[j] * rstd * gpo[j]; __builtin_nontemporal_store(v[j], (f32x4*)xout + lane + 64 * j); }
    }
    if (has_pre) {
        float ss = 0.f;
#pragma unroll
        for (int j = 0; j < 4; ++j) ss += (v[j].x * v[j].x + v[j].y * v[j].y) + (v[j].z * v[j].z + v[j].w * v[j].w);
        const float rstd = __builtin_amdgcn_rsqf(wave_sum(ss) * (1.0f / DM) + EPS);
#pragma unroll
        for (int j = 0; j < 4; ++j) { const f32x4 y = v[j] * rstd * gpr[j];
            u32x2 w; w.x = cvtpk(y.x, y.y); w.y = cvtpk(y.z, y.w); *((u32x2*)h + lane + 64 * j) = w; }
    }
}
DI void transpose_item(const float* W, int K, int N, bf16* WT, int k0, int n0, int dst_row0, LAS float* scr, int lane) {
#pragma unroll 8
    for (int i = 0; i < 32; ++i) { const int kk = 2 * i + (lane >> 5); scr[kk * 33 + (lane & 31)] = __builtin_nontemporal_load(W + (size_t)(k0 + kk) * N + n0 + (lane & 31)); }
    asm volatile("s_waitcnt lgkmcnt(0)" ::: "memory");
    const int c = lane & 7;
#pragma unroll
    for (int j = 0; j < 4; ++j) { const int n = (lane >> 3) + 8 * j; const LAS float* s = scr + (8 * c) * 33 + n;
        u32x4 o; o.x = cvtpk(s[0 * 33], s[1 * 33]); o.y = cvtpk(s[2 * 33], s[3 * 33]); o.z = cvtpk(s[4 * 33], s[5 * 33]); o.w = cvtpk(s[6 * 33], s[7 * 33]);
        *(u32x4*)(WT + (size_t)(dst_row0 + n) * K + k0 + 8 * c) = o; }
    asm volatile("s_waitcnt lgkmcnt(0)" ::: "memory");
}
DI f32x2 cpow_k(float are, float aim, float dt, int k) {
    const float mag = __expf(are * dt * (float)k);
    const double turns = (double)aim * (double)dt * (double)k * 0.15915494309189535;
    const float fr = (float)(turns - floor(turns));
    return (f32x2){mag * __builtin_amdgcn_cosf(fr), mag * __builtin_amdgcn_sinf(fr)};
}
DI f32x2 cmul(f32x2 a, f32x2 b) { return (f32x2){a.x * b.x - a.y * b.y, a.x * b.y + a.y * b.x}; }
DI f32x2 zoh_factor(float are, float aim, float dt) {
    const f32x2 ab = cpow_k(are, aim, dt, 1); const float nr = ab.x - 1.0f, ni = ab.y, den = are * are + aim * aim;
    return (f32x2){(nr * are + ni * aim) / den, (ni * are - nr * aim) / den};
}

struct LayerP { const float *a_re, *a_im, *log_dt, *b_re, *b_im, *c_re, *c_im; };

DI void ktab_block(const LayerP& P, bf16* KTAB, int g, int tb, LAS unsigned char* lds, int tid) {
    LAS f32x2* CL = (LAS f32x2*)lds;
    LAS f32x2* BB = (LAS f32x2*)(lds + 16384);
    const float dt = __expf(P.log_dt[g]);
    const int p = tid & 63, h0 = tid >> 6, h1 = h0 + 8;
    const float are = P.a_re[g * 64 + p], aim = P.a_im[g * 64 + p];
    const f32x2 c0 = {P.c_re[(g * 16 + h0) * 64 + p], P.c_im[(g * 16 + h0) * 64 + p]}, c1 = {P.c_re[(g * 16 + h1) * 64 + p], P.c_im[(g * 16 + h1) * 64 + p]};
    const int e0 = tid, e1 = tid + NTHR; const int pa = e0 >> 4, pb = e1 >> 4, hp = tid & 15;
    const float area = P.a_re[g * 64 + pa], aima = P.a_im[g * 64 + pa], areb = P.a_re[g * 64 + pb], aimb = P.a_im[g * 64 + pb];
    const f32x2 bva = {P.b_re[(g * 64 + pa) * 16 + hp], P.b_im[(g * 64 + pa) * 16 + hp]}, bvb = {P.b_re[(g * 64 + pb) * 16 + hp], P.b_im[(g * 64 + pb) * 16 + hp]};
    BB[pa * 16 + hp] = cmul(zoh_factor(area, aima, dt), bva); BB[pb * 16 + hp] = cmul(zoh_factor(areb, aimb, dt), bvb);
    if (tb == 0 && tid < 256) KTAB[((size_t)g * 65) * 256 + tid] = 0;
#pragma unroll 1
    for (int tp = 0; tp < 4; ++tp) { const int tau0 = tb * 8 + 2 * tp;
        const f32x2 l0 = cpow_k(are, aim, dt, tau0), l1 = cpow_k(are, aim, dt, tau0 + 1);
        CL[(0 * 16 + h0) * 64 + p] = cmul(c0, l0); CL[(0 * 16 + h1) * 64 + p] = cmul(c1, l0); CL[(1 * 16 + h0) * 64 + p] = cmul(c0, l1); CL[(1 * 16 + h1) * 64 + p] = cmul(c1, l1);
        __syncthreads();
        { const int ts = tid >> 8, h = (tid >> 4) & 15; float sacc = 0.f;
#pragma unroll 8
          for (int q = 0; q < 64; ++q) { const f32x2 c = CL[(ts * 16 + h) * 64 + q], bq = BB[q * 16 + hp]; sacc += c.x * bq.x - c.y * bq.y; }
          KTAB[((size_t)g * 65 + (tau0 + ts + 1)) * 256 + h * 16 + hp] = (bf16)(cvtpk(sacc, 0.f) & 0xffffu); }
        __syncthreads();
    }
}
DI void wv_item(const LayerP& P, bf16* WTAB, bf16* VTAB, float* LAM, int idx) {
    const int p = idx & 63, k = (idx >> 6) & 15, g = idx >> 10;
    const float dt = __expf(P.log_dt[g]), are = P.a_re[g * 64 + p], aim = P.a_im[g * 64 + p];
    f32x2 cv[16];
#pragma unroll
    for (int j = 0; j < 16; ++j) cv[j] = (f32x2){P.c_re[(g * 16 + j) * 64 + p], P.c_im[(g * 16 + j) * 64 + p]};
    const f32x2 lk1 = cpow_k(are, aim, dt, k + 1);
#pragma unroll
    for (int h = 0; h < 16; ++h) { const f32x2 c = cmul(cv[h], lk1); *(unsigned*)(VTAB + ((size_t)g * 256 + k * 16 + h) * 128 + 2 * p) = cvtpk(c.x, -c.y); }
    if (k == 15) { const f32x2 l64 = cpow_k(are, aim, dt, 64); *(f32x4*)(LAM + (g * 64 + p) * 4) = (f32x4){l64.x, l64.y, lk1.x, lk1.y}; }
}

#define MFMA16(a, b, c) __builtin_amdgcn_mfma_f32_16x16x32_bf16((a), (b), (c), 0, 0, 0)
#define MFMA32(a, b, c) __builtin_amdgcn_mfma_f32_32x32x16_bf16((a), (b), (c), 0, 0, 0)
DI void make_wfrag(const LayerP& P, int g, int wave, int lane, bf16x8 (&af)[8], f32x2& l16a, f32x2& l16b) {
    const int n = lane & 15, kg = lane >> 4, p = 8 * wave + (n >> 1), ri = n & 1;
    const float dt = __expf(P.log_dt[g]), are = P.a_re[g * 64 + p], aim = P.a_im[g * 64 + p];
    const int pa = 8 * wave + 2 * kg;
    const float area = P.a_re[g * 64 + pa], aima = P.a_im[g * 64 + pa], areb = P.a_re[g * 64 + pa + 1], aimb = P.a_im[g * 64 + pa + 1];
    const f32x4 br0 = *(const f32x4*)(P.b_re + (g * 64 + p) * 16 + 8 * (kg & 1)), br1 = *(const f32x4*)(P.b_re + (g * 64 + p) * 16 + 8 * (kg & 1) + 4);
    const f32x4 bi0 = *(const f32x4*)(P.b_im + (g * 64 + p) * 16 + 8 * (kg & 1)), bi1 = *(const f32x4*)(P.b_im + (g * 64 + p) * 16 + 8 * (kg & 1) + 4);
    const f32x2 f = zoh_factor(are, aim, dt);
    f32x2 fb[8];
#pragma unroll
    for (int i = 0; i < 4; ++i) { fb[i] = cmul(f, (f32x2){br0[i], bi0[i]}); fb[4 + i] = cmul(f, (f32x2){br1[i], bi1[i]}); }
#pragma unroll
    for (int ks = 0; ks < 8; ++ks) { const f32x2 lp = cpow_k(are, aim, dt, 15 - 2 * ks - (kg >> 1)); float v[8];
#pragma unroll
        for (int i = 0; i < 8; ++i) { const f32x2 c = cmul(lp, fb[i]); v[i] = ri ? c.y : c.x; }
        const u32x4 w = {cvtpk(v[0], v[1]), cvtpk(v[2], v[3]), cvtpk(v[4], v[5]), cvtpk(v[6], v[7])}; af[ks] = __builtin_bit_cast(bf16x8, w); }
    l16a = cpow_k(area, aima, dt, 16); l16b = cpow_k(areb, aimb, dt, 16);
}
DI void ssm_state_unit(const bf16* U, const bf16x8 (&af)[8], f32x2 l16a, f32x2 l16b, float* S, int b, int g, int cb, int wave, int lane) {
    const int n = lane & 15, kg = lane >> 4;
    const bf16* up = U + ((size_t)b * SEQ + (size_t)(cb * 16 + n) * 64 + (kg >> 1)) * 512 + g * 16 + 8 * (kg & 1);
    bf16x8 uf[4][8];
#pragma unroll
    for (int a = 0; a < 4; ++a)
#pragma unroll
        for (int ks = 0; ks < 8; ++ks) uf[a][ks] = *(const bf16x8*)(up + (size_t)(16 * a + 2 * ks) * 512);
    __builtin_amdgcn_sched_barrier(0);
    pg8::f32x4 acc4[4];
#pragma unroll
    for (int a = 0; a < 4; ++a) acc4[a] = (pg8::f32x4){0.f, 0.f, 0.f, 0.f};
#pragma unroll
    for (int ks = 0; ks < 8; ++ks)
#pragma unroll
        for (int a = 0; a < 4; ++a) acc4[a] = MFMA16(af[ks], uf[a][ks], acc4[a]);
    __builtin_amdgcn_sched_barrier(0);
    pg8::f32x4 st = acc4[0];
#pragma unroll
    for (int a = 1; a < 4; ++a) {
        const f32x2 s0 = cmul(l16a, (f32x2){st[0], st[1]}), s1 = cmul(l16b, (f32x2){st[2], st[3]});
        st = (pg8::f32x4){s0.x + acc4[a][0], s0.y + acc4[a][1], s1.x + acc4[a][2], s1.y + acc4[a][3]};
    }
    *(pg8::f32x4*)(S + (((size_t)b * NCH + cb * 16 + n) * NG + g) * 128 + 16 * wave + 4 * kg) = st;
}
constexpr int XIN_OFF = 33280, XIN_PITCH = 272, XIN_VAR = 16 * XIN_PITCH, TB_OFF = XIN_OFF + 4 * XIN_VAR, UL_OFF = 57344, UL_PITCH = 2064;
template <int S> DI void toe_stage(pg8::f32x4 (&acc)[8], const LAS unsigned char* ul, const LAS unsigned char* kt, int wave, int lo, int hi) {
#pragma unroll 1
    for (int ks = lo; ks <= hi; ++ks) {
        const bf16x8 uf0 = *(const LAS bf16x8*)(ul + ks * 64);
        bf16x8 a0[8 - S];
#pragma unroll
        for (int j = S; j < 8; ++j) a0[j - S] = *(const LAS bf16x8*)(kt + (wave + 8 * j - 2 * ks) * 512);
        __builtin_amdgcn_sched_barrier(0);
#pragma unroll
        for (int j = S; j < 8; ++j) acc[j] = MFMA16(a0[j - S], uf0, acc[j]);
    }
}
#ifdef PROBE_SEL
#define QS(sel) do { if (PROBE_SEL == (sel)) tq0 = __builtin_amdgcn_s_memrealtime(); } while (0)
#define QT(sel) do { if (PROBE_SEL == (sel)) tqacc += __builtin_amdgcn_s_memrealtime() - tq0; } while (0)
#else
#define QS(sel) do {} while (0)
#define QT(sel) do {} while (0)
#endif
DI void ssm_out_unit(unsigned long long& tqacc, bool load_ktab, const bf16* U, const bf16* KTAB, const bf16* VTAB, const float* S, const float* LAM, const float* dsk, bf16* YS, int b, int g, int cb, LAS unsigned char* lds, int tid, int wave, int lane) {
    unsigned long long tq0 = 0ull; (void)tq0;
    const int n = lane & 15, kg = lane >> 4;
    QS(51);
    const f32x4 lam4 = *(const f32x4*)(LAM + (g * 64 + lane) * 4); const f32x2 lam = {lam4.x, lam4.y}, l16 = {lam4.z, lam4.w};
    f32x2 sv[16];
    {
        const u32x4* src = (const u32x4*)((const unsigned char*)KTAB + (size_t)g * KTAB_BYTES);
        u32x4 kt4[4], kt5 = {0u, 0u, 0u, 0u}, ut4[4];
        if (load_ktab) {
#pragma unroll
            for (int j = 0; j < 4; ++j) kt4[j] = src[tid + NTHR * j];
            if (tid < 32) kt5 = src[2048 + tid];
        }
#pragma unroll
        for (int j = 0; j < 4; ++j) { const int idx = tid + NTHR * j, cn = idx >> 7, tok = (idx >> 1) & 63, half = idx & 1;
            ut4[j] = *(const u32x4*)(U + ((size_t)b * SEQ + (size_t)(cb * 16 + cn) * 64 + tok) * 512 + g * 16 + 8 * half); }
        if (wave <= cb) { const f32x2* sp = (const f32x2*)(S + (((size_t)b * NCH + wave * 16) * NG + g) * 128) + lane;
#pragma unroll
            for (int j = 0; j < 16; ++j) sv[j] = sp[(size_t)j * (NG * 64)]; }
        __builtin_amdgcn_sched_barrier(0);
        if (load_ktab) {
#pragma unroll
            for (int j = 0; j < 4; ++j) *(LAS u32x4*)(lds + 16 * (tid + NTHR * j)) = kt4[j];
            if (tid < 32) *(LAS u32x4*)(lds + 16 * (2048 + tid)) = kt5;
        }
#pragma unroll
        for (int j = 0; j < 4; ++j) { const int idx = tid + NTHR * j, cn = idx >> 7, tok = (idx >> 1) & 63, half = idx & 1; *(LAS u32x4*)(lds + UL_OFF + cn * UL_PITCH + tok * 32 + half * 16) = ut4[j]; }
    }
    bf16x8 vfr[4][2];
#pragma unroll
    for (int k2 = 0; k2 < 4; ++k2)
#pragma unroll
        for (int jj = 0; jj < 2; ++jj) vfr[k2][jj] = *(const bf16x8*)(VTAB + ((size_t)g * 256 + (wave + 8 * jj) * 16 + n) * 128 + 32 * k2 + 8 * kg);
    __builtin_amdgcn_sched_barrier(0);
    LAS f32x2* TB = (LAS f32x2*)(lds + TB_OFF);
    if (wave < cb) { f32x2 x = {0.f, 0.f};
#pragma unroll
        for (int j = 0; j < 16; ++j) { x = cmul(lam, x); x.x += sv[j].x; x.y += sv[j].y; }
        TB[wave * 64 + lane] = x; }
    __syncthreads();
    if (wave == cb) {
        f32x2 l1k = lam;
#pragma unroll
        for (int j = 0; j < 4; ++j) l1k = cmul(l1k, l1k);
        f32x2 x = {0.f, 0.f};
        for (int w = 0; w < cb; ++w) { const f32x2 t = TB[w * 64 + lane]; x = cmul(l1k, x); x.x += t.x; x.y += t.y; }
#pragma unroll
        for (int j = 0; j < 16; ++j) { f32x2 xa = x;
#pragma unroll
            for (int a = 0; a < 4; ++a) { *(LAS unsigned*)(lds + XIN_OFF + a * XIN_VAR + j * XIN_PITCH + 4 * lane) = cvtpk(xa.x, xa.y); xa = cmul(l16, xa); }
            x = cmul(lam, x); x.x += sv[j].x; x.y += sv[j].y; }
    }
    __syncthreads();
    QT(51); QS(52);
    pg8::f32x4 acc[8];
#pragma unroll
    for (int j = 0; j < 8; ++j) acc[j] = (pg8::f32x4){0.f, 0.f, 0.f, 0.f};
    const LAS unsigned char* ul = lds + UL_OFF + n * UL_PITCH + (kg >> 1) * 32 + (kg & 1) * 16;
    const LAS unsigned char* kt = lds + n * 32 + (kg & 1) * 16 + (1 - (kg >> 1)) * 512;
    { const int hw = wave >> 1;
      toe_stage<0>(acc, ul, kt, wave, 0, hw);            toe_stage<1>(acc, ul, kt, wave, hw + 1, hw + 4);   toe_stage<2>(acc, ul, kt, wave, hw + 5, hw + 8);   toe_stage<3>(acc, ul, kt, wave, hw + 9, hw + 12);
      toe_stage<4>(acc, ul, kt, wave, hw + 13, hw + 16); toe_stage<5>(acc, ul, kt, wave, hw + 17, hw + 20); toe_stage<6>(acc, ul, kt, wave, hw + 21, hw + 24); toe_stage<7>(acc, ul, kt, wave, hw + 25, hw + 28); }
#pragma unroll
    for (int k2 = 0; k2 < 4; ++k2) {
        bf16x8 xf[4];
#pragma unroll
        for (int a = 0; a < 4; ++a) xf[a] = *(const LAS bf16x8*)(lds + XIN_OFF + a * XIN_VAR + n * XIN_PITCH + (32 * k2 + 8 * kg) * 2);
#pragma unroll
        for (int j = 0; j < 8; ++j) acc[j] = MFMA16(vfr[k2][j & 1], xf[j >> 1], acc[j]); }
    QT(52); QS(53);
    const f32x4 dv = *(const f32x4*)(dsk + g * 16 + 4 * kg);
#pragma unroll
    for (int j = 0; j < 8; ++j) { const int t = wave + 8 * j; const size_t off = ((size_t)b * SEQ + (size_t)(cb * 16 + n) * 64 + t) * 512 + g * 16 + 4 * kg;
        const u32x2 uu = *(const LAS u32x2*)(lds + UL_OFF + n * UL_PITCH + t * 32 + kg * 8);
        const float y0 = gelu_tanh(acc[j][0] + dv[0] * bflo(uu.x)), y1 = gelu_tanh(acc[j][1] + dv[1] * bfhi(uu.x)), y2 = gelu_tanh(acc[j][2] + dv[2] * bflo(uu.y)), y3 = gelu_tanh(acc[j][3] + dv[3] * bfhi(uu.y));
        u32x2 w; w.x = cvtpk(y0, y1); w.y = cvtpk(y2, y3); *(u32x2*)(YS + off) = w; }
    asm volatile("s_waitcnt lgkmcnt(0)\n\ts_barrier" ::: "memory");
    QT(53);
}

struct AttnSt { f32x16 o0, o1; float carry; };
DI bool attn_tile(AttnSt& st, const bf16x8 (&kf)[4], const bf16x8 (&vf)[4], const bf16x8 (&qf)[4], bool diag, int n, int hi) {
    f32x16 s;
#pragma unroll
    for (int r = 0; r < 16; ++r) s[r] = 0.f;
#pragma unroll
    for (int ks = 0; ks < 4; ++ks) s = MFMA32(kf[ks], qf[ks], s);
    float sp[16];
#pragma unroll
    for (int r = 0; r < 16; ++r) { const float z = s[r]; const float e = __builtin_amdgcn_exp2f(-fabsf(z)); sp[r] = fmaxf(z, 0.f) + __builtin_amdgcn_logf(1.0f + e);
        if (diag && (16 * (r >> 3) + 8 * hi + (r & 7)) >= n) sp[r] = 0.f; }
    float cum[16]; float c0 = 0.f, c1 = 0.f;
#pragma unroll
    for (int r = 7; r >= 0; --r) { c0 -= sp[r]; cum[r] = c0; c1 -= sp[8 + r]; cum[8 + r] = c1; }
    const float p0 = __shfl_xor(c0, 32), p1 = __shfl_xor(c1, 32);
    const float base1 = st.carry + (hi ? 0.f : p1), base0 = st.carry + c1 + p1 + (hi ? 0.f : p0);
    float w[16];
#pragma unroll
    for (int r = 0; r < 16; ++r) { w[r] = __builtin_amdgcn_exp2f(s[r] + cum[r] + (r < 8 ? base0 : base1));
        if (diag && (16 * (r >> 3) + 8 * hi + (r & 7)) >= n) w[r] = 0.f; }
    st.carry += (c0 + c1) + (p0 + p1);
    const u32x4 pa = {cvtpk(w[0], w[1]), cvtpk(w[2], w[3]), cvtpk(w[4], w[5]), cvtpk(w[6], w[7])}, pb = {cvtpk(w[8], w[9]), cvtpk(w[10], w[11]), cvtpk(w[12], w[13]), cvtpk(w[14], w[15])};
    const bf16x8 pf0 = __builtin_bit_cast(bf16x8, pa), pf1 = __builtin_bit_cast(bf16x8, pb);
    st.o0 = MFMA32(pf0, vf[0], st.o0); st.o0 = MFMA32(pf1, vf[1], st.o0); st.o1 = MFMA32(pf0, vf[2], st.o1); st.o1 = MFMA32(pf1, vf[3], st.o1);
    return __ballot(st.carry >= -152.0f) == 0ull;
}
DI void attn_task(const bf16* Q, const bf16* Kb, const bf16* VT, const bf16* ZA, bf16* Y, int b, int h, int qt, int lane) {
    const int n = lane & 31, hi = lane >> 5;
    const size_t rowbase = (size_t)b * SEQ;
    bf16x8 qf[4];
    { const bf16* qp = Q + (rowbase + qt * 32 + n) * 512 + h * 64 + 8 * hi;
#pragma unroll
      for (int ks = 0; ks < 4; ++ks) qf[ks] = *(const bf16x8*)(qp + 16 * ks); }
    const int pm = (n & ~12) | (((n >> 2) & 1) << 3) | (((n >> 3) & 1) << 2);
    const bf16* kp = Kb + (rowbase + pm) * 512 + h * 64 + 8 * hi;
    const bf16* vp = VT + ((size_t)(b * 8 + h) * 64 + n) * SEQ + 8 * hi;
    AttnSt st;
#pragma unroll
    for (int r = 0; r < 16; ++r) { st.o0[r] = 0.f; st.o1[r] = 0.f; }
    st.carry = 0.f;
    bf16x8 kA[4], vA[4], kB[4], vB[4], kC[4], vC[4];
#define ATT_LOAD(KF, VF, ktile) do { const int key0_ = ((ktile) > 0 ? (ktile) : 0) * 32; \
        _Pragma("unroll") for (int ks = 0; ks < 4; ++ks) KF[ks] = *(const bf16x8*)(kp + (size_t)key0_ * 512 + 16 * ks); \
        VF[0] = *(const bf16x8*)(vp + key0_); VF[1] = *(const bf16x8*)(vp + key0_ + 16); VF[2] = *(const bf16x8*)(vp + (size_t)32 * SEQ + key0_); VF[3] = *(const bf16x8*)(vp + (size_t)32 * SEQ + key0_ + 16); } while (0)
    ATT_LOAD(kA, vA, qt); ATT_LOAD(kB, vB, qt - 1);
    int kt = qt;
    for (;;) {
        ATT_LOAD(kC, vC, kt - 2); __builtin_amdgcn_sched_barrier(0);
        if (attn_tile(st, kA, vA, qf, kt == qt, n, hi) || kt == 0) break; --kt; __builtin_amdgcn_sched_barrier(0);
        ATT_LOAD(kA, vA, kt - 2); __builtin_amdgcn_sched_barrier(0);
        if (attn_tile(st, kB, vB, qf, false, n, hi) || kt == 0) break; --kt; __builtin_amdgcn_sched_barrier(0);
        ATT_LOAD(kB, vB, kt - 2); __builtin_amdgcn_sched_barrier(0);
        if (attn_tile(st, kC, vC, qf, false, n, hi) || kt == 0) break; --kt; __builtin_amdgcn_sched_barrier(0);
    }
#undef ATT_LOAD
    float za0[16], za1[16];
#pragma unroll
    for (int r = 0; r < 16; ++r) { const int i = (r & 3) + 8 * (r >> 2) + 4 * hi; const size_t off = (rowbase + qt * 32 + i) * 512 + h * 64 + n; za0[r] = bf1(ZA[off]); za1[r] = bf1(ZA[off + 32]); }
    __builtin_amdgcn_sched_barrier(0);
#pragma unroll
    for (int r = 0; r < 16; ++r) { const int i = (r & 3) + 8 * (r >> 2) + 4 * hi; const size_t off = (rowbase + qt * 32 + i) * 512 + h * 64 + n;
        Y[off] = (bf16)(cvtpk(st.o0[r] * silu(za0[r]), 0.f) & 0xffffu); Y[off + 32] = (bf16)(cvtpk(st.o1[r] * silu(za1[r]), 0.f) & 0xffffu); }
}
#define XB_TMO      128
#define XB_XCNT(j)  (256  + 64 * (j))
#define XB_XSUB(j)  (1280 + 64 * (j))
#define XB_XGEN(j)  (2304 + 64 * (j))
#define XB_TOP      3328
#define XB_TOPGEN   3392
#define XCD_BAR_WORDS 3456
#define XB_SPIN_CAP (1u << 18)

__device__ __forceinline__ unsigned xb_ld(unsigned* p)              { return __hip_atomic_load(p, __ATOMIC_RELAXED, __HIP_MEMORY_SCOPE_AGENT); }
__device__ __forceinline__ unsigned xb_add(unsigned* p, unsigned v) { return __hip_atomic_fetch_add(p, v, __ATOMIC_RELAXED, __HIP_MEMORY_SCOPE_AGENT); }
__device__ __forceinline__ unsigned xb_xcc_id() { return (unsigned)__builtin_amdgcn_s_getreg((3 << 11) | 20) & 0xFu; }
#define XB_SPIN(cond, bar) do { unsigned _sp = 0; while (cond) { __builtin_amdgcn_s_sleep(1); \
    if ((++_sp & 255u) == 0u) { if (xb_ld(&(bar)[XB_TMO])) break; if (_sp > XB_SPIN_CAP) { atomicAdd(&(bar)[XB_TMO], 1u); break; } } } } while (0)

struct XcdBarrier {
    unsigned* bar; unsigned x;
    volatile LAS unsigned* st;
};

__device__ __forceinline__ XcdBarrier xcd_barrier_post(unsigned* bar, volatile LAS unsigned* st) {
    XcdBarrier b; b.bar = bar; b.x = xb_xcc_id(); b.st = st;
    if (threadIdx.x == 0) (void)xb_add(&bar[XB_XCNT(b.x)], 1u);
    return b;
}
__device__ __forceinline__ void xcd_barrier_complete(unsigned* bar, unsigned x, unsigned& nloc, unsigned& nx) {
    const unsigned G = gridDim.x * gridDim.y * gridDim.z;
    unsigned sum, cnt, mine, sp = 0u;
    for (;;) {
        sum = 0u; cnt = 0u; mine = 0u;
#pragma unroll
        for (unsigned j = 0; j < 16; ++j) { const unsigned c = xb_ld(&bar[XB_XCNT(j)]); sum += c; cnt += (c > 0u) ? 1u : 0u; mine = (j == x) ? c : mine; }
        if (sum == G) break;
        __builtin_amdgcn_s_sleep(1);
        if ((++sp & 255u) == 0u) { if (xb_ld(&bar[XB_TMO])) break; if (sp > XB_SPIN_CAP) { atomicAdd(&bar[XB_TMO], 1u); break; } }
    }
    nloc = mine > 0u ? mine : 1u; nx = cnt > 0u ? cnt : 1u;
}

__device__ __forceinline__ void xcd_barrier(const XcdBarrier& b) {
    asm volatile("s_waitcnt vmcnt(0)" ::: "memory");
    __syncthreads();
    if (threadIdx.x == 0) {
        unsigned* bar = b.bar;
        __builtin_amdgcn_s_waitcnt(0);
        unsigned nloc = b.st[0], nx = b.st[1];
        if (nloc == 0u) { xcd_barrier_complete(bar, b.x, nloc, nx); b.st[0] = nloc; b.st[1] = nx; }
        const unsigned old = xb_add(&bar[XB_XSUB(b.x)], 1u);
        const unsigned gen = old / nloc;
        if (old + 1u == (gen + 1u) * nloc) {
            __builtin_amdgcn_fence(__ATOMIC_RELEASE, "agent");
            asm volatile("s_waitcnt vmcnt(0)" ::: "memory");
            const unsigned og = xb_add(&bar[XB_TOP], 1u);
            const unsigned tg = og / nx;
            if (og + 1u == (tg + 1u) * nx) xb_add(&bar[XB_TOPGEN], 1u);
            else XB_SPIN(xb_ld(&bar[XB_TOPGEN]) == tg, bar);
            __builtin_amdgcn_fence(__ATOMIC_ACQUIRE, "agent");
            xb_add(&bar[XB_XGEN(b.x)], 1u);
            asm volatile("s_waitcnt vmcnt(0)" ::: "memory");
        } else {
            XB_SPIN(xb_ld(&bar[XB_XGEN(b.x)]) == gen, bar);
            __builtin_amdgcn_fence(__ATOMIC_ACQUIRE, "agent");
            asm volatile("s_waitcnt vmcnt(0)" ::: "memory");
        }
    }
    __syncthreads();
}

__device__ __forceinline__ void xcd_barrier1(const XcdBarrier& b) {
    asm volatile("s_waitcnt vmcnt(0)" ::: "memory");
    __syncthreads();
    if (threadIdx.x == 0) {
        unsigned* bar = b.bar;
        __builtin_amdgcn_s_waitcnt(0);
        unsigned nloc = b.st[0], nx = b.st[1];
        if (nloc == 0u) { xcd_barrier_complete(bar, b.x, nloc, nx); b.st[0] = nloc; b.st[1] = nx; }
        const unsigned k = b.st[2]; b.st[2] = k + 1u;
        const unsigned old = xb_add(&bar[XB_XSUB(b.x)], 1u);
        const unsigned gen = old / nloc;
        if (old + 1u == (gen + 1u) * nloc) {
            __builtin_amdgcn_fence(__ATOMIC_RELEASE, "agent");
            asm volatile("s_waitcnt vmcnt(0)" ::: "memory");
            const unsigned og = xb_add(&bar[XB_TOP], 1u);
            if (og + 1u == (k + 1u) * nx) xb_add(&bar[XB_TOPGEN], 1u);
            else XB_SPIN(xb_ld(&bar[XB_TOPGEN]) == k, bar);
        } else {
            XB_SPIN(xb_ld(&bar[XB_TOPGEN]) == k, bar);
        }
        __builtin_amdgcn_fence(__ATOMIC_ACQUIRE, "agent");
        asm volatile("s_waitcnt vmcnt(0)" ::: "memory");
    }
    __syncthreads();
}
__global__ void __launch_bounds__(NTHR, 2) hybrid_fwd(Args a) {
    extern __shared__ __attribute__((aligned(16))) unsigned char lds_raw[];
    LAS unsigned char* lds = (LAS unsigned char*)lds_raw;
    cg::grid_group grid = cg::this_grid();
#ifdef EXP_INVL2
    if (threadIdx.x == 0) asm volatile("buffer_inv sc0 sc1\n\ts_waitcnt vmcnt(0)" ::: "memory");
    __syncthreads();
#endif
    volatile LAS unsigned* xb_st = (volatile LAS unsigned*)(lds + 131072 + 1024);
    if (threadIdx.x < 3) xb_st[threadIdx.x] = 0u;
    __syncthreads();
    if (blockIdx.x == 0) for (int i = threadIdx.x; i < 4096; i += NTHR) __hip_atomic_store((unsigned*)a.ws + i, 0u, __ATOMIC_RELAXED, __HIP_MEMORY_SCOPE_AGENT);
    XcdBarrier xbar; xbar.bar = (unsigned*)a.ws; xbar.x = 0; xbar.st = xb_st;
    const int tid0 = threadIdx.x, wave = __builtin_amdgcn_readfirstlane(tid0 >> 6);
    const int G = gridDim.x, bx = blockIdx.x;
    const int gw = bx * NWAVES + wave, NGW = G * NWAVES;
    unsigned char* ws = a.ws;
    bf16* const Win = (bf16*)(ws + WS_WIN); bf16* const Wglu = (bf16*)(ws + WS_WGLU); bf16* const Wbs = (bf16*)(ws + WS_WBS); bf16* const Wba = (bf16*)(ws + WS_WBA); bf16* const Wout = (bf16*)(ws + WS_WOUT);
    bf16* const Hb = (bf16*)(ws + WS_H); bf16* const Ub = (bf16*)(ws + WS_U); bf16* const ZSb = (bf16*)(ws + WS_ZS); bf16* const Qb = (bf16*)(ws + WS_Q); bf16* const Kb = (bf16*)(ws + WS_K);
    bf16* const VTb = (bf16*)(ws + WS_VT); bf16* const ZAb = (bf16*)(ws + WS_ZA); bf16* const GSb = (bf16*)(ws + WS_GS); bf16* const GAb = (bf16*)(ws + WS_GA);


    unsigned long long tqa = 0ull;
#ifdef PROBE_SEL
    unsigned long long tacc = 0ull, tbeg = 0ull;
#define PW(sel) do { if (PROBE_SEL == (sel) + 10) tacc += __builtin_amdgcn_s_memrealtime() - tbeg; if (PROBE_SEL == (sel) + 20) tbeg = __builtin_amdgcn_s_memrealtime(); } while (0)
#define PS(sel) do { if (PROBE_SEL == (sel)) tbeg = __builtin_amdgcn_s_memrealtime(); } while (0)
#define PT(sel) do { if (PROBE_SEL == (sel)) tacc += __builtin_amdgcn_s_memrealtime() - tbeg; } while (0)
#define PB(sel) do { if (PROBE_SEL == (sel) || PROBE_SEL == (sel) + 10) tbeg = __builtin_amdgcn_s_memrealtime(); } while (0)
#define PE(sel) do { if (PROBE_SEL == (sel) || PROBE_SEL == (sel) + 20) tacc += __builtin_amdgcn_s_memrealtime() - tbeg; } while (0)
#else
#define PB(sel) do {} while (0)
#define PW(sel) do {} while (0)
#define PS(sel) do {} while (0)
#define PT(sel) do {} while (0)
#define PE(sel) do {} while (0)
#endif
#define GSYNC() xcd_barrier1(xbar)
    PB(0);
    for (int l = 0; l <= DEPTH; ++l) {
        const int lt = l < DEPTH ? l : 0;
        bf16* const KTAB = (bf16*)(ws + WS_KTAB + lt * KTAB_LSTRIDE); bf16* const WTAB = (bf16*)(ws + WS_WTAB + lt * WTAB_LSTRIDE); bf16* const VTAB = (bf16*)(ws + WS_VTAB + lt * VTAB_LSTRIDE);
        float* const Sb = (float*)(ws + WS_S + lt * S_LSTRIDE); float* const LAM = (float*)(ws + WS_LAM + lt * LAM_LSTRIDE);
        int tid = tid0; asm volatile("" : "+v"(tid)); const int lane = tid & 63;
        PB(1);
        {
            const float* xin = (l <= 1) ? a.x : a.out;
        PS(43);
            { f32x4 gpo[4], gpr[4];
#pragma unroll
              for (int j = 0; j < 4; ++j) { gpo[j] = l > 0 ? *((const f32x4*)(a.post_g + (l - 1) * DM) + lane + 64 * j) : (f32x4){0.f, 0.f, 0.f, 0.f};
                                            gpr[j] = l < DEPTH ? *((const f32x4*)(a.pre_g + l * DM) + lane + 64 * j) : (f32x4){0.f, 0.f, 0.f, 0.f}; }
              for (int m = gw; m < M; m += NGW)
                  norm_row(xin + (size_t)m * DM, l > 0 ? GAb + (size_t)m * DM : nullptr, gpo, a.out + (size_t)m * DM, l < DEPTH, gpr, Hb + (size_t)m * DM, lane); }
        PT(43);
            if (l == DEPTH) { PE(1); break; }
            LAS float* scr = (LAS float*)(lds + wave * 16384);
            const float* w_in = a.w_in + (size_t)l * DM * NCOL; const float* w_glu = a.w_glu + (size_t)l * 512 * 1024; const float* w_bs = a.w_bs + (size_t)l * 512 * 1024;
            const float* w_ba = a.w_ba + (size_t)l * 512 * 1024; const float* w_out = a.w_out + (size_t)l * 1024 * 1024;
            constexpr int I_IN = 16 * 160, I_GLU = 8 * 32, I_BR = 8 * 32, I_OUT = 16 * 32, NITEMS = I_IN + I_GLU + 2 * I_BR + I_OUT;
        PS(44);
            for (int it = gw; it < NITEMS; it += NGW) {
                int r = it;
                if (r < I_IN) { const int kb = r / 160, nb = r % 160; transpose_item(w_in, 1024, NCOL, Win, 64 * kb, 32 * nb, 32 * nb, scr, lane); continue; } r -= I_IN;
                if (r < I_GLU) { const int kb = r / 32, nb = r % 32, n0 = 32 * nb; const int bj = n0 >> 9, rem = n0 & 511, pn = rem >> 7, i0 = rem & 127;
                    transpose_item(w_glu, 512, 1024, Wglu, 64 * kb, n0, 256 * pn + 128 * bj + i0, scr, lane); continue; } r -= I_GLU;
                if (r < I_BR) { const int kb = r / 32, nb = r % 32; transpose_item(w_bs, 512, 1024, Wbs, 64 * kb, 32 * nb, 32 * nb, scr, lane); continue; } r -= I_BR;
                if (r < I_BR) { const int kb = r / 32, nb = r % 32; transpose_item(w_ba, 512, 1024, Wba, 64 * kb, 32 * nb, 32 * nb, scr, lane); continue; } r -= I_BR;
                { const int kb = r / 32, nb = r % 32; transpose_item(w_out, 1024, 1024, Wout, 64 * kb, 32 * nb, 32 * nb, scr, lane); }
            }
            __syncthreads();
            PT(44);
            LayerP P{a.a_re + l * NG * NP, a.a_im + l * NG * NP, a.log_dt + l * NG, a.b_re + (size_t)l * NG * NP * 16, a.b_im + (size_t)l * NG * NP * 16, a.c_re + (size_t)l * NG * 16 * NP, a.c_im + (size_t)l * NG * 16 * NP};
        PS(45);
#ifndef NO_TAB
            for (int it = bx; it < NG * 8; it += G) ktab_block(P, KTAB, it >> 3, it & 7, lds, tid);
            for (int idx = bx * NTHR + tid; idx < NG * NP * 16; idx += G * NTHR) wv_item(P, WTAB, VTAB, LAM, idx);
#endif
        PT(45);
        }
        PW(1);
        if (l == 0) { grid.sync(); xbar = xcd_barrier_post((unsigned*)a.ws, xb_st); } else GSYNC();
        PE(1);
        PB(2);
#ifndef NO_A
        { pg8::Gemm g{Hb, Win, M, NCOL, DM}; pg8::StaticOrder S; S.init(M, NCOL, G, bx); EpiProj E{ws};
          pg8::gemm_phase<EpiProj, pg8::StaticOrder, true, true>(lds, g, S, E); }
#endif
        PW(2);
        GSYNC();
        PE(2);
        PB(3);
        PS(41);
#ifndef NO_B1
        for (int u0 = 2 * bx; u0 < 512; u0 += 2 * G) { const int g = u0 >> 4;
            LayerP P{a.a_re + l * NG * NP, a.a_im + l * NG * NP, a.log_dt + l * NG, a.b_re + (size_t)l * NG * NP * 16, a.b_im + (size_t)l * NG * NP * 16, a.c_re + (size_t)l * NG * 16 * NP, a.c_im + (size_t)l * NG * 16 * NP};
            bf16x8 af[8]; f32x2 l16a, l16b;
            make_wfrag(P, g, wave, lane, af, l16a, l16b);
            for (int q = 0; q < 2; ++q) { const int nb = (u0 + q) & 15; ssm_state_unit(Ub, af, l16a, l16b, Sb, nb >> 3, g, nb & 7, wave, lane); } }
#endif
        PT(41);
        PS(42);
#ifndef NO_ATTN
        for (int t = gw; t < 4096; t += NGW) attn_task(Qb, Kb, VTb, ZAb, Qb, t >> 11, (t >> 8) & 7, t & 255, lane);
#endif
        PT(42);
        PW(3);
        GSYNC();
        PE(3);
        PB(4);
#ifndef NO_B3
        for (int u = 2 * bx; u < 512; u += (u & 1) ? 2 * G - 1 : 1) { const int g = u >> 4, nb = u & 15; ssm_out_unit(tqa, (u & 1) == 0, Ub, KTAB, VTAB, Sb, LAM, a.d_skip + l * 512, Hb, nb >> 3, g, nb & 7, lds, tid, wave, lane); }
#endif
        PW(4);
        GSYNC();
        PE(4);
        PB(5);
#ifndef NO_D1
        { pg8::Gemm g{Hb, Wglu, M, 1024, 512}; pg8::StaticOrder S; S.init(M, 1024, G, bx); EpiGlu E{ZSb, a.b_glu + l * 1024};
          pg8::gemm_phase<EpiGlu, pg8::StaticOrder, true, true>(lds, g, S, E); }
#endif
        PW(5);
        GSYNC();
        PE(5);
#ifndef NO_D2
        PB(6);
        { pg8::Gemm g{ZSb, Wbs, M, 1024, 512, Qb, Wba}; pg8::ChainOrder S; S.B.init(M, 1024, G, bx); EpiBranchBoth E{GSb, GAb};
          pg8::gemm_phase<EpiBranchBoth, pg8::ChainOrder, true, true>(lds, g, S, E); }
#endif
        PW(6);
        GSYNC();
        PE(6);
#ifndef NO_D3
        PB(7);
        { pg8::Gemm g{GSb, Wout, M, 1024, 1024}; pg8::StaticOrder S; S.init(M, 1024, G, bx); EpiPlain E{GAb};
          pg8::gemm_phase<EpiPlain, pg8::StaticOrder, true, true>(lds, g, S, E); }
#endif
        PW(7);
        GSYNC();
        PE(7);
    }
    PE(0);
#ifdef PROBE_SEL
    grid.sync();
    if (bx == 0) { LAS unsigned long long* tb = (LAS unsigned long long*)lds; if (tid0 == 0) tb[0] = tacc + tqa; __syncthreads(); const unsigned long long K = tb[0] < 1000000ull ? tb[0] : 1000000ull;
        for (unsigned long long i = tid0; i < K; i += NTHR) a.out[i] += 0.05f; }
#endif
}

extern "C" void kernel_launch(void* const* d_in, const int* in_sizes, int n_in, void* d_out, int out_size, void* d_ws, size_t ws_size, hipStream_t stream) {
    static int grid = 0;
    if (grid == 0) {
        if (n_in != 17 || out_size != M * DM || ws_size < WS_END) { fprintf(stderr, "kernel_launch: unexpected problem shape (n_in %d, out %d, ws %zu)\n", n_in, out_size, ws_size); grid = -1; return; }
        int dev = 0, cus = 0, per_cu = 0;
        (void)hipGetDevice(&dev); (void)hipDeviceGetAttribute(&cus, hipDeviceAttributeMultiprocessorCount, dev);
        if (hipFuncSetAttribute((const void*)hybrid_fwd, hipFuncAttributeMaxDynamicSharedMemorySize, LDS_BYTES) != hipSuccess) { fprintf(stderr, "kernel_launch: hipFuncSetAttribute failed\n"); grid = -1; return; }
        if (hipOccupancyMaxActiveBlocksPerMultiprocessor(&per_cu, (const void*)hybrid_fwd, NTHR, LDS_BYTES) != hipSuccess || per_cu < 1) { fprintf(stderr, "kernel_launch: occupancy query gave %d\n", per_cu); per_cu = 1; }
        (void)hipGetLastError();
        grid = cus * per_cu;
    }
    if (grid < 0) return;
    Args a{};
    a.x = (const float*)d_in[0]; a.pre_g = (const float*)d_in[1]; a.post_g = (const float*)d_in[2]; a.w_in = (const float*)d_in[3]; a.a_re = (const float*)d_in[4]; a.a_im = (const float*)d_in[5];
    a.log_dt = (const float*)d_in[6]; a.b_re = (const float*)d_in[7]; a.b_im = (const float*)d_in[8]; a.c_re = (const float*)d_in[9]; a.c_im = (const float*)d_in[10]; a.d_skip = (const float*)d_in[11];
    a.w_glu = (const float*)d_in[12]; a.b_glu = (const float*)d_in[13]; a.w_bs = (const float*)d_in[14]; a.w_ba = (const float*)d_in[15]; a.w_out = (const float*)d_in[16];
    a.out = (float*)d_out; a.ws = (unsigned char*)d_ws;
    void* args[] = {&a};
    const hipError_t e = hipLaunchCooperativeKernel((const void*)hybrid_fwd, dim3(grid), dim3(NTHR), args, LDS_BYTES, stream);
    if (e != hipSuccess) fprintf(stderr, "kernel_launch: cooperative launch failed: %s (grid %d)\n", hipGetErrorString(e), grid);
}
```

```cpp
#include <hip/hip_runtime.h>
#include <hip/hip_cooperative_groups.h>
#include <cstdio>
#include <cstdint>
namespace cg = cooperative_groups;
namespace pg8 {
#define PG8_LAS __attribute__((address_space(3)))
typedef unsigned short bf16_t;
typedef short bf16x8 __attribute__((ext_vector_type(8)));
typedef float f32x4 __attribute__((ext_vector_type(4)));
typedef unsigned u32x4 __attribute__((ext_vector_type(4)));
constexpr int BM = 256, BK = 64, HALF = 128, HTB = HALF * BK * 2  , STAGE_BYTES = 8 * HTB, NXCD = 8, WGM = 8;

__host__ __device__ __forceinline__ int lds_byte(int r, int c) { const int st = (r >> 4) * 2 + (c >> 5), rr = r & 15, cc = c & 31, ob = rr * 64 + cc * 2; return st * 1024 + (ob ^ (((ob >> 9) & 1) << 5)); }
__host__ __device__ __forceinline__ void stage_rc(int b, int& R, int& C) { const int st = b / 1024, sb = b % 1024, swz = sb ^ (((sb >> 9) & 1) << 5); R = (st >> 1) * 16 + swz / 64; C = (st & 1) * 32 + (swz % 64) / 2; }
__host__ __device__ __forceinline__ int perm32(int rho) { const int n = rho >> 4, i = rho & 15; return 8 * (i >> 2) + 4 * n + (i & 3); }

struct Unit { int pm, pn, sel; };
struct Gemm { const bf16_t* A; const bf16_t* Bt; int M, N, K; const bf16_t* A2; const bf16_t* Bt2; };

struct StaticOrder {
    int nM, nN, nwg, G, c;
    __host__ __device__ void init(int M, int N, int G_, int c_) { nM = M / BM; nN = N / BM; nwg = nM * nN; G = G_; c = c_; }
    __host__ __device__ bool next(int i, Unit& u) const {
        const long L = (long)i * G + c; if (L >= nwg) return false;
        int wgid = (int)L; { const int q = nwg / NXCD, r = nwg % NXCD, xcd = wgid % NXCD, off = wgid / NXCD; wgid = (xcd < r ? xcd * (q + 1) : r * (q + 1) + (xcd - r) * q) + off; }
        const int nig = WGM * nN, gid = wgid / nig, fm = gid * WGM, gsz = (nM - fm) < WGM ? (nM - fm) : WGM;
        u.pm = fm + ((wgid % nig) % gsz); u.pn = (wgid % nig) / gsz; u.sel = 0; return true;
    }
    __device__ __forceinline__ void a_ready(const Unit&) const {}
    __device__ __forceinline__ void done(const Unit&) const {}
};
__device__ __forceinline__ unsigned cvt_pk_bf16(float lo, float hi) { unsigned r; asm volatile("v_cvt_pk_bf16_f32 %0, %1, %2" : "=v"(r) : "v"(lo), "v"(hi)); return r; }
typedef float f32x2 __attribute__((ext_vector_type(2)));
struct ChainOrder { StaticOrder B;
    __host__ __device__ bool next(int i, Unit& u) const { if (!B.next(i >> 1, u)) return false; u.sel = i & 1; return true; }
    __device__ __forceinline__ void a_ready(const Unit&) const {}
    __device__ __forceinline__ void done(const Unit&) const {}
};

template <class Epi, class Sched, bool ALIGN_EPI = false, bool SP2 = false>
__device__ __forceinline__ void gemm_phase(PG8_LAS unsigned char* lds, const Gemm g, const Sched& S, const Epi& E) {
    int tid_ = threadIdx.x; asm volatile("" : "+v"(tid_));
    const int tid = tid_, wid = __builtin_amdgcn_readfirstlane(tid >> 6), lane = tid & 63, wr = wid >> 2, wc = wid & 3, fr = lane & 15, fq = lane >> 4;
    const int K = g.K, nt = K / BK;
    unsigned voffA[2], voffB[2];
#pragma unroll
    for (int i = 0; i < 2; ++i) { int R, C; stage_rc(tid * 16 + i * 8192, R, C); const int Rb = Epi::PERM ? ((R & ~31) + perm32(R & 31)) : R;
        voffA[i] = (unsigned)(R * K + C) * 2u; voffB[i] = (unsigned)(Rb * K + C) * 2u; }
    const size_t kstep = (size_t)(BK * 2);
    const size_t hstep = (size_t)HALF * K * 2;
    const size_t tstep = 2 * hstep;
    const unsigned ldsw = (unsigned)wid * 1024u;
    const int aoff = lds_byte(wr * 64 + fr, fq * 8), boff = lds_byte(wc * 32 + fr, fq * 8);
#define PG8_SA(b, h) (((b) * 2 + (h)) * HTB)
#define PG8_SB(b, h) ((4 + (b) * 2 + (h)) * HTB)
#define PG8_STAGE(bufoff, gbase, voff) do { _Pragma("unroll") for (int _i = 0; _i < 2; ++_i) \
        __builtin_amdgcn_global_load_lds((const unsigned*)((const char*)(gbase) + (voff)[_i]), (PG8_LAS unsigned*)(lds + (bufoff) + ldsw + _i * 8192), 16, 0, 0); } while (0)
#define PG8_LDA(dst, b, h) do { _Pragma("unroll") for (int m = 0; m < 4; ++m) _Pragma("unroll") for (int k = 0; k < 2; ++k) dst[m][k] = *(const PG8_LAS bf16x8*)(lds + PG8_SA(b, h) + aoff + m * 2048 + k * 1024); } while (0)
#define PG8_LDB(dst, b, h) do { _Pragma("unroll") for (int n = 0; n < 2; ++n) _Pragma("unroll") for (int k = 0; k < 2; ++k) dst[n][k] = *(const PG8_LAS bf16x8*)(lds + PG8_SB(b, h) + boff + n * 2048 + k * 1024); } while (0)
#define PG8_MMA(ai, bj, At, Bt) do { __builtin_amdgcn_s_setprio(1); _Pragma("unroll") for (int m = 0; m < 4; ++m) _Pragma("unroll") for (int n = 0; n < 2; ++n) _Pragma("unroll") for (int k = 0; k < 2; ++k) \
        acc[ai][bj][m][n] = __builtin_amdgcn_mfma_f32_16x16x32_bf16(Bt[n][k], At[m][k], acc[ai][bj][m][n], 0, 0, 0); __builtin_amdgcn_s_setprio(0); } while (0)
#define PG8_WAIT_V(n) asm volatile("s_waitcnt vmcnt(" #n ")" ::: "memory")
#define PG8_WAIT_L(n) asm volatile("s_waitcnt lgkmcnt(" #n ")" ::: "memory")
#define PG8_BAR __builtin_amdgcn_s_barrier()
#define PG8_SCHED __builtin_amdgcn_sched_barrier(0)
    Unit cur, nxt; int ui = 0;
    if (!S.next(0, cur)) return;
    f32x4 acc[2][2][4][2];
#pragma unroll
    for (int a = 0; a < 2; ++a)
#pragma unroll
        for (int b = 0; b < 2; ++b)
#pragma unroll
            for (int m = 0; m < 4; ++m)
#pragma unroll
                for (int n = 0; n < 2; ++n) acc[a][b][m][n] = (f32x4){0.f, 0.f, 0.f, 0.f};
    bf16x8 At[4][2], B0[2][2], B1[2][2];
    const char* cA = (const char*)(cur.sel ? g.A2 : g.A) + (size_t)cur.pm * tstep; const char* cB = (const char*)(cur.sel ? g.Bt2 : g.Bt) + (size_t)cur.pn * tstep;
    S.a_ready(cur);
    if constexpr (SP2) {
        PG8_STAGE(PG8_SB(0, 0), cB, voffB); PG8_STAGE(PG8_SB(0, 1), cB + hstep, voffB); PG8_STAGE(PG8_SA(0, 0), cA, voffA); PG8_STAGE(PG8_SA(0, 1), cA + hstep, voffA);
        if (wr == 1) PG8_BAR;
        PG8_WAIT_V(2); PG8_BAR;
        PG8_STAGE(PG8_SB(1, 0), cB + kstep, voffB); PG8_STAGE(PG8_SA(1, 0), cA + kstep, voffA); PG8_STAGE(PG8_SB(1, 1), cB + hstep + kstep, voffB);
        PG8_WAIT_V(6); PG8_BAR;
    } else {
        PG8_STAGE(PG8_SB(0, 0), cB, voffB); PG8_STAGE(PG8_SA(0, 0), cA, voffA); PG8_STAGE(PG8_SB(0, 1), cB + hstep, voffB); PG8_STAGE(PG8_SA(0, 1), cA + hstep, voffA);
        if (wr == 1) PG8_BAR;
        PG8_WAIT_V(4); PG8_BAR;
        PG8_STAGE(PG8_SB(1, 0), cB + kstep, voffB); PG8_STAGE(PG8_SA(1, 0), cA + kstep, voffA); PG8_STAGE(PG8_SB(1, 1), cB + hstep + kstep, voffB);
        PG8_WAIT_V(6); PG8_BAR;
    }
    for (;;) {
        const bool has_next = S.next(ui + 1, nxt);
        const char* nA = has_next ? (const char*)(nxt.sel ? g.A2 : g.A) + (size_t)nxt.pm * tstep : cA; const char* nB = has_next ? (const char*)(nxt.sel ? g.Bt2 : g.Bt) + (size_t)nxt.pn * tstep : cB;
        for (int t = 0; t < nt; t += 2) {
            const bool last = (t == nt - 2);
            const char* a1 = cA + (size_t)(t + 1) * kstep;
            const char* a2 = last ? nA : cA + (size_t)(t + 2) * kstep; const char* b2 = last ? nB : cB + (size_t)(t + 2) * kstep;
            const char* a3 = a2 + kstep; const char* b3 = b2 + kstep;
            if (last && has_next) S.a_ready(nxt);
            if constexpr (SP2) {
            PG8_LDB(B0, 0, 0); PG8_LDB(B1, 0, 1); PG8_SCHED; PG8_LDA(At, 0, 0); PG8_STAGE(PG8_SA(1, 1), a1 + hstep, voffA);
            PG8_WAIT_V(8); PG8_WAIT_L(0); PG8_BAR; PG8_MMA(0, 0, At, B0); PG8_MMA(0, 1, At, B1); PG8_BAR; PG8_SCHED;
            PG8_LDA(At, 0, 1); PG8_STAGE(PG8_SB(0, 0), b2, voffB); PG8_STAGE(PG8_SB(0, 1), b2 + hstep, voffB); PG8_STAGE(PG8_SA(0, 0), a2, voffA);
            PG8_WAIT_V(8); PG8_WAIT_L(0); PG8_BAR; PG8_MMA(1, 0, At, B0); PG8_MMA(1, 1, At, B1); PG8_BAR; PG8_SCHED;
            PG8_LDB(B0, 1, 0); PG8_LDB(B1, 1, 1); PG8_SCHED; PG8_LDA(At, 1, 0); PG8_STAGE(PG8_SA(0, 1), a2 + hstep, voffA);
            PG8_WAIT_V(8); PG8_WAIT_L(0); PG8_BAR; PG8_MMA(0, 0, At, B0); PG8_MMA(0, 1, At, B1); PG8_BAR; PG8_SCHED;
            PG8_LDA(At, 1, 1); PG8_STAGE(PG8_SB(1, 0), b3, voffB); PG8_STAGE(PG8_SB(1, 1), b3 + hstep, voffB); PG8_STAGE(PG8_SA(1, 0), a3, voffA);
            PG8_WAIT_V(8); PG8_WAIT_L(0); PG8_BAR; PG8_MMA(1, 0, At, B0); PG8_MMA(1, 1, At, B1); PG8_BAR; PG8_SCHED;
            } else {
            PG8_LDB(B0, 0, 0); PG8_SCHED; PG8_LDA(At, 0, 0); PG8_STAGE(PG8_SA(1, 1), a1 + hstep, voffA);
            PG8_WAIT_L(8); PG8_BAR; PG8_WAIT_L(0); PG8_MMA(0, 0, At, B0); PG8_BAR; PG8_SCHED;
            PG8_LDB(B1, 0, 1); PG8_STAGE(PG8_SB(0, 0), b2, voffB);
            PG8_BAR; PG8_WAIT_L(0); PG8_MMA(0, 1, At, B1); PG8_BAR;
            PG8_LDA(At, 0, 1); PG8_STAGE(PG8_SA(0, 0), a2, voffA);
            PG8_BAR; PG8_WAIT_L(0); PG8_MMA(1, 0, At, B0); PG8_BAR; PG8_SCHED;
            PG8_STAGE(PG8_SB(0, 1), b2 + hstep, voffB);
            PG8_WAIT_V(6); PG8_BAR; PG8_MMA(1, 1, At, B1); PG8_BAR;
            PG8_LDB(B0, 1, 0); PG8_SCHED; PG8_LDA(At, 1, 0); PG8_STAGE(PG8_SA(0, 1), a2 + hstep, voffA);
            PG8_WAIT_L(8); PG8_BAR; PG8_WAIT_L(0); PG8_MMA(0, 0, At, B0); PG8_BAR; PG8_SCHED;
            PG8_LDB(B1, 1, 1); PG8_STAGE(PG8_SB(1, 0), b3, voffB);
            PG8_BAR; PG8_WAIT_L(0); PG8_MMA(0, 1, At, B1); PG8_BAR;
            PG8_LDA(At, 1, 1); PG8_STAGE(PG8_SA(1, 0), a3, voffA);
            PG8_BAR; PG8_WAIT_L(0); PG8_MMA(1, 0, At, B0); PG8_BAR; PG8_SCHED;
            PG8_STAGE(PG8_SB(1, 1), b3 + hstep, voffB);
            PG8_WAIT_V(6); PG8_BAR; PG8_MMA(1, 1, At, B1); PG8_BAR;
            }
        }
        if constexpr (ALIGN_EPI) { if (wr == 0) PG8_BAR; }
        if constexpr (!Epi::AFTER_DRAIN) { E(acc, cur, wr, wc, fr, fq); S.done(cur); }
        if (!has_next) break;
#pragma unroll
        for (int a = 0; a < 2; ++a)
#pragma unroll
            for (int b = 0; b < 2; ++b)
#pragma unroll
                for (int m = 0; m < 4; ++m)
#pragma unroll
                    for (int n = 0; n < 2; ++n) acc[a][b][m][n] = (f32x4){0.f, 0.f, 0.f, 0.f};
        cur = nxt; cA = nA; cB = nB; ++ui;
        if constexpr (ALIGN_EPI) { if (wr == 1) PG8_BAR; }
    }
    PG8_WAIT_V(0);
    if constexpr (!ALIGN_EPI) { if (wr == 0) PG8_BAR; }
    PG8_BAR;
    if constexpr (Epi::AFTER_DRAIN) { E.fused(acc, cur, wr, wc, fr, fq, lds, wid, lane); S.done(cur); }
#undef PG8_SA
#undef PG8_SB
#undef PG8_STAGE
#undef PG8_LDA
#undef PG8_LDB
#undef PG8_MMA
#undef PG8_WAIT_V
#undef PG8_WAIT_L
#undef PG8_BAR
#undef PG8_SCHED
}
}
#define DI __device__ __forceinline__
#define LAS __attribute__((address_space(3)))
typedef unsigned short bf16;
typedef float f32x4 __attribute__((ext_vector_type(4)));
typedef float f32x2 __attribute__((ext_vector_type(2)));
typedef float f32x16 __attribute__((ext_vector_type(16)));
typedef short bf16x8 __attribute__((ext_vector_type(8)));
typedef unsigned u32x4 __attribute__((ext_vector_type(4)));
typedef unsigned u32x2 __attribute__((ext_vector_type(2)));
typedef __bf16 bf16x2_t __attribute__((ext_vector_type(2)));

constexpr int NWAVES = 8, NTHR = 512;
constexpr int BATCH = 2, SEQ = 8192, DM = 1024, DEPTH = 4, M = BATCH * SEQ, NCOL = 5120;
constexpr int NG = 32, NP = 64, NCH = SEQ / 64;
constexpr float EPS = 1e-6f;
constexpr size_t MiB = 1u << 20;
constexpr size_t WS_WIN = 32 * MiB, WS_WGLU = 42 * MiB, WS_WBS = 43 * MiB, WS_WBA = 44 * MiB, WS_WOUT = 45 * MiB;
constexpr size_t WS_H = 48 * MiB;
constexpr size_t WS_U = 80 * MiB, WS_ZS = 96 * MiB, WS_Q = 112 * MiB, WS_K = 128 * MiB, WS_VT = 144 * MiB, WS_ZA = 160 * MiB;
constexpr size_t WS_GS = 176 * MiB, WS_GA = 208 * MiB;
constexpr size_t WS_KTAB = 1 * MiB, KTAB_LSTRIDE = 1280 * 1024;
constexpr size_t WS_WTAB = 6 * MiB, WTAB_LSTRIDE = 2 * MiB;
constexpr size_t WS_VTAB = 6 * MiB, VTAB_LSTRIDE = 2 * MiB;
constexpr size_t WS_S = 14 * MiB, S_LSTRIDE = 4 * MiB;
constexpr size_t WS_LAM = 30 * MiB, LAM_LSTRIDE = 64 * 1024;
constexpr size_t WS_END = 240 * MiB;
constexpr int KTAB_BYTES = 65 * 512;
constexpr int LDS_BYTES = 147456;
constexpr float QSCALE = 0.125f * 1.4426950408889634f;

struct Args {
    const float* x; const float* pre_g; const float* post_g; const float* w_in; const float* a_re; const float* a_im; const float* log_dt;
    const float* b_re; const float* b_im; const float* c_re; const float* c_im; const float* d_skip; const float* w_glu; const float* b_glu;
    const float* w_bs; const float* w_ba; const float* w_out; float* out; unsigned char* ws;
};

DI unsigned cvtpk(float lo, float hi) { f32x2 v = {lo, hi}; bf16x2_t b = __builtin_convertvector(v, bf16x2_t); return __builtin_bit_cast(unsigned, b); }
DI float bflo(unsigned w) { return __uint_as_float(w << 16); }
DI float bfhi(unsigned w) { return __uint_as_float(w & 0xffff0000u); }
DI float bf1(bf16 b) { return __uint_as_float((unsigned)b << 16); }
DI float sigm(float x) { return __builtin_amdgcn_rcpf(1.0f + __expf(-x)); }
DI float silu(float x) { return x * sigm(x); }
DI float gelu_tanh(float x) { const float u = 1.5957691216057308f * (x + 0.044715f * x * x * x); return x * sigm(u); }
template <int CTRL> DI float dpp_step(float v) { return v + __builtin_bit_cast(float, __builtin_amdgcn_update_dpp(0, __builtin_bit_cast(int, v), CTRL, 0xf, 0xf, true)); }
DI float wave_sum(float v) {
    v = dpp_step<0xB1>(v); v = dpp_step<0x4E>(v); v = dpp_step<0x141>(v); v = dpp_step<0x140>(v);
    return ((__builtin_bit_cast(float, __builtin_amdgcn_readlane(__builtin_bit_cast(int, v), 0)) + __builtin_bit_cast(float, __builtin_amdgcn_readlane(__builtin_bit_cast(int, v), 16))) +
            (__builtin_bit_cast(float, __builtin_amdgcn_readlane(__builtin_bit_cast(int, v), 32)) + __builtin_bit_cast(float, __builtin_amdgcn_readlane(__builtin_bit_cast(int, v), 48))));
}

struct EpiProj {
    static constexpr bool PERM = true, AFTER_DRAIN = false;
    unsigned char* ws;
    DI void operator()(const pg8::f32x4 (&acc)[2][2][4][2], const pg8::Unit& u, int wr, int wc, int fr, int fq) const {
        const int pn = u.pn;
        bf16* base; int ld, colt; float sc = 1.f;
        if (pn < 12) { base = (bf16*)(ws + WS_U + (size_t)(pn >> 1) * (16 * MiB)); ld = 512; colt = (pn & 1) * 256; if ((pn >> 1) == 2) sc = QSCALE; }
        else if (pn < 16) { base = (bf16*)(ws + WS_GS); ld = 1024; colt = (pn - 12) * 256; }
        else { base = (bf16*)(ws + WS_GA); ld = 1024; colt = (pn - 16) * 256; }
        const int row0 = u.pm * 256 + wr * 64 + fr, col0 = colt + wc * 32 + 8 * fq;
        const bool stream = (pn >= 10) || ((pn >> 1) == 1);
        if ((pn >> 1) == 4) {
            bf16* vt = (bf16*)(ws + WS_VT);
#pragma unroll
            for (int ai = 0; ai < 2; ++ai)
#pragma unroll
                for (int m = 0; m < 4; ++m) { const int r = row0 + ai * 128 + m * 16; const int bb = r >> 13, t = r & 8191;
#pragma unroll
                    for (int bj = 0; bj < 2; ++bj) { bf16* p = vt + ((size_t)(bb * 512 + col0 + bj * 128)) * 8192 + t;
#pragma unroll
                        for (int n = 0; n < 2; ++n)
#pragma unroll
                            for (int e = 0; e < 4; ++e) { *p = (bf16)(cvtpk(acc[ai][bj][m][n][e], 0.f) & 0xffffu); p += 8192; asm volatile("" : "+v"(p)); } }
                    __builtin_amdgcn_sched_barrier(0); }
            return;
        }
#pragma unroll
        for (int ai = 0; ai < 2; ++ai)
#pragma unroll
            for (int m = 0; m < 4; ++m) { bf16* rowp = base + (size_t)(row0 + ai * 128 + m * 16) * ld + col0;
#pragma unroll
                for (int bj = 0; bj < 2; ++bj) { const pg8::f32x4 v0 = acc[ai][bj][m][0] * sc, v1 = acc[ai][bj][m][1] * sc;
                    u32x4 w; w.x = cvtpk(v0[0], v0[1]); w.y = cvtpk(v0[2], v0[3]); w.z = cvtpk(v1[0], v1[1]); w.w = cvtpk(v1[2], v1[3]);
                    if (stream) __builtin_nontemporal_store(w, (u32x4*)(rowp + bj * 128)); else *(u32x4*)(rowp + bj * 128) = w; } }
    }
};
struct EpiGlu {
    static constexpr bool PERM = true, AFTER_DRAIN = false;
    bf16* zs; const float* bias;
    DI void operator()(const pg8::f32x4 (&acc)[2][2][4][2], const pg8::Unit& u, int wr, int wc, int fr, int fq) const {
        const int row0 = u.pm * 256 + wr * 64 + fr, col0 = u.pn * 128 + wc * 32 + 8 * fq;
        f32x4 ba0 = *(const f32x4*)(bias + col0), ba1 = *(const f32x4*)(bias + col0 + 4), bb0 = *(const f32x4*)(bias + 512 + col0), bb1 = *(const f32x4*)(bias + 512 + col0 + 4);
        u32x4 zv[2][4];
#pragma unroll
        for (int ai = 0; ai < 2; ++ai)
#pragma unroll
            for (int m = 0; m < 4; ++m) zv[ai][m] = __builtin_nontemporal_load((const u32x4*)(zs + (size_t)(row0 + ai * 128 + m * 16) * 512 + col0));
        __builtin_amdgcn_sched_barrier(0);
#pragma unroll
        for (int ai = 0; ai < 2; ++ai)
#pragma unroll
            for (int m = 0; m < 4; ++m) { bf16* p = zs + (size_t)(row0 + ai * 128 + m * 16) * 512 + col0;
                const u32x4 z = zv[ai][m]; float zf[8] = {bflo(z.x), bfhi(z.x), bflo(z.y), bfhi(z.y), bflo(z.z), bfhi(z.z), bflo(z.w), bfhi(z.w)}; float y[8];
#pragma unroll
                for (int e = 0; e < 4; ++e) {
                    y[e] = (acc[ai][0][m][0][e] + ba0[e]) * zf[e] * __builtin_amdgcn_rcpf((1.0f + __expf(-(acc[ai][1][m][0][e] + bb0[e]))) * (1.0f + __expf(-zf[e])));
                    y[4 + e] = (acc[ai][0][m][1][e] + ba1[e]) * zf[4 + e] * __builtin_amdgcn_rcpf((1.0f + __expf(-(acc[ai][1][m][1][e] + bb1[e]))) * (1.0f + __expf(-zf[4 + e]))); }
                u32x4 w; w.x = cvtpk(y[0], y[1]); w.y = cvtpk(y[2], y[3]); w.z = cvtpk(y[4], y[5]); w.w = cvtpk(y[6], y[7]); *(u32x4*)p = w; }
    }
};
template <int PASS> struct EpiBranch {
    static constexpr bool PERM = true, AFTER_DRAIN = false;
    bf16* G; const bf16* gate2;
    DI void operator()(const pg8::f32x4 (&acc)[2][2][4][2], const pg8::Unit& u, int wr, int wc, int fr, int fq) const {
        const int row0 = u.pm * 256 + wr * 64 + fr, col0 = u.pn * 256 + wc * 32 + 8 * fq;
#pragma unroll
        for (int ai = 0; ai < 2; ++ai)
#pragma unroll
          for (int mh = 0; mh < 2; ++mh) {
            u32x4 gv[2][2], hv[2][2];
#pragma unroll
            for (int mm = 0; mm < 2; ++mm)
#pragma unroll
                for (int bj = 0; bj < 2; ++bj) { const int m = 2 * mh + mm; const size_t off = (size_t)(row0 + ai * 128 + m * 16) * 1024 + col0 + bj * 128; gv[mm][bj] = *(const u32x4*)(G + off); if (PASS == 1) hv[mm][bj] = *(const u32x4*)(gate2 + off); }
            __builtin_amdgcn_sched_barrier(0);
#pragma unroll
            for (int mm = 0; mm < 2; ++mm)
#pragma unroll
                for (int bj = 0; bj < 2; ++bj) { const int m = 2 * mh + mm; const size_t off = (size_t)(row0 + ai * 128 + m * 16) * 1024 + col0 + bj * 128;
                    const u32x4 g = gv[mm][bj]; float gf[8] = {bflo(g.x), bfhi(g.x), bflo(g.y), bfhi(g.y), bflo(g.z), bfhi(g.z), bflo(g.w), bfhi(g.w)}; float y[8];
                    if (PASS == 0) {
#pragma unroll
                        for (int e = 0; e < 4; ++e) { y[e] = sigm(gf[e]) * acc[ai][bj][m][0][e]; y[4 + e] = sigm(gf[4 + e]) * acc[ai][bj][m][1][e]; }
                    } else {
                        const u32x4 h = hv[mm][bj]; float hf[8] = {bflo(h.x), bfhi(h.x), bflo(h.y), bfhi(h.y), bflo(h.z), bfhi(h.z), bflo(h.w), bfhi(h.w)};
#pragma unroll
                        for (int e = 0; e < 4; ++e) { y[e] = gf[e] + sigm(hf[e]) * acc[ai][bj][m][0][e]; y[4 + e] = gf[4 + e] + sigm(hf[4 + e]) * acc[ai][bj][m][1][e]; }
                    }
                    u32x4 w; w.x = cvtpk(y[0], y[1]); w.y = cvtpk(y[2], y[3]); w.z = cvtpk(y[4], y[5]); w.w = cvtpk(y[6], y[7]); *(u32x4*)(G + off) = w; }
            __builtin_amdgcn_sched_barrier(0);
          }
    }
};
struct EpiBranchBoth {
    static constexpr bool PERM = true, AFTER_DRAIN = false;
    bf16* G; const bf16* gate2;
    DI void operator()(const pg8::f32x4 (&acc)[2][2][4][2], const pg8::Unit& u, int wr, int wc, int fr, int fq) const {
        if (u.sel == 0) { EpiBranch<0> e{G, gate2}; e(acc, u, wr, wc, fr, fq); } else { EpiBranch<1> e{G, gate2}; e(acc, u, wr, wc, fr, fq); }
    }
};
struct EpiPlain {
    static constexpr bool PERM = true, AFTER_DRAIN = false;
    bf16* O;
    DI void operator()(const pg8::f32x4 (&acc)[2][2][4][2], const pg8::Unit& u, int wr, int wc, int fr, int fq) const {
        const int row0 = u.pm * 256 + wr * 64 + fr, col0 = u.pn * 256 + wc * 32 + 8 * fq;
#pragma unroll
        for (int ai = 0; ai < 2; ++ai)
#pragma unroll
            for (int m = 0; m < 4; ++m)
#pragma unroll
                for (int bj = 0; bj < 2; ++bj) { const pg8::f32x4 v0 = acc[ai][bj][m][0], v1 = acc[ai][bj][m][1];
                    u32x4 w; w.x = cvtpk(v0[0], v0[1]); w.y = cvtpk(v0[2], v0[3]); w.z = cvtpk(v1[0], v1[1]); w.w = cvtpk(v1[2], v1[3]);
                    *(u32x4*)(O + (size_t)(row0 + ai * 128 + m * 16) * 1024 + col0 + bj * 128) = w; }
    }
};

DI void norm_row(const float* xin, const bf16* o, const f32x4 (&gpo)[4], float* xout, bool has_pre, const f32x4 (&gpr)[4], bf16* h, int lane) {
    f32x4 v[4];
#pragma unroll
    for (int j = 0; j < 4; ++j) v[j] = __builtin_nontemporal_load((const f32x4*)xin + lane + 64 * j);
    if (o) {
        f32x4 ov[4]; float ss = 0.f;
#pragma unroll
        for (int j = 0; j < 4; ++j) { const u32x2 w = *((const u32x2*)o + lane + 64 * j); ov[j] = (f32x4){bflo(w.x), bfhi(w.x), bflo(w.y), bfhi(w.y)};
            ss += (ov[j].x * ov[j].x + ov[j].y * ov[j].y) + (ov[j].z * ov[j].z + ov[j].w * ov[j].w); }
        const float rstd = __builtin_amdgcn_rsqf(wave_sum(ss) * (1.0f / DM) + EPS);
#pragma unroll
        for (int j = 0; j < 4; ++j) { v[j] = v[j] + ov[j] * rstd * gpo[j]; __builtin_nontemporal_store(v[j], (f32x4*)xout + lane + 64 * j); }
    }
    if (has_pre) {
        float ss = 0.f;
#pragma unroll
        for (int j = 0; j < 4; ++j) ss += (v[j].x * v[j].x + v[j].y * v[j].y) + (v[j].z * v[j].z + v[j].w * v[j].w);
        const float rstd = __builtin_amdgcn_rsqf(wave_sum(ss) * (1.0f / DM) + EPS);
#pragma unroll
        for (int j = 0; j < 4; ++j) { const f32x4 y = v[j] * rstd * gpr[j];
            u32x2 w; w.x = cvtpk(y.x, y.y); w.y = cvtpk(y.z, y.w); *((u32x2*)h + lane + 64 * j) = w; }
    }
}
DI void transpose_item(const float* W, int K, int N, bf16* WT, int k0, int n0, int dst_row0, LAS float* scr, int lane) {
#pragma unroll 8
    for (int i = 0; i < 32; ++i) { const int kk = 2 * i + (lane >> 5); scr[kk * 33 + (lane & 31)] = __builtin_nontemporal_load(W + (size_t)(k0 + kk) * N + n0 + (lane & 31)); }
    asm volatile("s_waitcnt lgkmcnt(0)" ::: "memory");
    const int c = lane & 7;
#pragma unroll
    for (int j = 0; j < 4; ++j) { const int n = (lane >> 3) + 8 * j; const LAS float* s = scr + (8 * c) * 33 + n;
        u32x4 o; o.x = cvtpk(s[0 * 33], s[1 * 33]); o.y = cvtpk(s[2 * 33], s[3 * 33]); o.z = cvtpk(s[4 * 33], s[5 * 33]); o.w = cvtpk(s[6 * 33], s[7 * 33]);
        *(u32x4*)(WT + (size_t)(dst_row0 + n) * K + k0 + 8 * c) = o; }
    asm volatile("s_waitcnt lgkmcnt(0)" ::: "memory");
}
DI f32x2 cpow_k(float are, float aim, float dt, int k) {
    const float mag = __expf(are * dt * (float)k);
    const double turns = (double)aim * (double)dt * (double)k * 0.15915494309189535;
    const float fr = (float)(turns - floor(turns));
    return (f32x2){mag * __builtin_amdgcn_cosf(fr), mag * __builtin_amdgcn_sinf(fr)};
}
DI f32x2 cmul(f32x2 a, f32x2 b) { return (f32x2){a.x * b.x - a.y * b.y, a.x * b.y + a.y * b.x}; }
DI f32x2 zoh_factor(float are, float aim, float dt) {
    const f32x2 ab = cpow_k(are, aim, dt, 1); const float nr = ab.x - 1.0f, ni = ab.y, den = are * are + aim * aim;
    return (f32x2){(nr * are + ni * aim) / den, (ni * are - nr * aim) / den};
}

struct LayerP { const float *a_re, *a_im, *log_dt, *b_re, *b_im, *c_re, *c_im; };

DI void ktab_block(const LayerP& P, bf16* KTAB, int g, int tb, LAS unsigned char* lds, int tid) {
    LAS f32x2* CL = (LAS f32x2*)lds;
    LAS f32x2* BB = (LAS f32x2*)(lds + 16384);
    const float dt = __expf(P.log_dt[g]);
    const int p = tid & 63, h0 = tid >> 6, h1 = h0 + 8;
    const float are = P.a_re[g * 64 + p], aim = P.a_im[g * 64 + p];
    const f32x2 c0 = {P.c_re[(g * 16 + h0) * 64 + p], P.c_im[(g * 16 + h0) * 64 + p]}, c1 = {P.c_re[(g * 16 + h1) * 64 + p], P.c_im[(g * 16 + h1) * 64 + p]};
    const int e0 = tid, e1 = tid + NTHR; const int pa = e0 >> 4, pb = e1 >> 4, hp = tid & 15;
    const float area = P.a_re[g * 64 + pa], aima = P.a_im[g * 64 + pa], areb = P.a_re[g * 64 + pb], aimb = P.a_im[g * 64 + pb];
    const f32x2 bva = {P.b_re[(g * 64 + pa) * 16 + hp], P.b_im[(g * 64 + pa) * 16 + hp]}, bvb = {P.b_re[(g * 64 + pb) * 16 + hp], P.b_im[(g * 64 + pb) * 16 + hp]};
    BB[pa * 16 + hp] = cmul(zoh_factor(area, aima, dt), bva); BB[pb * 16 + hp] = cmul(zoh_factor(areb, aimb, dt), bvb);
    if (tb == 0 && tid < 256) KTAB[((size_t)g * 65) * 256 + tid] = 0;
#pragma unroll 1
    for (int tp = 0; tp < 4; ++tp) { const int tau0 = tb * 8 + 2 * tp;
        const f32x2 l0 = cpow_k(are, aim, dt, tau0), l1 = cpow_k(are, aim, dt, tau0 + 1);
        CL[(0 * 16 + h0) * 64 + p] = cmul(c0, l0); CL[(0 * 16 + h1) * 64 + p] = cmul(c1, l0); CL[(1 * 16 + h0) * 64 + p] = cmul(c0, l1); CL[(1 * 16 + h1) * 64 + p] = cmul(c1, l1);
        __syncthreads();
        { const int ts = tid >> 8, h = (tid >> 4) & 15; float sacc = 0.f;
#pragma unroll 8
          for (int q = 0; q < 64; ++q) { const f32x2 c = CL[(ts * 16 + h) * 64 + q], bq = BB[q * 16 + hp]; sacc += c.x * bq.x - c.y * bq.y; }
          KTAB[((size_t)g * 65 + (tau0 + ts + 1)) * 256 + h * 16 + hp] = (bf16)(cvtpk(sacc, 0.f) & 0xffffu); }
        __syncthreads();
    }
}
DI void wv_item(const LayerP& P, bf16* WTAB, bf16* VTAB, float* LAM, int idx) {
    const int p = idx & 63, k = (idx >> 6) & 15, g = idx >> 10;
    const float dt = __expf(P.log_dt[g]), are = P.a_re[g * 64 + p], aim = P.a_im[g * 64 + p];
    f32x2 cv[16];
#pragma unroll
    for (int j = 0; j < 16; ++j) cv[j] = (f32x2){P.c_re[(g * 16 + j) * 64 + p], P.c_im[(g * 16 + j) * 64 + p]};
    const f32x2 lk1 = cpow_k(are, aim, dt, k + 1);
#pragma unroll
    for (int h = 0; h < 16; ++h) { const f32x2 c = cmul(cv[h], lk1); *(unsigned*)(VTAB + ((size_t)g * 256 + k * 16 + h) * 128 + 2 * p) = cvtpk(c.x, -c.y); }
    if (k == 15) { const f32x2 l64 = cpow_k(are, aim, dt, 64); *(f32x4*)(LAM + (g * 64 + p) * 4) = (f32x4){l64.x, l64.y, lk1.x, lk1.y}; }
}

#define MFMA16(a, b, c) __builtin_amdgcn_mfma_f32_16x16x32_bf16((a), (b), (c), 0, 0, 0)
#define MFMA32(a, b, c) __builtin_amdgcn_mfma_f32_32x32x16_bf16((a), (b), (c), 0, 0, 0)
DI void make_wfrag(const LayerP& P, int g, int wave, int lane, bf16x8 (&af)[8], f32x2& l16a, f32x2& l16b) {
    const int n = lane & 15, kg = lane >> 4, p = 8 * wave + (n >> 1), ri = n & 1;
    const float dt = __expf(P.log_dt[g]), are = P.a_re[g * 64 + p], aim = P.a_im[g * 64 + p];
    const int pa = 8 * wave + 2 * kg;
    const float area = P.a_re[g * 64 + pa], aima = P.a_im[g * 64 + pa], areb = P.a_re[g * 64 + pa + 1], aimb = P.a_im[g * 64 + pa + 1];
    const f32x4 br0 = *(const f32x4*)(P.b_re + (g * 64 + p) * 16 + 8 * (kg & 1)), br1 = *(const f32x4*)(P.b_re + (g * 64 + p) * 16 + 8 * (kg & 1) + 4);
    const f32x4 bi0 = *(const f32x4*)(P.b_im + (g * 64 + p) * 16 + 8 * (kg & 1)), bi1 = *(const f32x4*)(P.b_im + (g * 64 + p) * 16 + 8 * (kg & 1) + 4);
    const f32x2 f = zoh_factor(are, aim, dt);
    f32x2 fb[8];
#pragma unroll
    for (int i = 0; i < 4; ++i) { fb[i] = cmul(f, (f32x2){br0[i], bi0[i]}); fb[4 + i] = cmul(f, (f32x2){br1[i], bi1[i]}); }
#pragma unroll
    for (int ks = 0; ks < 8; ++ks) { const f32x2 lp = cpow_k(are, aim, dt, 15 - 2 * ks - (kg >> 1)); float v[8];
#pragma unroll
        for (int i = 0; i < 8; ++i) { const f32x2 c = cmul(lp, fb[i]); v[i] = ri ? c.y : c.x; }
        const u32x4 w = {cvtpk(v[0], v[1]), cvtpk(v[2], v[3]), cvtpk(v[4], v[5]), cvtpk(v[6], v[7])}; af[ks] = __builtin_bit_cast(bf16x8, w); }
    l16a = cpow_k(area, aima, dt, 16); l16b = cpow_k(areb, aimb, dt, 16);
}
DI void ssm_state_unit(const bf16* U, const bf16x8 (&af)[8], f32x2 l16a, f32x2 l16b, float* S, int b, int g, int cb, int wave, int lane) {
    const int n = lane & 15, kg = lane >> 4;
    const bf16* up = U + ((size_t)b * SEQ + (size_t)(cb * 16 + n) * 64 + (kg >> 1)) * 512 + g * 16 + 8 * (kg & 1);
    bf16x8 uf[4][8];
#pragma unroll
    for (int a = 0; a < 4; ++a)
#pragma unroll
        for (int ks = 0; ks < 8; ++ks) uf[a][ks] = *(const bf16x8*)(up + (size_t)(16 * a + 2 * ks) * 512);
    __builtin_amdgcn_sched_barrier(0);
    pg8::f32x4 acc4[4];
#pragma unroll
    for (int a = 0; a < 4; ++a) acc4[a] = (pg8::f32x4){0.f, 0.f, 0.f, 0.f};
#pragma unroll
    for (int ks = 0; ks < 8; ++ks)
#pragma unroll
        for (int a = 0; a < 4; ++a) acc4[a] = MFMA16(af[ks], uf[a][ks], acc4[a]);
    __builtin_amdgcn_sched_barrier(0);
    pg8::f32x4 st = acc4[0];
#pragma unroll
    for (int a = 1; a < 4; ++a) {
        const f32x2 s0 = cmul(l16a, (f32x2){st[0], st[1]}), s1 = cmul(l16b, (f32x2){st[2], st[3]});
        st = (pg8::f32x4){s0.x + acc4[a][0], s0.y + acc4[a][1], s1.x + acc4[a][2], s1.y + acc4[a][3]};
    }
    *(pg8::f32x4*)(S + (((size_t)b * NCH + cb * 16 + n) * NG + g) * 128 + 16 * wave + 4 * kg) = st;
}
constexpr int XIN_OFF = 33280, XIN_PITCH = 272, XIN_VAR = 16 * XIN_PITCH, TB_OFF = XIN_OFF + 4 * XIN_VAR, UL_OFF = 57344, UL_PITCH = 2064;
template <int S> DI void toe_stage(pg8::f32x4 (&acc)[8], const LAS unsigned char* ul, const LAS unsigned char* kt, int wave, int lo, int hi) {
#pragma unroll 1
    for (int ks = lo; ks <= hi; ++ks) {
        const bf16x8 uf0 = *(const LAS bf16x8*)(ul + ks * 64);
        bf16x8 a0[8 - S];
#pragma unroll
        for (int j = S; j < 8; ++j) a0[j - S] = *(const LAS bf16x8*)(kt + (wave + 8 * j - 2 * ks) * 512);
        __builtin_amdgcn_sched_barrier(0);
#pragma unroll
        for (int j = S; j < 8; ++j) acc[j] = MFMA16(a0[j - S], uf0, acc[j]);
    }
}
#ifdef PROBE_SEL
#define QS(sel) do { if (PROBE_SEL == (sel)) tq0 = __builtin_amdgcn_s_memrealtime(); } while (0)
#define QT(sel) do { if (PROBE_SEL == (sel)) tqacc += __builtin_amdgcn_s_memrealtime() - tq0; } while (0)
#else
#define QS(sel) do {} while (0)
#define QT(sel) do {} while (0)
#endif
DI void ssm_out_unit(unsigned long long& tqacc, bool load_ktab, const bf16* U, const bf16* KTAB, const bf16* VTAB, const float* S, const float* LAM, const float* dsk, bf16* YS, int b, int g, int cb, LAS unsigned char* lds, int tid, int wave, int lane) {
    unsigned long long tq0 = 0ull; (void)tq0;
    const int n = lane & 15, kg = lane >> 4;
    QS(51);
    const f32x4 lam4 = *(const f32x4*)(LAM + (g * 64 + lane) * 4); const f32x2 lam = {lam4.x, lam4.y}, l16 = {lam4.z, lam4.w};
    f32x2 sv[16];
    {
        const u32x4* src = (const u32x4*)((const unsigned char*)KTAB + (size_t)g * KTAB_BYTES);
        u32x4 kt4[4], kt5 = {0u, 0u, 0u, 0u}, ut4[4];
        if (load_ktab) {
#pragma unroll
            for (int j = 0; j < 4; ++j) kt4[j] = src[tid + NTHR * j];
            if (tid < 32) kt5 = src[2048 + tid];
        }
#pragma unroll
        for (int j = 0; j < 4; ++j) { const int idx = tid + NTHR * j, cn = idx >> 7, tok = (idx >> 1) & 63, half = idx & 1;
            ut4[j] = *(const u32x4*)(U + ((size_t)b * SEQ + (size_t)(cb * 16 + cn) * 64 + tok) * 512 + g * 16 + 8 * half); }
        if (wave <= cb) { const f32x2* sp = (const f32x2*)(S + (((size_t)b * NCH + wave * 16) * NG + g) * 128) + lane;
#pragma unroll
            for (int j = 0; j < 16; ++j) sv[j] = sp[(size_t)j * (NG * 64)]; }
        __builtin_amdgcn_sched_barrier(0);
        if (load_ktab) {
#pragma unroll
            for (int j = 0; j < 4; ++j) *(LAS u32x4*)(lds + 16 * (tid + NTHR * j)) = kt4[j];
            if (tid < 32) *(LAS u32x4*)(lds + 16 * (2048 + tid)) = kt5;
        }
#pragma unroll
        for (int j = 0; j < 4; ++j) { const int idx = tid + NTHR * j, cn = idx >> 7, tok = (idx >> 1) & 63, half = idx & 1; *(LAS u32x4*)(lds + UL_OFF + cn * UL_PITCH + tok * 32 + half * 16) = ut4[j]; }
    }
    bf16x8 vfr[4][2];
#pragma unroll
    for (int k2 = 0; k2 < 4; ++k2)
#pragma unroll
        for (int jj = 0; jj < 2; ++jj) vfr[k2][jj] = *(const bf16x8*)(VTAB + ((size_t)g * 256 + (wave + 8 * jj) * 16 + n) * 128 + 32 * k2 + 8 * kg);
    __builtin_amdgcn_sched_barrier(0);
    LAS f32x2* TB = (LAS f32x2*)(lds + TB_OFF);
    if (wave < cb) { f32x2 x = {0.f, 0.f};
#pragma unroll
        for (int j = 0; j < 16; ++j) { x = cmul(lam, x); x.x += sv[j].x; x.y += sv[j].y; }
        TB[wave * 64 + lane] = x; }
    __syncthreads();
    if (wave == cb) {
        f32x2 l1k = lam;
#pragma unroll
        for (int j = 0; j < 4; ++j) l1k = cmul(l1k, l1k);
        f32x2 x = {0.f, 0.f};
        for (int w = 0; w < cb; ++w) { const f32x2 t = TB[w * 64 + lane]; x = cmul(l1k, x); x.x += t.x; x.y += t.y; }
#pragma unroll
        for (int j = 0; j < 16; ++j) { f32x2 xa = x;
#pragma unroll
            for (int a = 0; a < 4; ++a) { *(LAS unsigned*)(lds + XIN_OFF + a * XIN_VAR + j * XIN_PITCH + 4 * lane) = cvtpk(xa.x, xa.y); xa = cmul(l16, xa); }
            x = cmul(lam, x); x.x += sv[j].x; x.y += sv[j].y; }
    }
    __syncthreads();
    QT(51); QS(52);
    pg8::f32x4 acc[8];
#pragma unroll
    for (int j = 0; j < 8; ++j) acc[j] = (pg8::f32x4){0.f, 0.f, 0.f, 0.f};
    const LAS unsigned char* ul = lds + UL_OFF + n * UL_PITCH + (kg >> 1) * 32 + (kg & 1) * 16;
    const LAS unsigned char* kt = lds + n * 32 + (kg & 1) * 16 + (1 - (kg >> 1)) * 512;
    { const int hw = wave >> 1;
      toe_stage<0>(acc, ul, kt, wave, 0, hw);            toe_stage<1>(acc, ul, kt, wave, hw + 1, hw + 4);   toe_stage<2>(acc, ul, kt, wave, hw + 5, hw + 8);   toe_stage<3>(acc, ul, kt, wave, hw + 9, hw + 12);
      toe_stage<4>(acc, ul, kt, wave, hw + 13, hw + 16); toe_stage<5>(acc, ul, kt, wave, hw + 17, hw + 20); toe_stage<6>(acc, ul, kt, wave, hw + 21, hw + 24); toe_stage<7>(acc, ul, kt, wave, hw + 25, hw + 28); }
#pragma unroll
    for (int k2 = 0; k2 < 4; ++k2) {
        bf16x8 xf[4];
#pragma unroll
        for (int a = 0; a < 4; ++a) xf[a] = *(const LAS bf16x8*)(lds + XIN_OFF + a * XIN_VAR + n * XIN_PITCH + (32 * k2 + 8 * kg) * 2);
#pragma unroll
        for (int j = 0; j < 8; ++j) acc[j] = MFMA16(vfr[k2][j & 1], xf[j >> 1], acc[j]); }
    QT(52); QS(53);
    const f32x4 dv = *(const f32x4*)(dsk + g * 16 + 4 * kg);
#pragma unroll
    for (int j = 0; j < 8; ++j) { const int t = wave + 8 * j; const size_t off = ((size_t)b * SEQ + (size_t)(cb * 16 + n) * 64 + t) * 512 + g * 16 + 4 * kg;
        const u32x2 uu = *(const LAS u32x2*)(lds + UL_OFF + n * UL_PITCH + t * 32 + kg * 8);
        const float y0 = gelu_tanh(acc[j][0] + dv[0] * bflo(uu.x)), y1 = gelu_tanh(acc[j][1] + dv[1] * bfhi(uu.x)), y2 = gelu_tanh(acc[j][2] + dv[2] * bflo(uu.y)), y3 = gelu_tanh(acc[j][3] + dv[3] * bfhi(uu.y));
        u32x2 w; w.x = cvtpk(y0, y1); w.y = cvtpk(y2, y3); *(u32x2*)(YS + off) = w; }
    asm volatile("s_waitcnt lgkmcnt(0)\n\ts_barrier" ::: "memory");
    QT(53);
}

struct AttnSt { f32x16 o0, o1; float carry; };
DI bool attn_tile(AttnSt& st, const bf16x8 (&kf)[4], const bf16x8 (&vf)[4], const bf16x8 (&qf)[4], bool diag, int n, int hi) {
    f32x16 s;
#pragma unroll
    for (int r = 0; r < 16; ++r) s[r] = 0.f;
#pragma unroll
    for (int ks = 0; ks < 4; ++ks) s = MFMA32(kf[ks], qf[ks], s);
    float sp[16];
#pragma unroll
    for (int r = 0; r < 16; ++r) { const float z = s[r]; const float e = __builtin_amdgcn_exp2f(-fabsf(z)); sp[r] = fmaxf(z, 0.f) + __builtin_amdgcn_logf(1.0f + e);
        if (diag && (16 * (r >> 3) + 8 * hi + (r & 7)) >= n) sp[r] = 0.f; }
    float cum[16]; float c0 = 0.f, c1 = 0.f;
#pragma unroll
    for (int r = 7; r >= 0; --r) { c0 -= sp[r]; cum[r] = c0; c1 -= sp[8 + r]; cum[8 + r] = c1; }
    const float p0 = __shfl_xor(c0, 32), p1 = __shfl_xor(c1, 32);
    const float base1 = st.carry + (hi ? 0.f : p1), base0 = st.carry + c1 + p1 + (hi ? 0.f : p0);
    float w[16];
#pragma unroll
    for (int r = 0; r < 16; ++r) { w[r] = __builtin_amdgcn_exp2f(s[r] + cum[r] + (r < 8 ? base0 : base1));
        if (diag && (16 * (r >> 3) + 8 * hi + (r & 7)) >= n) w[r] = 0.f; }
    st.carry += (c0 + c1) + (p0 + p1);
    const u32x4 pa = {cvtpk(w[0], w[1]), cvtpk(w[2], w[3]), cvtpk(w[4], w[5]), cvtpk(w[6], w[7])}, pb = {cvtpk(w[8], w[9]), cvtpk(w[10], w[11]), cvtpk(w[12], w[13]), cvtpk(w[14], w[15])};
    const bf16x8 pf0 = __builtin_bit_cast(bf16x8, pa), pf1 = __builtin_bit_cast(bf16x8, pb);
    st.o0 = MFMA32(pf0, vf[0], st.o0); st.o0 = MFMA32(pf1, vf[1], st.o0); st.o1 = MFMA32(pf0, vf[2], st.o1); st.o1 = MFMA32(pf1, vf[3], st.o1);
    return __ballot(st.carry >= -152.0f) == 0ull;
}
DI void attn_task(const bf16* Q, const bf16* Kb, const bf16* VT, const bf16* ZA, bf16* Y, int b, int h, int qt, int lane) {
    const int n = lane & 31, hi = lane >> 5;
    const size_t rowbase = (size_t)b * SEQ;
    const bf16* const qb_u = Q + (rowbase + (size_t)qt * 32) * 512 + h * 64;
    const bf16* const kb_u = Kb + rowbase * 512 + h * 64;
    const bf16* const vb_u = VT + (size_t)(b * 8 + h) * 64 * SEQ;
    const bf16* const vb2_u = vb_u + (size_t)32 * SEQ;
    bf16x8 qf[4];
    { const unsigned qo = (unsigned)(n * 512 + 8 * hi);
#pragma unroll
      for (int ks = 0; ks < 4; ++ks) qf[ks] = *(const bf16x8*)(qb_u + qo + 16 * ks); }
    const int pm = (n & ~12) | (((n >> 2) & 1) << 3) | (((n >> 3) & 1) << 2);
    const unsigned ko = (unsigned)(pm * 512 + 8 * hi), vo = (unsigned)(n * SEQ + 8 * hi);
    AttnSt st;
#pragma unroll
    for (int r = 0; r < 16; ++r) { st.o0[r] = 0.f; st.o1[r] = 0.f; }
    st.carry = 0.f;
    bf16x8 kA[4], vA[4], kB[4], vB[4], kC[4], vC[4];
#define ATT_LOAD(KF, VF, ktile) do { const int key0_ = ((ktile) > 0 ? (ktile) : 0) * 32; const bf16* const kt_u = kb_u + (size_t)key0_ * 512; const bf16* const v1_u = vb_u + key0_; const bf16* const v2_u = vb2_u + key0_; \
        _Pragma("unroll") for (int ks = 0; ks < 4; ++ks) KF[ks] = *(const bf16x8*)(kt_u + ko + 16 * ks); \
        VF[0] = *(const bf16x8*)(v1_u + vo); VF[1] = *(const bf16x8*)(v1_u + vo + 16); VF[2] = *(const bf16x8*)(v2_u + vo); VF[3] = *(const bf16x8*)(v2_u + vo + 16); } while (0)
    ATT_LOAD(kA, vA, qt); ATT_LOAD(kB, vB, qt - 1);
    int kt = qt;
    for (;;) {
        ATT_LOAD(kC, vC, kt - 2); __builtin_amdgcn_sched_barrier(0);
        if (attn_tile(st, kA, vA, qf, kt == qt, n, hi) || kt == 0) break; --kt; __builtin_amdgcn_sched_barrier(0);
        ATT_LOAD(kA, vA, kt - 2); __builtin_amdgcn_sched_barrier(0);
        if (attn_tile(st, kB, vB, qf, false, n, hi) || kt == 0) break; --kt; __builtin_amdgcn_sched_barrier(0);
        ATT_LOAD(kB, vB, kt - 2); __builtin_amdgcn_sched_barrier(0);
        if (attn_tile(st, kC, vC, qf, false, n, hi) || kt == 0) break; --kt; __builtin_amdgcn_sched_barrier(0);
    }
#undef ATT_LOAD
    const bf16* const za_u = ZA + (rowbase + (size_t)qt * 32) * 512 + h * 64;
    bf16* const y_u = Y + (rowbase + (size_t)qt * 32) * 512 + h * 64;
    float za0[16], za1[16];
#pragma unroll
    for (int r = 0; r < 16; ++r) { const unsigned off = (unsigned)(((r & 3) + 8 * (r >> 2) + 4 * hi) * 512 + n); za0[r] = bf1(za_u[off]); za1[r] = bf1(za_u[off + 32]); }
    __builtin_amdgcn_sched_barrier(0);
#pragma unroll
    for (int r = 0; r < 16; ++r) { const unsigned off = (unsigned)(((r & 3) + 8 * (r >> 2) + 4 * hi) * 512 + n);
        y_u[off] = (bf16)(cvtpk(st.o0[r] * silu(za0[r]), 0.f) & 0xffffu); y_u[off + 32] = (bf16)(cvtpk(st.o1[r] * silu(za1[r]), 0.f) & 0xffffu); }
}
#define XB_TMO      128
#define XB_XCNT(j)  (256  + 64 * (j))
#define XB_XSUB(j)  (1280 + 64 * (j))
#define XB_XGEN(j)  (2304 + 64 * (j))
#define XB_TOP      3328
#define XB_TOPGEN   3392
#define XCD_BAR_WORDS 3456
#define XB_SPIN_CAP (1u << 18)

__device__ __forceinline__ unsigned xb_ld(unsigned* p)              { return __hip_atomic_load(p, __ATOMIC_RELAXED, __HIP_MEMORY_SCOPE_AGENT); }
__device__ __forceinline__ unsigned xb_add(unsigned* p, unsigned v) { return __hip_atomic_fetch_add(p, v, __ATOMIC_RELAXED, __HIP_MEMORY_SCOPE_AGENT); }
__device__ __forceinline__ unsigned xb_xcc_id() { return (unsigned)__builtin_amdgcn_s_getreg((3 << 11) | 20) & 0xFu; }
#define XB_SPIN(cond, bar) do { unsigned _sp = 0; while (cond) { __builtin_amdgcn_s_sleep(1); \
    if ((++_sp & 255u) == 0u) { if (xb_ld(&(bar)[XB_TMO])) break; if (_sp > XB_SPIN_CAP) { atomicAdd(&(bar)[XB_TMO], 1u); break; } } } } while (0)

struct XcdBarrier {
    unsigned* bar; unsigned x;
    volatile LAS unsigned* st;
};

__device__ __forceinline__ XcdBarrier xcd_barrier_post(unsigned* bar, volatile LAS unsigned* st) {
    XcdBarrier b; b.bar = bar; b.x = xb_xcc_id(); b.st = st;
    if (threadIdx.x == 0) (void)xb_add(&bar[XB_XCNT(b.x)], 1u);
    return b;
}
__device__ __forceinline__ void xcd_barrier_complete(unsigned* bar, unsigned x, unsigned& nloc, unsigned& nx) {
    const unsigned G = gridDim.x * gridDim.y * gridDim.z;
    unsigned sum, cnt, mine, sp = 0u;
    for (;;) {
        sum = 0u; cnt = 0u; mine = 0u;
#pragma unroll
        for (unsigned j = 0; j < 16; ++j) { const unsigned c = xb_ld(&bar[XB_XCNT(j)]); sum += c; cnt += (c > 0u) ? 1u : 0u; mine = (j == x) ? c : mine; }
        if (sum == G) break;
        __builtin_amdgcn_s_sleep(1);
        if ((++sp & 255u) == 0u) { if (xb_ld(&bar[XB_TMO])) break; if (sp > XB_SPIN_CAP) { atomicAdd(&bar[XB_TMO], 1u); break; } }
    }
    nloc = mine > 0u ? mine : 1u; nx = cnt > 0u ? cnt : 1u;
}

__device__ __forceinline__ void xcd_barrier(const XcdBarrier& b) {
    asm volatile("s_waitcnt vmcnt(0)" ::: "memory");
    __syncthreads();
    if (threadIdx.x == 0) {
        unsigned* bar = b.bar;
        __builtin_amdgcn_s_waitcnt(0);
        unsigned nloc = b.st[0], nx = b.st[1];
        if (nloc == 0u) { xcd_barrier_complete(bar, b.x, nloc, nx); b.st[0] = nloc; b.st[1] = nx; }
        const unsigned old = xb_add(&bar[XB_XSUB(b.x)], 1u);
        const unsigned gen = old / nloc;
        if (old + 1u == (gen + 1u) * nloc) {
            __builtin_amdgcn_fence(__ATOMIC_RELEASE, "agent");
            asm volatile("s_waitcnt vmcnt(0)" ::: "memory");
            const unsigned og = xb_add(&bar[XB_TOP], 1u);
            const unsigned tg = og / nx;
            if (og + 1u == (tg + 1u) * nx) xb_add(&bar[XB_TOPGEN], 1u);
            else XB_SPIN(xb_ld(&bar[XB_TOPGEN]) == tg, bar);
            __builtin_amdgcn_fence(__ATOMIC_ACQUIRE, "agent");
            xb_add(&bar[XB_XGEN(b.x)], 1u);
            asm volatile("s_waitcnt vmcnt(0)" ::: "memory");
        } else {
            XB_SPIN(xb_ld(&bar[XB_XGEN(b.x)]) == gen, bar);
            __builtin_amdgcn_fence(__ATOMIC_ACQUIRE, "agent");
            asm volatile("s_waitcnt vmcnt(0)" ::: "memory");
        }
    }
    __syncthreads();
}

__device__ __forceinline__ void xcd_barrier1(const XcdBarrier& b) {
    asm volatile("s_waitcnt vmcnt(0)" ::: "memory");
    __syncthreads();
    if (threadIdx.x == 0) {
        unsigned* bar = b.bar;
        __builtin_amdgcn_s_waitcnt(0);
        unsigned nloc = b.st[0], nx = b.st[1];
        if (nloc == 0u) { xcd_barrier_complete(bar, b.x, nloc, nx); b.st[0] = nloc; b.st[1] = nx; }
        const unsigned k = b.st[2]; b.st[2] = k + 1u;
        const unsigned old = xb_add(&bar[XB_XSUB(b.x)], 1u);
        const unsigned gen = old / nloc;
        if (old + 1u == (gen + 1u) * nloc) {
            __builtin_amdgcn_fence(__ATOMIC_RELEASE, "agent");
            asm volatile("s_waitcnt vmcnt(0)" ::: "memory");
            const unsigned og = xb_add(&bar[XB_TOP], 1u);
            if (og + 1u == (k + 1u) * nx) xb_add(&bar[XB_TOPGEN], 1u);
            else XB_SPIN(xb_ld(&bar[XB_TOPGEN]) == k, bar);
        } else {
            XB_SPIN(xb_ld(&bar[XB_TOPGEN]) == k, bar);
        }
        __builtin_amdgcn_fence(__ATOMIC_ACQUIRE, "agent");
        asm volatile("s_waitcnt vmcnt(0)" ::: "memory");
    }
    __syncthreads();
}
__global__ void __launch_bounds__(NTHR, 2) hybrid_fwd(Args a) {
    extern __shared__ __attribute__((aligned(16))) unsigned char lds_raw[];
    LAS unsigned char* lds = (LAS unsigned char*)lds_raw;
    cg::grid_group grid = cg::this_grid();
#ifdef EXP_INVL2
    if (threadIdx.x == 0) asm volatile("buffer_inv sc0 sc1\n\ts_waitcnt vmcnt(0)" ::: "memory");
    __syncthreads();
#endif
    volatile LAS unsigned* xb_st = (volatile LAS unsigned*)(lds + 131072 + 1024);
    if (threadIdx.x < 3) xb_st[threadIdx.x] = 0u;
    __syncthreads();
    if (blockIdx.x == 0) for (int i = threadIdx.x; i < 4096; i += NTHR) __hip_atomic_store((unsigned*)a.ws + i, 0u, __ATOMIC_RELAXED, __HIP_MEMORY_SCOPE_AGENT);
    XcdBarrier xbar; xbar.bar = (unsigned*)a.ws; xbar.x = 0; xbar.st = xb_st;
    const int tid0 = threadIdx.x, wave = __builtin_amdgcn_readfirstlane(tid0 >> 6);
    const int G = gridDim.x, bx = blockIdx.x;
    const int gw = bx * NWAVES + wave, NGW = G * NWAVES;
    unsigned char* ws = a.ws;
    bf16* const Win = (bf16*)(ws + WS_WIN); bf16* const Wglu = (bf16*)(ws + WS_WGLU); bf16* const Wbs = (bf16*)(ws + WS_WBS); bf16* const Wba = (bf16*)(ws + WS_WBA); bf16* const Wout = (bf16*)(ws + WS_WOUT);
    bf16* const Hb = (bf16*)(ws + WS_H); bf16* const Ub = (bf16*)(ws + WS_U); bf16* const ZSb = (bf16*)(ws + WS_ZS); bf16* const Qb = (bf16*)(ws + WS_Q); bf16* const Kb = (bf16*)(ws + WS_K);
    bf16* const VTb = (bf16*)(ws + WS_VT); bf16* const ZAb = (bf16*)(ws + WS_ZA); bf16* const GSb = (bf16*)(ws + WS_GS); bf16* const GAb = (bf16*)(ws + WS_GA);


    unsigned long long tqa = 0ull;
#ifdef PROBE_SEL
    unsigned long long tacc = 0ull, tbeg = 0ull;
#define PW(sel) do { if (PROBE_SEL == (sel) + 10) tacc += __builtin_amdgcn_s_memrealtime() - tbeg; if (PROBE_SEL == (sel) + 20) tbeg = __builtin_amdgcn_s_memrealtime(); } while (0)
#define PS(sel) do { if (PROBE_SEL == (sel)) tbeg = __builtin_amdgcn_s_memrealtime(); } while (0)
#define PT(sel) do { if (PROBE_SEL == (sel)) tacc += __builtin_amdgcn_s_memrealtime() - tbeg; } while (0)
#define PB(sel) do { if (PROBE_SEL == (sel) || PROBE_SEL == (sel) + 10) tbeg = __builtin_amdgcn_s_memrealtime(); } while (0)
#define PE(sel) do { if (PROBE_SEL == (sel) || PROBE_SEL == (sel) + 20) tacc += __builtin_amdgcn_s_memrealtime() - tbeg; } while (0)
#else
#define PB(sel) do {} while (0)
#define PW(sel) do {} while (0)
#define PS(sel) do {} while (0)
#define PT(sel) do {} while (0)
#define PE(sel) do {} while (0)
#endif
#define GSYNC() xcd_barrier1(xbar)
    PB(0);
    for (int l = 0; l <= DEPTH; ++l) {
        const int lt = l < DEPTH ? l : 0;
        bf16* const KTAB = (bf16*)(ws + WS_KTAB + lt * KTAB_LSTRIDE); bf16* const WTAB = (bf16*)(ws + WS_WTAB + lt * WTAB_LSTRIDE); bf16* const VTAB = (bf16*)(ws + WS_VTAB + lt * VTAB_LSTRIDE);
        float* const Sb = (float*)(ws + WS_S + lt * S_LSTRIDE); float* const LAM = (float*)(ws + WS_LAM + lt * LAM_LSTRIDE);
        int tid = tid0; asm volatile("" : "+v"(tid)); const int lane = tid & 63;
        PB(1);
        {
            const float* xin = (l <= 1) ? a.x : a.out;
        PS(43);
            { f32x4 gpo[4], gpr[4];
#pragma unroll
              for (int j = 0; j < 4; ++j) { gpo[j] = l > 0 ? *((const f32x4*)(a.post_g + (l - 1) * DM) + lane + 64 * j) : (f32x4){0.f, 0.f, 0.f, 0.f};
                                            gpr[j] = l < DEPTH ? *((const f32x4*)(a.pre_g + l * DM) + lane + 64 * j) : (f32x4){0.f, 0.f, 0.f, 0.f}; }
              for (int m = gw; m < M; m += NGW)
                  norm_row(xin + (size_t)m * DM, l > 0 ? GAb + (size_t)m * DM : nullptr, gpo, a.out + (size_t)m * DM, l < DEPTH, gpr, Hb + (size_t)m * DM, lane); }
        PT(43);
            if (l == DEPTH) { PE(1); break; }
            LAS float* scr = (LAS float*)(lds + wave * 16384);
            const float* w_in = a.w_in + (size_t)l * DM * NCOL; const float* w_glu = a.w_glu + (size_t)l * 512 * 1024; const float* w_bs = a.w_bs + (size_t)l * 512 * 1024;
            const float* w_ba = a.w_ba + (size_t)l * 512 * 1024; const float* w_out = a.w_out + (size_t)l * 1024 * 1024;
            constexpr int I_IN = 16 * 160, I_GLU = 8 * 32, I_BR = 8 * 32, I_OUT = 16 * 32, NITEMS = I_IN + I_GLU + 2 * I_BR + I_OUT;
        PS(44);
            for (int it = gw; it < NITEMS; it += NGW) {
                int r = it;
                if (r < I_IN) { const int kb = r / 160, nb = r % 160; transpose_item(w_in, 1024, NCOL, Win, 64 * kb, 32 * nb, 32 * nb, scr, lane); continue; } r -= I_IN;
                if (r < I_GLU) { const int kb = r / 32, nb = r % 32, n0 = 32 * nb; const int bj = n0 >> 9, rem = n0 & 511, pn = rem >> 7, i0 = rem & 127;
                    transpose_item(w_glu, 512, 1024, Wglu, 64 * kb, n0, 256 * pn + 128 * bj + i0, scr, lane); continue; } r -= I_GLU;
                if (r < I_BR) { const int kb = r / 32, nb = r % 32; transpose_item(w_bs, 512, 1024, Wbs, 64 * kb, 32 * nb, 32 * nb, scr, lane); continue; } r -= I_BR;
                if (r < I_BR) { const int kb = r / 32, nb = r % 32; transpose_item(w_ba, 512, 1024, Wba, 64 * kb, 32 * nb, 32 * nb, scr, lane); continue; } r -= I_BR;
                { const int kb = r / 32, nb = r % 32; transpose_item(w_out, 1024, 1024, Wout, 64 * kb, 32 * nb, 32 * nb, scr, lane); }
            }
            __syncthreads();
            PT(44);
            LayerP P{a.a_re + l * NG * NP, a.a_im + l * NG * NP, a.log_dt + l * NG, a.b_re + (size_t)l * NG * NP * 16, a.b_im + (size_t)l * NG * NP * 16, a.c_re + (size_t)l * NG * 16 * NP, a.c_im + (size_t)l * NG * 16 * NP};
        PS(45);
#ifndef NO_TAB
            for (int it = bx; it < NG * 8; it += G) ktab_block(P, KTAB, it >> 3, it & 7, lds, tid);
            for (int idx = bx * NTHR + tid; idx < NG * NP * 16; idx += G * NTHR) wv_item(P, WTAB, VTAB, LAM, idx);
#endif
        PT(45);
        }
        PW(1);
        if (l == 0) { grid.sync(); xbar = xcd_barrier_post((unsigned*)a.ws, xb_st); } else GSYNC();
        PE(1);
        PB(2);
#ifndef NO_A
        { pg8::Gemm g{Hb, Win, M, NCOL, DM}; pg8::StaticOrder S; S.init(M, NCOL, G, bx); EpiProj E{ws};
          pg8::gemm_phase<EpiProj, pg8::StaticOrder, true, true>(lds, g, S, E); }
#endif
        PW(2);
        GSYNC();
        PE(2);
        PB(3);
        PS(41);
#ifndef NO_B1
        for (int u0 = 2 * bx; u0 < 512; u0 += 2 * G) { const int g = u0 >> 4;
            LayerP P{a.a_re + l * NG * NP, a.a_im + l * NG * NP, a.log_dt + l * NG, a.b_re + (size_t)l * NG * NP * 16, a.b_im + (size_t)l * NG * NP * 16, a.c_re + (size_t)l * NG * 16 * NP, a.c_im + (size_t)l * NG * 16 * NP};
            bf16x8 af[8]; f32x2 l16a, l16b;
            make_wfrag(P, g, wave, lane, af, l16a, l16b);
            for (int q = 0; q < 2; ++q) { const int nb = (u0 + q) & 15; ssm_state_unit(Ub, af, l16a, l16b, Sb, nb >> 3, g, nb & 7, wave, lane); } }
#endif
        PT(41);
        PS(42);
#ifndef NO_ATTN
        for (int t = gw; t < 4096; t += NGW) attn_task(Qb, Kb, VTb, ZAb, Qb, t >> 11, (t >> 8) & 7, t & 255, lane);
#endif
        PT(42);
        PW(3);
        GSYNC();
        PE(3);
        PB(4);
#ifndef NO_B3
        for (int u = 2 * bx; u < 512; u += (u & 1) ? 2 * G - 1 : 1) { const int g = u >> 4, nb = u & 15; ssm_out_unit(tqa, (u & 1) == 0, Ub, KTAB, VTAB, Sb, LAM, a.d_skip + l * 512, Hb, nb >> 3, g, nb & 7, lds, tid, wave, lane); }
#endif
        PW(4);
        GSYNC();
        PE(4);
        PB(5);
#ifndef NO_D1
        { pg8::Gemm g{Hb, Wglu, M, 1024, 512}; pg8::StaticOrder S; S.init(M, 1024, G, bx); EpiGlu E{ZSb, a.b_glu + l * 1024};
          pg8::gemm_phase<EpiGlu, pg8::StaticOrder, true, true>(lds, g, S, E); }
#endif
        PW(5);
        GSYNC();
        PE(5);
#ifndef NO_D2
        PB(6);
        { pg8::Gemm g{ZSb, Wbs, M, 1024, 512, Qb, Wba}; pg8::ChainOrder S; S.B.init(M, 1024, G, bx); EpiBranchBoth E{GSb, GAb};
          pg8::gemm_phase<EpiBranchBoth, pg8::ChainOrder, true, true>(lds, g, S, E); }
#endif
        PW(6);
        GSYNC();
        PE(6);
#ifndef NO_D3
        PB(7);
        { pg8::Gemm g{GSb, Wout, M, 1024, 1024}; pg8::StaticOrder S; S.init(M, 1024, G, bx); EpiPlain E{GAb};
          pg8::gemm_phase<EpiPlain, pg8::StaticOrder, true, true>(lds, g, S, E); }
#endif
        PW(7);
        GSYNC();
        PE(7);
    }
    PE(0);
#ifdef PROBE_SEL
    grid.sync();
    if (bx == 0) { LAS unsigned long long* tb = (LAS unsigned long long*)lds; if (tid0 == 0) tb[0] = tacc + tqa; __syncthreads(); const unsigned long long K = tb[0] < 1000000ull ? tb[0] : 1000000ull;
        for (unsigned long long i = tid0; i < K; i += NTHR) a.out[i] += 0.05f; }
#endif
}

extern "C" void kernel_launch(void* const* d_in, const int* in_sizes, int n_in, void* d_out, int out_size, void* d_ws, size_t ws_size, hipStream_t stream) {
    static int grid = 0;
    if (grid == 0) {
        if (n_in != 17 || out_size != M * DM || ws_size < WS_END) { fprintf(stderr, "kernel_launch: unexpected problem shape (n_in %d, out %d, ws %zu)\n", n_in, out_size, ws_size); grid = -1; return; }
        int dev = 0, cus = 0, per_cu = 0;
        (void)hipGetDevice(&dev); (void)hipDeviceGetAttribute(&cus, hipDeviceAttributeMultiprocessorCount, dev);
        if (hipFuncSetAttribute((const void*)hybrid_fwd, hipFuncAttributeMaxDynamicSharedMemorySize, LDS_BYTES) != hipSuccess) { fprintf(stderr, "kernel_launch: hipFuncSetAttribute failed\n"); grid = -1; return; }
        if (hipOccupancyMaxActiveBlocksPerMultiprocessor(&per_cu, (const void*)hybrid_fwd, NTHR, LDS_BYTES) != hipSuccess || per_cu < 1) { fprintf(stderr, "kernel_launch: occupancy query gave %d\n", per_cu); per_cu = 1; }
        (void)hipGetLastError();
        grid = cus * per_cu;
    }
    if (grid < 0) return;
    Args a{};
    a.x = (const float*)d_in[0]; a.pre_g = (const float*)d_in[1]; a.post_g = (const float*)d_in[2]; a.w_in = (const float*)d_in[3]; a.a_re = (const float*)d_in[4]; a.a_im = (const float*)d_in[5];
    a.log_dt = (const float*)d_in[6]; a.b_re = (const float*)d_in[7]; a.b_im = (const float*)d_in[8]; a.c_re = (const float*)d_in[9]; a.c_im = (const float*)d_in[10]; a.d_skip = (const float*)d_in[11];
    a.w_glu = (const float*)d_in[12]; a.b_glu = (const float*)d_in[13]; a.w_bs = (const float*)d_in[14]; a.w_ba = (const float*)d_in[15]; a.w_out = (const float*)d_in[16];
    a.out = (float*)d_out; a.ws = (unsigned char*)d_ws;
    void* args[] = {&a};
    const hipError_t e = hipLaunchCooperativeKernel((const void*)hybrid_fwd, dim3(grid), dim3(NTHR), args, LDS_BYTES, stream);
    if (e != hipSuccess) fprintf(stderr, "kernel_launch: cooperative launch failed: %s (grid %d)\n", hipGetErrorString(e), grid);
}
```

```cpp
#include <hip/hip_runtime.h>
#include <hip/hip_cooperative_groups.h>
#include <cstdio>
#include <cstdint>
namespace cg = cooperative_groups;
namespace pg8 {
#define PG8_LAS __attribute__((address_space(3)))
typedef unsigned short bf16_t;
typedef short bf16x8 __attribute__((ext_vector_type(8)));
typedef float f32x4 __attribute__((ext_vector_type(4)));
typedef unsigned u32x4 __attribute__((ext_vector_type(4)));
constexpr int BM = 256, BK = 64, HALF = 128, HTB = HALF * BK * 2  , STAGE_BYTES = 8 * HTB, NXCD = 8, WGM = 8;

__host__ __device__ __forceinline__ int lds_byte(int r, int c) { const int st = (r >> 4) * 2 + (c >> 5), rr = r & 15, cc = c & 31, ob = rr * 64 + cc * 2; return st * 1024 + (ob ^ (((ob >> 9) & 1) << 5)); }
__host__ __device__ __forceinline__ void stage_rc(int b, int& R, int& C) { const int st = b / 1024, sb = b % 1024, swz = sb ^ (((sb >> 9) & 1) << 5); R = (st >> 1) * 16 + swz / 64; C = (st & 1) * 32 + (swz % 64) / 2; }
__host__ __device__ __forceinline__ int perm32(int rho) { const int n = rho >> 4, i = rho & 15; return 8 * (i >> 2) + 4 * n + (i & 3); }

struct Unit { int pm, pn, sel; };
struct Gemm { const bf16_t* A; const bf16_t* Bt; int M, N, K; const bf16_t* A2; const bf16_t* Bt2; };

struct StaticOrder {
    int nM, nN, nwg, G, c;
    __host__ __device__ void init(int M, int N, int G_, int c_) { nM = M / BM; nN = N / BM; nwg = nM * nN; G = G_; c = c_; }
    __host__ __device__ bool next(int i, Unit& u) const {
        const long L = (long)i * G + c; if (L >= nwg) return false;
        int wgid = (int)L; { const int q = nwg / NXCD, r = nwg % NXCD, xcd = wgid % NXCD, off = wgid / NXCD; wgid = (xcd < r ? xcd * (q + 1) : r * (q + 1) + (xcd - r) * q) + off; }
        const int nig = WGM * nN, gid = wgid / nig, fm = gid * WGM, gsz = (nM - fm) < WGM ? (nM - fm) : WGM;
        u.pm = fm + ((wgid % nig) % gsz); u.pn = (wgid % nig) / gsz; u.sel = 0; return true;
    }
    __device__ __forceinline__ void a_ready(const Unit&) const {}
    __device__ __forceinline__ void done(const Unit&) const {}
};
__device__ __forceinline__ unsigned cvt_pk_bf16(float lo, float hi) { unsigned r; asm volatile("v_cvt_pk_bf16_f32 %0, %1, %2" : "=v"(r) : "v"(lo), "v"(hi)); return r; }
typedef float f32x2 __attribute__((ext_vector_type(2)));
struct ChainOrder { StaticOrder B;
    __host__ __device__ bool next(int i, Unit& u) const { if (!B.next(i >> 1, u)) return false; u.sel = i & 1; return true; }
    __device__ __forceinline__ void a_ready(const Unit&) const {}
    __device__ __forceinline__ void done(const Unit&) const {}
};

template <class Epi, class Sched, bool ALIGN_EPI = false, bool SP2 = false>
__device__ __forceinline__ void gemm_phase(PG8_LAS unsigned char* lds, const Gemm g, const Sched& S, const Epi& E) {
    int tid_ = threadIdx.x; asm volatile("" : "+v"(tid_));
    const int tid = tid_, wid = __builtin_amdgcn_readfirstlane(tid >> 6), lane = tid & 63, wr = wid >> 2, wc = wid & 3, fr = lane & 15, fq = lane >> 4;
    const int K = g.K, nt = K / BK;
    unsigned voffA[2], voffB[2];
#pragma unroll
    for (int i = 0; i < 2; ++i) { int R, C; stage_rc(tid * 16 + i * 8192, R, C); const int Rb = Epi::PERM ? ((R & ~31) + perm32(R & 31)) : R;
        voffA[i] = (unsigned)(R * K + C) * 2u; voffB[i] = (unsigned)(Rb * K + C) * 2u; }
    const size_t kstep = (size_t)(BK * 2);
    const size_t hstep = (size_t)HALF * K * 2;
    const size_t tstep = 2 * hstep;
    const unsigned ldsw = (unsigned)wid * 1024u;
    const int aoff = lds_byte(wr * 64 + fr, fq * 8), boff = lds_byte(wc * 32 + fr, fq * 8);
#define PG8_SA(b, h) (((b) * 2 + (h)) * HTB)
#define PG8_SB(b, h) ((4 + (b) * 2 + (h)) * HTB)
#define PG8_STAGE(bufoff, gbase, voff) do { _Pragma("unroll") for (int _i = 0; _i < 2; ++_i) \
        __builtin_amdgcn_global_load_lds((const unsigned*)((const char*)(gbase) + (voff)[_i]), (PG8_LAS unsigned*)(lds + (bufoff) + ldsw + _i * 8192), 16, 0, 0); } while (0)
#define PG8_LDA(dst, b, h) do { _Pragma("unroll") for (int m = 0; m < 4; ++m) _Pragma("unroll") for (int k = 0; k < 2; ++k) dst[m][k] = *(const PG8_LAS bf16x8*)(lds + PG8_SA(b, h) + aoff + m * 2048 + k * 1024); } while (0)
#define PG8_LDB(dst, b, h) do { _Pragma("unroll") for (int n = 0; n < 2; ++n) _Pragma("unroll") for (int k = 0; k < 2; ++k) dst[n][k] = *(const PG8_LAS bf16x8*)(lds + PG8_SB(b, h) + boff + n * 2048 + k * 1024); } while (0)
#define PG8_MMA(ai, bj, At, Bt) do { __builtin_amdgcn_s_setprio(1); _Pragma("unroll") for (int m = 0; m < 4; ++m) _Pragma("unroll") for (int n = 0; n < 2; ++n) _Pragma("unroll") for (int k = 0; k < 2; ++k) \
        acc[ai][bj][m][n] = __builtin_amdgcn_mfma_f32_16x16x32_bf16(Bt[n][k], At[m][k], acc[ai][bj][m][n], 0, 0, 0); __builtin_amdgcn_s_setprio(0); } while (0)
#define PG8_WAIT_V(n) asm volatile("s_waitcnt vmcnt(" #n ")" ::: "memory")
#define PG8_WAIT_L(n) asm volatile("s_waitcnt lgkmcnt(" #n ")" ::: "memory")
#define PG8_BAR __builtin_amdgcn_s_barrier()
#define PG8_SCHED __builtin_amdgcn_sched_barrier(0)
    Unit cur, nxt; int ui = 0;
    if (!S.next(0, cur)) return;
    f32x4 acc[2][2][4][2];
#pragma unroll
    for (int a = 0; a < 2; ++a)
#pragma unroll
        for (int b = 0; b < 2; ++b)
#pragma unroll
            for (int m = 0; m < 4; ++m)
#pragma unroll
                for (int n = 0; n < 2; ++n) acc[a][b][m][n] = (f32x4){0.f, 0.f, 0.f, 0.f};
    bf16x8 At[4][2], B0[2][2], B1[2][2];
    const char* cA = (const char*)(cur.sel ? g.A2 : g.A) + (size_t)cur.pm * tstep; const char* cB = (const char*)(cur.sel ? g.Bt2 : g.Bt) + (size_t)cur.pn * tstep;
    S.a_ready(cur);
    if constexpr (SP2) {
        PG8_STAGE(PG8_SB(0, 0), cB, voffB); PG8_STAGE(PG8_SB(0, 1), cB + hstep, voffB); PG8_STAGE(PG8_SA(0, 0), cA, voffA); PG8_STAGE(PG8_SA(0, 1), cA + hstep, voffA);
        if (wr == 1) PG8_BAR;
        PG8_WAIT_V(2); PG8_BAR;
        PG8_STAGE(PG8_SB(1, 0), cB + kstep, voffB); PG8_STAGE(PG8_SA(1, 0), cA + kstep, voffA); PG8_STAGE(PG8_SB(1, 1), cB + hstep + kstep, voffB);
        PG8_WAIT_V(6); PG8_BAR;
    } else {
        PG8_STAGE(PG8_SB(0, 0), cB, voffB); PG8_STAGE(PG8_SA(0, 0), cA, voffA); PG8_STAGE(PG8_SB(0, 1), cB + hstep, voffB); PG8_STAGE(PG8_SA(0, 1), cA + hstep, voffA);
        if (wr == 1) PG8_BAR;
        PG8_WAIT_V(4); PG8_BAR;
        PG8_STAGE(PG8_SB(1, 0), cB + kstep, voffB); PG8_STAGE(PG8_SA(1, 0), cA + kstep, voffA); PG8_STAGE(PG8_SB(1, 1), cB + hstep + kstep, voffB);
        PG8_WAIT_V(6); PG8_BAR;
    }
    for (;;) {
        const bool has_next = S.next(ui + 1, nxt);
        const char* nA = has_next ? (const char*)(nxt.sel ? g.A2 : g.A) + (size_t)nxt.pm * tstep : cA; const char* nB = has_next ? (const char*)(nxt.sel ? g.Bt2 : g.Bt) + (size_t)nxt.pn * tstep : cB;
        for (int t = 0; t < nt; t += 2) {
            const bool last = (t == nt - 2);
            const char* a1 = cA + (size_t)(t + 1) * kstep;
            const char* a2 = last ? nA : cA + (size_t)(t + 2) * kstep; const char* b2 = last ? nB : cB + (size_t)(t + 2) * kstep;
            const char* a3 = a2 + kstep; const char* b3 = b2 + kstep;
            if (last && has_next) S.a_ready(nxt);
            if constexpr (SP2) {
            PG8_LDB(B0, 0, 0); PG8_LDB(B1, 0, 1); PG8_SCHED; PG8_LDA(At, 0, 0); PG8_STAGE(PG8_SA(1, 1), a1 + hstep, voffA);
            PG8_WAIT_V(8); PG8_WAIT_L(0); PG8_BAR; PG8_MMA(0, 0, At, B0); PG8_MMA(0, 1, At, B1); PG8_BAR; PG8_SCHED;
            PG8_LDA(At, 0, 1); PG8_STAGE(PG8_SB(0, 0), b2, voffB); PG8_STAGE(PG8_SB(0, 1), b2 + hstep, voffB); PG8_STAGE(PG8_SA(0, 0), a2, voffA);
            PG8_WAIT_V(8); PG8_WAIT_L(0); PG8_BAR; PG8_MMA(1, 0, At, B0); PG8_MMA(1, 1, At, B1); PG8_BAR; PG8_SCHED;
            PG8_LDB(B0, 1, 0); PG8_LDB(B1, 1, 1); PG8_SCHED; PG8_LDA(At, 1, 0); PG8_STAGE(PG8_SA(0, 1), a2 + hstep, voffA);
            PG8_WAIT_V(8); PG8_WAIT_L(0); PG8_BAR; PG8_MMA(0, 0, At, B0); PG8_MMA(0, 1, At, B1); PG8_BAR; PG8_SCHED;
            PG8_LDA(At, 1, 1); PG8_STAGE(PG8_SB(1, 0), b3, voffB); PG8_STAGE(PG8_SB(1, 1), b3 + hstep, voffB); PG8_STAGE(PG8_SA(1, 0), a3, voffA);
            PG8_WAIT_V(8); PG8_WAIT_L(0); PG8_BAR; PG8_MMA(1, 0, At, B0); PG8_MMA(1, 1, At, B1); PG8_BAR; PG8_SCHED;
            } else {
            PG8_LDB(B0, 0, 0); PG8_SCHED; PG8_LDA(At, 0, 0); PG8_STAGE(PG8_SA(1, 1), a1 + hstep, voffA);
            PG8_WAIT_L(8); PG8_BAR; PG8_WAIT_L(0); PG8_MMA(0, 0, At, B0); PG8_BAR; PG8_SCHED;
            PG8_LDB(B1, 0, 1); PG8_STAGE(PG8_SB(0, 0), b2, voffB);
            PG8_BAR; PG8_WAIT_L(0); PG8_MMA(0, 1, At, B1); PG8_BAR;
            PG8_LDA(At, 0, 1); PG8_STAGE(PG8_SA(0, 0), a2, voffA);
            PG8_BAR; PG8_WAIT_L(0); PG8_MMA(1, 0, At, B0); PG8_BAR; PG8_SCHED;
            PG8_STAGE(PG8_SB(0, 1), b2 + hstep, voffB);
            PG8_WAIT_V(6); PG8_BAR; PG8_MMA(1, 1, At, B1); PG8_BAR;
            PG8_LDB(B0, 1, 0); PG8_SCHED; PG8_LDA(At, 1, 0); PG8_STAGE(PG8_SA(0, 1), a2 + hstep, voffA);
            PG8_WAIT_L(8); PG8_BAR; PG8_WAIT_L(0); PG8_MMA(0, 0, At, B0); PG8_BAR; PG8_SCHED;
            PG8_LDB(B1, 1, 1); PG8_STAGE(PG8_SB(1, 0), b3, voffB);
            PG8_BAR; PG8_WAIT_L(0); PG8_MMA(0, 1, At, B1); PG8_BAR;
            PG8_LDA(At, 1, 1); PG8_STAGE(PG8_SA(1, 0), a3, voffA);
            PG8_BAR; PG8_WAIT_L(0); PG8_MMA(1, 0, At, B0); PG8_BAR; PG8_SCHED;
            PG8_STAGE(PG8_SB(1, 1), b3 + hstep, voffB);
            PG8_WAIT_V(6); PG8_BAR; PG8_MMA(1, 1, At, B1); PG8_BAR;
            }
        }
        if constexpr (ALIGN_EPI) { if (wr == 0) PG8_BAR; }
        if constexpr (!Epi::AFTER_DRAIN) { E(acc, cur, wr, wc, fr, fq); S.done(cur); }
        if (!has_next) break;
#pragma unroll
        for (int a = 0; a < 2; ++a)
#pragma unroll
            for (int b = 0; b < 2; ++b)
#pragma unroll
                for (int m = 0; m < 4; ++m)
#pragma unroll
                    for (int n = 0; n < 2; ++n) acc[a][b][m][n] = (f32x4){0.f, 0.f, 0.f, 0.f};
        cur = nxt; cA = nA; cB = nB; ++ui;
        if constexpr (ALIGN_EPI) { if (wr == 1) PG8_BAR; }
    }
    PG8_WAIT_V(0);
    if constexpr (!ALIGN_EPI) { if (wr == 0) PG8_BAR; }
    PG8_BAR;
    if constexpr (Epi::AFTER_DRAIN) { E.fused(acc, cur, wr, wc, fr, fq, lds, wid, lane); S.done(cur); }
#undef PG8_SA
#undef PG8_SB
#undef PG8_STAGE
#undef PG8_LDA
#undef PG8_LDB
#undef PG8_MMA
#undef PG8_WAIT_V
#undef PG8_WAIT_L
#undef PG8_BAR
#undef PG8_SCHED
}
}
#define DI __device__ __forceinline__
#define LAS __attribute__((address_space(3)))
typedef unsigned short bf16;
typedef float f32x4 __attribute__((ext_vector_type(4)));
typedef float f32x2 __attribute__((ext_vector_type(2)));
typedef float f32x16 __attribute__((ext_vector_type(16)));
typedef short bf16x8 __attribute__((ext_vector_type(8)));
typedef unsigned u32x4 __attribute__((ext_vector_type(4)));
typedef unsigned u32x2 __attribute__((ext_vector_type(2)));
typedef __bf16 bf16x2_t __attribute__((ext_vector_type(2)));

constexpr int NWAVES = 8, NTHR = 512;
constexpr int BATCH = 2, SEQ = 8192, DM = 1024, DEPTH = 4, M = BATCH * SEQ, NCOL = 5120;
constexpr int NG = 32, NP = 64, NCH = SEQ / 64;
constexpr float EPS = 1e-6f;
constexpr size_t MiB = 1u << 20;
constexpr size_t WS_WIN = 32 * MiB, WS_WGLU = 42 * MiB, WS_WBS = 43 * MiB, WS_WBA = 44 * MiB, WS_WOUT = 45 * MiB;
constexpr size_t WS_H = 48 * MiB;
constexpr size_t WS_U = 80 * MiB, WS_ZS = 96 * MiB, WS_Q = 112 * MiB, WS_K = 128 * MiB, WS_VT = 144 * MiB, WS_ZA = 160 * MiB;
constexpr size_t WS_GS = 176 * MiB, WS_GA = 208 * MiB;
constexpr size_t WS_KTAB = 1 * MiB, KTAB_LSTRIDE = 1280 * 1024;
constexpr size_t WS_WTAB = 6 * MiB, WTAB_LSTRIDE = 2 * MiB;
constexpr size_t WS_VTAB = 6 * MiB, VTAB_LSTRIDE = 2 * MiB;
constexpr size_t WS_S = 14 * MiB, S_LSTRIDE = 4 * MiB;
constexpr size_t WS_LAM = 30 * MiB, LAM_LSTRIDE = 64 * 1024;
constexpr size_t WS_END = 240 * MiB;
constexpr int KTAB_BYTES = 65 * 512;
constexpr int LDS_BYTES = 147456;
constexpr float QSCALE = 0.125f * 1.4426950408889634f;

struct Args {
    const float* x; const float* pre_g; const float* post_g; const float* w_in; const float* a_re; const float* a_im; const float* log_dt;
    const float* b_re; const float* b_im; const float* c_re; const float* c_im; const float* d_skip; const float* w_glu; const float* b_glu;
    const float* w_bs; const float* w_ba; const float* w_out; float* out; unsigned char* ws;
};

DI unsigned cvtpk(float lo, float hi) { f32x2 v = {lo, hi}; bf16x2_t b = __builtin_convertvector(v, bf16x2_t); return __builtin_bit_cast(unsigned, b); }
DI float bflo(unsigned w) { return __uint_as_float(w << 16); }
DI float bfhi(unsigned w) { return __uint_as_float(w & 0xffff0000u); }
DI float bf1(bf16 b) { return __uint_as_float((unsigned)b << 16); }
DI float sigm(float x) { return __builtin_amdgcn_rcpf(1.0f + __expf(-x)); }
DI float silu(float x) { return x * sigm(x); }
DI float gelu_tanh(float x) { const float u = 1.5957691216057308f * (x + 0.044715f * x * x * x); return x * sigm(u); }
template <int CTRL> DI float dpp_step(float v) { return v + __builtin_bit_cast(float, __builtin_amdgcn_update_dpp(0, __builtin_bit_cast(int, v), CTRL, 0xf, 0xf, true)); }
DI float wave_sum(float v) {
    v = dpp_step<0xB1>(v); v = dpp_step<0x4E>(v); v = dpp_step<0x141>(v); v = dpp_step<0x140>(v);
    return ((__builtin_bit_cast(float, __builtin_amdgcn_readlane(__builtin_bit_cast(int, v), 0)) + __builtin_bit_cast(float, __builtin_amdgcn_readlane(__builtin_bit_cast(int, v), 16))) +
            (__builtin_bit_cast(float, __builtin_amdgcn_readlane(__builtin_bit_cast(int, v), 32)) + __builtin_bit_cast(float, __builtin_amdgcn_readlane(__builtin_bit_cast(int, v), 48))));
}

struct EpiProj {
    static constexpr bool PERM = true, AFTER_DRAIN = false;
    unsigned char* ws;
    DI void operator()(const pg8::f32x4 (&acc)[2][2][4][2], const pg8::Unit& u, int wr, int wc, int fr, int fq) const {
        const int pn = u.pn;
        bf16* base; int ld, colt; float sc = 1.f;
        if (pn < 12) { base = (bf16*)(ws + WS_U + (size_t)(pn >> 1) * (16 * MiB)); ld = 512; colt = (pn & 1) * 256; if ((pn >> 1) == 2) sc = QSCALE; }
        else if (pn < 16) { base = (bf16*)(ws + WS_GS); ld = 1024; colt = (pn - 12) * 256; }
        else { base = (bf16*)(ws + WS_GA); ld = 1024; colt = (pn - 16) * 256; }
        const int row0 = u.pm * 256 + wr * 64 + fr, col0 = colt + wc * 32 + 8 * fq;
        const bool stream = (pn >= 10) || ((pn >> 1) == 1);
        if ((pn >> 1) == 4) {
            bf16* vt = (bf16*)(ws + WS_VT);
#pragma unroll
            for (int ai = 0; ai < 2; ++ai)
#pragma unroll
                for (int m = 0; m < 4; ++m) { const int r = row0 + ai * 128 + m * 16; const int bb = r >> 13, t = r & 8191;
#pragma unroll
                    for (int bj = 0; bj < 2; ++bj) { bf16* p = vt + ((size_t)(bb * 512 + col0 + bj * 128)) * 8192 + t;
#pragma unroll
                        for (int n = 0; n < 2; ++n)
#pragma unroll
                            for (int e = 0; e < 4; ++e) { *p = (bf16)(cvtpk(acc[ai][bj][m][n][e], 0.f) & 0xffffu); p += 8192; asm volatile("" : "+v"(p)); } }
                    __builtin_amdgcn_sched_barrier(0); }
            return;
        }
#pragma unroll
        for (int ai = 0; ai < 2; ++ai)
#pragma unroll
            for (int m = 0; m < 4; ++m) { bf16* rowp = base + (size_t)(row0 + ai * 128 + m * 16) * ld + col0;
#pragma unroll
                for (int bj = 0; bj < 2; ++bj) { const pg8::f32x4 v0 = acc[ai][bj][m][0] * sc, v1 = acc[ai][bj][m][1] * sc;
                    u32x4 w; w.x = cvtpk(v0[0], v0[1]); w.y = cvtpk(v0[2], v0[3]); w.z = cvtpk(v1[0], v1[1]); w.w = cvtpk(v1[2], v1[3]);
                    if (stream) __builtin_nontemporal_store(w, (u32x4*)(rowp + bj * 128)); else *(u32x4*)(rowp + bj * 128) = w; } }
    }
};
struct EpiGlu {
    static constexpr bool PERM = true, AFTER_DRAIN = false;
    bf16* zs; const float* bias;
    DI void operator()(const pg8::f32x4 (&acc)[2][2][4][2], const pg8::Unit& u, int wr, int wc, int fr, int fq) const {
        const int row0 = u.pm * 256 + wr * 64 + fr, col0 = u.pn * 128 + wc * 32 + 8 * fq;
        f32x4 ba0 = *(const f32x4*)(bias + col0), ba1 = *(const f32x4*)(bias + col0 + 4), bb0 = *(const f32x4*)(bias + 512 + col0), bb1 = *(const f32x4*)(bias + 512 + col0 + 4);
        u32x4 zv[2][4];
#pragma unroll
        for (int ai = 0; ai < 2; ++ai)
#pragma unroll
            for (int m = 0; m < 4; ++m) zv[ai][m] = __builtin_nontemporal_load((const u32x4*)(zs + (size_t)(row0 + ai * 128 + m * 16) * 512 + col0));
        __builtin_amdgcn_sched_barrier(0);
#pragma unroll
        for (int ai = 0; ai < 2; ++ai)
#pragma unroll
            for (int m = 0; m < 4; ++m) { bf16* p = zs + (size_t)(row0 + ai * 128 + m * 16) * 512 + col0;
                const u32x4 z = zv[ai][m]; float zf[8] = {bflo(z.x), bfhi(z.x), bflo(z.y), bfhi(z.y), bflo(z.z), bfhi(z.z), bflo(z.w), bfhi(z.w)}; float y[8];
#pragma unroll
                for (int e = 0; e < 4; ++e) {
                    y[e] = (acc[ai][0][m][0][e] + ba0[e]) * zf[e] * __builtin_amdgcn_rcpf((1.0f + __expf(-(acc[ai][1][m][0][e] + bb0[e]))) * (1.0f + __expf(-zf[e])));
                    y[4 + e] = (acc[ai][0][m][1][e] + ba1[e]) * zf[4 + e] * __builtin_amdgcn_rcpf((1.0f + __expf(-(acc[ai][1][m][1][e] + bb1[e]))) * (1.0f + __expf(-zf[4 + e]))); }
                u32x4 w; w.x = cvtpk(y[0], y[1]); w.y = cvtpk(y[2], y[3]); w.z = cvtpk(y[4], y[5]); w.w = cvtpk(y[6], y[7]); *(u32x4*)p = w; }
    }
};
template <int PASS> struct EpiBranch {
    static constexpr bool PERM = true, AFTER_DRAIN = false;
    bf16* G; const bf16* gate2;
    DI void operator()(const pg8::f32x4 (&acc)[2][2][4][2], const pg8::Unit& u, int wr, int wc, int fr, int fq) const {
        const int row0 = u.pm * 256 + wr * 64 + fr, col0 = u.pn * 256 + wc * 32 + 8 * fq;
#pragma unroll
        for (int ai = 0; ai < 2; ++ai)
#pragma unroll
          for (int mh = 0; mh < 2; ++mh) {
            u32x4 gv[2][2], hv[2][2];
#pragma unroll
            for (int mm = 0; mm < 2; ++mm)
#pragma unroll
                for (int bj = 0; bj < 2; ++bj) { const int m = 2 * mh + mm; const size_t off = (size_t)(row0 + ai * 128 + m * 16) * 1024 + col0 + bj * 128; gv[mm][bj] = *(const u32x4*)(G + off); if (PASS == 1) hv[mm][bj] = *(const u32x4*)(gate2 + off); }
            __builtin_amdgcn_sched_barrier(0);
#pragma unroll
            for (int mm = 0; mm < 2; ++mm)
#pragma unroll
                for (int bj = 0; bj < 2; ++bj) { const int m = 2 * mh + mm; const size_t off = (size_t)(row0 + ai * 128 + m * 16) * 1024 + col0 + bj * 128;
                    const u32x4 g = gv[mm][bj]; float gf[8] = {bflo(g.x), bfhi(g.x), bflo(g.y), bfhi(g.y), bflo(g.z), bfhi(g.z), bflo(g.w), bfhi(g.w)}; float y[8];
                    if (PASS == 0) {
#pragma unroll
                        for (int e = 0; e < 4; ++e) { y[e] = sigm(gf[e]) * acc[ai][bj][m][0][e]; y[4 + e] = sigm(gf[4 + e]) * acc[ai][bj][m][1][e]; }
                    } else {
                        const u32x4 h = hv[mm][bj]; float hf[8] = {bflo(h.x), bfhi(h.x), bflo(h.y), bfhi(h.y), bflo(h.z), bfhi(h.z), bflo(h.w), bfhi(h.w)};
#pragma unroll
                        for (int e = 0; e < 4; ++e) { y[e] = gf[e] + sigm(hf[e]) * acc[ai][bj][m][0][e]; y[4 + e] = gf[4 + e] + sigm(hf[4 + e]) * acc[ai][bj][m][1][e]; }
                    }
                    u32x4 w; w.x = cvtpk(y[0], y[1]); w.y = cvtpk(y[2], y[3]); w.z = cvtpk(y[4], y[5]); w.w = cvtpk(y[6], y[7]); *(u32x4*)(G + off) = w; }
            __builtin_amdgcn_sched_barrier(0);
          }
    }
};
struct EpiBranchBoth {
    static constexpr bool PERM = true, AFTER_DRAIN = false;
    bf16* G; const bf16* gate2;
    DI void operator()(const pg8::f32x4 (&acc)[2][2][4][2], const pg8::Unit& u, int wr, int wc, int fr, int fq) const {
        if (u.sel == 0) { EpiBranch<0> e{G, gate2}; e(acc, u, wr, wc, fr, fq); } else { EpiBranch<1> e{G, gate2}; e(acc, u, wr, wc, fr, fq); }
    }
};
struct EpiPlain {
    static constexpr bool PERM = true, AFTER_DRAIN = false;
    bf16* O;
    DI void operator()(const pg8::f32x4 (&acc)[2][2][4][2], const pg8::Unit& u, int wr, int wc, int fr, int fq) const {
        const int row0 = u.pm * 256 + wr * 64 + fr, col0 = u.pn * 256 + wc * 32 + 8 * fq;
#pragma unroll
        for (int ai = 0; ai < 2; ++ai)
#pragma unroll
            for (int m = 0; m < 4; ++m)
#pragma unroll
                for (int bj = 0; bj < 2; ++bj) { const pg8::f32x4 v0 = acc[ai][bj][m][0], v1 = acc[ai][bj][m][1];
                    u32x4 w; w.x = cvtpk(v0[0], v0[1]); w.y = cvtpk(v0[2], v0[3]); w.z = cvtpk(v1[0], v1[1]); w.w = cvtpk(v1[2], v1[3]);
                    *(u32x4*)(O + (size_t)(row0 + ai * 128 + m * 16) * 1024 + col0 + bj * 128) = w; }
    }
};

DI void norm_row(const float* xin, const bf16* o, const f32x4 (&gpo)[4], float* xout, bool has_pre, const f32x4 (&gpr)[4], bf16* h, int lane) {
    f32x4 v[4];
#pragma unroll
    for (int j = 0; j < 4; ++j) v[j] = __builtin_nontemporal_load((const f32x4*)xin + lane + 64 * j);
    if (o) {
        f32x4 ov[4]; float ss = 0.f;
#pragma unroll
        for (int j = 0; j < 4; ++j) { const u32x2 w = *((const u32x2*)o + lane + 64 * j); ov[j] = (f32x4){bflo(w.x), bfhi(w.x), bflo(w.y), bfhi(w.y)};
            ss += (ov[j].x * ov[j].x + ov[j].y * ov[j].y) + (ov[j].z * ov[j].z + ov[j].w * ov[j].w); }
        const float rstd = __builtin_amdgcn_rsqf(wave_sum(ss) * (1.0f / DM) + EPS);
#pragma unroll
        for (int j = 0; j < 4; ++j) { v[j] = v[j] + ov[j] * rstd * gpo[j]; __builtin_nontemporal_store(v[j], (f32x4*)xout + lane + 64 * j); }
    }
    if (has_pre) {
        float ss = 0.f;
#pragma unroll
        for (int j = 0; j < 4; ++j) ss += (v[j].x * v[j].x + v[j].y * v[j].y) + (v[j].z * v[j].z + v[j].w * v[j].w);
        const float rstd = __builtin_amdgcn_rsqf(wave_sum(ss) * (1.0f / DM) + EPS);
#pragma unroll
        for (int j = 0; j < 4; ++j) { const f32x4 y = v[j] * rstd * gpr[j];
            u32x2 w; w.x = cvtpk(y.x, y.y); w.y = cvtpk(y.z, y.w); *((u32x2*)h + lane + 64 * j) = w; }
    }
}
DI void transpose_item(const float* W, int K, int N, bf16* WT, int k0, int n0, int dst_row0, LAS float* scr, int lane) {
#pragma unroll 8
    for (int i = 0; i < 32; ++i) { const int kk = 2 * i + (lane >> 5); scr[kk * 33 + (lane & 31)] = __builtin_nontemporal_load(W + (size_t)(k0 + kk) * N + n0 + (lane & 31)); }
    asm volatile("s_waitcnt lgkmcnt(0)" ::: "memory");
    const int c = lane & 7;
#pragma unroll
    for (int j = 0; j < 4; ++j) { const int n = (lane >> 3) + 8 * j; const LAS float* s = scr + (8 * c) * 33 + n;
        u32x4 o; o.x = cvtpk(s[0 * 33], s[1 * 33]); o.y = cvtpk(s[2 * 33], s[3 * 33]); o.z = cvtpk(s[4 * 33], s[5 * 33]); o.w = cvtpk(s[6 * 33], s[7 * 33]);
        *(u32x4*)(WT + (size_t)(dst_row0 + n) * K + k0 + 8 * c) = o; }
    asm volatile("s_waitcnt lgkmcnt(0)" ::: "memory");
}
DI f32x2 cpow_k(float are, float aim, float dt, int k) {
    const float mag = __expf(are * dt * (float)k);
    const double turns = (double)aim * (double)dt * (double)k * 0.15915494309189535;
    const float fr = (float)(turns - floor(turns));
    return (f32x2){mag * __builtin_amdgcn_cosf(fr), mag * __builtin_amdgcn_sinf(fr)};
}
DI f32x2 cmul(f32x2 a, f32x2 b) { return (f32x2){a.x * b.x - a.y * b.y, a.x * b.y + a.y * b.x}; }
DI f32x2 zoh_factor(float are, float aim, float dt) {
    const f32x2 ab = cpow_k(are, aim, dt, 1); const float nr = ab.x - 1.0f, ni = ab.y, den = are * are + aim * aim;
    return (f32x2){(nr * are + ni * aim) / den, (ni * are - nr * aim) / den};
}

struct LayerP { const float *a_re, *a_im, *log_dt, *b_re, *b_im, *c_re, *c_im; };

DI void ktab_block(const LayerP& P, bf16* KTAB, int g, int tb, LAS unsigned char* lds, int tid) {
    LAS f32x2* CL = (LAS f32x2*)lds;
    LAS f32x2* BB = (LAS f32x2*)(lds + 16384);
    const float dt = __expf(P.log_dt[g]);
    const int p = tid & 63, h0 = tid >> 6, h1 = h0 + 8;
    const float are = P.a_re[g * 64 + p], aim = P.a_im[g * 64 + p];
    const f32x2 c0 = {P.c_re[(g * 16 + h0) * 64 + p], P.c_im[(g * 16 + h0) * 64 + p]}, c1 = {P.c_re[(g * 16 + h1) * 64 + p], P.c_im[(g * 16 + h1) * 64 + p]};
    const int e0 = tid, e1 = tid + NTHR; const int pa = e0 >> 4, pb = e1 >> 4, hp = tid & 15;
    const float area = P.a_re[g * 64 + pa], aima = P.a_im[g * 64 + pa], areb = P.a_re[g * 64 + pb], aimb = P.a_im[g * 64 + pb];
    const f32x2 bva = {P.b_re[(g * 64 + pa) * 16 + hp], P.b_im[(g * 64 + pa) * 16 + hp]}, bvb = {P.b_re[(g * 64 + pb) * 16 + hp], P.b_im[(g * 64 + pb) * 16 + hp]};
    BB[pa * 16 + hp] = cmul(zoh_factor(area, aima, dt), bva); BB[pb * 16 + hp] = cmul(zoh_factor(areb, aimb, dt), bvb);
    if (tb == 0 && tid < 256) KTAB[((size_t)g * 65) * 256 + tid] = 0;
#pragma unroll 1
    for (int tp = 0; tp < 4; ++tp) { const int tau0 = tb * 8 + 2 * tp;
        const f32x2 l0 = cpow_k(are, aim, dt, tau0), l1 = cpow_k(are, aim, dt, tau0 + 1);
        CL[(0 * 16 + h0) * 64 + p] = cmul(c0, l0); CL[(0 * 16 + h1) * 64 + p] = cmul(c1, l0); CL[(1 * 16 + h0) * 64 + p] = cmul(c0, l1); CL[(1 * 16 + h1) * 64 + p] = cmul(c1, l1);
        __syncthreads();
        { const int ts = tid >> 8, h = (tid >> 4) & 15; float sacc = 0.f;
#pragma unroll 8
          for (int q = 0; q < 64; ++q) { const f32x2 c = CL[(ts * 16 + h) * 64 + q], bq = BB[q * 16 + hp]; sacc += c.x * bq.x - c.y * bq.y; }
          KTAB[((size_t)g * 65 + (tau0 + ts + 1)) * 256 + h * 16 + hp] = (bf16)(cvtpk(sacc, 0.f) & 0xffffu); }
        __syncthreads();
    }
}
DI void wv_item(const LayerP& P, bf16* WTAB, bf16* VTAB, float* LAM, int idx) {
    const int p = idx & 63, k = (idx >> 6) & 15, g = idx >> 10;
    const float dt = __expf(P.log_dt[g]), are = P.a_re[g * 64 + p], aim = P.a_im[g * 64 + p];
    f32x2 cv[16];
#pragma unroll
    for (int j = 0; j < 16; ++j) cv[j] = (f32x2){P.c_re[(g * 16 + j) * 64 + p], P.c_im[(g * 16 + j) * 64 + p]};
    const f32x2 lk1 = cpow_k(are, aim, dt, k + 1);
#pragma unroll
    for (int h = 0; h < 16; ++h) { const f32x2 c = cmul(cv[h], lk1); *(unsigned*)(VTAB + ((size_t)g * 256 + k * 16 + h) * 128 + 2 * p) = cvtpk(c.x, -c.y); }
    if (k == 15) { const f32x2 l64 = cpow_k(are, aim, dt, 64); *(f32x4*)(LAM + (g * 64 + p) * 4) = (f32x4){l64.x, l64.y, lk1.x, lk1.y}; }
}

#define MFMA16(a, b, c) __builtin_amdgcn_mfma_f32_16x16x32_bf16((a), (b), (c), 0, 0, 0)
#define MFMA32(a, b, c) __builtin_amdgcn_mfma_f32_32x32x16_bf16((a), (b), (c), 0, 0, 0)
DI void make_wfrag(const LayerP& P, int g, int wave, int lane, bf16x8 (&af)[8], f32x2& l16a, f32x2& l16b) {
    const int n = lane & 15, kg = lane >> 4, p = 8 * wave + (n >> 1), ri = n & 1;
    const float dt = __expf(P.log_dt[g]), are = P.a_re[g * 64 + p], aim = P.a_im[g * 64 + p];
    const int pa = 8 * wave + 2 * kg;
    const float area = P.a_re[g * 64 + pa], aima = P.a_im[g * 64 + pa], areb = P.a_re[g * 64 + pa + 1], aimb = P.a_im[g * 64 + pa + 1];
    const f32x4 br0 = *(const f32x4*)(P.b_re + (g * 64 + p) * 16 + 8 * (kg & 1)), br1 = *(const f32x4*)(P.b_re + (g * 64 + p) * 16 + 8 * (kg & 1) + 4);
    const f32x4 bi0 = *(const f32x4*)(P.b_im + (g * 64 + p) * 16 + 8 * (kg & 1)), bi1 = *(const f32x4*)(P.b_im + (g * 64 + p) * 16 + 8 * (kg & 1) + 4);
    const f32x2 f = zoh_factor(are, aim, dt);
    f32x2 fb[8];
#pragma unroll
    for (int i = 0; i < 4; ++i) { fb[i] = cmul(f, (f32x2){br0[i], bi0[i]}); fb[4 + i] = cmul(f, (f32x2){br1[i], bi1[i]}); }
#pragma unroll
    for (int ks = 0; ks < 8; ++ks) { const f32x2 lp = cpow_k(are, aim, dt, 15 - 2 * ks - (kg >> 1)); float v[8];
#pragma unroll
        for (int i = 0; i < 8; ++i) { const f32x2 c = cmul(lp, fb[i]); v[i] = ri ? c.y : c.x; }
        const u32x4 w = {cvtpk(v[0], v[1]), cvtpk(v[2], v[3]), cvtpk(v[4], v[5]), cvtpk(v[6], v[7])}; af[ks] = __builtin_bit_cast(bf16x8, w); }
    l16a = cpow_k(area, aima, dt, 16); l16b = cpow_k(areb, aimb, dt, 16);
}
DI void ssm_state_unit(const bf16* U, const bf16x8 (&af)[8], f32x2 l16a, f32x2 l16b, float* S, int b, int g, int cb, int wave, int lane) {
    const int n = lane & 15, kg = lane >> 4;
    const bf16* const ub_u = U + ((size_t)b * SEQ + (size_t)cb * 16 * 64) * 512 + g * 16;
    const unsigned uo = (unsigned)((n * 64 + (kg >> 1)) * 512 + 8 * (kg & 1));
    bf16x8 uf[4][8];
#pragma unroll
    for (int a = 0; a < 4; ++a)
#pragma unroll
        for (int ks = 0; ks < 8; ++ks) uf[a][ks] = *(const bf16x8*)(ub_u + (uo + (unsigned)((16 * a + 2 * ks) * 512)));
    __builtin_amdgcn_sched_barrier(0);
    pg8::f32x4 acc4[4];
#pragma unroll
    for (int a = 0; a < 4; ++a) acc4[a] = (pg8::f32x4){0.f, 0.f, 0.f, 0.f};
#pragma unroll
    for (int ks = 0; ks < 8; ++ks)
#pragma unroll
        for (int a = 0; a < 4; ++a) acc4[a] = MFMA16(af[ks], uf[a][ks], acc4[a]);
    __builtin_amdgcn_sched_barrier(0);
    pg8::f32x4 st = acc4[0];
#pragma unroll
    for (int a = 1; a < 4; ++a) {
        const f32x2 s0 = cmul(l16a, (f32x2){st[0], st[1]}), s1 = cmul(l16b, (f32x2){st[2], st[3]});
        st = (pg8::f32x4){s0.x + acc4[a][0], s0.y + acc4[a][1], s1.x + acc4[a][2], s1.y + acc4[a][3]};
    }
    *(pg8::f32x4*)(S + (((size_t)b * NCH + cb * 16 + n) * NG + g) * 128 + 16 * wave + 4 * kg) = st;
}
constexpr int XIN_OFF = 33280, XIN_PITCH = 272, XIN_VAR = 16 * XIN_PITCH, TB_OFF = XIN_OFF + 4 * XIN_VAR, UL_OFF = 57344, UL_PITCH = 2064;
template <int S> DI void toe_stage(pg8::f32x4 (&acc)[8], const LAS unsigned char* ul, const LAS unsigned char* kt, int wave, int lo, int hi) {
#pragma unroll 1
    for (int ks = lo; ks <= hi; ++ks) {
        const bf16x8 uf0 = *(const LAS bf16x8*)(ul + ks * 64);
        bf16x8 a0[8 - S];
#pragma unroll
        for (int j = S; j < 8; ++j) a0[j - S] = *(const LAS bf16x8*)(kt + (wave + 8 * j - 2 * ks) * 512);
        __builtin_amdgcn_sched_barrier(0);
#pragma unroll
        for (int j = S; j < 8; ++j) acc[j] = MFMA16(a0[j - S], uf0, acc[j]);
    }
}
#ifdef PROBE_SEL
#define QS(sel) do { if (PROBE_SEL == (sel)) tq0 = __builtin_amdgcn_s_memrealtime(); } while (0)
#define QT(sel) do { if (PROBE_SEL == (sel)) tqacc += __builtin_amdgcn_s_memrealtime() - tq0; } while (0)
#else
#define QS(sel) do {} while (0)
#define QT(sel) do {} while (0)
#endif
DI void ssm_out_unit(unsigned long long& tqacc, bool load_ktab, const bf16* U, const bf16* KTAB, const bf16* VTAB, const float* S, const float* LAM, const float* dsk, bf16* YS, int b, int g, int cb, LAS unsigned char* lds, int tid, int wave, int lane) {
    unsigned long long tq0 = 0ull; (void)tq0;
    const int n = lane & 15, kg = lane >> 4;
    QS(51);
    const f32x4 lam4 = *(const f32x4*)(LAM + (g * 64 + lane) * 4); const f32x2 lam = {lam4.x, lam4.y}, l16 = {lam4.z, lam4.w};
    f32x2 sv[16];
    {
        const u32x4* src = (const u32x4*)((const unsigned char*)KTAB + (size_t)g * KTAB_BYTES);
        u32x4 kt4[4], kt5 = {0u, 0u, 0u, 0u}, ut4[4];
        if (load_ktab) {
#pragma unroll
            for (int j = 0; j < 4; ++j) kt4[j] = src[tid + NTHR * j];
            if (tid < 32) kt5 = src[2048 + tid];
        }
#pragma unroll
        for (int j = 0; j < 4; ++j) { const int idx = tid + NTHR * j, cn = idx >> 7, tok = (idx >> 1) & 63, half = idx & 1;
            ut4[j] = *(const u32x4*)(U + ((size_t)b * SEQ + (size_t)(cb * 16 + cn) * 64 + tok) * 512 + g * 16 + 8 * half); }
        if (wave <= cb) { const f32x2* sp = (const f32x2*)(S + (((size_t)b * NCH + wave * 16) * NG + g) * 128) + lane;
#pragma unroll
            for (int j = 0; j < 16; ++j) sv[j] = sp[(size_t)j * (NG * 64)]; }
        __builtin_amdgcn_sched_barrier(0);
        if (load_ktab) {
#pragma unroll
            for (int j = 0; j < 4; ++j) *(LAS u32x4*)(lds + 16 * (tid + NTHR * j)) = kt4[j];
            if (tid < 32) *(LAS u32x4*)(lds + 16 * (2048 + tid)) = kt5;
        }
#pragma unroll
        for (int j = 0; j < 4; ++j) { const int idx = tid + NTHR * j, cn = idx >> 7, tok = (idx >> 1) & 63, half = idx & 1; *(LAS u32x4*)(lds + UL_OFF + cn * UL_PITCH + tok * 32 + half * 16) = ut4[j]; }
    }
    bf16x8 vfr[4][2];
#pragma unroll
    for (int k2 = 0; k2 < 4; ++k2)
#pragma unroll
        for (int jj = 0; jj < 2; ++jj) vfr[k2][jj] = *(const bf16x8*)(VTAB + ((size_t)g * 256 + (wave + 8 * jj) * 16 + n) * 128 + 32 * k2 + 8 * kg);
    __builtin_amdgcn_sched_barrier(0);
    LAS f32x2* TB = (LAS f32x2*)(lds + TB_OFF);
    if (wave < cb) { f32x2 x = {0.f, 0.f};
#pragma unroll
        for (int j = 0; j < 16; ++j) { x = cmul(lam, x); x.x += sv[j].x; x.y += sv[j].y; }
        TB[wave * 64 + lane] = x; }
    __syncthreads();
    if (wave == cb) {
        f32x2 l1k = lam;
#pragma unroll
        for (int j = 0; j < 4; ++j) l1k = cmul(l1k, l1k);
        f32x2 x = {0.f, 0.f};
        for (int w = 0; w < cb; ++w) { const f32x2 t = TB[w * 64 + lane]; x = cmul(l1k, x); x.x += t.x; x.y += t.y; }
#pragma unroll
        for (int j = 0; j < 16; ++j) { f32x2 xa = x;
#pragma unroll
            for (int a = 0; a < 4; ++a) { *(LAS unsigned*)(lds + XIN_OFF + a * XIN_VAR + j * XIN_PITCH + 4 * lane) = cvtpk(xa.x, xa.y); xa = cmul(l16, xa); }
            x = cmul(lam, x); x.x += sv[j].x; x.y += sv[j].y; }
    }
    __syncthreads();
    QT(51); QS(52);
    pg8::f32x4 acc[8];
#pragma unroll
    for (int j = 0; j < 8; ++j) acc[j] = (pg8::f32x4){0.f, 0.f, 0.f, 0.f};
    const LAS unsigned char* ul = lds + UL_OFF + n * UL_PITCH + (kg >> 1) * 32 + (kg & 1) * 16;
    const LAS unsigned char* kt = lds + n * 32 + (kg & 1) * 16 + (1 - (kg >> 1)) * 512;
    { const int hw = wave >> 1;
      toe_stage<0>(acc, ul, kt, wave, 0, hw);            toe_stage<1>(acc, ul, kt, wave, hw + 1, hw + 4);   toe_stage<2>(acc, ul, kt, wave, hw + 5, hw + 8);   toe_stage<3>(acc, ul, kt, wave, hw + 9, hw + 12);
      toe_stage<4>(acc, ul, kt, wave, hw + 13, hw + 16); toe_stage<5>(acc, ul, kt, wave, hw + 17, hw + 20); toe_stage<6>(acc, ul, kt, wave, hw + 21, hw + 24); toe_stage<7>(acc, ul, kt, wave, hw + 25, hw + 28); }
#pragma unroll
    for (int k2 = 0; k2 < 4; ++k2) {
        bf16x8 xf[4];
#pragma unroll
        for (int a = 0; a < 4; ++a) xf[a] = *(const LAS bf16x8*)(lds + XIN_OFF + a * XIN_VAR + n * XIN_PITCH + (32 * k2 + 8 * kg) * 2);
#pragma unroll
        for (int j = 0; j < 8; ++j) acc[j] = MFMA16(vfr[k2][j & 1], xf[j >> 1], acc[j]); }
    QT(52); QS(53);
    const f32x4 dv = *(const f32x4*)(dsk + g * 16 + 4 * kg);
#pragma unroll
    for (int j = 0; j < 8; ++j) { const int t = wave + 8 * j; const size_t off = ((size_t)b * SEQ + (size_t)(cb * 16 + n) * 64 + t) * 512 + g * 16 + 4 * kg;
        const u32x2 uu = *(const LAS u32x2*)(lds + UL_OFF + n * UL_PITCH + t * 32 + kg * 8);
        const float y0 = gelu_tanh(acc[j][0] + dv[0] * bflo(uu.x)), y1 = gelu_tanh(acc[j][1] + dv[1] * bfhi(uu.x)), y2 = gelu_tanh(acc[j][2] + dv[2] * bflo(uu.y)), y3 = gelu_tanh(acc[j][3] + dv[3] * bfhi(uu.y));
        u32x2 w; w.x = cvtpk(y0, y1); w.y = cvtpk(y2, y3); *(u32x2*)(YS + off) = w; }
    asm volatile("s_waitcnt lgkmcnt(0)\n\ts_barrier" ::: "memory");
    QT(53);
}

struct AttnSt { f32x16 o0, o1; float carry; };
DI bool attn_tile(AttnSt& st, const bf16x8 (&kf)[4], const bf16x8 (&vf)[4], const bf16x8 (&qf)[4], bool diag, int n, int hi) {
    f32x16 s;
#pragma unroll
    for (int r = 0; r < 16; ++r) s[r] = 0.f;
#pragma unroll
    for (int ks = 0; ks < 4; ++ks) s = MFMA32(kf[ks], qf[ks], s);
    float sp[16];
#pragma unroll
    for (int r = 0; r < 16; ++r) { const float z = s[r]; const float e = __builtin_amdgcn_exp2f(-fabsf(z)); sp[r] = fmaxf(z, 0.f) + __builtin_amdgcn_logf(1.0f + e);
        if (diag && (16 * (r >> 3) + 8 * hi + (r & 7)) >= n) sp[r] = 0.f; }
    float cum[16]; float c0 = 0.f, c1 = 0.f;
#pragma unroll
    for (int r = 7; r >= 0; --r) { c0 -= sp[r]; cum[r] = c0; c1 -= sp[8 + r]; cum[8 + r] = c1; }
    const float p0 = __shfl_xor(c0, 32), p1 = __shfl_xor(c1, 32);
    const float base1 = st.carry + (hi ? 0.f : p1), base0 = st.carry + c1 + p1 + (hi ? 0.f : p0);
    float w[16];
#pragma unroll
    for (int r = 0; r < 16; ++r) { w[r] = __builtin_amdgcn_exp2f(s[r] + cum[r] + (r < 8 ? base0 : base1));
        if (diag && (16 * (r >> 3) + 8 * hi + (r & 7)) >= n) w[r] = 0.f; }
    st.carry += (c0 + c1) + (p0 + p1);
    const u32x4 pa = {cvtpk(w[0], w[1]), cvtpk(w[2], w[3]), cvtpk(w[4], w[5]), cvtpk(w[6], w[7])}, pb = {cvtpk(w[8], w[9]), cvtpk(w[10], w[11]), cvtpk(w[12], w[13]), cvtpk(w[14], w[15])};
    const bf16x8 pf0 = __builtin_bit_cast(bf16x8, pa), pf1 = __builtin_bit_cast(bf16x8, pb);
    st.o0 = MFMA32(pf0, vf[0], st.o0); st.o0 = MFMA32(pf1, vf[1], st.o0); st.o1 = MFMA32(pf0, vf[2], st.o1); st.o1 = MFMA32(pf1, vf[3], st.o1);
    return __ballot(st.carry >= -152.0f) == 0ull;
}
DI void attn_task(const bf16* Q, const bf16* Kb, const bf16* VT, const bf16* ZA, bf16* Y, int b, int h, int qt, int lane) {
    const int n = lane & 31, hi = lane >> 5;
    const size_t rowbase = (size_t)b * SEQ;
    const bf16* const qb_u = Q + (rowbase + (size_t)qt * 32) * 512 + h * 64;
    const bf16* const kb_u = Kb + rowbase * 512 + h * 64;
    const bf16* const vb_u = VT + (size_t)(b * 8 + h) * 64 * SEQ;
    const bf16* const vb2_u = vb_u + (size_t)32 * SEQ;
    bf16x8 qf[4];
    { const unsigned qo = (unsigned)(n * 512 + 8 * hi);
#pragma unroll
      for (int ks = 0; ks < 4; ++ks) qf[ks] = *(const bf16x8*)(qb_u + qo + 16 * ks); }
    const int pm = (n & ~12) | (((n >> 2) & 1) << 3) | (((n >> 3) & 1) << 2);
    const unsigned ko = (unsigned)(pm * 512 + 8 * hi), vo = (unsigned)(n * SEQ + 8 * hi);
    AttnSt st;
#pragma unroll
    for (int r = 0; r < 16; ++r) { st.o0[r] = 0.f; st.o1[r] = 0.f; }
    st.carry = 0.f;
    bf16x8 kA[4], vA[4], kB[4], vB[4], kC[4], vC[4];
#define ATT_LOAD(KF, VF, ktile) do { const int key0_ = ((ktile) > 0 ? (ktile) : 0) * 32; const bf16* const kt_u = kb_u + (size_t)key0_ * 512; const bf16* const v1_u = vb_u + key0_; const bf16* const v2_u = vb2_u + key0_; \
        _Pragma("unroll") for (int ks = 0; ks < 4; ++ks) KF[ks] = *(const bf16x8*)(kt_u + ko + 16 * ks); \
        VF[0] = *(const bf16x8*)(v1_u + vo); VF[1] = *(const bf16x8*)(v1_u + vo + 16); VF[2] = *(const bf16x8*)(v2_u + vo); VF[3] = *(const bf16x8*)(v2_u + vo + 16); } while (0)
    ATT_LOAD(kA, vA, qt); ATT_LOAD(kB, vB, qt - 1);
    int kt = qt;
    for (;;) {
        ATT_LOAD(kC, vC, kt - 2); __builtin_amdgcn_sched_barrier(0);
        if (attn_tile(st, kA, vA, qf, kt == qt, n, hi) || kt == 0) break; --kt; __builtin_amdgcn_sched_barrier(0);
        ATT_LOAD(kA, vA, kt - 2); __builtin_amdgcn_sched_barrier(0);
        if (attn_tile(st, kB, vB, qf, false, n, hi) || kt == 0) break; --kt; __builtin_amdgcn_sched_barrier(0);
        ATT_LOAD(kB, vB, kt - 2); __builtin_amdgcn_sched_barrier(0);
        if (attn_tile(st, kC, vC, qf, false, n, hi) || kt == 0) break; --kt; __builtin_amdgcn_sched_barrier(0);
    }
#undef ATT_LOAD
    const bf16* const za_u = ZA + (rowbase + (size_t)qt * 32) * 512 + h * 64;
    bf16* const y_u = Y + (rowbase + (size_t)qt * 32) * 512 + h * 64;
    float za0[16], za1[16];
#pragma unroll
    for (int r = 0; r < 16; ++r) { const unsigned off = (unsigned)(((r & 3) + 8 * (r >> 2) + 4 * hi) * 512 + n); za0[r] = bf1(za_u[off]); za1[r] = bf1(za_u[off + 32]); }
    __builtin_amdgcn_sched_barrier(0);
#pragma unroll
    for (int r = 0; r < 16; ++r) { const unsigned off = (unsigned)(((r & 3) + 8 * (r >> 2) + 4 * hi) * 512 + n);
        y_u[off] = (bf16)(cvtpk(st.o0[r] * silu(za0[r]), 0.f) & 0xffffu); y_u[off + 32] = (bf16)(cvtpk(st.o1[r] * silu(za1[r]), 0.f) & 0xffffu); }
}
#define XB_TMO      128
#define XB_XCNT(j)  (256  + 64 * (j))
#define XB_XSUB(j)  (1280 + 64 * (j))
#define XB_XGEN(j)  (2304 + 64 * (j))
#define XB_TOP      3328
#define XB_TOPGEN   3392
#define XCD_BAR_WORDS 3456
#define XB_SPIN_CAP (1u << 18)

__device__ __forceinline__ unsigned xb_ld(unsigned* p)              { return __hip_atomic_load(p, __ATOMIC_RELAXED, __HIP_MEMORY_SCOPE_AGENT); }
__device__ __forceinline__ unsigned xb_add(unsigned* p, unsigned v) { return __hip_atomic_fetch_add(p, v, __ATOMIC_RELAXED, __HIP_MEMORY_SCOPE_AGENT); }
__device__ __forceinline__ unsigned xb_xcc_id() { return (unsigned)__builtin_amdgcn_s_getreg((3 << 11) | 20) & 0xFu; }
#define XB_SPIN(cond, bar) do { unsigned _sp = 0; while (cond) { __builtin_amdgcn_s_sleep(1); \
    if ((++_sp & 255u) == 0u) { if (xb_ld(&(bar)[XB_TMO])) break; if (_sp > XB_SPIN_CAP) { atomicAdd(&(bar)[XB_TMO], 1u); break; } } } } while (0)

struct XcdBarrier {
    unsigned* bar; unsigned x;
    volatile LAS unsigned* st;
};

__device__ __forceinline__ XcdBarrier xcd_barrier_post(unsigned* bar, volatile LAS unsigned* st) {
    XcdBarrier b; b.bar = bar; b.x = xb_xcc_id(); b.st = st;
    if (threadIdx.x == 0) (void)xb_add(&bar[XB_XCNT(b.x)], 1u);
    return b;
}
__device__ __forceinline__ void xcd_barrier_complete(unsigned* bar, unsigned x, unsigned& nloc, unsigned& nx) {
    const unsigned G = gridDim.x * gridDim.y * gridDim.z;
    unsigned sum, cnt, mine, sp = 0u;
    for (;;) {
        sum = 0u; cnt = 0u; mine = 0u;
#pragma unroll
        for (unsigned j = 0; j < 16; ++j) { const unsigned c = xb_ld(&bar[XB_XCNT(j)]); sum += c; cnt += (c > 0u) ? 1u : 0u; mine = (j == x) ? c : mine; }
        if (sum == G) break;
        __builtin_amdgcn_s_sleep(1);
        if ((++sp & 255u) == 0u) { if (xb_ld(&bar[XB_TMO])) break; if (sp > XB_SPIN_CAP) { atomicAdd(&bar[XB_TMO], 1u); break; } }
    }
    nloc = mine > 0u ? mine : 1u; nx = cnt > 0u ? cnt : 1u;
}

__device__ __forceinline__ void xcd_barrier(const XcdBarrier& b) {
    asm volatile("s_waitcnt vmcnt(0)" ::: "memory");
    __syncthreads();
    if (threadIdx.x == 0) {
        unsigned* bar = b.bar;
        __builtin_amdgcn_s_waitcnt(0);
        unsigned nloc = b.st[0], nx = b.st[1];
        if (nloc == 0u) { xcd_barrier_complete(bar, b.x, nloc, nx); b.st[0] = nloc; b.st[1] = nx; }
        const unsigned old = xb_add(&bar[XB_XSUB(b.x)], 1u);
        const unsigned gen = old / nloc;
        if (old + 1u == (gen + 1u) * nloc) {
            __builtin_amdgcn_fence(__ATOMIC_RELEASE, "agent");
            asm volatile("s_waitcnt vmcnt(0)" ::: "memory");
            const unsigned og = xb_add(&bar[XB_TOP], 1u);
            const unsigned tg = og / nx;
            if (og + 1u == (tg + 1u) * nx) xb_add(&bar[XB_TOPGEN], 1u);
            else XB_SPIN(xb_ld(&bar[XB_TOPGEN]) == tg, bar);
            __builtin_amdgcn_fence(__ATOMIC_ACQUIRE, "agent");
            xb_add(&bar[XB_XGEN(b.x)], 1u);
            asm volatile("s_waitcnt vmcnt(0)" ::: "memory");
        } else {
            XB_SPIN(xb_ld(&bar[XB_XGEN(b.x)]) == gen, bar);
            __builtin_amdgcn_fence(__ATOMIC_ACQUIRE, "agent");
            asm volatile("s_waitcnt vmcnt(0)" ::: "memory");
        }
    }
    __syncthreads();
}

__device__ __forceinline__ void xcd_barrier1(const XcdBarrier& b) {
    asm volatile("s_waitcnt vmcnt(0)" ::: "memory");
    __syncthreads();
    if (threadIdx.x == 0) {
        unsigned* bar = b.bar;
        __builtin_amdgcn_s_waitcnt(0);
        unsigned nloc = b.st[0], nx = b.st[1];
        if (nloc == 0u) { xcd_barrier_complete(bar, b.x, nloc, nx); b.st[0] = nloc; b.st[1] = nx; }
        const unsigned k = b.st[2]; b.st[2] = k + 1u;
        const unsigned old = xb_add(&bar[XB_XSUB(b.x)], 1u);
        const unsigned gen = old / nloc;
        if (old + 1u == (gen + 1u) * nloc) {
            __builtin_amdgcn_fence(__ATOMIC_RELEASE, "agent");
            asm volatile("s_waitcnt vmcnt(0)" ::: "memory");
            const unsigned og = xb_add(&bar[XB_TOP], 1u);
            if (og + 1u == (k + 1u) * nx) xb_add(&bar[XB_TOPGEN], 1u);
            else XB_SPIN(xb_ld(&bar[XB_TOPGEN]) == k, bar);
        } else {
            XB_SPIN(xb_ld(&bar[XB_TOPGEN]) == k, bar);
        }
        __builtin_amdgcn_fence(__ATOMIC_ACQUIRE, "agent");
        asm volatile("s_waitcnt vmcnt(0)" ::: "memory");
    }
    __syncthreads();
}
__global__ void __launch_bounds__(NTHR, 2) hybrid_fwd(Args a) {
    extern __shared__ __attribute__((aligned(16))) unsigned char lds_raw[];
    LAS unsigned char* lds = (LAS unsigned char*)lds_raw;
    cg::grid_group grid = cg::this_grid();
#ifdef EXP_INVL2
    if (threadIdx.x == 0) asm volatile("buffer_inv sc0 sc1\n\ts_waitcnt vmcnt(0)" ::: "memory");
    __syncthreads();
#endif
    volatile LAS unsigned* xb_st = (volatile LAS unsigned*)(lds + 131072 + 1024);
    if (threadIdx.x < 3) xb_st[threadIdx.x] = 0u;
    __syncthreads();
    if (blockIdx.x == 0) for (int i = threadIdx.x; i < 4096; i += NTHR) __hip_atomic_store((unsigned*)a.ws + i, 0u, __ATOMIC_RELAXED, __HIP_MEMORY_SCOPE_AGENT);
    XcdBarrier xbar; xbar.bar = (unsigned*)a.ws; xbar.x = 0; xbar.st = xb_st;
    const int tid0 = threadIdx.x, wave = __builtin_amdgcn_readfirstlane(tid0 >> 6);
    const int G = gridDim.x, bx = blockIdx.x;
    const int gw = bx * NWAVES + wave, NGW = G * NWAVES;
    unsigned char* ws = a.ws;
    bf16* const Win = (bf16*)(ws + WS_WIN); bf16* const Wglu = (bf16*)(ws + WS_WGLU); bf16* const Wbs = (bf16*)(ws + WS_WBS); bf16* const Wba = (bf16*)(ws + WS_WBA); bf16* const Wout = (bf16*)(ws + WS_WOUT);
    bf16* const Hb = (bf16*)(ws + WS_H); bf16* const Ub = (bf16*)(ws + WS_U); bf16* const ZSb = (bf16*)(ws + WS_ZS); bf16* const Qb = (bf16*)(ws + WS_Q); bf16* const Kb = (bf16*)(ws + WS_K);
    bf16* const VTb = (bf16*)(ws + WS_VT); bf16* const ZAb = (bf16*)(ws + WS_ZA); bf16* const GSb = (bf16*)(ws + WS_GS); bf16* const GAb = (bf16*)(ws + WS_GA);


    unsigned long long tqa = 0ull;
#ifdef PROBE_SEL
    unsigned long long tacc = 0ull, tbeg = 0ull;
#define PW(sel) do { if (PROBE_SEL == (sel) + 10) tacc += __builtin_amdgcn_s_memrealtime() - tbeg; if (PROBE_SEL == (sel) + 20) tbeg = __builtin_amdgcn_s_memrealtime(); } while (0)
#define PS(sel) do { if (PROBE_SEL == (sel)) tbeg = __builtin_amdgcn_s_memrealtime(); } while (0)
#define PT(sel) do { if (PROBE_SEL == (sel)) tacc += __builtin_amdgcn_s_memrealtime() - tbeg; } while (0)
#define PB(sel) do { if (PROBE_SEL == (sel) || PROBE_SEL == (sel) + 10) tbeg = __builtin_amdgcn_s_memrealtime(); } while (0)
#define PE(sel) do { if (PROBE_SEL == (sel) || PROBE_SEL == (sel) + 20) tacc += __builtin_amdgcn_s_memrealtime() - tbeg; } while (0)
#else
#define PB(sel) do {} while (0)
#define PW(sel) do {} while (0)
#define PS(sel) do {} while (0)
#define PT(sel) do {} while (0)
#define PE(sel) do {} while (0)
#endif
#define GSYNC() xcd_barrier1(xbar)
    PB(0);
    for (int l = 0; l <= DEPTH; ++l) {
        const int lt = l < DEPTH ? l : 0;
        bf16* const KTAB = (bf16*)(ws + WS_KTAB + lt * KTAB_LSTRIDE); bf16* const WTAB = (bf16*)(ws + WS_WTAB + lt * WTAB_LSTRIDE); bf16* const VTAB = (bf16*)(ws + WS_VTAB + lt * VTAB_LSTRIDE);
        float* const Sb = (float*)(ws + WS_S + lt * S_LSTRIDE); float* const LAM = (float*)(ws + WS_LAM + lt * LAM_LSTRIDE);
        int tid = tid0; asm volatile("" : "+v"(tid)); const int lane = tid & 63;
        PB(1);
        {
            const float* xin = (l <= 1) ? a.x : a.out;
        PS(43);
            { f32x4 gpo[4], gpr[4];
#pragma unroll
              for (int j = 0; j < 4; ++j) { gpo[j] = l > 0 ? *((const f32x4*)(a.post_g + (l - 1) * DM) + lane + 64 * j) : (f32x4){0.f, 0.f, 0.f, 0.f};
                                            gpr[j] = l < DEPTH ? *((const f32x4*)(a.pre_g + l * DM) + lane + 64 * j) : (f32x4){0.f, 0.f, 0.f, 0.f}; }
              for (int m = gw; m < M; m += NGW)
                  norm_row(xin + (size_t)m * DM, l > 0 ? GAb + (size_t)m * DM : nullptr, gpo, a.out + (size_t)m * DM, l < DEPTH, gpr, Hb + (size_t)m * DM, lane); }
        PT(43);
            if (l == DEPTH) { PE(1); break; }
            LAS float* scr = (LAS float*)(lds + wave * 16384);
            const float* w_in = a.w_in + (size_t)l * DM * NCOL; const float* w_glu = a.w_glu + (size_t)l * 512 * 1024; const float* w_bs = a.w_bs + (size_t)l * 512 * 1024;
            const float* w_ba = a.w_ba + (size_t)l * 512 * 1024; const float* w_out = a.w_out + (size_t)l * 1024 * 1024;
            constexpr int I_IN = 16 * 160, I_GLU = 8 * 32, I_BR = 8 * 32, I_OUT = 16 * 32, NITEMS = I_IN + I_GLU + 2 * I_BR + I_OUT;
        PS(44);
            for (int it = gw; it < NITEMS; it += NGW) {
                int r = it;
                if (r < I_IN) { const int kb = r / 160, nb = r % 160; transpose_item(w_in, 1024, NCOL, Win, 64 * kb, 32 * nb, 32 * nb, scr, lane); continue; } r -= I_IN;
                if (r < I_GLU) { const int kb = r / 32, nb = r % 32, n0 = 32 * nb; const int bj = n0 >> 9, rem = n0 & 511, pn = rem >> 7, i0 = rem & 127;
                    transpose_item(w_glu, 512, 1024, Wglu, 64 * kb, n0, 256 * pn + 128 * bj + i0, scr, lane); continue; } r -= I_GLU;
                if (r < I_BR) { const int kb = r / 32, nb = r % 32; transpose_item(w_bs, 512, 1024, Wbs, 64 * kb, 32 * nb, 32 * nb, scr, lane); continue; } r -= I_BR;
                if (r < I_BR) { const int kb = r / 32, nb = r % 32; transpose_item(w_ba, 512, 1024, Wba, 64 * kb, 32 * nb, 32 * nb, scr, lane); continue; } r -= I_BR;
                { const int kb = r / 32, nb = r % 32; transpose_item(w_out, 1024, 1024, Wout, 64 * kb, 32 * nb, 32 * nb, scr, lane); }
            }
            __syncthreads();
            PT(44);
            LayerP P{a.a_re + l * NG * NP, a.a_im + l * NG * NP, a.log_dt + l * NG, a.b_re + (size_t)l * NG * NP * 16, a.b_im + (size_t)l * NG * NP * 16, a.c_re + (size_t)l * NG * 16 * NP, a.c_im + (size_t)l * NG * 16 * NP};
        PS(45);
#ifndef NO_TAB
            for (int it = bx; it < NG * 8; it += G) ktab_block(P, KTAB, it >> 3, it & 7, lds, tid);
            for (int idx = bx * NTHR + tid; idx < NG * NP * 16; idx += G * NTHR) wv_item(P, WTAB, VTAB, LAM, idx);
#endif
        PT(45);
        }
        PW(1);
        if (l == 0) { grid.sync(); xbar = xcd_barrier_post((unsigned*)a.ws, xb_st); } else GSYNC();
        PE(1);
        PB(2);
#ifndef NO_A
        { pg8::Gemm g{Hb, Win, M, NCOL, DM}; pg8::StaticOrder S; S.init(M, NCOL, G, bx); EpiProj E{ws};
          pg8::gemm_phase<EpiProj, pg8::StaticOrder, true, true>(lds, g, S, E); }
#endif
        PW(2);
        GSYNC();
        PE(2);
        PB(3);
        PS(41);
#ifndef NO_B1
        for (int u0 = 2 * bx; u0 < 512; u0 += 2 * G) { const int g = u0 >> 4;
            LayerP P{a.a_re + l * NG * NP, a.a_im + l * NG * NP, a.log_dt + l * NG, a.b_re + (size_t)l * NG * NP * 16, a.b_im + (size_t)l * NG * NP * 16, a.c_re + (size_t)l * NG * 16 * NP, a.c_im + (size_t)l * NG * 16 * NP};
            bf16x8 af[8]; f32x2 l16a, l16b;
            make_wfrag(P, g, wave, lane, af, l16a, l16b);
            for (int q = 0; q < 2; ++q) { const int nb = (u0 + q) & 15; ssm_state_unit(Ub, af, l16a, l16b, Sb, nb >> 3, g, nb & 7, wave, lane); } }
#endif
        PT(41);
        PS(42);
#ifndef NO_ATTN
        for (int t = gw; t < 4096; t += NGW) attn_task(Qb, Kb, VTb, ZAb, Qb, t >> 11, (t >> 8) & 7, t & 255, lane);
#endif
        PT(42);
        PW(3);
        GSYNC();
        PE(3);
        PB(4);
#ifndef NO_B3
        for (int u = 2 * bx; u < 512; u += (u & 1) ? 2 * G - 1 : 1) { const int g = u >> 4, nb = u & 15; ssm_out_unit(tqa, (u & 1) == 0, Ub, KTAB, VTAB, Sb, LAM, a.d_skip + l * 512, Hb, nb >> 3, g, nb & 7, lds, tid, wave, lane); }
#endif
        PW(4);
        GSYNC();
        PE(4);
        PB(5);
#ifndef NO_D1
        { pg8::Gemm g{Hb, Wglu, M, 1024, 512}; pg8::StaticOrder S; S.init(M, 1024, G, bx); EpiGlu E{ZSb, a.b_glu + l * 1024};
          pg8::gemm_phase<EpiGlu, pg8::StaticOrder, true, true>(lds, g, S, E); }
#endif
        PW(5);
        GSYNC();
        PE(5);
#ifndef NO_D2
        PB(6);
        { pg8::Gemm g{ZSb, Wbs, M, 1024, 512, Qb, Wba}; pg8::ChainOrder S; S.B.init(M, 1024, G, bx); EpiBranchBoth E{GSb, GAb};
          pg8::gemm_phase<EpiBranchBoth, pg8::ChainOrder, true, true>(lds, g, S, E); }
#endif
        PW(6);
        GSYNC();
        PE(6);
#ifndef NO_D3
        PB(7);
        { pg8::Gemm g{GSb, Wout, M, 1024, 1024}; pg8::StaticOrder S; S.init(M, 1024, G, bx); EpiPlain E{GAb};
          pg8::gemm_phase<EpiPlain, pg8::StaticOrder, true, true>(lds, g, S, E); }
#endif
        PW(7);
        GSYNC();
        PE(7);
    }
    PE(0);
#ifdef PROBE_SEL
    grid.sync();
    if (bx == 0) { LAS unsigned long long* tb = (LAS unsigned long long*)lds; if (tid0 == 0) tb[0] = tacc + tqa; __syncthreads(); const unsigned long long K = tb[0] < 1000000ull ? tb[0] : 1000000ull;
        for (unsigned long long i = tid0; i < K; i += NTHR) a.out[i] += 0.05f; }
#endif
}

extern "C" void kernel_launch(void* const* d_in, const int* in_sizes, int n_in, void* d_out, int out_size, void* d_ws, size_t ws_size, hipStream_t stream) {
    static int grid = 0;
    if (grid == 0) {
        if (n_in != 17 || out_size != M * DM || ws_size < WS_END) { fprintf(stderr, "kernel_launch: unexpected problem shape (n_in %d, out %d, ws %zu)\n", n_in, out_size, ws_size); grid = -1; return; }
        int dev = 0, cus = 0, per_cu = 0;
        (void)hipGetDevice(&dev); (void)hipDeviceGetAttribute(&cus, hipDeviceAttributeMultiprocessorCount, dev);
        if (hipFuncSetAttribute((const void*)hybrid_fwd, hipFuncAttributeMaxDynamicSharedMemorySize, LDS_BYTES) != hipSuccess) { fprintf(stderr, "kernel_launch: hipFuncSetAttribute failed\n"); grid = -1; return; }
        if (hipOccupancyMaxActiveBlocksPerMultiprocessor(&per_cu, (const void*)hybrid_fwd, NTHR, LDS_BYTES) != hipSuccess || per_cu < 1) { fprintf(stderr, "kernel_launch: occupancy query gave %d\n", per_cu); per_cu = 1; }
        (void)hipGetLastError();
        grid = cus * per_cu;
    }
    if (grid < 0) return;
    Args a{};
    a.x = (const float*)d_in[0]; a.pre_g = (const float*)d_in[1]; a.post_g = (const float*)d_in[2]; a.w_in = (const float*)d_in[3]; a.a_re = (const float*)d_in[4]; a.a_im = (const float*)d_in[5];
    a.log_dt = (const float*)d_in[6]; a.b_re = (const float*)d_in[7]; a.b_im = (const float*)d_in[8]; a.c_re = (const float*)d_in[9]; a.c_im = (const float*)d_in[10]; a.d_skip = (const float*)d_in[11];
    a.w_glu = (const float*)d_in[12]; a.b_glu = (const float*)d_in[13]; a.w_bs = (const float*)d_in[14]; a.w_ba = (const float*)d_in[15]; a.w_out = (const float*)d_in[16];
    a.out = (float*)d_out; a.ws = (unsigned char*)d_ws;
    void* args[] = {&a};
    const hipError_t e = hipLaunchCooperativeKernel((const void*)hybrid_fwd, dim3(grid), dim3(NTHR), args, LDS_BYTES, stream);
    if (e != hipSuccess) fprintf(stderr, "kernel_launch: cooperative launch failed: %s (grid %d)\n", hipGetErrorString(e), grid);
}
```
